# Optimizing an MI355X kernel written in HIP

```python
import jax, jax.numpy as jnp
from jax import lax
import numpy as np

D_MODEL = 4096
BATCH = 4
SEQ = 4096
DEPTH = 2

N_META = 16
HEAD_DIM = 64
NORM_EPS = 1e-5
NEG_INF = -1e30

RWKV_WIDTH = 3 * D_MODEL // 8
RWKV_HEADS = RWKV_WIDTH // HEAD_DIM
RWKV_DECAY_RANK = 64
RWKV_ICLR_RANK = 64
RWKV_GATE_RANK = 128
RWKV_GN_EPS = 64e-5

SWA_WIDTH = 3 * D_MODEL // 8
SWA_Q_HEADS = SWA_WIDTH // HEAD_DIM
SWA_KV_HEADS = 3
SWA_GROUP = SWA_Q_HEADS // SWA_KV_HEADS
SWA_KV_WIDTH = SWA_KV_HEADS * HEAD_DIM
SWA_WINDOW = 128
SWA_BLOCK = 128
ROPE_THETA = 500000.0
ROPE_DIMS = HEAD_DIM // 4

HGRN_WIDTH = D_MODEL - RWKV_WIDTH - SWA_WIDTH
HGRN_HEAD_DIM = 128
HGRN_HEADS = HGRN_WIDTH // HGRN_HEAD_DIM
HGRN_CHUNK = 64

PAD_FRONT = SWA_BLOCK - N_META

PEER_HEADS = 8
PEER_N_KEYS = 128
PEER_N_EXPERTS = PEER_N_KEYS ** 2
PEER_QUERY_DIM = 256
PEER_HALF_DIM = PEER_QUERY_DIM // 2
PEER_TOPK = 16
PEER_TOKEN_BLOCK = 128

RWKV_SIZES = (RWKV_WIDTH, RWKV_WIDTH, RWKV_WIDTH, RWKV_DECAY_RANK, RWKV_ICLR_RANK, RWKV_GATE_RANK)
RWKV_COLS = sum(RWKV_SIZES)
SWA_SIZES = (SWA_WIDTH, SWA_KV_WIDTH, SWA_KV_WIDTH)
HGRN_SIZES = (HGRN_WIDTH, HGRN_WIDTH, HGRN_WIDTH, HGRN_WIDTH)
IN_COLS = RWKV_COLS + sum(SWA_SIZES) + sum(HGRN_SIZES)

kernel_name = 'hybrid_rwkv7_swa_hgrn2_peer'


def _offsets(sizes):
    offs, acc = [], 0
    for s in sizes[:-1]:
        acc += s
        offs.append(acc)
    return offs


def rms_norm(x, gain, eps=NORM_EPS):
    xf = x.astype(jnp.float32)
    y = xf * lax.rsqrt(jnp.mean(xf * xf, axis=-1, keepdims=True) + eps)
    return (y * gain.astype(jnp.float32)).astype(x.dtype)


def rope_tables(length):
    pos = jnp.arange(length, dtype=jnp.float32)
    inv_freq = ROPE_THETA ** (-jnp.arange(0, ROPE_DIMS, 2, dtype=jnp.float32) / ROPE_DIMS)
    ang = pos[:, None] * inv_freq[None, :]
    return jnp.cos(ang), jnp.sin(ang)


def apply_partial_rope(x, cos, sin):
    half = ROPE_DIMS // 2
    shape = (1, x.shape[1]) + (1,) * (x.ndim - 3) + (half,)
    c = cos.reshape(shape).astype(x.dtype)
    s = sin.reshape(shape).astype(x.dtype)
    x1 = x[..., :half]
    x2 = x[..., half:ROPE_DIMS]
    return jnp.concatenate([x1 * c - x2 * s, x2 * c + x1 * s, x[..., ROPE_DIMS:]], axis=-1)


def rwkv7_time_mix(pa, mu, w0, w2, a0, a2, g2, k_k, k_a, r_k, lnx_w, lnx_b):
    B, L, _ = pa.shape
    H, N = RWKV_HEADS, HEAD_DIM
    f32 = jnp.float32
    prev = jnp.pad(pa, ((0, 0), (1, 0), (0, 0)))[:, :-1]
    pa = pa + (prev - pa) * mu
    r, k, v, wl, al, gl = jnp.split(pa, _offsets(RWKV_SIZES), axis=-1)
    w = -jax.nn.softplus(-(w0 + jnp.tanh(wl) @ w2).astype(f32)) - 0.5
    decay = jnp.exp(-jnp.exp(w))
    a = jax.nn.sigmoid(a0 + al @ a2)
    g = jax.nn.sigmoid(gl) @ g2
    kk = (k * k_k).reshape(B, L, H, N).astype(f32)
    kk = kk / jnp.maximum(jnp.sqrt(jnp.sum(kk * kk, axis=-1, keepdims=True)), 1e-12)
    k = k * (1.0 + (a - 1.0) * k_a)

    def heads(t):
        return t.reshape(B, L, H, N).astype(f32).transpose(1, 0, 2, 3)

    xs = (heads(r), heads(k), heads(v), kk.transpose(1, 0, 2, 3), heads(a), heads(decay))

    def step(S, inp):
        r_t, k_t, v_t, kk_t, a_t, w_t = inp
        sa = jnp.einsum('bhvk,bhk->bhv', S, -kk_t)
        S = (S * w_t[:, :, None, :] + sa[..., None] * (kk_t * a_t)[:, :, None, :]
             + v_t[..., None] * k_t[:, :, None, :])
        return S, jnp.einsum('bhvk,bhk->bhv', S, r_t)

    _, y = lax.scan(step, jnp.zeros((B, H, N, N), f32), xs)
    y = y.transpose(1, 0, 2, 3)
    mean = jnp.mean(y, axis=-1, keepdims=True)
    var = jnp.mean(jnp.square(y - mean), axis=-1, keepdims=True)
    y = ((y - mean) * lax.rsqrt(var + RWKV_GN_EPS)).reshape(B, L, H * N)
    y = y * lnx_w.astype(f32) + lnx_b.astype(f32)
    rh = r.reshape(B, L, H, N).astype(f32)
    kh = k.reshape(B, L, H, N).astype(f32)
    vh = v.reshape(B, L, H, N).astype(f32)
    bonus = jnp.sum(rh * kh * r_k.reshape(H, N).astype(f32), axis=-1, keepdims=True) * vh
    y = (y + bonus.reshape(B, L, H * N)) * g.astype(f32)
    return y.astype(pa.dtype)


def swa_sink_attention(q, k, v, sinks, cos, sin):
    B, L, _ = q.shape
    Hk, G, Dh, Bk = SWA_KV_HEADS, SWA_GROUP, HEAD_DIM, SWA_BLOCK
    q = apply_partial_rope(q.reshape(B, L, Hk, G, Dh), cos, sin)
    k = apply_partial_rope(k.reshape(B, L, Hk, Dh), cos, sin)
    v = v.reshape(B, L, Hk, Dh)
    Lp = L + PAD_FRONT
    nb = Lp // Bk
    qb = jnp.pad(q, ((0, 0), (PAD_FRONT, 0), (0, 0), (0, 0), (0, 0))).reshape(B, nb, Bk, Hk, G, Dh)

    def band(t):
        tb = jnp.pad(t, ((0, 0), (PAD_FRONT, 0), (0, 0), (0, 0))).reshape(B, nb, Bk, Hk, Dh)
        prev = jnp.pad(tb, ((0, 0), (1, 0), (0, 0), (0, 0), (0, 0)))[:, :-1]
        return jnp.concatenate([prev, tb], axis=2)

    k_band, v_band = band(k), band(v)
    k_meta, v_meta = k[:, :N_META], v[:, :N_META]
    s_meta = jnp.einsum('bnqhgd,bmhd->bnhgqm', qb, k_meta)
    s_band = jnp.einsum('bnqhgd,bnkhd->bnhgqk', qb, k_band)
    s = jnp.concatenate([s_meta, s_band], axis=-1).astype(jnp.float32) * (HEAD_DIM ** -0.5)
    blk = jnp.arange(nb)[:, None]
    qpos = blk * Bk + jnp.arange(Bk)[None, :] - PAD_FRONT
    kpos = (blk - 1) * Bk + jnp.arange(2 * Bk)[None, :] - PAD_FRONT
    rel = qpos[:, :, None] - kpos[:, None, :]
    band_ok = (kpos[:, None, :] >= N_META) & (rel >= 0) & (rel < SWA_WINDOW)
    meta_ok = jnp.arange(N_META)[None, None, :] <= qpos[:, :, None]
    mask = jnp.concatenate([meta_ok, band_ok], axis=-1)
    s = jnp.where(mask[None, :, None, None], s, NEG_INF)
    sink = jnp.broadcast_to(sinks.reshape(1, 1, Hk, G, 1, 1).astype(jnp.float32), s.shape[:-1] + (1,))
    p = jax.nn.softmax(jnp.concatenate([s, sink], axis=-1), axis=-1).astype(v.dtype)
    out = (jnp.einsum('bnhgqm,bmhd->bnqhgd', p[..., :N_META], v_meta)
           + jnp.einsum('bnhgqk,bnkhd->bnqhgd', p[..., N_META:-1], v_band))
    return out.reshape(B, Lp, SWA_WIDTH)[:, PAD_FRONT:]


def hgrn2_mix(q, f_raw, i, g, lower_bound, norm_gain):
    B, L, _ = q.shape
    H, Dk, C = HGRN_HEADS, HGRN_HEAD_DIM, HGRN_CHUNK
    f32 = jnp.float32
    f = lower_bound.astype(f32) + (1.0 - lower_bound.astype(f32)) * jax.nn.sigmoid(f_raw.astype(f32))
    log_f = jnp.log(f)
    k = 1.0 - f
    pad = ((0, 0), (PAD_FRONT, 0), (0, 0))
    qp, kp, ip, lp = [jnp.pad(t.astype(f32), pad) for t in (q, k, i, log_f)]
    Lp = L + PAD_FRONT
    nc = Lp // C

    def chunks(t):
        return t.reshape(B, nc, C, H, Dk).transpose(1, 0, 3, 2, 4)

    tri = jnp.tril(jnp.ones((C, C), dtype=bool))

    def step(S, inp):
        qc, kc, ic, lc = inp
        Gc = jnp.cumsum(lc, axis=2)
        diff = Gc[:, :, :, None, :] - Gc[:, :, None, :, :]
        dec = jnp.exp(jnp.where(tri[:, :, None], diff, NEG_INF))
        attn = jnp.einsum('bhtk,bhtsk,bhsk->bhts', qc, dec, kc)
        o = attn @ ic + jnp.einsum('bhtk,bhkv->bhtv', qc * jnp.exp(Gc), S)
        g_last = Gc[:, :, -1:, :]
        S = (S * jnp.exp(g_last[:, :, 0, :])[..., None]
             + jnp.einsum('bhsk,bhsv->bhkv', kc * jnp.exp(g_last - Gc), ic))
        return S, o

    _, o = lax.scan(step, jnp.zeros((B, H, Dk, Dk), f32), (chunks(qp), chunks(kp), chunks(ip), chunks(lp)))
    o = o.transpose(1, 0, 3, 2, 4).reshape(B, Lp, H, Dk)[:, PAD_FRONT:]
    o = rms_norm(o, norm_gain.reshape(H, Dk)).reshape(B, L, HGRN_WIDTH)
    return (o * jax.nn.silu(g.astype(f32))).astype(q.dtype)


def peer_ffn(h, w_q, sub_keys, u_tab, v_tab):
    B, L, D = h.shape
    T = B * L
    t = h.reshape(T, D)
    q = (t @ w_q).reshape(T, PEER_HEADS, 2, PEER_HALF_DIM)
    s = jnp.einsum('thcd,hcnd->thcn', q, sub_keys).astype(jnp.float32)
    s1, i1 = lax.top_k(s[:, :, 0], PEER_TOPK)
    s2, i2 = lax.top_k(s[:, :, 1], PEER_TOPK)
    cand = (s1[..., :, None] + s2[..., None, :]).reshape(T, PEER_HEADS, PEER_TOPK * PEER_TOPK)
    cand_ids = (i1[..., :, None] * PEER_N_KEYS + i2[..., None, :]).reshape(T, PEER_HEADS, PEER_TOPK * PEER_TOPK)
    best, pos = lax.top_k(cand, PEER_TOPK)
    experts = jnp.take_along_axis(cand_ids, pos, axis=-1).reshape(T, PEER_HEADS * PEER_TOPK)
    gates = jax.nn.softmax(best, axis=-1).reshape(T, PEER_HEADS * PEER_TOPK)
    T_pad = -(-T // PEER_TOKEN_BLOCK) * PEER_TOKEN_BLOCK
    n_blk = T_pad // PEER_TOKEN_BLOCK
    extra = T_pad - T
    tb = jnp.pad(t, ((0, extra), (0, 0))).reshape(n_blk, PEER_TOKEN_BLOCK, D)
    eb = jnp.pad(experts, ((0, extra), (0, 0))).reshape(n_blk, PEER_TOKEN_BLOCK, -1)
    gb = jnp.pad(gates, ((0, extra), (0, 0))).reshape(n_blk, PEER_TOKEN_BLOCK, -1)

    def block(args):
        x_b, e_b, g_b = args
        hid = jax.nn.gelu(jnp.einsum('ted,td->te', u_tab[e_b], x_b).astype(jnp.float32), approximate=False)
        return jnp.einsum('te,ted->td', (g_b * hid).astype(v_tab.dtype), v_tab[e_b])

    out = lax.map(block, (tb, eb, gb))
    return out.reshape(T_pad, D)[:T].reshape(B, L, D).astype(h.dtype)


def setup_inputs(seed: int = 0) -> dict:
    key = jax.random.key(seed)
    ks = jax.random.split(key, 25)
    D = D_MODEL
    nrm = jax.random.normal
    f32 = jnp.float32
    return {
        'x': nrm(ks[0], (BATCH, SEQ, D), f32),
        'meta_tokens': nrm(ks[1], (N_META, D), f32),
        'norm_mix': 1.0 + 0.02 * nrm(ks[2], (DEPTH, D), f32),
        'norm_ffn': 1.0 + 0.02 * nrm(ks[3], (DEPTH, D), f32),
        'norm_final': 1.0 + 0.02 * nrm(ks[4], (D,), f32),
        'w_in': nrm(ks[5], (DEPTH, D, IN_COLS), f32) * D ** -0.5,
        'w_out': nrm(ks[6], (DEPTH, D, D), f32) * (0.5 * D ** -0.5),
        'rwkv_mu': jax.random.uniform(ks[7], (DEPTH, RWKV_COLS), f32),
        'rwkv_w0': -2.0 + 0.5 * nrm(ks[8], (DEPTH, RWKV_WIDTH), f32),
        'rwkv_w2': 0.1 * nrm(ks[9], (DEPTH, RWKV_DECAY_RANK, RWKV_WIDTH), f32),
        'rwkv_a0': 0.1 * nrm(ks[10], (DEPTH, RWKV_WIDTH), f32),
        'rwkv_a2': 0.1 * nrm(ks[11], (DEPTH, RWKV_ICLR_RANK, RWKV_WIDTH), f32),
        'rwkv_g2': nrm(ks[12], (DEPTH, RWKV_GATE_RANK, RWKV_WIDTH), f32) * RWKV_GATE_RANK ** -0.5,
        'rwkv_k_k': 0.85 + 0.02 * nrm(ks[13], (DEPTH, RWKV_WIDTH), f32),
        'rwkv_k_a': 1.0 + 0.02 * nrm(ks[14], (DEPTH, RWKV_WIDTH), f32),
        'rwkv_r_k': 0.1 * nrm(ks[15], (DEPTH, RWKV_WIDTH), f32),
        'rwkv_lnx_w': 1.0 + 0.02 * nrm(ks[16], (DEPTH, RWKV_WIDTH), f32),
        'rwkv_lnx_b': 0.01 * nrm(ks[17], (DEPTH, RWKV_WIDTH), f32),
        'swa_sinks': 0.5 * nrm(ks[18], (DEPTH, SWA_Q_HEADS), f32),
        'hgrn_lb': 0.5 * nrm(ks[19], (DEPTH, HGRN_WIDTH), f32),
        'hgrn_norm': 1.0 + 0.02 * nrm(ks[20], (DEPTH, HGRN_WIDTH), f32),
        'peer_wq': nrm(ks[21], (DEPTH, D, PEER_HEADS * PEER_QUERY_DIM), f32) * D ** -0.5,
        'peer_keys': nrm(ks[22], (DEPTH, PEER_HEADS, 2, PEER_N_KEYS, PEER_HALF_DIM), f32) * PEER_HALF_DIM ** -0.5,
        'peer_u': nrm(ks[23], (DEPTH, PEER_N_EXPERTS, D), f32) * D ** -0.5,
        'peer_v': 0.1 * nrm(ks[24], (DEPTH, PEER_N_EXPERTS, D), f32),
    }


def reference(x, meta_tokens, norm_mix, norm_ffn, norm_final, w_in, w_out,
              rwkv_mu, rwkv_w0, rwkv_w2, rwkv_a0, rwkv_a2, rwkv_g2, rwkv_k_k, rwkv_k_a, rwkv_r_k,
              rwkv_lnx_w, rwkv_lnx_b, swa_sinks, hgrn_lb, hgrn_norm,
              peer_wq, peer_keys, peer_u, peer_v):
    B = x.shape[0]
    meta = jnp.broadcast_to(meta_tokens.astype(x.dtype)[None], (B, N_META, D_MODEL))
    h = jnp.concatenate([meta, x], axis=1)
    L = h.shape[1]
    cos, sin = rope_tables(L)
    lb_all = jnp.cumsum(jax.nn.softmax(hgrn_lb.astype(jnp.float32), axis=0), axis=0)
    lb_all = lb_all - lb_all[0:1]
    for l in range(DEPTH):
        z = rms_norm(h, norm_mix[l])
        proj = z @ w_in[l]
        pa = proj[..., :RWKV_COLS]
        sq, sk, sv, hq, hf, hi, hg = jnp.split(proj[..., RWKV_COLS:], _offsets(SWA_SIZES + HGRN_SIZES), axis=-1)
        y_a = rwkv7_time_mix(pa, rwkv_mu[l], rwkv_w0[l], rwkv_w2[l], rwkv_a0[l], rwkv_a2[l], rwkv_g2[l],
                             rwkv_k_k[l], rwkv_k_a[l], rwkv_r_k[l], rwkv_lnx_w[l], rwkv_lnx_b[l])
        y_b = swa_sink_attention(sq, sk, sv, swa_sinks[l], cos, sin)
        y_c = hgrn2_mix(hq, hf, hi, hg, lb_all[l], hgrn_norm[l])
        mixed = jnp.concatenate([y_a.astype(h.dtype), y_b.astype(h.dtype), y_c.astype(h.dtype)], axis=-1)
        h = h + mixed @ w_out[l]
        h = h + peer_ffn(rms_norm(h, norm_ffn[l]), peer_wq[l], peer_keys[l], peer_u[l], peer_v[l])
    out = rms_norm(h, norm_final)[:, N_META:]
    return out
```

```cpp
#include <hip/hip_runtime.h>
#include <cstdio>
#include <cstdint>
#ifndef MK_ONE_LAUNCH
#define MK_ONE_LAUNCH 0
#endif
namespace pg8 {
#define PG8_LAS __attribute__((address_space(3)))
typedef unsigned short bf16_t;
typedef short bf16x8 __attribute__((ext_vector_type(8)));
typedef float f32x4 __attribute__((ext_vector_type(4)));
typedef unsigned u32x4 __attribute__((ext_vector_type(4)));
constexpr int BM = 256, BK = 64, HALF = 128, HTB = HALF * BK * 2  , STAGE_BYTES = 8 * HTB, NXCD = 8, WGM = 8;

__host__ __device__ __forceinline__ int lds_byte(int r, int c) { const int st = (r >> 4) * 2 + (c >> 5), rr = r & 15, cc = c & 31, ob = rr * 64 + cc * 2; return st * 1024 + (ob ^ (((ob >> 9) & 1) << 5)); }
__host__ __device__ __forceinline__ void stage_rc(int b, int& R, int& C) { const int st = b / 1024, sb = b % 1024, swz = sb ^ (((sb >> 9) & 1) << 5); R = (st >> 1) * 16 + swz / 64; C = (st & 1) * 32 + (swz % 64) / 2; }
__host__ __device__ __forceinline__ int perm32(int rho) { const int n = rho >> 4, i = rho & 15; return 8 * (i >> 2) + 4 * n + (i & 3); }

struct Unit { int pm, pn; };
struct Gemm { const bf16_t* A; const bf16_t* Bt; int M, N, K; };

struct StaticOrder {
    int nM, nN, nwg, G, c;
    __host__ __device__ void init(int M, int N, int G_, int c_) { nM = M / BM; nN = N / BM; nwg = nM * nN; G = G_; c = c_; }
    __host__ __device__ bool next(int i, Unit& u) const {
        const long L = (long)i * G + c; if (L >= nwg) return false;
        int wgid = (int)L; { const int q = nwg / NXCD, r = nwg % NXCD, xcd = wgid % NXCD, off = wgid / NXCD; wgid = (xcd < r ? xcd * (q + 1) : r * (q + 1) + (xcd - r) * q) + off; }
        const int nig = WGM * nN, gid = wgid / nig, fm = gid * WGM, gsz = (nM - fm) < WGM ? (nM - fm) : WGM;
        u.pm = fm + ((wgid % nig) % gsz); u.pn = (wgid % nig) / gsz; return true;
    }
    __device__ __forceinline__ void a_ready(const Unit&) const {}
    __device__ __forceinline__ void done(const Unit&) const {}
};
__device__ __forceinline__ unsigned cvt_pk_bf16(float lo, float hi) { unsigned r; asm volatile("v_cvt_pk_bf16_f32 %0, %1, %2" : "=v"(r) : "v"(lo), "v"(hi)); return r; }
typedef float f32x2 __attribute__((ext_vector_type(2)));
__device__ __forceinline__ f32x2 gelu_pk(f32x2 v) {
    const f32x2 av = __builtin_elementwise_abs(v), d = av * 0.2316418882f + 1.0f;
    f32x2 t; t.x = __builtin_amdgcn_rcpf(d.x); t.y = __builtin_amdgcn_rcpf(d.y);
    f32x2 q = t * 0.5307027145f + (-0.7265760135f); q = q * t + 0.7107068705f; q = q * t + (-0.142248368f); q = q * t + 0.127414796f; q = q * t;
    const f32x2 s = (v * v) * (-0.72134752044f);
    f32x2 e; e.x = __builtin_amdgcn_exp2f(s.x); e.y = __builtin_amdgcn_exp2f(s.y);
    const f32x2 m = v * (q * e), r = v - m;
    f32x2 o; o.x = v.x < 0.f ? m.x : r.x; o.y = v.y < 0.f ? m.y : r.y; return o;
}
struct EpiF32 {
    static constexpr bool PERM = false, AFTER_DRAIN = false;
    float* C; int ldc; const float* bias;
    __device__ __forceinline__ void operator()(const f32x4 (&acc)[2][2][4][2], const Unit& u, int wr, int wc, int fr, int fq) const {
        const int row0 = u.pm * BM + wr * 64 + fr, col0 = u.pn * BM + wc * 32 + 4 * fq;
        f32x4 bv[2][2];
#pragma unroll
        for (int bj = 0; bj < 2; ++bj)
#pragma unroll
            for (int n = 0; n < 2; ++n) bv[bj][n] = bias ? *(const f32x4*)(bias + col0 + bj * HALF + n * 16) : (f32x4){0.f, 0.f, 0.f, 0.f};
#pragma unroll
        for (int ai = 0; ai < 2; ++ai)
#pragma unroll
            for (int m = 0; m < 4; ++m) { float* rowp = C + (size_t)(row0 + ai * HALF + m * 16) * ldc + col0;
#pragma unroll
                for (int bj = 0; bj < 2; ++bj)
#pragma unroll
                    for (int n = 0; n < 2; ++n) *(f32x4*)(rowp + bj * HALF + n * 16) = acc[ai][bj][m][n] + bv[bj][n]; }
    }
};
template <int ACT  > struct EpiBf16 {
    static constexpr bool PERM = true, AFTER_DRAIN = false;
    bf16_t* O; int ldc; const float* bias; int split_cols; size_t split_stride;
    __device__ __forceinline__ void operator()(const f32x4 (&acc)[2][2][4][2], const Unit& u, int wr, int wc, int fr, int fq) const {
        const int row0 = u.pm * BM + wr * 64 + fr; int colt = u.pn * BM; bf16_t* base = O;
        if (split_cols) { const int t = colt / split_cols; base += (size_t)t * split_stride; colt -= t * split_cols; }
        const int col0 = colt + wc * 32 + 8 * fq, bcol0 = u.pn * BM + wc * 32 + 8 * fq;
        f32x4 bv[2][2];
#pragma unroll
        for (int bj = 0; bj < 2; ++bj)
#pragma unroll
            for (int n = 0; n < 2; ++n) bv[bj][n] = bias ? *(const f32x4*)(bias + bcol0 + bj * HALF + 4 * n) : (f32x4){0.f, 0.f, 0.f, 0.f};
#pragma unroll
        for (int ai = 0; ai < 2; ++ai)
#pragma unroll
            for (int m = 0; m < 4; ++m) { bf16_t* rowp = base + (size_t)(row0 + ai * HALF + m * 16) * ldc + col0;
#pragma unroll
                for (int bj = 0; bj < 2; ++bj) { f32x4 v0 = acc[ai][bj][m][0] + bv[bj][0], v1 = acc[ai][bj][m][1] + bv[bj][1];
                    if (ACT == 1) { f32x2 a = gelu_pk((f32x2){v0[0], v0[1]}), b = gelu_pk((f32x2){v0[2], v0[3]}), c = gelu_pk((f32x2){v1[0], v1[1]}), d = gelu_pk((f32x2){v1[2], v1[3]});
                        v0 = (f32x4){a.x, a.y, b.x, b.y}; v1 = (f32x4){c.x, c.y, d.x, d.y}; }
                    if (ACT == 2) {
#pragma unroll
                        for (int j = 0; j < 4; ++j) { v0[j] = 0.5f * v0[j] * (1.0f + erff(v0[j] * 0.70710678f)); v1[j] = 0.5f * v1[j] * (1.0f + erff(v1[j] * 0.70710678f)); } }
                    u32x4 w; w.x = cvt_pk_bf16(v0[0], v0[1]); w.y = cvt_pk_bf16(v0[2], v0[3]); w.z = cvt_pk_bf16(v1[0], v1[1]); w.w = cvt_pk_bf16(v1[2], v1[3]);
                    *(u32x4*)(rowp + bj * HALF) = w; } }
    }
};
template <class Epi, class Sched, bool STAMP = false>
__device__ __forceinline__ void gemm_phase(PG8_LAS unsigned char* lds, const Gemm g, const Sched& S, const Epi& E, unsigned long long* stamps) {
    int tid_ = threadIdx.x; asm volatile("" : "+v"(tid_));
    const int tid = tid_, wid = __builtin_amdgcn_readfirstlane(tid >> 6), lane = tid & 63, wr = wid >> 2, wc = wid & 3, fr = lane & 15, fq = lane >> 4;
    const int K = g.K, nt = K / BK;
    int ts_lo = 0, ts_hi = 0, nts = 0; const unsigned long long rt_entry = STAMP ? (unsigned long long)wall_clock64() : 0ull;
#define PG8_STAMP() do { if (STAMP && wid == 0 && nts < 64) { const unsigned long long _c = (unsigned long long)clock64(); \
        ts_lo = (lane == nts) ? (int)(unsigned)_c : ts_lo; ts_hi = (lane == nts) ? (int)(unsigned)(_c >> 32) : ts_hi; ++nts; } } while (0)
    PG8_STAMP();
    unsigned voffA[2], voffB[2];
#pragma unroll
    for (int i = 0; i < 2; ++i) { int R, C; stage_rc(tid * 16 + i * 8192, R, C); const int Rb = Epi::PERM ? ((R & ~31) + perm32(R & 31)) : R;
        voffA[i] = (unsigned)(R * K + C) * 2u; voffB[i] = (unsigned)(Rb * K + C) * 2u; }
    const size_t kstep = (size_t)(BK * 2);
    const size_t hstep = (size_t)HALF * K * 2;
    const size_t tstep = 2 * hstep;
    const unsigned ldsw = (unsigned)wid * 1024u;
    const int aoff = lds_byte(wr * 64 + fr, fq * 8), boff = lds_byte(wc * 32 + fr, fq * 8);
#define PG8_SA(b, h) (((b) * 2 + (h)) * HTB)
#define PG8_SB(b, h) ((4 + (b) * 2 + (h)) * HTB)
#define PG8_STAGE(bufoff, gbase, voff) do { _Pragma("unroll") for (int _i = 0; _i < 2; ++_i) \
        __builtin_amdgcn_global_load_lds((const unsigned*)((const char*)(gbase) + (voff)[_i]), (PG8_LAS unsigned*)(lds + (bufoff) + ldsw + _i * 8192), 16, 0, 0); } while (0)
#define PG8_LDA(dst, b, h) do { _Pragma("unroll") for (int m = 0; m < 4; ++m) _Pragma("unroll") for (int k = 0; k < 2; ++k) dst[m][k] = *(const PG8_LAS bf16x8*)(lds + PG8_SA(b, h) + aoff + m * 2048 + k * 1024); } while (0)
#define PG8_LDB(dst, b, h) do { _Pragma("unroll") for (int n = 0; n < 2; ++n) _Pragma("unroll") for (int k = 0; k < 2; ++k) dst[n][k] = *(const PG8_LAS bf16x8*)(lds + PG8_SB(b, h) + boff + n * 2048 + k * 1024); } while (0)
#define PG8_MMA(ai, bj, At, Bt) do { __builtin_amdgcn_s_setprio(1); _Pragma("unroll") for (int m = 0; m < 4; ++m) _Pragma("unroll") for (int n = 0; n < 2; ++n) _Pragma("unroll") for (int k = 0; k < 2; ++k) \
        acc[ai][bj][m][n] = __builtin_amdgcn_mfma_f32_16x16x32_bf16(Bt[n][k], At[m][k], acc[ai][bj][m][n], 0, 0, 0); __builtin_amdgcn_s_setprio(0); } while (0)
#define PG8_WAIT_V(n) asm volatile("s_waitcnt vmcnt(" #n ")" ::: "memory")
#define PG8_WAIT_L(n) asm volatile("s_waitcnt lgkmcnt(" #n ")" ::: "memory")
#define PG8_BAR __builtin_amdgcn_s_barrier()
#define PG8_SCHED __builtin_amdgcn_sched_barrier(0)
    Unit cur, nxt; int ui = 0;
    if (!S.next(0, cur)) return;
    f32x4 acc[2][2][4][2];
#pragma unroll
    for (int a = 0; a < 2; ++a)
#pragma unroll
        for (int b = 0; b < 2; ++b)
#pragma unroll
            for (int m = 0; m < 4; ++m)
#pragma unroll
                for (int n = 0; n < 2; ++n) acc[a][b][m][n] = (f32x4){0.f, 0.f, 0.f, 0.f};
    bf16x8 At[4][2], B0[2][2], B1[2][2];
    const char* cA = (const char*)g.A + (size_t)cur.pm * tstep; const char* cB = (const char*)g.Bt + (size_t)cur.pn * tstep;
    S.a_ready(cur);
    PG8_STAGE(PG8_SB(0, 0), cB, voffB); PG8_STAGE(PG8_SA(0, 0), cA, voffA); PG8_STAGE(PG8_SB(0, 1), cB + hstep, voffB); PG8_STAGE(PG8_SA(0, 1), cA + hstep, voffA);
    if (wr == 1) PG8_BAR;
    PG8_WAIT_V(4); PG8_BAR;
    PG8_STAGE(PG8_SB(1, 0), cB + kstep, voffB); PG8_STAGE(PG8_SA(1, 0), cA + kstep, voffA); PG8_STAGE(PG8_SB(1, 1), cB + hstep + kstep, voffB);
    PG8_WAIT_V(6); PG8_BAR;
    PG8_STAMP();
    for (;;) {
        const bool has_next = S.next(ui + 1, nxt);
        const char* nA = has_next ? (const char*)g.A + (size_t)nxt.pm * tstep : cA; const char* nB = has_next ? (const char*)g.Bt + (size_t)nxt.pn * tstep : cB;
        for (int t = 0; t < nt; t += 2) {
            const bool last = (t == nt - 2);
            const char* a1 = cA + (size_t)(t + 1) * kstep;
            const char* a2 = last ? nA : cA + (size_t)(t + 2) * kstep; const char* b2 = last ? nB : cB + (size_t)(t + 2) * kstep;
            const char* a3 = a2 + kstep; const char* b3 = b2 + kstep;
            if (last && has_next) S.a_ready(nxt);
            PG8_LDB(B0, 0, 0); PG8_SCHED; PG8_LDA(At, 0, 0); PG8_STAGE(PG8_SA(1, 1), a1 + hstep, voffA);
            PG8_WAIT_L(8); PG8_BAR; PG8_WAIT_L(0); PG8_MMA(0, 0, At, B0); PG8_BAR; PG8_SCHED;
            PG8_LDB(B1, 0, 1); PG8_STAGE(PG8_SB(0, 0), b2, voffB);
            PG8_BAR; PG8_WAIT_L(0); PG8_MMA(0, 1, At, B1); PG8_BAR;
            PG8_LDA(At, 0, 1); PG8_STAGE(PG8_SA(0, 0), a2, voffA);
            PG8_BAR; PG8_WAIT_L(0); PG8_MMA(1, 0, At, B0); PG8_BAR; PG8_SCHED;
            PG8_STAGE(PG8_SB(0, 1), b2 + hstep, voffB);
            PG8_WAIT_V(6); PG8_BAR; PG8_MMA(1, 1, At, B1); PG8_BAR;
            PG8_LDB(B0, 1, 0); PG8_SCHED; PG8_LDA(At, 1, 0); PG8_STAGE(PG8_SA(0, 1), a2 + hstep, voffA);
            PG8_WAIT_L(8); PG8_BAR; PG8_WAIT_L(0); PG8_MMA(0, 0, At, B0); PG8_BAR; PG8_SCHED;
            PG8_LDB(B1, 1, 1); PG8_STAGE(PG8_SB(1, 0), b3, voffB);
            PG8_BAR; PG8_WAIT_L(0); PG8_MMA(0, 1, At, B1); PG8_BAR;
            PG8_LDA(At, 1, 1); PG8_STAGE(PG8_SA(1, 0), a3, voffA);
            PG8_BAR; PG8_WAIT_L(0); PG8_MMA(1, 0, At, B0); PG8_BAR; PG8_SCHED;
            PG8_STAGE(PG8_SB(1, 1), b3 + hstep, voffB);
            PG8_WAIT_V(6); PG8_BAR; PG8_MMA(1, 1, At, B1); PG8_BAR;
        }
        PG8_STAMP();
        if constexpr (!Epi::AFTER_DRAIN) { E(acc, cur, wr, wc, fr, fq); S.done(cur); }
        PG8_STAMP();
        if (!has_next) break;
#pragma unroll
        for (int a = 0; a < 2; ++a)
#pragma unroll
            for (int b = 0; b < 2; ++b)
#pragma unroll
                for (int m = 0; m < 4; ++m)
#pragma unroll
                    for (int n = 0; n < 2; ++n) acc[a][b][m][n] = (f32x4){0.f, 0.f, 0.f, 0.f};
        cur = nxt; cA = nA; cB = nB; ++ui;
    }
    PG8_WAIT_V(0);
    if (wr == 0) PG8_BAR;
    PG8_BAR;
    if constexpr (Epi::AFTER_DRAIN) { E.fused(acc, cur, wr, wc, fr, fq, lds, wid, lane); S.done(cur); }
    PG8_STAMP();
    if (STAMP && wid == 0) { stamps[lane] = lane < nts ? (((unsigned long long)(unsigned)ts_hi << 32) | (unsigned)ts_lo) : 0ull;
        if (lane == 62) stamps[62] = rt_entry; if (lane == 63) stamps[63] = (unsigned long long)wall_clock64(); }
#undef PG8_STAMP
#undef PG8_SA
#undef PG8_SB
#undef PG8_STAGE
#undef PG8_LDA
#undef PG8_LDB
#undef PG8_MMA
#undef PG8_WAIT_V
#undef PG8_WAIT_L
#undef PG8_BAR
#undef PG8_SCHED
}
}
#define XB_TMO      128
#define XB_XCNT(j)  (256  + 64 * (j))
#define XB_XSUB(j)  (1280 + 64 * (j))
#define XB_XGEN(j)  (2304 + 64 * (j))
#define XB_TOP      3328
#define XB_TOPGEN   3392
#define XCD_BAR_WORDS 3456
#define XB_SPIN_CAP (1u << 23)
#define LAS __attribute__((address_space(3)))

__device__ __forceinline__ unsigned xb_ld(unsigned* p)              { return __hip_atomic_load(p, __ATOMIC_RELAXED, __HIP_MEMORY_SCOPE_AGENT); }
__device__ __forceinline__ unsigned xb_add(unsigned* p, unsigned v) { return __hip_atomic_fetch_add(p, v, __ATOMIC_RELAXED, __HIP_MEMORY_SCOPE_AGENT); }
__device__ __forceinline__ unsigned xb_xcc_id() { return (unsigned)__builtin_amdgcn_s_getreg((3 << 11) | 20) & 0xFu; }
#define XB_SPIN(cond, bar) do { unsigned _sp = 0; while (cond) { __builtin_amdgcn_s_sleep(1); \
    if ((++_sp & 255u) == 0u) { if (xb_ld(&(bar)[XB_TMO])) break; if (_sp > XB_SPIN_CAP) { atomicAdd(&(bar)[XB_TMO], 1u); break; } } } } while (0)

struct XcdBarrier {
    unsigned* bar; unsigned x;
    volatile LAS unsigned* st;
};

__device__ __forceinline__ XcdBarrier xcd_barrier_post(unsigned* bar, volatile LAS unsigned* st) {
    XcdBarrier b; b.bar = bar; b.x = xb_xcc_id(); b.st = st;
    if (threadIdx.x == 0) (void)xb_add(&bar[XB_XCNT(b.x)], 1u);
    return b;
}
__device__ __forceinline__ void xcd_barrier_complete(unsigned* bar, unsigned x, unsigned& nloc, unsigned& nx) {
    const unsigned G = gridDim.x * gridDim.y * gridDim.z;
    unsigned sum, cnt, mine, sp = 0u;
    for (;;) {
        sum = 0u; cnt = 0u; mine = 0u;
#pragma unroll
        for (unsigned j = 0; j < 16; ++j) { const unsigned c = xb_ld(&bar[XB_XCNT(j)]); sum += c; cnt += (c > 0u) ? 1u : 0u; mine = (j == x) ? c : mine; }
        if (sum == G) break;
        __builtin_amdgcn_s_sleep(1);
        if ((++sp & 255u) == 0u) { if (xb_ld(&bar[XB_TMO])) break; if (sp > XB_SPIN_CAP) { atomicAdd(&bar[XB_TMO], 1u); break; } }
    }
    nloc = mine > 0u ? mine : 1u; nx = cnt > 0u ? cnt : 1u;
}

__device__ __forceinline__ void xcd_barrier(const XcdBarrier& b) {
    asm volatile("s_waitcnt vmcnt(0)" ::: "memory");
    __syncthreads();
    if (threadIdx.x == 0) {
        unsigned* bar = b.bar;
        __builtin_amdgcn_s_waitcnt(0);
        unsigned nloc = b.st[0], nx = b.st[1];
        if (nloc == 0u) { xcd_barrier_complete(bar, b.x, nloc, nx); b.st[0] = nloc; b.st[1] = nx; }
        const unsigned old = xb_add(&bar[XB_XSUB(b.x)], 1u);
        const unsigned gen = old / nloc;
        if (old + 1u == (gen + 1u) * nloc) {
            __builtin_amdgcn_fence(__ATOMIC_RELEASE, "agent");
            asm volatile("s_waitcnt vmcnt(0)" ::: "memory");
            const unsigned og = xb_add(&bar[XB_TOP], 1u);
            const unsigned tg = og / nx;
            if (og + 1u == (tg + 1u) * nx) xb_add(&bar[XB_TOPGEN], 1u);
            else XB_SPIN(xb_ld(&bar[XB_TOPGEN]) == tg, bar);
            __builtin_amdgcn_fence(__ATOMIC_ACQUIRE, "agent");
            xb_add(&bar[XB_XGEN(b.x)], 1u);
            asm volatile("s_waitcnt vmcnt(0)" ::: "memory");
        } else {
            XB_SPIN(xb_ld(&bar[XB_XGEN(b.x)]) == gen, bar);
            __builtin_amdgcn_fence(__ATOMIC_ACQUIRE, "agent");
            asm volatile("s_waitcnt vmcnt(0)" ::: "memory");
        }
    }
    __syncthreads();
}
#define GAS __attribute__((address_space(1)))
typedef unsigned short bf16;
typedef float f32x4 __attribute__((ext_vector_type(4)));
typedef unsigned u32x4 __attribute__((ext_vector_type(4)));
typedef unsigned u32x2 __attribute__((ext_vector_type(2)));
typedef LAS float lfloat;
typedef LAS f32x4 lf32x4;

constexpr int DM = 4096, NB = 4, NMETA = 16, LT = 4112, TT = NB * LT  , MP = 16640  ;
constexpr int PN = 11008;
constexpr int C_R = 0, C_K = 1536, C_V = 3072, C_WL = 4608, C_SQ = 4864, C_SK = 6400, C_SV = 6592, C_HQ = 6912, C_HF = 7936, C_HI = 8960, C_HG = 9984;
constexpr int NE = 16384;
constexpr int NHR = 24;
constexpr int NCH = 66;

constexpr size_t MiB = 1ull << 20;
constexpr size_t WS_CTL = 0, WS_WIN = 2 * MiB, WS_WO = 88 * MiB, WS_WS = 120 * MiB, WS_U = 136 * MiB, WS_VT = 264 * MiB, WS_H = 392 * MiB, WS_Z = 652 * MiB, WS_R = 782 * MiB;
constexpr size_t WS_PROJ = WS_R, WS_RA = 1132 * MiB, WS_RG = 1711 * MiB, WS_RY = 1760 * MiB, WS_HDS = 1809 * MiB, WS_HQG = 1875 * MiB, WS_HAT = 1908 * MiB, WS_HED = 1941 * MiB, WS_END = 1943 * MiB;
constexpr size_t WS_GG = WS_R, WS_SC = 1302 * MiB;
static_assert(WS_WIN + (size_t)PN * DM * 2 <= WS_WO && WS_WO + (size_t)DM * DM * 2 <= WS_WS && WS_WS + (size_t)2048 * DM * 2 <= WS_U && WS_U + (size_t)NE * DM * 2 <= WS_VT && WS_VT + (size_t)NE * DM * 2 <= WS_H, "ws map 1");
static_assert(WS_H + (size_t)MP * DM * 4 <= WS_Z && WS_Z + (size_t)MP * DM * 2 <= WS_R, "ws map 2");
static_assert(WS_PROJ + (size_t)MP * PN * 2 <= WS_RA && WS_RA + (size_t)96 * LT * 384 * 4 <= WS_RG && WS_RG + (size_t)TT * 1536 * 2 <= WS_RY && WS_RY + (size_t)TT * 1536 * 2 <= WS_HDS, "ws map 3");
static_assert(WS_HDS + (size_t)32 * NCH * 16384 * 2 <= WS_HQG && WS_HQG + (size_t)32 * NCH * 8192 * 2 <= WS_HAT && WS_HAT + (size_t)32 * NCH * 4096 * 4 <= WS_HED && WS_HED + (size_t)32 * NCH * 128 * 4 <= WS_END, "ws map 4");
static_assert(WS_GG + (size_t)MP * NE * 2 <= WS_SC && WS_SC + (size_t)MP * 2048 * 4 <= WS_END, "ws map 5");

constexpr int LDS_BYTES = 147456;
constexpr int LDS_MISC = 143360;
constexpr int CW_BAR = 4096;
constexpr size_t CTL_ZERO_BYTES = 64 * 1024;

__device__ __forceinline__ float bf2f(unsigned b) { return __uint_as_float(b << 16); }
__device__ __forceinline__ unsigned f2bf(float f) { unsigned u = __float_as_uint(f); return (u + 0x7fffu + ((u >> 16) & 1u)) >> 16; }
__device__ __forceinline__ unsigned pk2(float lo, float hi) { return f2bf(lo) | (f2bf(hi) << 16); }
#define LDS_WAIT() asm volatile("s_waitcnt lgkmcnt(0)" ::: "memory")
__device__ __forceinline__ float wave_sum(float v) {
#pragma unroll
    for (int o = 1; o < 64; o <<= 1) v += __shfl_xor(v, o);
    return v;
}
template <int CTRL> __device__ __forceinline__ float dpp_mov(float x) { return __int_as_float(__builtin_amdgcn_update_dpp(0, __float_as_int(x), CTRL, 0xF, 0xF, false)); }
__device__ __forceinline__ float rowsum16(float x) {
    x += dpp_mov<0xB1>(x); x += dpp_mov<0x4E>(x); x += dpp_mov<0x141>(x); x += dpp_mov<0x140>(x); return x;
}
__device__ __forceinline__ void rope_sc(float pos, int j, float& sn, float& cs) {
    const float ang = pos * exp2f(-(float)j * 2.3664460711655218f);
    float rev = ang * 0.15915494309189535f; rev = rev - floorf(rev);
    sn = __builtin_amdgcn_sinf(rev); cs = __builtin_amdgcn_cosf(rev);
}
__device__ __forceinline__ float sigmoidf_(float x) { return 1.0f / (1.0f + __expf(-x)); }

__device__ __forceinline__ int ltid() { int t = threadIdx.x; asm volatile("" : "+v"(t)); return t; }
struct Ctx {
    const float* in[25];
    float* out;
    unsigned char* ws;
    int ph_lo, ph_hi;
};
typedef const __attribute__((address_space(4))) Ctx CtxK;
__device__ __forceinline__ Ctx load_ctx() { CtxK* p = (CtxK*)__builtin_amdgcn_kernarg_segment_ptr(); asm volatile("" : "+s"(p)); Ctx c;
#pragma unroll
    for (int i = 0; i < 25; ++i) c.in[i] = p->in[i];
    c.out = p->out; c.ws = p->ws; c.ph_lo = p->ph_lo; c.ph_hi = p->ph_hi; return c; }
#define LOAD_CTX() const Ctx C = load_ctx()
__device__ __forceinline__ int uni_launder(int x) { int y = __builtin_amdgcn_readfirstlane(x); asm volatile("" : "+s"(y)); return y; }
#define UNI(x) uni_launder(x)
#define UNI_LDS(p) ((LAS unsigned char*)(uintptr_t)(unsigned)__builtin_amdgcn_readfirstlane((int)(unsigned)(uintptr_t)(p)))
enum { I_X = 0, I_META, I_NMIX, I_NFFN, I_NFIN, I_WIN, I_WOUT, I_MU, I_W0, I_W2, I_A0, I_A2, I_G2, I_KK, I_KA, I_RK, I_LNW, I_LNB, I_SINK, I_HLB, I_HNORM, I_WQ, I_KEYS, I_PU, I_PV };

namespace pg8 {
struct EpiResF32 {
    static constexpr bool PERM = false, AFTER_DRAIN = false;
    float* H; int ldc;
    __device__ __forceinline__ void operator()(const f32x4 (&acc)[2][2][4][2], const Unit& u, int wr, int wc, int fr, int fq) const {
        const int row0 = u.pm * BM + wr * 64 + fr, col0 = u.pn * BM + wc * 32 + 4 * fq;
#pragma unroll
        for (int ai = 0; ai < 2; ++ai)
#pragma unroll
            for (int m = 0; m < 4; ++m) { float* rowp = H + (size_t)(row0 + ai * HALF + m * 16) * ldc + col0;
                f32x4 old[2][2];
#pragma unroll
                for (int bj = 0; bj < 2; ++bj)
#pragma unroll
                    for (int n = 0; n < 2; ++n) old[bj][n] = *(const f32x4*)(rowp + bj * HALF + n * 16);
#pragma unroll
                for (int bj = 0; bj < 2; ++bj)
#pragma unroll
                    for (int n = 0; n < 2; ++n) *(f32x4*)(rowp + bj * HALF + n * 16) = old[bj][n] + acc[ai][bj][m][n]; }
    }
};
struct EpiGate {
    static constexpr bool PERM = true, AFTER_DRAIN = false;
    bf16_t* G; int ldc;
    __device__ __forceinline__ void operator()(const f32x4 (&acc)[2][2][4][2], const Unit& u, int wr, int wc, int fr, int fq) const {
        const int row0 = u.pm * BM + wr * 64 + fr, col0 = u.pn * BM + wc * 32 + 8 * fq;
#pragma unroll
        for (int ai = 0; ai < 2; ++ai)
#pragma unroll
            for (int m = 0; m < 4; ++m) { bf16_t* rowp = G + (size_t)(row0 + ai * HALF + m * 16) * ldc + col0;
                u32x4 gv[2];
#pragma unroll
                for (int bj = 0; bj < 2; ++bj) gv[bj] = *(const u32x4*)(rowp + bj * HALF);
#pragma unroll
                for (int bj = 0; bj < 2; ++bj) {
                    const u32x4 g = gv[bj];
                    if ((g.x | g.y | g.z | g.w) != 0u) {
                        const f32x4 v0 = acc[ai][bj][m][0], v1 = acc[ai][bj][m][1];
                        const f32x2 a = gelu_pk((f32x2){v0[0], v0[1]}), b = gelu_pk((f32x2){v0[2], v0[3]}), c = gelu_pk((f32x2){v1[0], v1[1]}), d = gelu_pk((f32x2){v1[2], v1[3]});
                        u32x4 w;
                        w.x = cvt_pk_bf16(a.x * __uint_as_float(g.x << 16), a.y * __uint_as_float(g.x & 0xffff0000u));
                        w.y = cvt_pk_bf16(b.x * __uint_as_float(g.y << 16), b.y * __uint_as_float(g.y & 0xffff0000u));
                        w.z = cvt_pk_bf16(c.x * __uint_as_float(g.z << 16), c.y * __uint_as_float(g.z & 0xffff0000u));
                        w.w = cvt_pk_bf16(d.x * __uint_as_float(g.w << 16), d.y * __uint_as_float(g.w & 0xffff0000u));
                        *(u32x4*)(rowp + bj * HALF) = w;
                    }
                } }
    }
};
}

__device__ __forceinline__ void transpose_item(const float* W, int N, bf16* WT, int Kp, int k0, int n0, int dst_row0, lfloat* scr, int lane) {
#pragma unroll 8
    for (int i = 0; i < 32; ++i) { const int kk = 2 * i + (lane >> 5); scr[kk * 33 + (lane & 31)] = W[(size_t)(k0 + kk) * N + n0 + (lane & 31)]; }
    LDS_WAIT();
    const int c = lane & 7;
#pragma unroll
    for (int j = 0; j < 4; ++j) { const int n = (lane >> 3) + 8 * j; const lfloat* s = scr + (8 * c) * 33 + n;
        u32x4 o; o.x = pk2(s[0 * 33], s[1 * 33]); o.y = pk2(s[2 * 33], s[3 * 33]); o.z = pk2(s[4 * 33], s[5 * 33]); o.w = pk2(s[6 * 33], s[7 * 33]);
        *(u32x4*)(WT + (size_t)(dst_row0 + n) * Kp + k0 + 8 * c) = o; }
    LDS_WAIT();
}
__device__ __forceinline__ void norm_row(const float* src, const float* gain, bf16* dst, float* hdst, int lane) {
    const f32x4* xr = (const f32x4*)src + lane;
    f32x4 v[16]; float ss = 0.f;
#pragma unroll
    for (int j = 0; j < 16; ++j) { v[j] = xr[64 * j]; ss += (v[j].x * v[j].x + v[j].y * v[j].y) + (v[j].z * v[j].z + v[j].w * v[j].w); }
    ss = wave_sum(ss);
    const float r = rsqrtf(ss * (1.0f / 4096.0f) + 1e-5f);
    const f32x4* gr = (const f32x4*)gain + lane;
    u32x2* o8 = (u32x2*)dst + lane;
#pragma unroll
    for (int j = 0; j < 16; ++j) { const f32x4 g = gr[64 * j]; u32x2 o; o.x = pk2(v[j].x * r * g.x, v[j].y * r * g.y); o.y = pk2(v[j].z * r * g.z, v[j].w * r * g.w); o8[64 * j] = o; }
    if (hdst) { f32x4* hr = (f32x4*)hdst + lane;
#pragma unroll
        for (int j = 0; j < 16; ++j) hr[64 * j] = v[j]; }
}

__device__ __forceinline__ void phase_conv_norm(int l_, LAS unsigned char* lds_) {
    LOAD_CTX(); const int l = UNI(l_); LAS unsigned char* lds = UNI_LDS(lds_);
    const int tid = ltid(), lane = tid & 63, wave = tid >> 6;
    const int gw = blockIdx.x * 8 + wave, NGW = gridDim.x * 8;
    unsigned char* ws = C.ws;
    bf16* WinT = (bf16*)(ws + WS_WIN); bf16* WoT = (bf16*)(ws + WS_WO); bf16* WsT = (bf16*)(ws + WS_WS); bf16* Ub = (bf16*)(ws + WS_U); bf16* VT = (bf16*)(ws + WS_VT);
    float* H = (float*)(ws + WS_H); bf16* Z = (bf16*)(ws + WS_Z);
    const float* w_in = C.in[I_WIN] + (size_t)l * DM * 10880;
    const float* w_out = C.in[I_WOUT] + (size_t)l * DM * DM;
    const float* wq = C.in[I_WQ] + (size_t)l * DM * 2048;
    const float* keys = C.in[I_KEYS] + (size_t)l * 16 * 128 * 128;
    const float* pu = C.in[I_PU] + (size_t)l * NE * DM;
    const float* pv = C.in[I_PV] + (size_t)l * NE * DM;
    lfloat* scr = (lfloat*)(lds + wave * 16384);
    constexpr int I_WIN_N = 64 * 340, I_WO_N = 64 * 128, I_VT_N = 256 * 128, I_U_N = 8192, I_ZW_N = 64, I_NORM_N = TT, I_ZP_N = MP - TT;
    constexpr int NITEMS = I_WIN_N + I_WO_N + I_VT_N + I_U_N + I_ZW_N + I_NORM_N + I_ZP_N;
    for (int it = gw; it < NITEMS; it += NGW) {
        int r = it;
        if (r < I_NORM_N) {
            const int m = r, b = m / LT, t = m - b * LT;
            if (l == 0) { const float* src = (t < NMETA) ? C.in[I_META] + (size_t)t * DM : C.in[I_X] + ((size_t)b * 4096 + (t - NMETA)) * DM;
                norm_row(src, C.in[I_NMIX], Z + (size_t)m * DM, H + (size_t)m * DM, lane); }
            else norm_row(H + (size_t)m * DM, C.in[I_NMIX] + DM, Z + (size_t)m * DM, nullptr, lane);
            continue; }
        r -= I_NORM_N;
        if (r < I_ZP_N) {
            const int m = TT + r; u32x4* z = (u32x4*)(Z + (size_t)m * DM) + lane;
#pragma unroll
            for (int j = 0; j < 8; ++j) z[64 * j] = (u32x4){0u, 0u, 0u, 0u};
            if (l == 0) { f32x4* hz = (f32x4*)(H + (size_t)m * DM) + lane;
#pragma unroll
                for (int j = 0; j < 16; ++j) hz[64 * j] = (f32x4){0.f, 0.f, 0.f, 0.f}; }
            continue; }
        r -= I_ZP_N;
        if (r < I_WIN_N) { const int kb = r / 340, nb = r % 340, n0 = 32 * nb; transpose_item(w_in, 10880, WinT, DM, 64 * kb, n0, n0 < 6784 ? n0 : n0 + 128, scr, lane); continue; }
        r -= I_WIN_N;
        if (r < I_WO_N) { const int kb = r / 128, nb = r % 128; transpose_item(w_out, DM, WoT, DM, 64 * kb, 32 * nb, 32 * nb, scr, lane); continue; }
        r -= I_WO_N;
        if (r < I_VT_N) { const int kb = r / 128, nb = r % 128; transpose_item(pv, DM, VT, NE, 64 * kb, 32 * nb, 32 * nb, scr, lane); continue; }
        r -= I_VT_N;
        if (r < I_U_N) {
            const size_t e0 = (size_t)r * 8192;
#pragma unroll 4
            for (int j = 0; j < 16; ++j) { const size_t e = e0 + (size_t)(j * 64 + lane) * 8; const f32x4 a = *(const f32x4*)(pu + e), b2 = *(const f32x4*)(pu + e + 4);
                u32x4 o; o.x = pk2(a.x, a.y); o.y = pk2(a.z, a.w); o.z = pk2(b2.x, b2.y); o.w = pk2(b2.z, b2.w); *(u32x4*)(Ub + e) = o; }
            continue; }
        r -= I_U_N;
        {
            u32x4* z = (u32x4*)(WinT + (size_t)6784 * DM) + (size_t)r * 1024 + lane;
#pragma unroll
            for (int j = 0; j < 16; ++j) z[64 * j] = (u32x4){0u, 0u, 0u, 0u};
        }
    }
    __syncthreads();
    lfloat* keyS = (lfloat*)lds;
    lfloat* wqS = keyS + 128 * 129;
    for (int u = blockIdx.x; u < 1024; u += gridDim.x) {
        const int hc = u >> 6, k0 = (u & 63) * 64;
        for (int e = tid; e < 128 * 128; e += 512) { const int n = e >> 7, d = e & 127; keyS[n * 129 + d] = keys[(size_t)hc * 16384 + e]; }
        for (int e = tid; e < 64 * 128; e += 512) { const int k = e >> 7, d = e & 127; wqS[k * 129 + d] = wq[(size_t)(k0 + k) * 2048 + hc * 128 + d]; }
        __syncthreads();
        const int kq = tid & 63, ng = tid >> 6;
        float acc[16];
#pragma unroll
        for (int i = 0; i < 16; ++i) acc[i] = 0.f;
        for (int d = 0; d < 128; ++d) { const float wv = wqS[kq * 129 + d];
#pragma unroll
            for (int i = 0; i < 16; ++i) acc[i] += wv * keyS[(16 * ng + i) * 129 + d]; }
#pragma unroll
        for (int i = 0; i < 16; ++i) WsT[(size_t)(hc * 128 + 16 * ng + i) * DM + k0 + kq] = (bf16)f2bf(acc[i]);
        __syncthreads();
    }
}

__device__ __forceinline__ void swa_unit(int l_, int u_, LAS unsigned char* lds_) {
    LOAD_CTX(); const int l = UNI(l_), u = UNI(u_); LAS unsigned char* lds = UNI_LDS(lds_);
    const int tid = ltid();
    const int qt = u % 65, hk = (u / 65) % 3, b = u / 195;
    const int t0 = qt * 64;
    const int lo = (t0 - 127 > 16) ? t0 - 127 : 16;
    const int hi = (t0 + 63 < LT - 1) ? t0 + 63 : LT - 1;
    const int nrows = 16 + (hi - lo + 1);
    const bf16* proj = (const bf16*)(C.ws + WS_PROJ);
    bf16* mixed = (bf16*)(C.ws + WS_Z);
    lfloat* Ks = (lfloat*)lds; lfloat* Vs = Ks + 207 * 68;
    __syncthreads();
    for (int e = tid; e < nrows * 64; e += 512) {
        const int row = e >> 6, d = e & 63;
        const int ut = row < 16 ? row : lo + (row - 16);
        const bf16* pr = proj + (size_t)(b * LT + ut) * PN;
        float kv = bf2f(pr[C_SK + hk * 64 + d]);
        const float vv = bf2f(pr[C_SV + hk * 64 + d]);
        if (d < 16) { const float other = bf2f(pr[C_SK + hk * 64 + (d ^ 8)]);
            float sn, cs; rope_sc((float)ut, d & 7, sn, cs);
            kv = d < 8 ? kv * cs - other * sn : kv * cs + other * sn; }
        Ks[row * 68 + d] = kv; Vs[row * 68 + d] = vv;
    }
    __syncthreads();
    const int qi = tid >> 3, g = tid & 7, t = t0 + qi, hq = hk * 8 + g;
    const bool valid = t < LT;
    float q[64];
    {
        const bf16* qp = proj + (size_t)(b * LT + (valid ? t : 0)) * PN + C_SQ + hq * 64;
#pragma unroll
        for (int i = 0; i < 8; ++i) { const u32x4 w = *(const u32x4*)(qp + 8 * i);
            q[8 * i + 0] = bf2f(w.x & 0xffffu); q[8 * i + 1] = bf2f(w.x >> 16); q[8 * i + 2] = bf2f(w.y & 0xffffu); q[8 * i + 3] = bf2f(w.y >> 16);
            q[8 * i + 4] = bf2f(w.z & 0xffffu); q[8 * i + 5] = bf2f(w.z >> 16); q[8 * i + 6] = bf2f(w.w & 0xffffu); q[8 * i + 7] = bf2f(w.w >> 16); }
#pragma unroll
        for (int j = 0; j < 8; ++j) { float sn, cs; rope_sc((float)t, j, sn, cs);
            const float x1 = q[j], x2 = q[j + 8]; q[j] = x1 * cs - x2 * sn; q[j + 8] = x2 * cs + x1 * sn; }
#pragma unroll
        for (int i = 0; i < 64; ++i) q[i] *= 0.125f;
    }
    float m_run = C.in[I_SINK][l * 24 + hq], l_run = 1.0f;
    float o[64];
#pragma unroll
    for (int i = 0; i < 64; ++i) o[i] = 0.f;
    for (int n = 0; n < 144; ++n) {
        int row; bool ok;
        if (n < 16) { row = n; ok = valid && (n <= t); }
        else { const int uu = t - 127 + (n - 16); ok = valid && (uu >= 16); row = 16 + (uu - lo); }
        if (!ok) row = 0;
        const lf32x4* kr = (const lf32x4*)(Ks + row * 68);
        float s0 = 0.f, s1 = 0.f, s2 = 0.f, s3 = 0.f;
#pragma unroll
        for (int i = 0; i < 16; ++i) { const f32x4 kv = kr[i]; s0 += q[4 * i] * kv.x; s1 += q[4 * i + 1] * kv.y; s2 += q[4 * i + 2] * kv.z; s3 += q[4 * i + 3] * kv.w; }
        const float s = (s0 + s1) + (s2 + s3);
        if (ok) {
            if (s > m_run) { const float sc = __expf(m_run - s); l_run *= sc;
#pragma unroll
                for (int i = 0; i < 64; ++i) o[i] *= sc;
                m_run = s; }
            const float p = __expf(s - m_run); l_run += p;
            const lf32x4* vr = (const lf32x4*)(Vs + row * 68);
#pragma unroll
            for (int i = 0; i < 16; ++i) { const f32x4 vv = vr[i]; o[4 * i] += p * vv.x; o[4 * i + 1] += p * vv.y; o[4 * i + 2] += p * vv.z; o[4 * i + 3] += p * vv.w; }
        }
    }
    if (valid) {
        const float inv = 1.0f / l_run;
        bf16* op = mixed + (size_t)(b * LT + t) * DM + 1536 + hq * 64;
#pragma unroll
        for (int i = 0; i < 8; ++i) { u32x4 w; w.x = pk2(o[8 * i] * inv, o[8 * i + 1] * inv); w.y = pk2(o[8 * i + 2] * inv, o[8 * i + 3] * inv); w.z = pk2(o[8 * i + 4] * inv, o[8 * i + 5] * inv); w.w = pk2(o[8 * i + 6] * inv, o[8 * i + 7] * inv);
            *(u32x4*)(op + 8 * i) = w; }
    }
}

__device__ __forceinline__ void hgrn_local_unit(int l_, int u_, LAS unsigned char* lds_) {
    LOAD_CTX(); const int l = UNI(l_), u = UNI(u_); LAS unsigned char* lds = UNI_LDS(lds_);
    const int tid = ltid(), lane = tid & 63, wave = tid >> 6;
    const int bh = u / 65, c = u % 65 + 1, b = bh >> 3, h = bh & 7;
    const bf16* proj = (const bf16*)(C.ws + WS_PROJ);
    bf16* HDS = (bf16*)(C.ws + WS_HDS); bf16* HQG = (bf16*)(C.ws + WS_HQG); float* HAT = (float*)(C.ws + WS_HAT); float* HED = (float*)(C.ws + WS_HED);
    lfloat* qs = (lfloat*)lds; lfloat* kvs = qs + 8192; lfloat* is = qs + 16384; lfloat* Gs = qs + 24576; lfloat* segtot = qs + 32768;
    const int k = tid & 127, seg = tid >> 7;
    float lb = 0.f;
    if (l == 1) { const float a0 = C.in[I_HLB][h * 128 + k], a1 = C.in[I_HLB][1024 + h * 128 + k]; lb = 1.0f / (1.0f + __expf(a0 - a1)); }
    __syncthreads();
    float gl[16]; float run = 0.f;
#pragma unroll
    for (int r = 0; r < 16; ++r) {
        const int tl = 16 * seg + r, t = 64 * c + tl - 112;
        float qv = 0.f, kv = 0.f, iv = 0.f, lf = 0.f;
        if (t >= 0 && t < LT) { const bf16* pr = proj + (size_t)(b * LT + t) * PN + h * 128 + k;
            qv = bf2f(pr[C_HQ]); const float fr = bf2f(pr[C_HF]); iv = bf2f(pr[C_HI]);
            const float f = lb + (1.0f - lb) * sigmoidf_(fr); lf = __logf(f); kv = 1.0f - f; }
        run += lf; gl[r] = run;
        qs[tl * 128 + k] = qv; kvs[tl * 128 + k] = kv; is[tl * 128 + k] = iv;
    }
    segtot[seg * 128 + k] = run;
    __syncthreads();
    float off = 0.f;
    for (int s2 = 0; s2 < seg; ++s2) off += segtot[s2 * 128 + k];
#pragma unroll
    for (int r = 0; r < 16; ++r) Gs[(16 * seg + r) * 128 + k] = gl[r] + off;
    __syncthreads();
    const size_t uc = (size_t)bh * NCH + c;
    for (int j = 0; j < 8; ++j) {
        const int t_ = wave + 8 * j, s_ = lane;
        float acc = 0.f;
        if (s_ <= t_) {
            for (int kk = 0; kk < 128; ++kk) { const int k2 = (kk + lane) & 127;
                acc += qs[t_ * 128 + k2] * kvs[s_ * 128 + k2] * __expf(Gs[t_ * 128 + k2] - Gs[s_ * 128 + k2]); }
        }
        HAT[(uc * 64 + t_) * 64 + s_] = acc;
    }
    __syncthreads();
    for (int e = tid; e < 8192; e += 512) { const int kx = e & 127; const float ge = Gs[e];
        HQG[uc * 8192 + e] = (bf16)f2bf(qs[e] * __expf(ge));
        kvs[e] = kvs[e] * __expf(Gs[63 * 128 + kx] - ge); }
    if (tid < 128) HED[uc * 128 + tid] = __expf(Gs[63 * 128 + tid]);
    __syncthreads();
    {
        const int kg = tid >> 5, vg = tid & 31;
        float acc[8][4];
#pragma unroll
        for (int r = 0; r < 8; ++r)
#pragma unroll
            for (int q = 0; q < 4; ++q) acc[r][q] = 0.f;
        for (int s = 0; s < 64; ++s) {
            const f32x4 k0 = *(const lf32x4*)(kvs + s * 128 + 8 * kg), k1 = *(const lf32x4*)(kvs + s * 128 + 8 * kg + 4), iv = *(const lf32x4*)(is + s * 128 + 4 * vg);
            const float kr[8] = {k0.x, k0.y, k0.z, k0.w, k1.x, k1.y, k1.z, k1.w};
#pragma unroll
            for (int r = 0; r < 8; ++r) { acc[r][0] += kr[r] * iv.x; acc[r][1] += kr[r] * iv.y; acc[r][2] += kr[r] * iv.z; acc[r][3] += kr[r] * iv.w; }
        }
#pragma unroll
        for (int r = 0; r < 8; ++r) { u32x2 w; w.x = pk2(acc[r][0], acc[r][1]); w.y = pk2(acc[r][2], acc[r][3]);
            *(u32x2*)(HDS + (uc * 128 + 8 * kg + r) * 128 + 4 * vg) = w; }
    }
}

__device__ __forceinline__ void rwkv_prep_unit(int l_, int u_, LAS unsigned char* lds_) {
    LOAD_CTX(); const int l = UNI(l_), u = UNI(u_); LAS unsigned char* lds = UNI_LDS(lds_);
    const int tid = ltid();
    const int b = u / 257, t0 = (u % 257) * 16;
    const bf16* proj = (const bf16*)(C.ws + WS_PROJ);
    float* RA = (float*)(C.ws + WS_RA); bf16* RG = (bf16*)(C.ws + WS_RG);
    const float* mu = C.in[I_MU] + l * 4864;
    lfloat* feat = (lfloat*)lds;
    __syncthreads();
#pragma unroll
    for (int j = 0; j < 8; ++j) { const int e = tid + 512 * j, tok = e >> 8, f = e & 255, t = t0 + tok; const size_t m = (size_t)b * LT + t;
        const float cur = bf2f(proj[m * PN + C_WL + f]); const float prev = t > 0 ? bf2f(proj[(m - 1) * PN + C_WL + f]) : 0.f;
        const float xs = cur + (prev - cur) * mu[C_WL + f];
        feat[tok * 256 + f] = f < 64 ? tanhf(xs) : (f < 128 ? xs : sigmoidf_(xs)); }
    __syncthreads();
    const int c0 = tid, c1 = tid + 512, c2 = tid + 1024;
    float acc[16][3];
    {
        const float* w2 = C.in[I_W2] + (size_t)l * 64 * 1536;
#pragma unroll
        for (int tok = 0; tok < 16; ++tok) { acc[tok][0] = 0.f; acc[tok][1] = 0.f; acc[tok][2] = 0.f; }
        for (int kk = 0; kk < 64; ++kk) { const float a0 = w2[kk * 1536 + c0], a1 = w2[kk * 1536 + c1], a2 = w2[kk * 1536 + c2];
#pragma unroll
            for (int tok = 0; tok < 16; ++tok) { const float f = feat[tok * 256 + kk]; acc[tok][0] += f * a0; acc[tok][1] += f * a1; acc[tok][2] += f * a2; } }
        const float* w0 = C.in[I_W0] + l * 1536;
#pragma unroll
        for (int j = 0; j < 3; ++j) { const int c = tid + 512 * j, h = c >> 6, i = c & 63; const float w0c = w0[c];
#pragma unroll
            for (int tok = 0; tok < 16; ++tok) { const float x = -(w0c + acc[tok][j]);
                const float sp = fmaxf(x, 0.f) + log1pf(__expf(-fabsf(x)));
                const float ww = -sp - 0.5f; const float dec = __expf(-__expf(ww));
                RA[(((size_t)(b * NHR + h) * LT + t0 + tok) * 6 + 1) * 64 + i] = dec; } }
    }
    {
        const float* g2 = C.in[I_G2] + (size_t)l * 128 * 1536;
#pragma unroll
        for (int tok = 0; tok < 16; ++tok) { acc[tok][0] = 0.f; acc[tok][1] = 0.f; acc[tok][2] = 0.f; }
        for (int kk = 0; kk < 128; ++kk) { const float a0 = g2[kk * 1536 + c0], a1 = g2[kk * 1536 + c1], a2 = g2[kk * 1536 + c2];
#pragma unroll
            for (int tok = 0; tok < 16; ++tok) { const float f = feat[tok * 256 + 128 + kk]; acc[tok][0] += f * a0; acc[tok][1] += f * a1; acc[tok][2] += f * a2; } }
#pragma unroll
        for (int j = 0; j < 3; ++j) { const int c = tid + 512 * j;
#pragma unroll
            for (int tok = 0; tok < 16; ++tok) RG[((size_t)b * LT + t0 + tok) * 1536 + c] = (bf16)f2bf(acc[tok][j]); }
    }
    {
        const float* a2 = C.in[I_A2] + (size_t)l * 64 * 1536;
#pragma unroll
        for (int tok = 0; tok < 16; ++tok) { acc[tok][0] = 0.f; acc[tok][1] = 0.f; acc[tok][2] = 0.f; }
        for (int kk = 0; kk < 64; ++kk) { const float a0 = a2[kk * 1536 + c0], a1 = a2[kk * 1536 + c1], a2v = a2[kk * 1536 + c2];
#pragma unroll
            for (int tok = 0; tok < 16; ++tok) { const float f = feat[tok * 256 + 64 + kk]; acc[tok][0] += f * a0; acc[tok][1] += f * a1; acc[tok][2] += f * a2v; } }
#pragma unroll
        for (int j = 0; j < 3; ++j) { const int c = tid + 512 * j, h = c >> 6, i = c & 63;
            const float a0c = C.in[I_A0][l * 1536 + c], kkc = C.in[I_KK][l * 1536 + c], kac = C.in[I_KA][l * 1536 + c];
            const float mur = mu[C_R + c], muk = mu[C_K + c], muv = mu[C_V + c];
            float pr_ = 0.f, pk_ = 0.f, pv_ = 0.f;
            if (t0 > 0) { const bf16* pp = proj + ((size_t)b * LT + t0 - 1) * PN; pr_ = bf2f(pp[C_R + c]); pk_ = bf2f(pp[C_K + c]); pv_ = bf2f(pp[C_V + c]); }
#pragma unroll
            for (int tok = 0; tok < 16; ++tok) { const bf16* pc = proj + ((size_t)b * LT + t0 + tok) * PN;
                const float cr = bf2f(pc[C_R + c]), ck = bf2f(pc[C_K + c]), cv = bf2f(pc[C_V + c]);
                const float xr = cr + (pr_ - cr) * mur, xk = ck + (pk_ - ck) * muk, xv = cv + (pv_ - cv) * muv;
                pr_ = cr; pk_ = ck; pv_ = cv;
                const float kkr = xk * kkc; const float ss = wave_sum(kkr * kkr);
                const float kkn = kkr / fmaxf(sqrtf(ss), 1e-12f);
                const float a = sigmoidf_(a0c + acc[tok][j]);
                const float kp = xk * (1.0f + (a - 1.0f) * kac);
                float* ra = RA + ((size_t)(b * NHR + h) * LT + t0 + tok) * 384 + i;
                ra[0] = kkn; ra[128] = kkn * a; ra[192] = kp; ra[256] = xr; ra[320] = xv; } }
    }
}

__device__ __forceinline__ void rwkv_scan_unit(int unit_, LAS unsigned char* lds_) {
    LOAD_CTX(); const int unit = UNI(unit_); LAS unsigned char* lds = UNI_LDS(lds_);
    const int tid = ltid(), lane = tid & 63, wave = tid >> 6;
    const int bh = unit >> 1, half = unit & 1, b = bh / NHR, h = bh % NHR;
    const int rg = lane >> 4, j = lane & 15, rowl = 4 * wave + rg, row = 32 * half + rowl;
    const f32x4* RA4 = (const f32x4*)((const float*)(C.ws + WS_RA) + (size_t)bh * LT * 384);
    bf16* RY = (bf16*)(C.ws + WS_RY);
    lfloat* buf0 = (lfloat*)lds; lfloat* buf1 = buf0 + 12288; lfloat* ybuf = buf0 + 24576;
    constexpr int NCHK = (LT + 31) / 32;
    f32x4 regs[6];
    float S0 = 0.f, S1 = 0.f, S2 = 0.f, S3 = 0.f;
    __syncthreads();
#pragma unroll
    for (int q = 0; q < 6; ++q) { const int e = tid + 512 * q; regs[q] = RA4[e]; }
#pragma unroll
    for (int q = 0; q < 6; ++q) { const int e = tid + 512 * q; ((lf32x4*)buf0)[e] = regs[q]; }
    __syncthreads();
    for (int ci = 0; ci < NCHK; ++ci) {
        lfloat* cur = (ci & 1) ? buf1 : buf0; lfloat* nxt = (ci & 1) ? buf0 : buf1;
        const int ns = (LT - 32 * ci < 32) ? LT - 32 * ci : 32;
        if (ci + 1 < NCHK) { const int nsn = (LT - 32 * (ci + 1) < 32) ? LT - 32 * (ci + 1) : 32;
#pragma unroll
            for (int q = 0; q < 6; ++q) { const int e = tid + 512 * q; regs[q] = (e < nsn * 96) ? RA4[(size_t)(ci + 1) * 3072 + e] : (f32x4){0.f, 0.f, 0.f, 0.f}; } }
        for (int s = 0; s < ns; ++s) {
            const lfloat* sp = cur + s * 384;
            const f32x4 kk = *(const lf32x4*)(sp + 4 * j), w = *(const lf32x4*)(sp + 64 + 4 * j), ka = *(const lf32x4*)(sp + 128 + 4 * j), kp = *(const lf32x4*)(sp + 192 + 4 * j), r = *(const lf32x4*)(sp + 256 + 4 * j);
            const float vv = sp[320 + row];
            float p = (S0 * kk.x + S1 * kk.y) + (S2 * kk.z + S3 * kk.w);
            const float u0 = S0 * w.x + vv * kp.x, u1 = S1 * w.y + vv * kp.y, u2 = S2 * w.z + vv * kp.z, u3 = S3 * w.w + vv * kp.w;
            p = rowsum16(p);
            S0 = u0 - p * ka.x; S1 = u1 - p * ka.y; S2 = u2 - p * ka.z; S3 = u3 - p * ka.w;
            float y = (S0 * r.x + S1 * r.y) + (S2 * r.z + S3 * r.w);
            y = rowsum16(y);
            if (j == 0) ybuf[s * 32 + rowl] = y;
        }
        __syncthreads();
#pragma unroll
        for (int q = 0; q < 2; ++q) { const int e = tid + 512 * q, s = e >> 5, rl = e & 31;
            if (s < ns) RY[((size_t)b * LT + 32 * ci + s) * 1536 + h * 64 + 32 * half + rl] = (bf16)f2bf(ybuf[e]); }
        if (ci + 1 < NCHK) {
#pragma unroll
            for (int q = 0; q < 6; ++q) { const int e = tid + 512 * q; ((lf32x4*)nxt)[e] = regs[q]; } }
        __syncthreads();
    }
}
__device__ __forceinline__ void hgrn_scan_slice(int sl_) {
    LOAD_CTX(); const int sl = UNI(sl_);
    const int tid = ltid();
    bf16* HDS = (bf16*)(C.ws + WS_HDS); const float* HED = (const float*)(C.ws + WS_HED);
    float S[4][4];
#pragma unroll
    for (int q = 0; q < 4; ++q) { S[q][0] = 0.f; S[q][1] = 0.f; S[q][2] = 0.f; S[q][3] = 0.f; }
    const int e0 = sl * 8192 + tid * 4, bh = e0 >> 14;
    for (int c = 1; c < NCH; ++c) {
        const size_t uc = (size_t)bh * NCH + c;
        u32x2 d[4]; float ed[4];
#pragma unroll
        for (int q = 0; q < 4; ++q) { const int kv = (e0 + q * 2048) & 16383; d[q] = *(const u32x2*)(HDS + uc * 16384 + kv); ed[q] = HED[uc * 128 + (kv >> 7)]; }
#pragma unroll
        for (int q = 0; q < 4; ++q) { const int kv = (e0 + q * 2048) & 16383;
            u32x2 o; o.x = pk2(S[q][0], S[q][1]); o.y = pk2(S[q][2], S[q][3]); *(u32x2*)(HDS + uc * 16384 + kv) = o;
            S[q][0] = S[q][0] * ed[q] + bf2f(d[q].x & 0xffffu); S[q][1] = S[q][1] * ed[q] + bf2f(d[q].x >> 16); S[q][2] = S[q][2] * ed[q] + bf2f(d[q].y & 0xffffu); S[q][3] = S[q][3] * ed[q] + bf2f(d[q].y >> 16); }
    }
}

__device__ __forceinline__ void rwkv_post_task(const Ctx& C, int l, int task, int lane) {
    const int m = task / NHR, h = task % NHR, b = m / LT, t = m - b * LT, c = h * 64 + lane;
    const bf16* RY = (const bf16*)(C.ws + WS_RY); const bf16* RG = (const bf16*)(C.ws + WS_RG);
    const float* ra = (const float*)(C.ws + WS_RA) + ((size_t)(b * NHR + h) * LT + t) * 384 + lane;
    bf16* mixed = (bf16*)(C.ws + WS_Z);
    const float y = bf2f(RY[(size_t)m * 1536 + c]);
    const float mean = wave_sum(y) * (1.0f / 64.0f);
    const float dy = y - mean;
    const float var = wave_sum(dy * dy) * (1.0f / 64.0f);
    const float yn = dy * rsqrtf(var + 64e-5f) * C.in[I_LNW][l * 1536 + c] + C.in[I_LNB][l * 1536 + c];
    const float kp = ra[192], r = ra[256], v = ra[320];
    const float bonus = wave_sum(r * kp * C.in[I_RK][l * 1536 + c]) * v;
    const float g = bf2f(RG[(size_t)m * 1536 + c]);
    mixed[(size_t)m * DM + c] = (bf16)f2bf((yn + bonus) * g);
}
__device__ __forceinline__ void rwkv_post_all(int l_) {
    LOAD_CTX(); const int l = UNI(l_);
    const int tid = ltid(), lane = tid & 63, wave = UNI(tid >> 6);
    for (int task = blockIdx.x * 8 + wave; task < TT * NHR; task += gridDim.x * 8) rwkv_post_task(C, l, task, lane);
}
__device__ __forceinline__ void hgrn_out_unit(int l_, int u_, LAS unsigned char* lds_) {
    LOAD_CTX(); const int l = UNI(l_), u = UNI(u_); LAS unsigned char* lds = UNI_LDS(lds_);
    const int tid = ltid();
    const int bh = u / 65, c = u % 65 + 1, b = bh >> 3, h = bh & 7;
    const bf16* proj = (const bf16*)(C.ws + WS_PROJ);
    const bf16* HDS = (const bf16*)(C.ws + WS_HDS); const bf16* HQG = (const bf16*)(C.ws + WS_HQG); const float* HAT = (const float*)(C.ws + WS_HAT);
    bf16* mixed = (bf16*)(C.ws + WS_Z);
    lfloat* at = (lfloat*)lds; lfloat* is = at + 4096; lfloat* qg = at + 12288; lfloat* Ss = at + 20480;
    const size_t uc = (size_t)bh * NCH + c;
    __syncthreads();
    for (int e = tid; e < 4096; e += 512) at[e] = HAT[uc * 4096 + e];
    for (int e = tid; e < 8192; e += 512) { const int tl = e >> 7, k = e & 127, t = 64 * c + tl - 112;
        is[e] = (t >= 0 && t < LT) ? bf2f(proj[(size_t)(b * LT + t) * PN + C_HI + h * 128 + k]) : 0.f;
        qg[e] = bf2f(HQG[uc * 8192 + e]); }
    const int tg = tid >> 5, vg = tid & 31;
    float acc[4][4];
#pragma unroll
    for (int r = 0; r < 4; ++r)
#pragma unroll
        for (int q = 0; q < 4; ++q) acc[r][q] = 0.f;
    __syncthreads();
    for (int s = 0; s < 64; ++s) { const f32x4 iv = *(const lf32x4*)(is + s * 128 + 4 * vg);
#pragma unroll
        for (int r = 0; r < 4; ++r) { const float a = at[(4 * tg + r) * 64 + s]; acc[r][0] += a * iv.x; acc[r][1] += a * iv.y; acc[r][2] += a * iv.z; acc[r][3] += a * iv.w; } }
    for (int hf = 0; hf < 2; ++hf) {
        __syncthreads();
        for (int e = tid; e < 8192; e += 512) Ss[e] = bf2f(HDS[uc * 16384 + hf * 8192 + e]);
        __syncthreads();
        for (int k = 0; k < 64; ++k) { const f32x4 sv = *(const lf32x4*)(Ss + k * 128 + 4 * vg);
#pragma unroll
            for (int r = 0; r < 4; ++r) { const float a = qg[(4 * tg + r) * 128 + hf * 64 + k]; acc[r][0] += a * sv.x; acc[r][1] += a * sv.y; acc[r][2] += a * sv.z; acc[r][3] += a * sv.w; } }
    }
    const f32x4 gn = *(const f32x4*)(C.in[I_HNORM] + l * 1024 + h * 128 + 4 * vg);
#pragma unroll
    for (int r = 0; r < 4; ++r) {
        float ss = (acc[r][0] * acc[r][0] + acc[r][1] * acc[r][1]) + (acc[r][2] * acc[r][2] + acc[r][3] * acc[r][3]);
        ss += __shfl_xor(ss, 1); ss += __shfl_xor(ss, 2); ss += __shfl_xor(ss, 4); ss += __shfl_xor(ss, 8); ss += __shfl_xor(ss, 16);
        const float rn = rsqrtf(ss * (1.0f / 128.0f) + 1e-5f);
        const int tl = 4 * tg + r, t = 64 * c + tl - 112;
        if (t >= 0 && t < LT) { const size_t m = (size_t)b * LT + t;
            const u32x2 gw = *(const u32x2*)(proj + m * PN + C_HG + h * 128 + 4 * vg);
            const float g0 = bf2f(gw.x & 0xffffu), g1 = bf2f(gw.x >> 16), g2 = bf2f(gw.y & 0xffffu), g3 = bf2f(gw.y >> 16);
            u32x2 w; w.x = pk2(acc[r][0] * rn * gn.x * (g0 * sigmoidf_(g0)), acc[r][1] * rn * gn.y * (g1 * sigmoidf_(g1)));
            w.y = pk2(acc[r][2] * rn * gn.z * (g2 * sigmoidf_(g2)), acc[r][3] * rn * gn.w * (g3 * sigmoidf_(g3)));
            *(u32x2*)(mixed + m * DM + 3072 + h * 128 + 4 * vg) = w; }
    }
}

__device__ __forceinline__ unsigned ordkey(float v) { const unsigned b = __float_as_uint(v); return b ^ ((b >> 31) ? 0xFFFFFFFFu : 0x80000000u); }
__device__ __forceinline__ int mbcnt64(unsigned long long m) { return __builtin_amdgcn_mbcnt_hi((unsigned)(m >> 32), __builtin_amdgcn_mbcnt_lo((unsigned)m, 0u)); }
__device__ __forceinline__ void top16_of_128(float v0, float v1, int lane, lfloat* selv, LAS int* seli) {
    const unsigned k0 = (ordkey(v0) & ~127u) | (unsigned)(127 - lane), k1 = (ordkey(v1) & ~127u) | (unsigned)(63 - lane);
    unsigned thr = 0u;
    for (int bit = 31; bit >= 0; --bit) { const unsigned cand = thr | (1u << bit);
        const int cnt = __popcll(__ballot(k0 >= cand)) + __popcll(__ballot(k1 >= cand));
        if (cnt >= 16) thr = cand; }
    const unsigned long long m0 = __ballot(k0 >= thr), m1 = __ballot(k1 >= thr);
    if (k0 >= thr) { const int s = mbcnt64(m0); if (s < 16) { selv[s] = v0; seli[s] = lane; } }
    if (k1 >= thr) { const int s = __popcll(m0) + mbcnt64(m1); if (s < 16) { selv[s] = v1; seli[s] = lane + 64; } }
}
__device__ __forceinline__ void route_token(const Ctx& C, int m, int lane, LAS unsigned char* wl) {
    const float* sc = (const float*)(C.ws + WS_SC) + (size_t)m * 2048;
    bf16* GG = (bf16*)(C.ws + WS_GG);
    lfloat* s1v = (lfloat*)wl; LAS int* s1i = (LAS int*)(wl + 64); lfloat* s2v = (lfloat*)(wl + 128); LAS int* s2i = (LAS int*)(wl + 192);
    lfloat* bv = (lfloat*)(wl + 256); LAS int* bi = (LAS int*)(wl + 320);
    LAS int* eid = (LAS int*)(wl + 384); lfloat* eg = (lfloat*)(wl + 896);
    for (int h = 0; h < 8; ++h) {
        const float a0 = sc[h * 256 + lane], a1 = sc[h * 256 + 64 + lane], b0 = sc[h * 256 + 128 + lane], b1 = sc[h * 256 + 192 + lane];
        top16_of_128(a0, a1, lane, s1v, s1i);
        top16_of_128(b0, b1, lane, s2v, s2i);
        LDS_WAIT();
        const float sa = s1v[lane >> 2]; const f32x4 sb = *(const lf32x4*)(s2v + 4 * (lane & 3));
        const float cv[4] = {sa + sb.x, sa + sb.y, sa + sb.z, sa + sb.w};
        unsigned ck[4];
#pragma unroll
        for (int jj = 0; jj < 4; ++jj) ck[jj] = (ordkey(cv[jj]) & ~255u) | (unsigned)(255 - (4 * lane + jj));
        unsigned thr = 0u;
        for (int bit = 31; bit >= 0; --bit) { const unsigned cand = thr | (1u << bit);
            const int cnt = __popcll(__ballot(ck[0] >= cand)) + __popcll(__ballot(ck[1] >= cand)) + __popcll(__ballot(ck[2] >= cand)) + __popcll(__ballot(ck[3] >= cand));
            if (cnt >= 16) thr = cand; }
        int base = 0;
        const int ia = s1i[lane >> 2];
#pragma unroll
        for (int jj = 0; jj < 4; ++jj) { const unsigned long long mk = __ballot(ck[jj] >= thr);
            if (ck[jj] >= thr) { const int s = base + mbcnt64(mk); if (s < 16) { bv[s] = cv[jj]; bi[s] = ia * 128 + s2i[4 * (lane & 3) + jj]; } }
            base += __popcll(mk); }
        LDS_WAIT();
        float mx = -3.0e38f;
#pragma unroll
        for (int i = 0; i < 16; ++i) mx = fmaxf(mx, bv[i]);
        float sum = 0.f;
#pragma unroll
        for (int i = 0; i < 16; ++i) sum += __expf(bv[i] - mx);
        if (lane < 16) { eid[h * 16 + lane] = bi[lane]; eg[h * 16 + lane] = __expf(bv[lane] - mx) / sum; }
        LDS_WAIT();
    }
    const int my0 = eid[lane], my1 = eid[lane + 64];
    float g0 = 0.f, g1 = 0.f; bool f0 = true, f1 = true;
    for (int i = 0; i < 128; ++i) { const int id = eid[i]; const float gv = eg[i];
        if (id == my0) { g0 += gv; if (i < lane) f0 = false; }
        if (id == my1) { g1 += gv; if (i < lane + 64) f1 = false; } }
    if (f0) GG[(size_t)m * NE + my0] = (bf16)f2bf(g0);
    if (f1) GG[(size_t)m * NE + my1] = (bf16)f2bf(g1);
    LDS_WAIT();
}

__device__ __forceinline__ void route_all(LAS unsigned char* lds_) {
    LOAD_CTX(); LAS unsigned char* lds = UNI_LDS(lds_);
    const int tid = ltid(), lane = tid & 63, wave = UNI(tid >> 6);
    __syncthreads();
    for (int m = blockIdx.x * 8 + wave; m < TT; m += gridDim.x * 8) route_token(C, m, lane, lds + wave * 2048);
}
__device__ __forceinline__ void norm2_zero_all(int l_) {
    LOAD_CTX(); const int l = UNI(l_);
    const int tid = ltid(), lane = tid & 63, wave = UNI((int)(tid >> 6)), G = gridDim.x;
    unsigned char* ws = C.ws; bf16* Z = (bf16*)(ws + WS_Z); float* H = (float*)(ws + WS_H);
    for (int m = blockIdx.x * 8 + wave; m < TT; m += G * 8) norm_row(H + (size_t)m * DM, C.in[I_NFFN] + l * DM, Z + (size_t)m * DM, nullptr, lane);
    u32x4* gz = (u32x4*)(ws + WS_GG);
    const size_t n16 = (size_t)MP * NE * 2 / 16;
    for (size_t e = (size_t)blockIdx.x * 512 + tid; e < n16; e += (size_t)G * 512) gz[e] = (u32x4){0u, 0u, 0u, 0u};
}
__device__ __forceinline__ void final_norm_all() {
    LOAD_CTX();
    const int tid = ltid(), lane = tid & 63, wave = UNI((int)(tid >> 6)), G = gridDim.x;
    const float* H = (const float*)(C.ws + WS_H);
    for (int r = blockIdx.x * 8 + wave; r < NB * 4096; r += G * 8) {
        const int b = r >> 12, s = r & 4095; const size_t m = (size_t)b * LT + NMETA + s;
        const f32x4* xr = (const f32x4*)(H + m * DM) + lane;
        f32x4 v[16]; float ss = 0.f;
#pragma unroll
        for (int j = 0; j < 16; ++j) { v[j] = xr[64 * j]; ss += (v[j].x * v[j].x + v[j].y * v[j].y) + (v[j].z * v[j].z + v[j].w * v[j].w); }
        ss = wave_sum(ss);
        const float rn = rsqrtf(ss * (1.0f / 4096.0f) + 1e-5f);
        const f32x4* gr = (const f32x4*)C.in[I_NFIN] + lane; f32x4* o = (f32x4*)(C.out + (size_t)r * DM) + lane;
#pragma unroll
        for (int j = 0; j < 16; ++j) o[64 * j] = v[j] * rn * gr[64 * j];
    }
}
constexpr int NPL = 11;
constexpr int NPH = 2 * NPL + 1;
__global__ void __launch_bounds__(512, 2) hybrid_fwd(Ctx C) {
    extern __shared__ __attribute__((aligned(16))) unsigned char lds_raw[];
    LAS unsigned char* lds = (LAS unsigned char*)lds_raw;
    const int tid = threadIdx.x, lane = tid & 63, wave = __builtin_amdgcn_readfirstlane(tid >> 6);
    const int G = gridDim.x;
    unsigned char* ws = C.ws;
    unsigned* ctl = (unsigned*)(ws + WS_CTL);
    volatile LAS unsigned* MISC = (volatile LAS unsigned*)(lds + LDS_MISC);
    if (tid < 64) MISC[tid] = 0u;
    __syncthreads();
#if MK_ONE_LAUNCH
    XcdBarrier bar = xcd_barrier_post(ctl + CW_BAR, MISC + 8);
#define GRID_BAR() xcd_barrier(bar)
#else
#define GRID_BAR() do {} while (0)
#endif
    const int lo = C.ph_lo, hi = C.ph_hi;
#define IN(k) (lo <= (k) && (k) < hi)
#define SEAM(k) do { if (IN((k) + 1)) GRID_BAR(); } while (0)
    bf16* Z = (bf16*)(ws + WS_Z); float* H = (float*)(ws + WS_H);
#pragma unroll 1
    for (int l = 0; l < 2; ++l) {
        const int p0 = l * NPL;
        if (IN(p0 + 0)) { phase_conv_norm(l, lds); SEAM(p0 + 0); }
        if (IN(p0 + 1)) {
            pg8::Gemm g{(const pg8::bf16_t*)Z, (const pg8::bf16_t*)(ws + WS_WIN), MP, PN, DM}; pg8::StaticOrder S; S.init(MP, PN, G, (int)blockIdx.x);
            pg8::EpiBf16<0> E{(pg8::bf16_t*)(ws + WS_PROJ), PN, nullptr, 0, 0};
            pg8::gemm_phase<pg8::EpiBf16<0>, pg8::StaticOrder, false>(lds, g, S, E, nullptr);
            SEAM(p0 + 1);
        }
        if (IN(p0 + 2)) {
            for (int u = blockIdx.x; u < 780; u += G) swa_unit(l, u, lds);
            for (int u = blockIdx.x; u < 2080; u += G) hgrn_local_unit(l, u, lds);
            for (int u = blockIdx.x; u < 1028; u += G) rwkv_prep_unit(l, u, lds);
            SEAM(p0 + 2);
        }
        if (IN(p0 + 3)) {
            for (int r = blockIdx.x; r < 256; r += G) { if (r < 192) rwkv_scan_unit(r, lds); else hgrn_scan_slice(r - 192); }
            SEAM(p0 + 3);
        }
        if (IN(p0 + 4)) {
            for (int u = blockIdx.x; u < 2080; u += G) hgrn_out_unit(l, u, lds);
            rwkv_post_all(l);
            SEAM(p0 + 4);
        }
        if (IN(p0 + 5)) {
            pg8::Gemm g{(const pg8::bf16_t*)Z, (const pg8::bf16_t*)(ws + WS_WO), MP, DM, DM}; pg8::StaticOrder S; S.init(MP, DM, G, (int)blockIdx.x);
            pg8::EpiResF32 E{H, DM};
            pg8::gemm_phase<pg8::EpiResF32, pg8::StaticOrder, false>(lds, g, S, E, nullptr);
            SEAM(p0 + 5);
        }
        if (IN(p0 + 6)) { norm2_zero_all(l); SEAM(p0 + 6); }
        if (IN(p0 + 7)) {
            pg8::Gemm g{(const pg8::bf16_t*)Z, (const pg8::bf16_t*)(ws + WS_WS), MP, 2048, DM}; pg8::StaticOrder S; S.init(MP, 2048, G, (int)blockIdx.x);
            pg8::EpiF32 E{(float*)(ws + WS_SC), 2048, nullptr};
            pg8::gemm_phase<pg8::EpiF32, pg8::StaticOrder, false>(lds, g, S, E, nullptr);
            SEAM(p0 + 7);
        }
        if (IN(p0 + 8)) { route_all(lds); SEAM(p0 + 8); }
        if (IN(p0 + 9)) {
            pg8::Gemm g{(const pg8::bf16_t*)Z, (const pg8::bf16_t*)(ws + WS_U), MP, NE, DM}; pg8::StaticOrder S; S.init(MP, NE, G, (int)blockIdx.x);
            pg8::EpiGate E{(pg8::bf16_t*)(ws + WS_GG), NE};
            pg8::gemm_phase<pg8::EpiGate, pg8::StaticOrder, false>(lds, g, S, E, nullptr);
            SEAM(p0 + 9);
        }
        if (IN(p0 + 10)) {
            pg8::Gemm g{(const pg8::bf16_t*)(ws + WS_GG), (const pg8::bf16_t*)(ws + WS_VT), MP, DM, NE}; pg8::StaticOrder S; S.init(MP, DM, G, (int)blockIdx.x);
            pg8::EpiResF32 E{H, DM};
            pg8::gemm_phase<pg8::EpiResF32, pg8::StaticOrder, false>(lds, g, S, E, nullptr);
            SEAM(p0 + 10);
        }
    }
    if (IN(2 * NPL)) final_norm_all();
#undef IN
#undef SEAM
}

extern "C" void kernel_launch(void* const* d_in, const int* in_sizes, int n_in, void* d_out, int out_size, void* d_ws, size_t ws_size, hipStream_t stream) {
    static int grid = 0;
    if (grid == 0) {
        if (n_in != 25 || ws_size < WS_END) { fprintf(stderr, "kernel_launch: need 25 inputs and %zu bytes of workspace (got %d, %zu)\n", (size_t)WS_END, n_in, ws_size); grid = -1; return; }
        int dev = 0, cus = 0, per_cu = 0;
        if (hipGetDevice(&dev) != hipSuccess || hipDeviceGetAttribute(&cus, hipDeviceAttributeMultiprocessorCount, dev) != hipSuccess) { grid = -1; return; }
        if (hipFuncSetAttribute((const void*)hybrid_fwd, hipFuncAttributeMaxDynamicSharedMemorySize, LDS_BYTES) != hipSuccess) { fprintf(stderr, "kernel_launch: hipFuncSetAttribute failed\n"); grid = -1; return; }
        if (hipOccupancyMaxActiveBlocksPerMultiprocessor(&per_cu, (const void*)hybrid_fwd, 512, LDS_BYTES) != hipSuccess || per_cu < 1) { fprintf(stderr, "kernel_launch: occupancy query says %d blocks per CU\n", per_cu); }
        (void)hipGetLastError();
        grid = cus;
    }
    if (grid < 0) return;
    (void)hipMemsetAsync((char*)d_ws + WS_CTL, 0, CTL_ZERO_BYTES, stream);
    Ctx c{};
    for (int i = 0; i < 25; ++i) c.in[i] = (const float*)d_in[i];
    c.out = (float*)d_out; c.ws = (unsigned char*)d_ws;
#if MK_ONE_LAUNCH
    c.ph_lo = 0; c.ph_hi = NPH;
    hipLaunchKernelGGL(hybrid_fwd, dim3(grid), dim3(512), LDS_BYTES, stream, c);
#else
    for (int p = 0; p < NPH; ++p) { c.ph_lo = p; c.ph_hi = p + 1; hipLaunchKernelGGL(hybrid_fwd, dim3(grid), dim3(512), LDS_BYTES, stream, c); }
#endif
}
```

```cpp
#include <hip/hip_runtime.h>
#include <cstdio>
#include <cstdint>
#ifndef MK_ONE_LAUNCH
#define MK_ONE_LAUNCH 1
#endif
namespace pg8 {
#define PG8_LAS __attribute__((address_space(3)))
typedef unsigned short bf16_t;
typedef short bf16x8 __attribute__((ext_vector_type(8)));
typedef float f32x4 __attribute__((ext_vector_type(4)));
typedef unsigned u32x4 __attribute__((ext_vector_type(4)));
constexpr int BM = 256, BK = 64, HALF = 128, HTB = HALF * BK * 2  , STAGE_BYTES = 8 * HTB, NXCD = 8, WGM = 8;

__host__ __device__ __forceinline__ int lds_byte(int r, int c) { const int st = (r >> 4) * 2 + (c >> 5), rr = r & 15, cc = c & 31, ob = rr * 64 + cc * 2; return st * 1024 + (ob ^ (((ob >> 9) & 1) << 5)); }
__host__ __device__ __forceinline__ void stage_rc(int b, int& R, int& C) { const int st = b / 1024, sb = b % 1024, swz = sb ^ (((sb >> 9) & 1) << 5); R = (st >> 1) * 16 + swz / 64; C = (st & 1) * 32 + (swz % 64) / 2; }
__host__ __device__ __forceinline__ int perm32(int rho) { const int n = rho >> 4, i = rho & 15; return 8 * (i >> 2) + 4 * n + (i & 3); }

struct Unit { int pm, pn; };
struct Gemm { const bf16_t* A; const bf16_t* Bt; int M, N, K; };

struct StaticOrder {
    int nM, nN, nwg, G, c;
    __host__ __device__ void init(int M, int N, int G_, int c_) { nM = M / BM; nN = N / BM; nwg = nM * nN; G = G_; c = c_; }
    __host__ __device__ bool next(int i, Unit& u) const {
        const long L = (long)i * G + c; if (L >= nwg) return false;
        int wgid = (int)L; { const int q = nwg / NXCD, r = nwg % NXCD, xcd = wgid % NXCD, off = wgid / NXCD; wgid = (xcd < r ? xcd * (q + 1) : r * (q + 1) + (xcd - r) * q) + off; }
        const int nig = WGM * nN, gid = wgid / nig, fm = gid * WGM, gsz = (nM - fm) < WGM ? (nM - fm) : WGM;
        u.pm = fm + ((wgid % nig) % gsz); u.pn = (wgid % nig) / gsz; return true;
    }
    __device__ __forceinline__ void a_ready(const Unit&) const {}
    __device__ __forceinline__ void done(const Unit&) const {}
};
__device__ __forceinline__ unsigned cvt_pk_bf16(float lo, float hi) { unsigned r; asm volatile("v_cvt_pk_bf16_f32 %0, %1, %2" : "=v"(r) : "v"(lo), "v"(hi)); return r; }
typedef float f32x2 __attribute__((ext_vector_type(2)));
__device__ __forceinline__ f32x2 gelu_pk(f32x2 v) {
    const f32x2 av = __builtin_elementwise_abs(v), d = av * 0.2316418882f + 1.0f;
    f32x2 t; t.x = __builtin_amdgcn_rcpf(d.x); t.y = __builtin_amdgcn_rcpf(d.y);
    f32x2 q = t * 0.5307027145f + (-0.7265760135f); q = q * t + 0.7107068705f; q = q * t + (-0.142248368f); q = q * t + 0.127414796f; q = q * t;
    const f32x2 s = (v * v) * (-0.72134752044f);
    f32x2 e; e.x = __builtin_amdgcn_exp2f(s.x); e.y = __builtin_amdgcn_exp2f(s.y);
    const f32x2 m = v * (q * e), r = v - m;
    f32x2 o; o.x = v.x < 0.f ? m.x : r.x; o.y = v.y < 0.f ? m.y : r.y; return o;
}
struct EpiF32 {
    static constexpr bool PERM = false, AFTER_DRAIN = false;
    float* C; int ldc; const float* bias;
    __device__ __forceinline__ void operator()(const f32x4 (&acc)[2][2][4][2], const Unit& u, int wr, int wc, int fr, int fq) const {
        const int row0 = u.pm * BM + wr * 64 + fr, col0 = u.pn * BM + wc * 32 + 4 * fq;
        f32x4 bv[2][2];
#pragma unroll
        for (int bj = 0; bj < 2; ++bj)
#pragma unroll
            for (int n = 0; n < 2; ++n) bv[bj][n] = bias ? *(const f32x4*)(bias + col0 + bj * HALF + n * 16) : (f32x4){0.f, 0.f, 0.f, 0.f};
#pragma unroll
        for (int ai = 0; ai < 2; ++ai)
#pragma unroll
            for (int m = 0; m < 4; ++m) { float* rowp = C + (size_t)(row0 + ai * HALF + m * 16) * ldc + col0;
#pragma unroll
                for (int bj = 0; bj < 2; ++bj)
#pragma unroll
                    for (int n = 0; n < 2; ++n) *(f32x4*)(rowp + bj * HALF + n * 16) = acc[ai][bj][m][n] + bv[bj][n]; }
    }
};
template <int ACT  > struct EpiBf16 {
    static constexpr bool PERM = true, AFTER_DRAIN = false;
    bf16_t* O; int ldc; const float* bias; int split_cols; size_t split_stride;
    __device__ __forceinline__ void operator()(const f32x4 (&acc)[2][2][4][2], const Unit& u, int wr, int wc, int fr, int fq) const {
        const int row0 = u.pm * BM + wr * 64 + fr; int colt = u.pn * BM; bf16_t* base = O;
        if (split_cols) { const int t = colt / split_cols; base += (size_t)t * split_stride; colt -= t * split_cols; }
        const int col0 = colt + wc * 32 + 8 * fq, bcol0 = u.pn * BM + wc * 32 + 8 * fq;
        f32x4 bv[2][2];
#pragma unroll
        for (int bj = 0; bj < 2; ++bj)
#pragma unroll
            for (int n = 0; n < 2; ++n) bv[bj][n] = bias ? *(const f32x4*)(bias + bcol0 + bj * HALF + 4 * n) : (f32x4){0.f, 0.f, 0.f, 0.f};
#pragma unroll
        for (int ai = 0; ai < 2; ++ai)
#pragma unroll
            for (int m = 0; m < 4; ++m) { bf16_t* rowp = base + (size_t)(row0 + ai * HALF + m * 16) * ldc + col0;
#pragma unroll
                for (int bj = 0; bj < 2; ++bj) { f32x4 v0 = acc[ai][bj][m][0] + bv[bj][0], v1 = acc[ai][bj][m][1] + bv[bj][1];
                    if (ACT == 1) { f32x2 a = gelu_pk((f32x2){v0[0], v0[1]}), b = gelu_pk((f32x2){v0[2], v0[3]}), c = gelu_pk((f32x2){v1[0], v1[1]}), d = gelu_pk((f32x2){v1[2], v1[3]});
                        v0 = (f32x4){a.x, a.y, b.x, b.y}; v1 = (f32x4){c.x, c.y, d.x, d.y}; }
                    if (ACT == 2) {
#pragma unroll
                        for (int j = 0; j < 4; ++j) { v0[j] = 0.5f * v0[j] * (1.0f + erff(v0[j] * 0.70710678f)); v1[j] = 0.5f * v1[j] * (1.0f + erff(v1[j] * 0.70710678f)); } }
                    u32x4 w; w.x = cvt_pk_bf16(v0[0], v0[1]); w.y = cvt_pk_bf16(v0[2], v0[3]); w.z = cvt_pk_bf16(v1[0], v1[1]); w.w = cvt_pk_bf16(v1[2], v1[3]);
                    *(u32x4*)(rowp + bj * HALF) = w; } }
    }
};
template <class Epi, class Sched, bool STAMP = false>
__device__ __forceinline__ void gemm_phase(PG8_LAS unsigned char* lds, const Gemm g, const Sched& S, const Epi& E, unsigned long long* stamps) {
    int tid_ = threadIdx.x; asm volatile("" : "+v"(tid_));
    const int tid = tid_, wid = __builtin_amdgcn_readfirstlane(tid >> 6), lane = tid & 63, wr = wid >> 2, wc = wid & 3, fr = lane & 15, fq = lane >> 4;
    const int K = g.K, nt = K / BK;
    int ts_lo = 0, ts_hi = 0, nts = 0; const unsigned long long rt_entry = STAMP ? (unsigned long long)wall_clock64() : 0ull;
#define PG8_STAMP() do { if (STAMP && wid == 0 && nts < 64) { const unsigned long long _c = (unsigned long long)clock64(); \
        ts_lo = (lane == nts) ? (int)(unsigned)_c : ts_lo; ts_hi = (lane == nts) ? (int)(unsigned)(_c >> 32) : ts_hi; ++nts; } } while (0)
    PG8_STAMP();
    unsigned voffA[2], voffB[2];
#pragma unroll
    for (int i = 0; i < 2; ++i) { int R, C; stage_rc(tid * 16 + i * 8192, R, C); const int Rb = Epi::PERM ? ((R & ~31) + perm32(R & 31)) : R;
        voffA[i] = (unsigned)(R * K + C) * 2u; voffB[i] = (unsigned)(Rb * K + C) * 2u; }
    const size_t kstep = (size_t)(BK * 2);
    const size_t hstep = (size_t)HALF * K * 2;
    const size_t tstep = 2 * hstep;
    const unsigned ldsw = (unsigned)wid * 1024u;
    const unsigned ldsdst = (unsigned)__builtin_amdgcn_readfirstlane((int)((unsigned)(size_t)lds + ldsw));
    const int aoff = lds_byte(wr * 64 + fr, fq * 8), boff = lds_byte(wc * 32 + fr, fq * 8);
#define PG8_SA(b, h) (((b) * 2 + (h)) * HTB)
#define PG8_SB(b, h) ((4 + (b) * 2 + (h)) * HTB)
#define PG8_STAGE(bufoff, gbase, voff) do { _Pragma("unroll") for (int _i = 0; _i < 2; ++_i) { unsigned keep_; \
        asm volatile("s_mov_b32 %0, m0\n\ts_mov_b32 m0, %3\n\ts_nop 0\n\tglobal_load_lds_dwordx4 %1, %2\n\ts_mov_b32 m0, %0" : "=&s"(keep_) : "v"((voff)[_i]), "s"((unsigned long long)(gbase)), "s"(ldsdst + (unsigned)((bufoff) + _i * 8192)) : "memory"); } } while (0)
#define PG8_LDA(dst, b, h) do { _Pragma("unroll") for (int m = 0; m < 4; ++m) _Pragma("unroll") for (int k = 0; k < 2; ++k) dst[m][k] = *(const PG8_LAS bf16x8*)(lds + PG8_SA(b, h) + aoff + m * 2048 + k * 1024); } while (0)
#define PG8_LDB(dst, b, h) do { _Pragma("unroll") for (int n = 0; n < 2; ++n) _Pragma("unroll") for (int k = 0; k < 2; ++k) dst[n][k] = *(const PG8_LAS bf16x8*)(lds + PG8_SB(b, h) + boff + n * 2048 + k * 1024); } while (0)
#define PG8_MMA(ai, bj, At, Bt) do { __builtin_amdgcn_s_setprio(1); _Pragma("unroll") for (int m = 0; m < 4; ++m) _Pragma("unroll") for (int n = 0; n < 2; ++n) _Pragma("unroll") for (int k = 0; k < 2; ++k) \
        acc[ai][bj][m][n] = __builtin_amdgcn_mfma_f32_16x16x32_bf16(Bt[n][k], At[m][k], acc[ai][bj][m][n], 0, 0, 0); __builtin_amdgcn_s_setprio(0); } while (0)
#define PG8_WAIT_V(n) asm volatile("s_waitcnt vmcnt(" #n ")" ::: "memory")
#define PG8_WAIT_L(n) asm volatile("s_waitcnt lgkmcnt(" #n ")" ::: "memory")
#define PG8_BAR __builtin_amdgcn_s_barrier()
#define PG8_SCHED __builtin_amdgcn_sched_barrier(0)
    Unit cur, nxt; int ui = 0;
    if (!S.next(0, cur)) return;
    f32x4 acc[2][2][4][2];
#pragma unroll
    for (int a = 0; a < 2; ++a)
#pragma unroll
        for (int b = 0; b < 2; ++b)
#pragma unroll
            for (int m = 0; m < 4; ++m)
#pragma unroll
                for (int n = 0; n < 2; ++n) acc[a][b][m][n] = (f32x4){0.f, 0.f, 0.f, 0.f};
    bf16x8 At[4][2], B0[2][2], B1[2][2];
    const char* cA = (const char*)g.A + (size_t)cur.pm * tstep; const char* cB = (const char*)g.Bt + (size_t)cur.pn * tstep;
    S.a_ready(cur);
    PG8_STAGE(PG8_SB(0, 0), cB, voffB); PG8_STAGE(PG8_SA(0, 0), cA, voffA); PG8_STAGE(PG8_SB(0, 1), cB + hstep, voffB); PG8_STAGE(PG8_SA(0, 1), cA + hstep, voffA);
    if (wr == 1) PG8_BAR;
    PG8_WAIT_V(4); PG8_BAR;
    PG8_STAGE(PG8_SB(1, 0), cB + kstep, voffB); PG8_STAGE(PG8_SA(1, 0), cA + kstep, voffA); PG8_STAGE(PG8_SB(1, 1), cB + hstep + kstep, voffB);
    PG8_WAIT_V(6); PG8_BAR;
    PG8_STAMP();
    for (;;) {
        const bool has_next = S.next(ui + 1, nxt);
        const char* nA = has_next ? (const char*)g.A + (size_t)nxt.pm * tstep : cA; const char* nB = has_next ? (const char*)g.Bt + (size_t)nxt.pn * tstep : cB;
        for (int t = 0; t < nt; t += 2) {
            const bool last = (t == nt - 2);
            const char* a1 = cA + (size_t)(t + 1) * kstep;
            const char* a2 = last ? nA : cA + (size_t)(t + 2) * kstep; const char* b2 = last ? nB : cB + (size_t)(t + 2) * kstep;
            const char* a3 = a2 + kstep; const char* b3 = b2 + kstep;
            if (last && has_next) S.a_ready(nxt);
            PG8_LDB(B0, 0, 0); PG8_SCHED; PG8_LDA(At, 0, 0); PG8_STAGE(PG8_SA(1, 1), a1 + hstep, voffA);
            PG8_WAIT_L(8); PG8_BAR; PG8_WAIT_L(0); PG8_MMA(0, 0, At, B0); PG8_BAR; PG8_SCHED;
            PG8_LDB(B1, 0, 1); PG8_STAGE(PG8_SB(0, 0), b2, voffB);
            PG8_BAR; PG8_WAIT_L(0); PG8_MMA(0, 1, At, B1); PG8_BAR;
            PG8_LDA(At, 0, 1); PG8_STAGE(PG8_SA(0, 0), a2, voffA);
            PG8_BAR; PG8_WAIT_L(0); PG8_MMA(1, 0, At, B0); PG8_BAR; PG8_SCHED;
            PG8_STAGE(PG8_SB(0, 1), b2 + hstep, voffB);
            PG8_WAIT_V(6); PG8_BAR; PG8_MMA(1, 1, At, B1); PG8_BAR;
            PG8_LDB(B0, 1, 0); PG8_SCHED; PG8_LDA(At, 1, 0); PG8_STAGE(PG8_SA(0, 1), a2 + hstep, voffA);
            PG8_WAIT_L(8); PG8_BAR; PG8_WAIT_L(0); PG8_MMA(0, 0, At, B0); PG8_BAR; PG8_SCHED;
            PG8_LDB(B1, 1, 1); PG8_STAGE(PG8_SB(1, 0), b3, voffB);
            PG8_BAR; PG8_WAIT_L(0); PG8_MMA(0, 1, At, B1); PG8_BAR;
            PG8_LDA(At, 1, 1); PG8_STAGE(PG8_SA(1, 0), a3, voffA);
            PG8_BAR; PG8_WAIT_L(0); PG8_MMA(1, 0, At, B0); PG8_BAR; PG8_SCHED;
            PG8_STAGE(PG8_SB(1, 1), b3 + hstep, voffB);
            PG8_WAIT_V(6); PG8_BAR; PG8_MMA(1, 1, At, B1); PG8_BAR;
        }
        PG8_STAMP();
        if constexpr (!Epi::AFTER_DRAIN) { E(acc, cur, wr, wc, fr, fq); S.done(cur); }
        PG8_STAMP();
        if (!has_next) break;
#pragma unroll
        for (int a = 0; a < 2; ++a)
#pragma unroll
            for (int b = 0; b < 2; ++b)
#pragma unroll
                for (int m = 0; m < 4; ++m)
#pragma unroll
                    for (int n = 0; n < 2; ++n) acc[a][b][m][n] = (f32x4){0.f, 0.f, 0.f, 0.f};
        cur = nxt; cA = nA; cB = nB; ++ui;
    }
    PG8_WAIT_V(0);
    if (wr == 0) PG8_BAR;
    PG8_BAR;
    if constexpr (Epi::AFTER_DRAIN) { E.fused(acc, cur, wr, wc, fr, fq, lds, wid, lane); S.done(cur); }
    PG8_STAMP();
    if (STAMP && wid == 0) { stamps[lane] = lane < nts ? (((unsigned long long)(unsigned)ts_hi << 32) | (unsigned)ts_lo) : 0ull;
        if (lane == 62) stamps[62] = rt_entry; if (lane == 63) stamps[63] = (unsigned long long)wall_clock64(); }
#undef PG8_STAMP
#undef PG8_SA
#undef PG8_SB
#undef PG8_STAGE
#undef PG8_LDA
#undef PG8_LDB
#undef PG8_MMA
#undef PG8_WAIT_V
#undef PG8_WAIT_L
#undef PG8_BAR
#undef PG8_SCHED
}
typedef int i32x4 __attribute__((ext_vector_type(4)));
typedef int i32x8 __attribute__((ext_vector_type(8)));
struct Gemm8 { const unsigned char* A; const unsigned char* Bt; int M, N, K; int scale; };
template <class Epi, class Sched, bool STAMP = false>
__device__ __forceinline__ void gemm_phase8(PG8_LAS unsigned char* lds, const Gemm8 g, const Sched& S, const Epi& E, unsigned long long* stamps) {
    int tid_ = threadIdx.x; asm volatile("" : "+v"(tid_));
    const int tid = tid_, wid = __builtin_amdgcn_readfirstlane(tid >> 6), lane = tid & 63, wr = wid >> 2, wc = wid & 3, fr = lane & 15, fq = lane >> 4;
    const int K = g.K  , nt = K / 128;
    int ts_lo = 0, ts_hi = 0, nts = 0; const unsigned long long rt_entry = STAMP ? (unsigned long long)wall_clock64() : 0ull;
#define PG8_STAMP() do { if (STAMP && wid == 0 && nts < 64) { const unsigned long long _c = (unsigned long long)clock64(); \
        ts_lo = (lane == nts) ? (int)(unsigned)_c : ts_lo; ts_hi = (lane == nts) ? (int)(unsigned)(_c >> 32) : ts_hi; ++nts; } } while (0)
    PG8_STAMP();
    unsigned voffA[2], voffB[2];
#pragma unroll
    for (int i = 0; i < 2; ++i) { int R, C; stage_rc(tid * 16 + i * 8192, R, C); const int Rb = Epi::PERM ? ((R & ~31) + perm32(R & 31)) : R;
        voffA[i] = (unsigned)(R * K + 2 * C); voffB[i] = (unsigned)(Rb * K + 2 * C); }
    const size_t kstep = (size_t)(BK * 2);
    const size_t hstep = (size_t)HALF * K;
    const size_t tstep = 2 * hstep;
    const unsigned ldsw = (unsigned)wid * 1024u;
    const unsigned ldsdst = (unsigned)__builtin_amdgcn_readfirstlane((int)((unsigned)(size_t)lds + ldsw));
    const int aoff = lds_byte(wr * 64 + fr, fq * 16), boff = lds_byte(wc * 32 + fr, fq * 16);
#define PG8_SA(b, h) (((b) * 2 + (h)) * HTB)
#define PG8_SB(b, h) ((4 + (b) * 2 + (h)) * HTB)
#define PG8_STAGE(bufoff, gbase, voff) do { _Pragma("unroll") for (int _i = 0; _i < 2; ++_i) { unsigned keep_; \
        asm volatile("s_mov_b32 %0, m0\n\ts_mov_b32 m0, %3\n\ts_nop 0\n\tglobal_load_lds_dwordx4 %1, %2\n\ts_mov_b32 m0, %0" : "=&s"(keep_) : "v"((voff)[_i]), "s"((unsigned long long)(gbase)), "s"(ldsdst + (unsigned)((bufoff) + _i * 8192)) : "memory"); } } while (0)
#define PG8_LDA(dst, b, h) do { _Pragma("unroll") for (int m = 0; m < 4; ++m) { const i32x4 lo_ = *(const PG8_LAS i32x4*)(lds + PG8_SA(b, h) + aoff + m * 2048), hi_ = *(const PG8_LAS i32x4*)(lds + PG8_SA(b, h) + aoff + m * 2048 + 16); dst[m] = __builtin_shufflevector(lo_, hi_, 0, 1, 2, 3, 4, 5, 6, 7); } } while (0)
#define PG8_LDB(dst, b, h) do { _Pragma("unroll") for (int n = 0; n < 2; ++n) { const i32x4 lo_ = *(const PG8_LAS i32x4*)(lds + PG8_SB(b, h) + boff + n * 2048), hi_ = *(const PG8_LAS i32x4*)(lds + PG8_SB(b, h) + boff + n * 2048 + 16); dst[n] = __builtin_shufflevector(lo_, hi_, 0, 1, 2, 3, 4, 5, 6, 7); } } while (0)
#define PG8_MMA(ai, bj, At, Bt) do { __builtin_amdgcn_s_setprio(1); _Pragma("unroll") for (int m = 0; m < 4; ++m) _Pragma("unroll") for (int n = 0; n < 2; ++n) \
        acc[ai][bj][m][n] = __builtin_amdgcn_mfma_scale_f32_16x16x128_f8f6f4(Bt[n], At[m], acc[ai][bj][m][n], 0, 0, 0, g.scale, 0, 0x7f7f7f7f); __builtin_amdgcn_s_setprio(0); } while (0)
#define PG8_WAIT_V(n) asm volatile("s_waitcnt vmcnt(" #n ")" ::: "memory")
#define PG8_WAIT_L(n) asm volatile("s_waitcnt lgkmcnt(" #n ")" ::: "memory")
#define PG8_BAR __builtin_amdgcn_s_barrier()
#define PG8_SCHED __builtin_amdgcn_sched_barrier(0)
    Unit cur, nxt; int ui = 0;
    if (!S.next(0, cur)) return;
    f32x4 acc[2][2][4][2];
#pragma unroll
    for (int a = 0; a < 2; ++a)
#pragma unroll
        for (int b = 0; b < 2; ++b)
#pragma unroll
            for (int m = 0; m < 4; ++m)
#pragma unroll
                for (int n = 0; n < 2; ++n) acc[a][b][m][n] = (f32x4){0.f, 0.f, 0.f, 0.f};
    i32x8 At[4], B0[2], B1[2];
    const char* cA = (const char*)g.A + (size_t)cur.pm * tstep; const char* cB = (const char*)g.Bt + (size_t)cur.pn * tstep;
    S.a_ready(cur);
    PG8_STAGE(PG8_SB(0, 0), cB, voffB); PG8_STAGE(PG8_SA(0, 0), cA, voffA); PG8_STAGE(PG8_SB(0, 1), cB + hstep, voffB); PG8_STAGE(PG8_SA(0, 1), cA + hstep, voffA);
    if (wr == 1) PG8_BAR;
    PG8_WAIT_V(4); PG8_BAR;
    PG8_STAGE(PG8_SB(1, 0), cB + kstep, voffB); PG8_STAGE(PG8_SA(1, 0), cA + kstep, voffA); PG8_STAGE(PG8_SB(1, 1), cB + hstep + kstep, voffB);
    PG8_WAIT_V(6); PG8_BAR;
    PG8_STAMP();
    for (;;) {
        const bool has_next = S.next(ui + 1, nxt);
        const char* nA = has_next ? (const char*)g.A + (size_t)nxt.pm * tstep : cA; const char* nB = has_next ? (const char*)g.Bt + (size_t)nxt.pn * tstep : cB;
        for (int t = 0; t < nt; t += 2) {
            const bool last = (t == nt - 2);
            const char* a1 = cA + (size_t)(t + 1) * kstep;
            const char* a2 = last ? nA : cA + (size_t)(t + 2) * kstep; const char* b2 = last ? nB : cB + (size_t)(t + 2) * kstep;
            const char* a3 = a2 + kstep; const char* b3 = b2 + kstep;
            if (last && has_next) S.a_ready(nxt);
            PG8_LDB(B0, 0, 0); PG8_SCHED; PG8_LDA(At, 0, 0); PG8_STAGE(PG8_SA(1, 1), a1 + hstep, voffA);
            PG8_WAIT_L(8); PG8_BAR; PG8_WAIT_L(0); PG8_MMA(0, 0, At, B0); PG8_BAR; PG8_SCHED;
            PG8_LDB(B1, 0, 1); PG8_STAGE(PG8_SB(0, 0), b2, voffB);
            PG8_BAR; PG8_WAIT_L(0); PG8_MMA(0, 1, At, B1); PG8_BAR;
            PG8_LDA(At, 0, 1); PG8_STAGE(PG8_SA(0, 0), a2, voffA);
            PG8_BAR; PG8_WAIT_L(0); PG8_MMA(1, 0, At, B0); PG8_BAR; PG8_SCHED;
            PG8_STAGE(PG8_SB(0, 1), b2 + hstep, voffB);
            PG8_WAIT_V(6); PG8_BAR; PG8_MMA(1, 1, At, B1); PG8_BAR;
            PG8_LDB(B0, 1, 0); PG8_SCHED; PG8_LDA(At, 1, 0); PG8_STAGE(PG8_SA(0, 1), a2 + hstep, voffA);
            PG8_WAIT_L(8); PG8_BAR; PG8_WAIT_L(0); PG8_MMA(0, 0, At, B0); PG8_BAR; PG8_SCHED;
            PG8_LDB(B1, 1, 1); PG8_STAGE(PG8_SB(1, 0), b3, voffB);
            PG8_BAR; PG8_WAIT_L(0); PG8_MMA(0, 1, At, B1); PG8_BAR;
            PG8_LDA(At, 1, 1); PG8_STAGE(PG8_SA(1, 0), a3, voffA);
            PG8_BAR; PG8_WAIT_L(0); PG8_MMA(1, 0, At, B0); PG8_BAR; PG8_SCHED;
            PG8_STAGE(PG8_SB(1, 1), b3 + hstep, voffB);
            PG8_WAIT_V(6); PG8_BAR; PG8_MMA(1, 1, At, B1); PG8_BAR;
        }
        PG8_STAMP();
        if constexpr (!Epi::AFTER_DRAIN) { E(acc, cur, wr, wc, fr, fq); S.done(cur); }
        PG8_STAMP();
        if (!has_next) break;
#pragma unroll
        for (int a = 0; a < 2; ++a)
#pragma unroll
            for (int b = 0; b < 2; ++b)
#pragma unroll
                for (int m = 0; m < 4; ++m)
#pragma unroll
                    for (int n = 0; n < 2; ++n) acc[a][b][m][n] = (f32x4){0.f, 0.f, 0.f, 0.f};
        cur = nxt; cA = nA; cB = nB; ++ui;
    }
    PG8_WAIT_V(0);
    if (wr == 0) PG8_BAR;
    PG8_BAR;
    if constexpr (Epi::AFTER_DRAIN) { E.fused(acc, cur, wr, wc, fr, fq, lds, wid, lane); S.done(cur); }
    PG8_STAMP();
    if (STAMP && wid == 0) { stamps[lane] = lane < nts ? (((unsigned long long)(unsigned)ts_hi << 32) | (unsigned)ts_lo) : 0ull;
        if (lane == 62) stamps[62] = rt_entry; if (lane == 63) stamps[63] = (unsigned long long)wall_clock64(); }
#undef PG8_STAMP
#undef PG8_SA
#undef PG8_SB
#undef PG8_STAGE
#undef PG8_LDA
#undef PG8_LDB
#undef PG8_MMA
#undef PG8_WAIT_V
#undef PG8_WAIT_L
#undef PG8_BAR
#undef PG8_SCHED
}
}
#define XB_TMO      128
#define XB_XCNT(j)  (256  + 64 * (j))
#define XB_XSUB(j)  (1280 + 64 * (j))
#define XB_XGEN(j)  (2304 + 64 * (j))
#define XB_TOP      3328
#define XB_TOPGEN   3392
#define XCD_BAR_WORDS 3456
#define XB_SPIN_CAP (1u << 23)
#define LAS __attribute__((address_space(3)))

__device__ __forceinline__ unsigned xb_ld(unsigned* p)              { return __hip_atomic_load(p, __ATOMIC_RELAXED, __HIP_MEMORY_SCOPE_AGENT); }
__device__ __forceinline__ unsigned xb_add(unsigned* p, unsigned v) { return __hip_atomic_fetch_add(p, v, __ATOMIC_RELAXED, __HIP_MEMORY_SCOPE_AGENT); }
__device__ __forceinline__ unsigned xb_xcc_id() { return (unsigned)__builtin_amdgcn_s_getreg((3 << 11) | 20) & 0xFu; }
#define XB_SPIN(cond, bar) do { unsigned _sp = 0; while (cond) { __builtin_amdgcn_s_sleep(1); \
    if ((++_sp & 255u) == 0u) { if (xb_ld(&(bar)[XB_TMO])) break; if (_sp > XB_SPIN_CAP) { atomicAdd(&(bar)[XB_TMO], 1u); break; } } } } while (0)

struct XcdBarrier {
    unsigned* bar; unsigned x;
    volatile LAS unsigned* st;
};

__device__ __forceinline__ XcdBarrier xcd_barrier_post(unsigned* bar, volatile LAS unsigned* st) {
    XcdBarrier b; b.bar = bar; b.x = xb_xcc_id(); b.st = st;
    if (threadIdx.x == 0) (void)xb_add(&bar[XB_XCNT(b.x)], 1u);
    return b;
}
__device__ __forceinline__ void xcd_barrier_complete(unsigned* bar, unsigned x, unsigned& nloc, unsigned& nx) {
    const unsigned G = gridDim.x * gridDim.y * gridDim.z;
    unsigned sum, cnt, mine, sp = 0u;
    for (;;) {
        sum = 0u; cnt = 0u; mine = 0u;
#pragma unroll
        for (unsigned j = 0; j < 16; ++j) { const unsigned c = xb_ld(&bar[XB_XCNT(j)]); sum += c; cnt += (c > 0u) ? 1u : 0u; mine = (j == x) ? c : mine; }
        if (sum == G) break;
        __builtin_amdgcn_s_sleep(1);
        if ((++sp & 255u) == 0u) { if (xb_ld(&bar[XB_TMO])) break; if (sp > XB_SPIN_CAP) { atomicAdd(&bar[XB_TMO], 1u); break; } }
    }
    nloc = mine > 0u ? mine : 1u; nx = cnt > 0u ? cnt : 1u;
}

__device__ __forceinline__ void xcd_barrier(const XcdBarrier& b) {
    asm volatile("s_waitcnt vmcnt(0)" ::: "memory");
    __syncthreads();
    if (threadIdx.x == 0) {
        unsigned* bar = b.bar; asm volatile("" : "+s"(bar));
        __builtin_amdgcn_s_waitcnt(0);
        unsigned nloc = b.st[0], nx = b.st[1];
        if (nloc == 0u) { xcd_barrier_complete(bar, b.x, nloc, nx); b.st[0] = nloc; b.st[1] = nx; }
        const unsigned old = xb_add(&bar[XB_XSUB(b.x)], 1u);
        const unsigned gen = old / nloc;
        if (old + 1u == (gen + 1u) * nloc) {
            __builtin_amdgcn_fence(__ATOMIC_RELEASE, "agent");
            asm volatile("s_waitcnt vmcnt(0)" ::: "memory");
            const unsigned og = xb_add(&bar[XB_TOP], 1u);
            const unsigned tg = og / nx;
            if (og + 1u == (tg + 1u) * nx) xb_add(&bar[XB_TOPGEN], 1u);
            else XB_SPIN(xb_ld(&bar[XB_TOPGEN]) == tg, bar);
            __builtin_amdgcn_fence(__ATOMIC_ACQUIRE, "agent");
            xb_add(&bar[XB_XGEN(b.x)], 1u);
            asm volatile("s_waitcnt vmcnt(0)" ::: "memory");
        } else {
            XB_SPIN(xb_ld(&bar[XB_XGEN(b.x)]) == gen, bar);
            __builtin_amdgcn_fence(__ATOMIC_ACQUIRE, "agent");
            asm volatile("s_waitcnt vmcnt(0)" ::: "memory");
        }
    }
    __syncthreads();
}
#define GAS __attribute__((address_space(1)))
typedef unsigned short bf16;
typedef float f32x4 __attribute__((ext_vector_type(4)));
typedef unsigned u32x4 __attribute__((ext_vector_type(4)));
typedef unsigned u32x2 __attribute__((ext_vector_type(2)));
typedef LAS float lfloat;
typedef LAS f32x4 lf32x4;

constexpr int DM = 4096, NB = 4, NMETA = 16, LT = 4112, TT = NB * LT  , MP = 16640  ;
constexpr int PN = 11008;
constexpr int C_R = 0, C_K = 1536, C_V = 3072, C_WL = 4608, C_SQ = 4864, C_SK = 6400, C_SV = 6592, C_HQ = 6912, C_HF = 7936, C_HI = 8960, C_HG = 9984;
constexpr int NE = 16384;
constexpr int NHR = 24;
constexpr int NCH = 66;

constexpr size_t MiB = 1ull << 20;
constexpr size_t WS_CTL = 0, WS_WIN = 2 * MiB, WS_WO = 88 * MiB, WS_WS = 120 * MiB, WS_U = 136 * MiB  , WS_VT = 200 * MiB  , WS_HN8 = 264 * MiB  , WS_H = 392 * MiB, WS_Z = 652 * MiB, WS_R = 782 * MiB;
constexpr size_t WS_PROJ = WS_R, WS_RA = 1132 * MiB, WS_RG = 1711 * MiB, WS_RY = 1760 * MiB, WS_HDS = 1809 * MiB, WS_HQG = 1875 * MiB, WS_HAT = 1908 * MiB, WS_HED = 1941 * MiB, WS_END = 1975 * MiB;
constexpr size_t WS_CHB = 1943 * MiB;
constexpr size_t WS_ME = 1 * MiB + 832 * 1024;
constexpr size_t WS_HM = WS_ME + 64 * 1024;
constexpr size_t WS_LW = 1 * MiB;
constexpr size_t WS_GG = WS_R, WS_SC = 1302 * MiB, WS_HG8 = 1432 * MiB  ;
constexpr size_t WS_BM = 1700 * MiB;
static_assert(WS_WIN + (size_t)PN * DM * 2 <= WS_WO && WS_WO + (size_t)DM * DM * 2 <= WS_WS && WS_WS + (size_t)2048 * DM * 2 <= WS_U && WS_U + (size_t)NE * DM <= WS_VT && WS_VT + (size_t)NE * DM <= WS_HN8 && WS_HN8 + (size_t)MP * DM <= WS_H, "ws map 1");
static_assert(WS_H + (size_t)MP * DM * 4 <= WS_Z && WS_Z + (size_t)MP * DM * 2 <= WS_R, "ws map 2");
static_assert(WS_PROJ + (size_t)MP * PN * 2 <= WS_RA && WS_RA + (size_t)96 * LT * 384 * 4 <= WS_RG && WS_RG + (size_t)TT * 1536 * 2 <= WS_RY && WS_RY + (size_t)TT * 1536 * 2 <= WS_HDS, "ws map 3");
static_assert(WS_HDS + (size_t)32 * NCH * 16384 * 2 <= WS_HQG && WS_HQG + (size_t)32 * NCH * 8192 * 2 <= WS_HAT && WS_HAT + (size_t)32 * NCH * 4096 * 4 <= WS_HED && WS_HED + (size_t)32 * NCH * 128 * 4 <= WS_END, "ws map 4");
static_assert(WS_GG + (size_t)MP * NE * 2 <= WS_SC && WS_SC + (size_t)MP * 2048 * 4 <= WS_HG8 && WS_HG8 + (size_t)MP * NE <= WS_BM && WS_BM + (size_t)16384 * 64 * 4 <= WS_END, "ws map 5");

constexpr int LDS_BYTES = 147456;
constexpr int LDS_MISC = 143360;
constexpr int CW_BAR = 4096;
constexpr int CW_HG = 8192;
constexpr size_t CTL_ZERO_BYTES = 64 * 1024;

__device__ __forceinline__ float bf2f(unsigned b) { return __uint_as_float(b << 16); }
typedef __bf16 bf16x2_t __attribute__((ext_vector_type(2)));
typedef float f32x2_t __attribute__((ext_vector_type(2)));
__device__ __forceinline__ unsigned pk2(float lo, float hi) { const f32x2_t v = {lo, hi}; const bf16x2_t r = __builtin_convertvector(v, bf16x2_t); return __builtin_bit_cast(unsigned, r); }
__device__ __forceinline__ unsigned f2bf(float f) { return pk2(f, 0.0f) & 0xffffu; }
__device__ __forceinline__ unsigned pk4_fp8(float a, float b, float c, float d) {
    a = __builtin_amdgcn_fmed3f(a, -448.f, 448.f); b = __builtin_amdgcn_fmed3f(b, -448.f, 448.f); c = __builtin_amdgcn_fmed3f(c, -448.f, 448.f); d = __builtin_amdgcn_fmed3f(d, -448.f, 448.f);
    int v = __builtin_amdgcn_cvt_pk_fp8_f32(a, b, 0, false); v = __builtin_amdgcn_cvt_pk_fp8_f32(c, d, v, true); return (unsigned)v;
}
constexpr float U8_SCALE = 64.f, V8_SCALE = 8.f, HG8_SCALE = 64.f;
constexpr int U8_E8M0 = 0x79797979  , V8_E8M0 = 0x76767676  ;
constexpr float MX8_SCALE = 8.f, WO8_SCALE = 128.f; constexpr int WO8_E8M0 = 0x75757575  ;
constexpr size_t WS_MX8 = WS_HN8  , WS_WO8 = 332 * MiB  ;
static_assert(WS_HN8 + (size_t)MP * DM <= WS_WO8 && WS_WO8 + (size_t)DM * DM <= WS_H, "ws map 6");
__device__ __forceinline__ unsigned char fp8_1(float a) { a = __builtin_amdgcn_fmed3f(a, -448.f, 448.f); return (unsigned char)(__builtin_amdgcn_cvt_pk_fp8_f32(a, 0.f, 0, false) & 0xff); }
#define LDS_WAIT() asm volatile("s_waitcnt lgkmcnt(0)" ::: "memory")
__device__ __forceinline__ float wave_sum(float v) {
#pragma unroll
    for (int o = 1; o < 64; o <<= 1) v += __shfl_xor(v, o);
    return v;
}
template <int CTRL> __device__ __forceinline__ float dpp_mov(float x) { return __int_as_float(__builtin_amdgcn_update_dpp(0, __float_as_int(x), CTRL, 0xF, 0xF, false)); }
__device__ __forceinline__ float rowsum16(float x) {
    x += dpp_mov<0xB1>(x); x += dpp_mov<0x4E>(x); x += dpp_mov<0x141>(x); x += dpp_mov<0x140>(x); return x;
}
__device__ __forceinline__ void rope_sc(float pos, int j, float& sn, float& cs) {
    const float ang = pos * exp2f(-(float)j * 2.3664460711655218f);
    float rev = ang * 0.15915494309189535f; rev = rev - floorf(rev);
    sn = __builtin_amdgcn_sinf(rev); cs = __builtin_amdgcn_cosf(rev);
}
__device__ __forceinline__ float sigmoidf_(float x) { return 1.0f / (1.0f + __expf(-x)); }

__device__ __forceinline__ int ltid() { int t = threadIdx.x; asm volatile("" : "+v"(t)); return t; }
__device__ __forceinline__ int ROWOF(int b, int t) { return t >= NMETA ? b * 4096 + (t - NMETA) : 16384 + b * NMETA + t; }
constexpr int MAIN_ROWS = 16384;
struct Ctx {
    const float* in[25];
    float* out;
    unsigned char* ws;
    int ph_lo, ph_hi;
};
typedef const __attribute__((address_space(4))) Ctx CtxK;
__device__ __forceinline__ Ctx load_ctx() { CtxK* p = (CtxK*)__builtin_amdgcn_kernarg_segment_ptr(); asm volatile("" : "+s"(p)); Ctx c;
#pragma unroll
    for (int i = 0; i < 25; ++i) c.in[i] = p->in[i];
    c.out = p->out; c.ws = p->ws; c.ph_lo = p->ph_lo; c.ph_hi = p->ph_hi; return c; }
#define LOAD_CTX() const Ctx C = load_ctx()
__device__ __forceinline__ int uni_launder(int x) { int y = __builtin_amdgcn_readfirstlane(x); asm volatile("" : "+s"(y)); return y; }
#define UNI(x) uni_launder(x)
#define UNI_LDS(p) ((LAS unsigned char*)(uintptr_t)(unsigned)__builtin_amdgcn_readfirstlane((int)(unsigned)(uintptr_t)(p)))
enum { I_X = 0, I_META, I_NMIX, I_NFFN, I_NFIN, I_WIN, I_WOUT, I_MU, I_W0, I_W2, I_A0, I_A2, I_G2, I_KK, I_KA, I_RK, I_LNW, I_LNB, I_SINK, I_HLB, I_HNORM, I_WQ, I_KEYS, I_PU, I_PV };

namespace pg8 {
struct EpiResF32 {
    static constexpr bool PERM = false, AFTER_DRAIN = false;
    float* H; int ldc; const float* Src;
    __device__ __forceinline__ void operator()(const f32x4 (&acc)[2][2][4][2], const Unit& u, int wr, int wc, int fr, int fq) const {
        const int row0 = u.pm * BM + wr * 64 + fr, col0 = u.pn * BM + wc * 32 + 4 * fq;
#pragma unroll
        for (int ai = 0; ai < 2; ++ai)
#pragma unroll
            for (int m = 0; m < 4; ++m) { float* rowp = H + (size_t)(row0 + ai * HALF + m * 16) * ldc + col0; const float* srcp = Src + (size_t)(row0 + ai * HALF + m * 16) * ldc + col0;
                f32x4 old[2][2];
#pragma unroll
                for (int bj = 0; bj < 2; ++bj)
#pragma unroll
                    for (int n = 0; n < 2; ++n) old[bj][n] = *(const f32x4*)(srcp + bj * HALF + n * 16);
#pragma unroll
                for (int bj = 0; bj < 2; ++bj)
#pragma unroll
                    for (int n = 0; n < 2; ++n) *(f32x4*)(rowp + bj * HALF + n * 16) = old[bj][n] + acc[ai][bj][m][n]; }
    }
};
struct EpiGate8 {
    static constexpr bool PERM = true, AFTER_DRAIN = false;
    unsigned char* wsb;
    __device__ __forceinline__ void operator()(const f32x4 (&acc)[2][2][4][2], const Unit& u, int wr, int wc, int fr_, int fq_) const {
        (void)fr_; (void)fq_; int ln = (int)__builtin_amdgcn_workitem_id_x() & 63; asm volatile("" : "+v"(ln)); const int fr = ln & 15, fq = ln >> 4;
        const bf16_t* G = (const bf16_t*)(wsb + WS_GG); unsigned char* Hg = wsb + WS_HG8; const unsigned* Bm = (const unsigned*)(wsb + WS_BM); constexpr int ldc = NE;
        const int row0 = u.pm * BM + wr * 64 + fr, col0 = u.pn * BM + wc * 32 + 8 * fq;
#pragma unroll
        for (int ai = 0; ai < 2; ++ai)
#pragma unroll
            for (int m = 0; m < 4; ++m) { const size_t ro = (size_t)(row0 + ai * HALF + m * 16) * ldc + col0;
                const unsigned bits = Bm[(size_t)(row0 + ai * HALF + m * 16) * 64 + u.pn];
#pragma unroll
                for (int bj = 0; bj < 2; ++bj) {
                    u32x2 w = (u32x2){0u, 0u};
                    if ((bits >> (16 * bj + 4 * wc + fq)) & 1u) {
                        const u32x4 g = *(const u32x4*)(G + ro + bj * HALF);
                        const f32x4 v0 = acc[ai][bj][m][0], v1 = acc[ai][bj][m][1];
                        const f32x2 a = gelu_pk((f32x2){v0[0], v0[1]}), b = gelu_pk((f32x2){v0[2], v0[3]}), c = gelu_pk((f32x2){v1[0], v1[1]}), d = gelu_pk((f32x2){v1[2], v1[3]});
                        w.x = pk4_fp8(64.f * a.x * __uint_as_float(g.x << 16), 64.f * a.y * __uint_as_float(g.x & 0xffff0000u), 64.f * b.x * __uint_as_float(g.y << 16), 64.f * b.y * __uint_as_float(g.y & 0xffff0000u));
                        w.y = pk4_fp8(64.f * c.x * __uint_as_float(g.z << 16), 64.f * c.y * __uint_as_float(g.z & 0xffff0000u), 64.f * d.x * __uint_as_float(g.w << 16), 64.f * d.y * __uint_as_float(g.w & 0xffff0000u));
                    }
                    *(u32x2*)(Hg + ro + bj * HALF) = w;
                }
                __builtin_amdgcn_sched_barrier(0); }
    }
};
}

__device__ __forceinline__ void tr_load_tile(const float* W, int N, int k0, int n0, lfloat* scr, int lane) {
    const int q = lane & 15, r = lane >> 4;
    f32x4 v[16];
#pragma unroll
    for (int i = 0; i < 16; ++i) v[i] = *(const f32x4*)(W + (size_t)(k0 + r + 4 * i) * N + n0 + 4 * q);
#pragma unroll
    for (int i = 0; i < 16; ++i) { lfloat* d = scr + (r + 4 * i) * 65 + 4 * q; d[0] = v[i].x; d[1] = v[i].y; d[2] = v[i].z; d[3] = v[i].w; }
    LDS_WAIT();
}
__device__ __forceinline__ void transpose_item(const float* W, int N, bf16* WT, int Kp, int k0, int n0, int dst_row0, lfloat* scr, int lane) {
    tr_load_tile(W, N, k0, n0, scr, lane);
    const int c = lane & 7, nn = lane >> 3;
#pragma unroll
    for (int p = 0; p < 8; ++p) { const int n = 8 * p + nn; const lfloat* s = scr + (8 * c) * 65 + n;
        u32x4 o; o.x = pk2(s[0 * 65], s[1 * 65]); o.y = pk2(s[2 * 65], s[3 * 65]); o.z = pk2(s[4 * 65], s[5 * 65]); o.w = pk2(s[6 * 65], s[7 * 65]);
        *(u32x4*)(WT + (size_t)(dst_row0 + n) * Kp + k0 + 8 * c) = o; }
    LDS_WAIT();
}
__device__ __forceinline__ void transpose_item8(const float* W, int N, unsigned char* WT, int Kp, int k0, int n0, float sc, lfloat* scr, int lane) {
    tr_load_tile(W, N, k0, n0, scr, lane);
    const int c = lane & 3, nn = lane >> 2;
#pragma unroll
    for (int p = 0; p < 4; ++p) { const int n = 16 * p + nn; const lfloat* s = scr + (16 * c) * 65 + n;
        u32x4 o; o.x = pk4_fp8(s[0 * 65] * sc, s[1 * 65] * sc, s[2 * 65] * sc, s[3 * 65] * sc); o.y = pk4_fp8(s[4 * 65] * sc, s[5 * 65] * sc, s[6 * 65] * sc, s[7 * 65] * sc);
        o.z = pk4_fp8(s[8 * 65] * sc, s[9 * 65] * sc, s[10 * 65] * sc, s[11 * 65] * sc); o.w = pk4_fp8(s[12 * 65] * sc, s[13 * 65] * sc, s[14 * 65] * sc, s[15 * 65] * sc);
        *(u32x4*)(WT + (size_t)(n0 + n) * Kp + k0 + 16 * c) = o; }
    LDS_WAIT();
}
__device__ __forceinline__ void norm_row(const float* src, const float* gain, bf16* dst, float* hdst, int lane, unsigned char* dst8 = nullptr) {
    const f32x4* xr = (const f32x4*)src + lane;
    f32x4 v[16]; float ss = 0.f;
#pragma unroll
    for (int j = 0; j < 16; ++j) { v[j] = xr[64 * j]; ss += (v[j].x * v[j].x + v[j].y * v[j].y) + (v[j].z * v[j].z + v[j].w * v[j].w); }
    ss = wave_sum(ss);
    const float r = rsqrtf(ss * (1.0f / 4096.0f) + 1e-5f);
    const f32x4* gr = (const f32x4*)gain + lane;
    u32x2* o8 = (u32x2*)dst + lane;
#pragma unroll
    for (int j = 0; j < 16; ++j) { const f32x4 g = gr[64 * j]; const f32x4 y = (f32x4){v[j].x * r * g.x, v[j].y * r * g.y, v[j].z * r * g.z, v[j].w * r * g.w};
        u32x2 o; o.x = pk2(y.x, y.y); o.y = pk2(y.z, y.w); o8[64 * j] = o;
        if (dst8) ((unsigned*)dst8)[lane + 64 * j] = pk4_fp8(y.x, y.y, y.z, y.w); }
    if (hdst) { f32x4* hr = (f32x4*)hdst + lane;
#pragma unroll
        for (int j = 0; j < 16; ++j) hr[64 * j] = v[j]; }
}

#define ROW_LOAD16(v_, p_) do { const f32x4* xr_ = (const f32x4*)(p_) + lane; _Pragma("unroll") for (int j_ = 0; j_ < 16; ++j_) v_[j_] = xr_[64 * j_]; } while (0)
__device__ __forceinline__ void norm_row_fin(const f32x4 (&v)[16], const f32x4 (&gn)[16], bf16* dst, float* hdst, int lane, unsigned char* dst8) {
    float ss = 0.f;
#pragma unroll
    for (int j = 0; j < 16; ++j) ss += (v[j].x * v[j].x + v[j].y * v[j].y) + (v[j].z * v[j].z + v[j].w * v[j].w);
    ss = wave_sum(ss);
    const float r = rsqrtf(ss * (1.0f / 4096.0f) + 1e-5f);
    u32x2* o8 = (u32x2*)dst + lane;
#pragma unroll
    for (int j = 0; j < 16; ++j) { const f32x4 g = gn[j]; const f32x4 y = (f32x4){v[j].x * r * g.x, v[j].y * r * g.y, v[j].z * r * g.z, v[j].w * r * g.w};
        u32x2 o; o.x = pk2(y.x, y.y); o.y = pk2(y.z, y.w); o8[64 * j] = o;
        if (dst8) ((unsigned*)dst8)[lane + 64 * j] = pk4_fp8(y.x, y.y, y.z, y.w); }
    if (hdst) { f32x4* hr = (f32x4*)hdst + lane;
#pragma unroll
        for (int j = 0; j < 16; ++j) hr[64 * j] = v[j]; }
}
template <class SrcOf, class Fin>
__device__ __forceinline__ void rows_pipe(int first, int stride, int n, int lane, SrcOf src_of, Fin fin) {
    f32x4 va[16], vb[16];
    int m = first;
    if (m < n) ROW_LOAD16(va, src_of(m));
    while (m < n) {
        const int m2 = m + stride;
        if (m2 < n) ROW_LOAD16(vb, src_of(m2));
        fin(va, m);
        if (m2 >= n) break;
        const int m3 = m2 + stride;
        if (m3 < n) ROW_LOAD16(va, src_of(m3));
        fin(vb, m2);
        m = m3;
    }
}

__device__ __forceinline__ void phase_conv_norm(int l_, LAS unsigned char* lds_) {
    LOAD_CTX(); const int l = UNI(l_); LAS unsigned char* lds = UNI_LDS(lds_);
    const int tid = ltid(), lane = tid & 63, wave = tid >> 6;
    const int gw = blockIdx.x * 8 + wave, NGW = gridDim.x * 8;
    unsigned char* ws = C.ws;
    bf16* WinT = (bf16*)(ws + WS_WIN); bf16* WoT = (bf16*)(ws + WS_WO); bf16* WsT = (bf16*)(ws + WS_WS); unsigned char* U8 = ws + WS_U; unsigned char* VT8 = ws + WS_VT;
    float* H = (float*)(ws + WS_H); bf16* Z = (bf16*)(ws + WS_Z);
    const float* w_in = C.in[I_WIN] + (size_t)l * DM * 10880;
    const float* w_out = C.in[I_WOUT] + (size_t)l * DM * DM;
    const float* wq = C.in[I_WQ] + (size_t)l * DM * 2048;
    const float* keys = C.in[I_KEYS] + (size_t)l * 16 * 128 * 128;
    const float* pu = C.in[I_PU] + (size_t)l * NE * DM;
    const float* pv = C.in[I_PV] + (size_t)l * NE * DM;
    lfloat* scr = (lfloat*)(lds + wave * 16896);
    constexpr int I_WIN_N = 64 * 170, I_WO_N = 64 * 64, I_VT_N = 256 * 64, I_U_N = 8192, I_ZW_N = 64, I_NORM_N = TT, I_ZP_N = MP - TT;
    constexpr int NITEMS = I_WIN_N + I_WO_N + I_VT_N + I_U_N + I_ZW_N + I_NORM_N + I_ZP_N;
    {
        const int gwu = UNI(gw);
        f32x4 gn[16]; { const f32x4* gr = (const f32x4*)(C.in[I_NMIX] + (l == 0 ? 0 : DM)) + lane;
#pragma unroll
            for (int j = 0; j < 16; ++j) gn[j] = gr[64 * j]; }
        rows_pipe(gwu, NGW, I_NORM_N, lane,
            [&](int m) -> const float* { if (l != 0) return H + (size_t)m * DM;
                const int b = m < MAIN_ROWS ? (m >> 12) : ((m - MAIN_ROWS) >> 4), t = m < MAIN_ROWS ? (m & 4095) + NMETA : ((m - MAIN_ROWS) & 15);
                return (t < NMETA) ? C.in[I_META] + (size_t)t * DM : C.in[I_X] + ((size_t)b * 4096 + (t - NMETA)) * DM; },
            [&](const f32x4 (&v)[16], int m) { norm_row_fin(v, gn, Z + (size_t)m * DM, (l == 0 && m >= MAIN_ROWS) ? H + (size_t)m * DM : nullptr, lane, nullptr); });
    }
    int it0 = gw; while (it0 < I_NORM_N) it0 += NGW;
    for (int it = it0; it < NITEMS; it += NGW) {
        int r = it;
        r -= I_NORM_N;
        if (r < I_ZP_N) {
            const int m = TT + r; u32x4* z = (u32x4*)(Z + (size_t)m * DM) + lane;
#pragma unroll
            for (int j = 0; j < 8; ++j) z[64 * j] = (u32x4){0u, 0u, 0u, 0u};
            if (l == 0) { f32x4* hz = (f32x4*)(H + (size_t)m * DM) + lane;
#pragma unroll
                for (int j = 0; j < 16; ++j) hz[64 * j] = (f32x4){0.f, 0.f, 0.f, 0.f}; }
            continue; }
        r -= I_ZP_N;
        if (r < I_WIN_N) { const int kb = r / 170, nb = r % 170, n0 = 64 * nb; transpose_item(w_in, 10880, WinT, DM, 64 * kb, n0, n0 < 6784 ? n0 : n0 + 128, scr, lane); continue; }
        r -= I_WIN_N;
        if (r < I_WO_N) { const int kb = r / 64, nb = r % 64; transpose_item8(w_out, DM, ws + WS_WO8, DM, 64 * kb, 64 * nb, WO8_SCALE, scr, lane);
            if (l == 0) transpose_item(w_out, DM, WoT, DM, 64 * kb, 64 * nb, 64 * nb, scr, lane);
            continue; }
        r -= I_WO_N;
        if (r < I_VT_N) { const int kb = r / 64, nb = r % 64; transpose_item8(pv, DM, VT8, NE, 64 * kb, 64 * nb, V8_SCALE, scr, lane); continue; }
        r -= I_VT_N;
        if (r < I_U_N) {
            const size_t e0 = (size_t)r * 8192;
#pragma unroll 2
            for (int j = 0; j < 8; ++j) { const size_t e = e0 + (size_t)(j * 64 + lane) * 16;
                const f32x4 a = *(const f32x4*)(pu + e), b2 = *(const f32x4*)(pu + e + 4), c2 = *(const f32x4*)(pu + e + 8), d2 = *(const f32x4*)(pu + e + 12);
                u32x4 o; o.x = pk4_fp8(a.x * U8_SCALE, a.y * U8_SCALE, a.z * U8_SCALE, a.w * U8_SCALE); o.y = pk4_fp8(b2.x * U8_SCALE, b2.y * U8_SCALE, b2.z * U8_SCALE, b2.w * U8_SCALE);
                o.z = pk4_fp8(c2.x * U8_SCALE, c2.y * U8_SCALE, c2.z * U8_SCALE, c2.w * U8_SCALE); o.w = pk4_fp8(d2.x * U8_SCALE, d2.y * U8_SCALE, d2.z * U8_SCALE, d2.w * U8_SCALE);
                *(u32x4*)(U8 + e) = o; }
            continue; }
        r -= I_U_N;
        {
            u32x4* z = (u32x4*)(WinT + (size_t)6784 * DM) + (size_t)r * 1024 + lane;
#pragma unroll
            for (int j = 0; j < 16; ++j) z[64 * j] = (u32x4){0u, 0u, 0u, 0u};
        }
    }
    {
        bf16* LW = (bf16*)(ws + WS_LW);
        const float* w2 = C.in[I_W2] + (size_t)l * 64 * 1536; const float* a2 = C.in[I_A2] + (size_t)l * 64 * 1536; const float* g2 = C.in[I_G2] + (size_t)l * 128 * 1536;
        for (int e = blockIdx.x * 512 + tid; e < 256 * 1536; e += gridDim.x * 512) { const int k = e / 1536, n = e - k * 1536;
            const float v = k < 64 ? w2[k * 1536 + n] : (k < 128 ? a2[(k - 64) * 1536 + n] : g2[(k - 128) * 1536 + n]);
            LW[n * 256 + k] = (bf16)f2bf(v); }
    }
    {
        const int wv = UNI(tid >> 6), fr = lane & 15, g4 = lane >> 4;
        for (int u = blockIdx.x; u < 1024; u += gridDim.x) {
            const int hc = u >> 6, k0 = (u & 63) * 64;
            const float* kp_ = keys + (size_t)hc * 16384 + (size_t)(16 * wv + fr) * 128 + 8 * g4;
            pg8::bf16x8 Af[4];
#pragma unroll
            for (int ks = 0; ks < 4; ++ks) { const f32x4 x = *(const f32x4*)(kp_ + 32 * ks), y = *(const f32x4*)(kp_ + 32 * ks + 4);
                const u32x4 wq_ = (u32x4){pk2(x.x, x.y), pk2(x.z, x.w), pk2(y.x, y.y), pk2(y.z, y.w)}; Af[ks] = (pg8::bf16x8)wq_; }
#pragma unroll
            for (int nt = 0; nt < 4; ++nt) {
                const float* wp = wq + (size_t)(k0 + 16 * nt + fr) * 2048 + hc * 128 + 8 * g4;
                f32x4 d = (f32x4){0.f, 0.f, 0.f, 0.f};
#pragma unroll
                for (int ks = 0; ks < 4; ++ks) { const f32x4 x = *(const f32x4*)(wp + 32 * ks), y = *(const f32x4*)(wp + 32 * ks + 4);
                    const u32x4 bw = (u32x4){pk2(x.x, x.y), pk2(x.z, x.w), pk2(y.x, y.y), pk2(y.z, y.w)};
                    d = __builtin_amdgcn_mfma_f32_16x16x32_bf16(Af[ks], (pg8::bf16x8)bw, d, 0, 0, 0); }
#pragma unroll
                for (int r = 0; r < 4; ++r) WsT[(size_t)(hc * 128 + 16 * wv + 4 * g4 + r) * DM + k0 + 16 * nt + fr] = (bf16)f2bf(d[r]);
            }
        }
    }
}

__device__ __forceinline__ void swa_unit(int l_, int u_, LAS unsigned char* lds_) {
    LOAD_CTX(); const int l = UNI(l_), u = UNI(u_); LAS unsigned char* lds = UNI_LDS(lds_);
    const int tid = ltid(), lane = tid & 63, wave = UNI(tid >> 6);
    const int qtile = u % 129, hk = (u / 129) % 3, b = u / 387;
    const int t0 = qtile * 32, lo = t0 - 127;
    const bf16* proj = (const bf16*)(C.ws + WS_PROJ);
    bf16* mixed = (bf16*)(C.ws + WS_Z);
    LAS bf16* Ks = (LAS bf16*)lds;
    LAS bf16* Vt = (LAS bf16*)(lds + 27648);
    LAS bf16* Qs = (LAS bf16*)(lds + 53248);
    __syncthreads();
#define SWA_ROPE8(dst, x, y, pos, first) do { _Pragma("unroll") for (int j_ = 0; j_ < 8; ++j_) { float sn_, cs_; rope_sc((float)(pos), j_, sn_, cs_); dst[j_] = (first) ? x[j_] * cs_ - y[j_] * sn_ : x[j_] * cs_ + y[j_] * sn_; } } while (0)
#define SWA_UNPK(dst, vec_) do { dst[0] = bf2f(vec_.x & 0xffffu); dst[1] = bf2f(vec_.x >> 16); dst[2] = bf2f(vec_.y & 0xffffu); dst[3] = bf2f(vec_.y >> 16); dst[4] = bf2f(vec_.z & 0xffffu); dst[5] = bf2f(vec_.z >> 16); dst[6] = bf2f(vec_.w & 0xffffu); dst[7] = bf2f(vec_.w >> 16); } while (0)
#pragma unroll
    for (int i = 0; i < 3; ++i) {
        const int task = tid + 512 * i, s = task >> 3, c = task & 7;
        const int ut = s < 16 ? s : lo + s - 16;
        const bool ok = (s < 16) || (s < 176 && ut >= 16 && ut < LT);
        u32x4 w = (u32x4){0u, 0u, 0u, 0u};
        if (ok) { const bf16* pr = proj + (size_t)ROWOF(b, ut) * PN + C_SK + hk * 64;
            w = *(const u32x4*)(pr + 8 * c);
            if (c < 2) { const u32x4 wo = *(const u32x4*)(pr + 8 * (c ^ 1)); float x[8], y[8], z[8]; SWA_UNPK(x, w); SWA_UNPK(y, wo); SWA_ROPE8(z, x, y, ut, c == 0);
                w.x = pk2(z[0], z[1]); w.y = pk2(z[2], z[3]); w.z = pk2(z[4], z[5]); w.w = pk2(z[6], z[7]); } }
        *(LAS u32x4*)(Ks + s * 72 + 8 * c) = w;
    }
#pragma unroll
    for (int i = 0; i < 3; ++i) {
        const int task = tid + 512 * i, s = task >> 3, c = task & 7;
        const int ut = s < 16 ? s : lo + s - 16;
        const bool ok = (s < 16) || (s < 176 && ut >= 16 && ut < LT);
        u32x4 w = (u32x4){0u, 0u, 0u, 0u};
        if (ok) w = *(const u32x4*)(proj + (size_t)ROWOF(b, ut) * PN + C_SV + hk * 64 + 8 * c);
        LAS bf16* vp = Vt + (8 * c) * 200 + s;
        vp[0] = (bf16)(w.x & 0xffffu); vp[200] = (bf16)(w.x >> 16); vp[400] = (bf16)(w.y & 0xffffu); vp[600] = (bf16)(w.y >> 16);
        vp[800] = (bf16)(w.z & 0xffffu); vp[1000] = (bf16)(w.z >> 16); vp[1200] = (bf16)(w.w & 0xffffu); vp[1400] = (bf16)(w.w >> 16);
    }
#pragma unroll
    for (int i = 0; i < 4; ++i) {
        const int task = tid + 512 * i, row = task >> 3, c = task & 7, g = row >> 5, t = t0 + (row & 31);
        u32x4 w = (u32x4){0u, 0u, 0u, 0u};
        if (t < LT) { const bf16* qp = proj + (size_t)ROWOF(b, t) * PN + C_SQ + (hk * 8 + g) * 64;
            w = *(const u32x4*)(qp + 8 * c);
            float x[8], z[8]; SWA_UNPK(x, w);
            if (c < 2) { const u32x4 wo = *(const u32x4*)(qp + 8 * (c ^ 1)); float y[8]; SWA_UNPK(y, wo); SWA_ROPE8(z, x, y, t, c == 0); }
            else {
#pragma unroll
                for (int j = 0; j < 8; ++j) z[j] = x[j]; }
            w.x = pk2(z[0] * 0.125f, z[1] * 0.125f); w.y = pk2(z[2] * 0.125f, z[3] * 0.125f); w.z = pk2(z[4] * 0.125f, z[5] * 0.125f); w.w = pk2(z[6] * 0.125f, z[7] * 0.125f); }
        *(LAS u32x4*)(Qs + row * 72 + 8 * c) = w;
    }
#undef SWA_ROPE8
#undef SWA_UNPK
    __syncthreads();
    const int fr = lane & 15, g4 = lane >> 4;
    const int hq = hk * 8 + wave;
    const float sink = C.in[I_SINK][l * 24 + hq];
    pg8::bf16x8 Qf[2][2];
#pragma unroll
    for (int qt = 0; qt < 2; ++qt)
#pragma unroll
        for (int ks = 0; ks < 2; ++ks) Qf[qt][ks] = *(const LAS pg8::bf16x8*)(Qs + (wave * 32 + 16 * qt + fr) * 72 + 32 * ks + 8 * g4);
    f32x4 sc[12][2];
#pragma unroll
    for (int kt = 0; kt < 12; ++kt) {
        const pg8::bf16x8 k0 = *(const LAS pg8::bf16x8*)(Ks + (16 * kt + fr) * 72 + 8 * g4), k1 = *(const LAS pg8::bf16x8*)(Ks + (16 * kt + fr) * 72 + 32 + 8 * g4);
#pragma unroll
        for (int qt = 0; qt < 2; ++qt) { f32x4 a = (f32x4){0.f, 0.f, 0.f, 0.f};
            a = __builtin_amdgcn_mfma_f32_16x16x32_bf16(k0, Qf[qt][0], a, 0, 0, 0); a = __builtin_amdgcn_mfma_f32_16x16x32_bf16(k1, Qf[qt][1], a, 0, 0, 0); sc[kt][qt] = a; }
    }
    float inv[2];
    pg8::bf16x8 Pf[2][6];
#pragma unroll
    for (int qt = 0; qt < 2; ++qt) {
        const int t = t0 + 16 * qt + fr; const bool tv = t < LT;
        float m = sink;
#pragma unroll
        for (int kt = 0; kt < 12; ++kt)
#pragma unroll
            for (int r = 0; r < 4; ++r) { const int s = 16 * kt + 4 * g4 + r; const int uu = lo + s - 16;
                const bool ok = tv && (kt == 0 ? (s <= t) : (uu >= 16 && uu <= t && uu >= t - 127));
                const float v = ok ? sc[kt][qt][r] : -1.0e30f; sc[kt][qt][r] = v; m = fmaxf(m, v); }
        m = fmaxf(m, __shfl_xor(m, 16)); m = fmaxf(m, __shfl_xor(m, 32));
        float ls = 0.f;
#pragma unroll
        for (int kt = 0; kt < 12; ++kt)
#pragma unroll
            for (int r = 0; r < 4; ++r) { const float p = __expf(sc[kt][qt][r] - m); sc[kt][qt][r] = p; ls += p; }
        ls += __shfl_xor(ls, 16); ls += __shfl_xor(ls, 32);
        ls += __expf(sink - m);
        inv[qt] = 1.0f / ls;
#pragma unroll
        for (int s2 = 0; s2 < 6; ++s2) { const f32x4 pa = sc[2 * s2][qt], pb = sc[2 * s2 + 1][qt];
            u32x4 w; w.x = pk2(pa[0], pa[1]); w.y = pk2(pa[2], pa[3]); w.z = pk2(pb[0], pb[1]); w.w = pk2(pb[2], pb[3]);
            Pf[qt][s2] = (pg8::bf16x8)w; }
    }
    f32x4 o[4][2];
#pragma unroll
    for (int dt = 0; dt < 4; ++dt) { o[dt][0] = (f32x4){0.f, 0.f, 0.f, 0.f}; o[dt][1] = (f32x4){0.f, 0.f, 0.f, 0.f}; }
#pragma unroll
    for (int dt = 0; dt < 4; ++dt)
#pragma unroll
        for (int s2 = 0; s2 < 6; ++s2) {
            const u32x2 va = *(const LAS u32x2*)(Vt + (16 * dt + fr) * 200 + 32 * s2 + 4 * g4), vb = *(const LAS u32x2*)(Vt + (16 * dt + fr) * 200 + 32 * s2 + 16 + 4 * g4);
            const u32x4 vw = (u32x4){va.x, va.y, vb.x, vb.y};
            const pg8::bf16x8 vf = (pg8::bf16x8)vw;
            o[dt][0] = __builtin_amdgcn_mfma_f32_16x16x32_bf16(vf, Pf[0][s2], o[dt][0], 0, 0, 0);
            o[dt][1] = __builtin_amdgcn_mfma_f32_16x16x32_bf16(vf, Pf[1][s2], o[dt][1], 0, 0, 0);
        }
#pragma unroll
    for (int qt = 0; qt < 2; ++qt) { const int t = t0 + 16 * qt + fr;
        if (t < LT) { bf16* op = mixed + (size_t)ROWOF(b, t) * DM + 1536 + hq * 64 + 4 * g4;
#pragma unroll
            for (int dt = 0; dt < 4; ++dt) { const f32x4 v = o[dt][qt] * inv[qt]; if (t < NMETA) { u32x2 w; w.x = pk2(v[0], v[1]); w.y = pk2(v[2], v[3]); *(u32x2*)(op + 16 * dt) = w; }
                *(unsigned*)(C.ws + WS_MX8 + (size_t)ROWOF(b, t) * DM + 1536 + hq * 64 + 4 * g4 + 16 * dt) = pk4_fp8(v[0] * MX8_SCALE, v[1] * MX8_SCALE, v[2] * MX8_SCALE, v[3] * MX8_SCALE); } }
    }
}

__device__ __forceinline__ void hgrn_local_unit(int l_, int u_, LAS unsigned char* lds_) {
    LOAD_CTX(); const int l = UNI(l_), u = UNI(u_); LAS unsigned char* lds = UNI_LDS(lds_);
    const int tid = ltid(), lane = tid & 63, wave = UNI(tid >> 6);
    const int bh = u / 65, c = u % 65 + 1, b = bh >> 3, h = bh & 7;
    const bf16* proj = (const bf16*)(C.ws + WS_PROJ);
    bf16* HDS = (bf16*)(C.ws + WS_HDS); bf16* HQG = (bf16*)(C.ws + WS_HQG); float* HAT = (float*)(C.ws + WS_HAT); float* HED = (float*)(C.ws + WS_HED);
    lfloat* qs = (lfloat*)lds; lfloat* kvs = qs + 8192; lfloat* Gs = qs + 16384;
    LAS bf16* iT = (LAS bf16*)(lds + 98304);
    LAS unsigned char* shr = lds + 116736;
    lfloat* segtot = (lfloat*)shr; LAS bf16* QK = (LAS bf16*)shr; LAS bf16* kdT = (LAS bf16*)shr;
    const int k = tid & 127, seg = tid >> 7;
    const int fr = lane & 15, g4 = lane >> 4;
    float lb = 0.f;
    if (l == 1) { const float a0 = C.in[I_HLB][h * 128 + k], a1 = C.in[I_HLB][1024 + h * 128 + k]; lb = 1.0f / (1.0f + __expf(a0 - a1)); }
    __syncthreads();
    float gl[16]; float run = 0.f;
#pragma unroll
    for (int r = 0; r < 16; ++r) {
        const int tl = 16 * seg + r, t = 64 * c + tl - 112;
        float qv = 0.f, kv = 0.f, lf = 0.f; unsigned ib = 0u;
        if (t >= 0 && t < LT) { const bf16* pr = proj + (size_t)ROWOF(b, t) * PN + h * 128 + k;
            qv = bf2f(pr[C_HQ]); const float frw = bf2f(pr[C_HF]); ib = pr[C_HI];
            const float f = lb + (1.0f - lb) * sigmoidf_(frw); lf = __logf(f); kv = 1.0f - f; }
        run += lf; gl[r] = run;
        qs[tl * 128 + k] = qv; kvs[tl * 128 + k] = kv; iT[k * 72 + tl] = (bf16)ib;
    }
    segtot[seg * 128 + k] = run;
    __syncthreads();
    float off = 0.f;
    for (int s2 = 0; s2 < seg; ++s2) off += segtot[s2 * 128 + k];
#pragma unroll
    for (int r = 0; r < 16; ++r) Gs[(16 * seg + r) * 128 + k] = gl[r] + off;
    __syncthreads();
    const size_t uc = (size_t)bh * NCH + c;
    float* at = HAT + uc * 4096;
    for (int e = tid; e < 4096; e += 512) { const int t_ = e >> 6, s_ = e & 63; if (s_ > t_) at[e] = 0.f; }
    if (tid < 480) {
        const int blk = tid / 120, q = tid - blk * 120;
        int tt = (int)((1.0f + sqrtf(1.0f + 8.0f * (float)q)) * 0.5f);
        if (tt * (tt - 1) / 2 > q) --tt; if ((tt + 1) * tt / 2 <= q) ++tt;
        const int ss = q - tt * (tt - 1) / 2, t_ = 16 * blk + tt, s_ = 16 * blk + ss;
        float acc = 0.f;
        for (int kk = 0; kk < 128; ++kk) { const int k2 = (kk + lane) & 127;
            acc += qs[t_ * 128 + k2] * kvs[s_ * 128 + k2] * __expf(Gs[t_ * 128 + k2] - Gs[s_ * 128 + k2]); }
        at[t_ * 64 + s_] = acc;
    }
    if (tid >= 448) {
        const int t_ = tid - 448; float acc = 0.f;
        for (int kk = 0; kk < 128; ++kk) { const int k2 = (kk + lane) & 127; acc += qs[t_ * 128 + k2] * kvs[t_ * 128 + k2]; }
        at[t_ * 64 + t_] = acc;
    }
#pragma unroll 1
    for (int pass = 0; pass < 2; ++pass) {
        __syncthreads();
#pragma unroll 4
        for (int i = 0; i < 16; ++i) { const int e = tid + 512 * i, row = e >> 7, kx = e & 127;
            int src, ref; bool isq = row < 32;
            if (pass == 0) { src = isq ? 32 + row : row - 32; ref = 31; }
            else { const int r16 = row & 15, hi = (row >> 4) & 1; src = isq ? (hi ? 48 + r16 : 16 + r16) : (hi ? 32 + r16 : r16); ref = hi ? 47 : 15; }
            const float gr = Gs[ref * 128 + kx], gs_ = Gs[src * 128 + kx];
            const float v = isq ? qs[src * 128 + kx] * __expf(gs_ - gr) : kvs[src * 128 + kx] * __expf(gr - gs_);
            QK[row * 136 + kx] = (bf16)f2bf(v); }
        __syncthreads();
        const int ntile = pass == 0 ? 4 : 2;
        if (wave < ntile) {
            const int qrow = pass == 0 ? 16 * (wave >> 1) : 16 * wave, krow = pass == 0 ? 32 + 16 * (wave & 1) : 32 + 16 * wave;
            const int I = pass == 0 ? 2 + (wave >> 1) : (wave == 0 ? 1 : 3), J = pass == 0 ? (wave & 1) : (wave == 0 ? 0 : 2);
            f32x4 d = (f32x4){0.f, 0.f, 0.f, 0.f};
#pragma unroll
            for (int ks = 0; ks < 4; ++ks) { const pg8::bf16x8 a = *(const LAS pg8::bf16x8*)(QK + (qrow + fr) * 136 + 32 * ks + 8 * g4), bb = *(const LAS pg8::bf16x8*)(QK + (krow + fr) * 136 + 32 * ks + 8 * g4);
                d = __builtin_amdgcn_mfma_f32_16x16x32_bf16(a, bb, d, 0, 0, 0); }
#pragma unroll
            for (int r = 0; r < 4; ++r) at[(16 * I + 4 * g4 + r) * 64 + 16 * J + fr] = d[r];
        }
    }
    __syncthreads();
    for (int e = tid; e < 8192; e += 512) { const int s_ = e >> 7, kx = e & 127; const float ge = Gs[e];
        HQG[uc * 8192 + e] = (bf16)f2bf(qs[e] * __expf(ge));
        kdT[kx * 72 + s_] = (bf16)f2bf(kvs[e] * __expf(Gs[63 * 128 + kx] - ge)); }
    if (tid < 128) HED[uc * 128 + tid] = __expf(Gs[63 * 128 + tid]);
    __syncthreads();
    {
        const pg8::bf16x8 a0 = *(const LAS pg8::bf16x8*)(kdT + (16 * wave + fr) * 72 + 8 * g4), a1 = *(const LAS pg8::bf16x8*)(kdT + (16 * wave + fr) * 72 + 32 + 8 * g4);
        f32x4 dd[8];
#pragma unroll
        for (int nt = 0; nt < 8; ++nt) {
            const pg8::bf16x8 b0 = *(const LAS pg8::bf16x8*)(iT + (8 * fr + nt) * 72 + 8 * g4), b1 = *(const LAS pg8::bf16x8*)(iT + (8 * fr + nt) * 72 + 32 + 8 * g4);
            f32x4 d = (f32x4){0.f, 0.f, 0.f, 0.f};
            d = __builtin_amdgcn_mfma_f32_16x16x32_bf16(a0, b0, d, 0, 0, 0); d = __builtin_amdgcn_mfma_f32_16x16x32_bf16(a1, b1, d, 0, 0, 0);
            dd[nt] = d;
        }
#pragma unroll
        for (int r = 0; r < 4; ++r) { u32x4 w; w.x = pk2(dd[0][r], dd[1][r]); w.y = pk2(dd[2][r], dd[3][r]); w.z = pk2(dd[4][r], dd[5][r]); w.w = pk2(dd[6][r], dd[7][r]);
            *(u32x4*)(HDS + (uc * 128 + 16 * wave + 4 * g4 + r) * 128 + 8 * fr) = w; }
    }
}

__device__ __forceinline__ void rwkv_chunk_prep(const Ctx& C, int bh, int c, int lane, LAS unsigned char* wl) {
    float* RAc = (float*)(C.ws + WS_RA) + ((size_t)bh * LT + 16 * c) * 384;
    unsigned char* chb = C.ws + WS_CHB + ((size_t)bh * 257 + c) * 1280;
    LAS bf16* AbS = (LAS bf16*)(wl + 4608); LAS bf16* RbS = AbS + 16 * 72; LAS bf16* BtS = RbS + 16 * 72; LAS bf16* KtS = BtS + 16 * 72;
    float kk[16], w[16], ka[16], kp[16], rr[16], vv[16];
#pragma unroll
    for (int i = 0; i < 16; ++i) { const float* p = RAc + i * 384 + lane; kk[i] = p[0]; w[i] = p[64]; ka[i] = p[128]; kp[i] = p[192]; rr[i] = p[256]; vv[i] = p[320]; }
    float g = 1.0f; float bp[16], kq[16];
#pragma unroll
    for (int i = 0; i < 16; ++i) { const float gprev = g; g *= w[i]; const float ig = 1.0f / g;
        const float ab = -kk[i] * gprev, rb = rr[i] * g, bt = ka[i] * ig, kt = kp[i] * ig;
        AbS[i * 72 + lane] = (bf16)f2bf(ab); RbS[i * 72 + lane] = (bf16)f2bf(rb); BtS[i * 72 + lane] = (bf16)f2bf(bt); KtS[i * 72 + lane] = (bf16)f2bf(kt);
        bp[i] = bt; kq[i] = kt;
        unsigned short* rec = (unsigned short*)(RAc + i * 384);
        rec[lane] = (unsigned short)f2bf(ab); rec[64 + lane] = (unsigned short)f2bf(rb); }
    const float gC = g;
    {
        u32x4 o0, o1, q0, q1;
        o0.x = pk2(bp[0] * gC, bp[1] * gC); o0.y = pk2(bp[2] * gC, bp[3] * gC); o0.z = pk2(bp[4] * gC, bp[5] * gC); o0.w = pk2(bp[6] * gC, bp[7] * gC);
        o1.x = pk2(bp[8] * gC, bp[9] * gC); o1.y = pk2(bp[10] * gC, bp[11] * gC); o1.z = pk2(bp[12] * gC, bp[13] * gC); o1.w = pk2(bp[14] * gC, bp[15] * gC);
        q0.x = pk2(kq[0] * gC, kq[1] * gC); q0.y = pk2(kq[2] * gC, kq[3] * gC); q0.z = pk2(kq[4] * gC, kq[5] * gC); q0.w = pk2(kq[6] * gC, kq[7] * gC);
        q1.x = pk2(kq[8] * gC, kq[9] * gC); q1.y = pk2(kq[10] * gC, kq[11] * gC); q1.z = pk2(kq[12] * gC, kq[13] * gC); q1.w = pk2(kq[14] * gC, kq[15] * gC);
        unsigned char* rb_ = (unsigned char*)(RAc + (lane >> 3) * 384) + 512 + (lane & 7) * 32;
        *(u32x4*)rb_ = o0; *(u32x4*)(rb_ + 16) = o1;
        unsigned char* rk_ = (unsigned char*)(RAc + (8 + (lane >> 3)) * 384) + 512 + (lane & 7) * 32;
        *(u32x4*)rk_ = q0; *(u32x4*)(rk_ + 16) = q1;
        ((float*)(chb + 1024))[lane] = gC;
    }
    LDS_WAIT();
    const int fr = lane & 15, g4 = lane >> 4;
    lfloat* AabM = (lfloat*)wl; lfloat* AakM = AabM + 16 * 17; lfloat* BrkM = AakM + 16 * 17; lfloat* TM = BrkM + 16 * 17;
    {
        const pg8::bf16x8 a0 = *(const LAS pg8::bf16x8*)(AbS + fr * 72 + 8 * g4), a1 = *(const LAS pg8::bf16x8*)(AbS + fr * 72 + 32 + 8 * g4);
        const pg8::bf16x8 r0 = *(const LAS pg8::bf16x8*)(RbS + fr * 72 + 8 * g4), r1 = *(const LAS pg8::bf16x8*)(RbS + fr * 72 + 32 + 8 * g4);
        const pg8::bf16x8 b0 = *(const LAS pg8::bf16x8*)(BtS + fr * 72 + 8 * g4), b1 = *(const LAS pg8::bf16x8*)(BtS + fr * 72 + 32 + 8 * g4);
        const pg8::bf16x8 k0 = *(const LAS pg8::bf16x8*)(KtS + fr * 72 + 8 * g4), k1 = *(const LAS pg8::bf16x8*)(KtS + fr * 72 + 32 + 8 * g4);
        const f32x4 z = (f32x4){0.f, 0.f, 0.f, 0.f};
        f32x4 aab = __builtin_amdgcn_mfma_f32_16x16x32_bf16(a0, b0, z, 0, 0, 0); aab = __builtin_amdgcn_mfma_f32_16x16x32_bf16(a1, b1, aab, 0, 0, 0);
        f32x4 aak = __builtin_amdgcn_mfma_f32_16x16x32_bf16(a0, k0, z, 0, 0, 0); aak = __builtin_amdgcn_mfma_f32_16x16x32_bf16(a1, k1, aak, 0, 0, 0);
        f32x4 brb = __builtin_amdgcn_mfma_f32_16x16x32_bf16(r0, b0, z, 0, 0, 0); brb = __builtin_amdgcn_mfma_f32_16x16x32_bf16(r1, b1, brb, 0, 0, 0);
        f32x4 brk = __builtin_amdgcn_mfma_f32_16x16x32_bf16(r0, k0, z, 0, 0, 0); brk = __builtin_amdgcn_mfma_f32_16x16x32_bf16(r1, k1, brk, 0, 0, 0);
#pragma unroll
        for (int r = 0; r < 4; ++r) { const int t = 4 * g4 + r, s = fr;
            AabM[t * 17 + s] = s < t ? aab[r] : 0.f; AakM[t * 17 + s] = s < t ? aak[r] : 0.f; BrkM[t * 17 + s] = s <= t ? brk[r] : 0.f;
            *(unsigned short*)(chb + 512 + t * 32 + s * 2) = (unsigned short)f2bf(s <= t ? brb[r] : 0.f); }
    }
    const int t_ = lane >> 2, s0 = 4 * (lane & 3);
    LDS_WAIT();
    if (lane < 16) {
        float tc[16];
#pragma unroll
        for (int t = 0; t < 16; ++t) { float acc = (t == lane) ? 1.0f : 0.0f;
#pragma unroll
            for (int s = 0; s < t; ++s) acc += AabM[t * 17 + s] * tc[s];
            tc[t] = acc; TM[t * 17 + lane] = acc; }
    }
    LDS_WAIT();
    { u32x2 wv; wv.x = pk2(TM[t_ * 17 + s0], TM[t_ * 17 + s0 + 1]); wv.y = pk2(TM[t_ * 17 + s0 + 2], TM[t_ * 17 + s0 + 3]); *(u32x2*)(chb + t_ * 32 + s0 * 2) = wv; }
#pragma unroll
    for (int t = 0; t < 16; ++t) { float p1 = 0.f, p2 = 0.f;
#pragma unroll
        for (int s = 0; s <= t; ++s) { if (s < t) p1 += AakM[t * 17 + s] * vv[s]; p2 += BrkM[t * 17 + s] * vv[s]; }
        unsigned short* rec = (unsigned short*)(RAc + t * 384);
        rec[128 + lane] = (unsigned short)f2bf(p1); rec[192 + lane] = (unsigned short)f2bf(p2); }
    LDS_WAIT();
}

__device__ __forceinline__ void rwkv_prep_unit(int l_, int u_, LAS unsigned char* lds_) {
    LOAD_CTX(); const int l = UNI(l_), u = UNI(u_); LAS unsigned char* lds = UNI_LDS(lds_);
    const int tid = ltid(), lane = tid & 63, wave = UNI(tid >> 6);
    const int b = u / 257, t0 = (u % 257) * 16;
    const bf16* proj = (const bf16*)(C.ws + WS_PROJ);
    float* RA = (float*)(C.ws + WS_RA); bf16* RG = (bf16*)(C.ws + WS_RG);
    const bf16* LW = (const bf16*)(C.ws + WS_LW);
    const float* mu = C.in[I_MU] + l * 4864;
    LAS bf16* featb = (LAS bf16*)lds;
    const size_t row0 = (size_t)ROWOF(b, t0), rowp = (size_t)ROWOF(b, t0 > 0 ? t0 - 1 : 0);
    __syncthreads();
#pragma unroll
    for (int j = 0; j < 8; ++j) { const int e = tid + 512 * j, tok = e >> 8, f = e & 255, t = t0 + tok; const size_t m = row0 + tok;
        const float cur = bf2f(proj[m * PN + C_WL + f]); const float prev = t > 0 ? bf2f(proj[(tok > 0 ? m - 1 : rowp) * PN + C_WL + f]) : 0.f;
        const float xs = cur + (prev - cur) * mu[C_WL + f];
        featb[tok * 264 + f] = (bf16)f2bf(f < 64 ? tanhf(xs) : (f < 128 ? xs : sigmoidf_(xs))); }
    __syncthreads();
    const int fr = lane & 15, kc = lane >> 4;
    pg8::bf16x8 Af[8];
#pragma unroll
    for (int ks = 0; ks < 8; ++ks) Af[ks] = *(const LAS pg8::bf16x8*)(featb + fr * 264 + 32 * ks + 8 * kc);
#pragma unroll 1
    for (int hh = 0; hh < 3; ++hh) {
        const int ch0 = 192 * wave + 64 * hh, h = ch0 >> 6;
        f32x4 aw[4], aa[4], ag[4];
#pragma unroll
        for (int nt = 0; nt < 4; ++nt) {
            const bf16* bp = LW + (size_t)(ch0 + 4 * fr + nt) * 256 + 8 * kc;
            pg8::bf16x8 Bf[8];
#pragma unroll
            for (int ks = 0; ks < 8; ++ks) Bf[ks] = *(const pg8::bf16x8*)(bp + 32 * ks);
            f32x4 z = (f32x4){0.f, 0.f, 0.f, 0.f};
            aw[nt] = __builtin_amdgcn_mfma_f32_16x16x32_bf16(Af[0], Bf[0], z, 0, 0, 0); aw[nt] = __builtin_amdgcn_mfma_f32_16x16x32_bf16(Af[1], Bf[1], aw[nt], 0, 0, 0);
            aa[nt] = __builtin_amdgcn_mfma_f32_16x16x32_bf16(Af[2], Bf[2], z, 0, 0, 0); aa[nt] = __builtin_amdgcn_mfma_f32_16x16x32_bf16(Af[3], Bf[3], aa[nt], 0, 0, 0);
            ag[nt] = __builtin_amdgcn_mfma_f32_16x16x32_bf16(Af[4], Bf[4], z, 0, 0, 0); ag[nt] = __builtin_amdgcn_mfma_f32_16x16x32_bf16(Af[5], Bf[5], ag[nt], 0, 0, 0);
            ag[nt] = __builtin_amdgcn_mfma_f32_16x16x32_bf16(Af[6], Bf[6], ag[nt], 0, 0, 0); ag[nt] = __builtin_amdgcn_mfma_f32_16x16x32_bf16(Af[7], Bf[7], ag[nt], 0, 0, 0);
        }
        const int cb = ch0 + 4 * fr;
        const f32x4 mur = *(const f32x4*)(mu + C_R + cb), muk = *(const f32x4*)(mu + C_K + cb), muv = *(const f32x4*)(mu + C_V + cb);
        const f32x4 w0c = *(const f32x4*)(C.in[I_W0] + l * 1536 + cb), a0c = *(const f32x4*)(C.in[I_A0] + l * 1536 + cb), kkc = *(const f32x4*)(C.in[I_KK] + l * 1536 + cb), kac = *(const f32x4*)(C.in[I_KA] + l * 1536 + cb);
        f32x4 pr, pk, pv;
#define PREP_LD4(dst, p_) do { const u32x2 w_ = *(const u32x2*)(p_); dst = (f32x4){bf2f(w_.x & 0xffffu), bf2f(w_.x >> 16), bf2f(w_.y & 0xffffu), bf2f(w_.y >> 16)}; } while (0)
        {
            const bool has = (kc > 0) || (t0 > 0);
            const bf16* pp = proj + (kc > 0 ? row0 + 4 * kc - 1 : rowp) * PN + cb;
            const f32x4 z4 = (f32x4){0.f, 0.f, 0.f, 0.f};
            if (has) { PREP_LD4(pr, pp + C_R); PREP_LD4(pk, pp + C_K); PREP_LD4(pv, pp + C_V); } else { pr = z4; pk = z4; pv = z4; }
        }
#pragma unroll
        for (int r = 0; r < 4; ++r) {
            const int tok = 4 * kc + r, t = t0 + tok;
            const bf16* pc = proj + (row0 + tok) * PN + cb;
            f32x4 cr, ck, cv; PREP_LD4(cr, pc + C_R); PREP_LD4(ck, pc + C_K); PREP_LD4(cv, pc + C_V);
            const f32x4 xr = cr + (pr - cr) * mur, xk = ck + (pk - ck) * muk, xv = cv + (pv - cv) * muv;
            pr = cr; pk = ck; pv = cv;
            const f32x4 kkr = xk * kkc;
            float ss = (kkr[0] * kkr[0] + kkr[1] * kkr[1]) + (kkr[2] * kkr[2] + kkr[3] * kkr[3]);
            ss = rowsum16(ss);
            const float rn = 1.0f / fmaxf(sqrtf(ss), 1e-12f);
            f32x4 dec, av, gv4;
#pragma unroll
            for (int nt = 0; nt < 4; ++nt) {
                const float x = -(w0c[nt] + aw[nt][r]);
                const float sp = fmaxf(x, 0.f) + __logf(1.0f + __expf(-fabsf(x)));
                dec[nt] = __expf(-__expf(-sp - 0.5f)); av[nt] = sigmoidf_(a0c[nt] + aa[nt][r]); gv4[nt] = ag[nt][r]; }
            const f32x4 kkn = kkr * rn;
            float* ra = RA + ((size_t)(b * NHR + h) * LT + t) * 384 + 4 * fr;
            *(f32x4*)(ra) = kkn; *(f32x4*)(ra + 64) = dec; *(f32x4*)(ra + 128) = kkn * av; *(f32x4*)(ra + 192) = xk * ((av - 1.0f) * kac + 1.0f); *(f32x4*)(ra + 256) = xr; *(f32x4*)(ra + 320) = xv;
            u32x2 gw; gw.x = pk2(gv4[0], gv4[1]); gw.y = pk2(gv4[2], gv4[3]);
            *(u32x2*)(RG + ((size_t)b * LT + t) * 1536 + cb) = gw;
        }
#undef PREP_LD4
    }
    asm volatile("s_waitcnt vmcnt(0)" ::: "memory"); __syncthreads();
#pragma unroll 1
    for (int hh = 0; hh < 3; ++hh) rwkv_chunk_prep(C, b * NHR + 3 * wave + hh, t0 >> 4, lane, lds + wave * 16640);
}

__device__ __forceinline__ pg8::bf16x8 pack8(const f32x4 a, const f32x4 b2) { u32x4 w; w.x = pk2(a[0], a[1]); w.y = pk2(a[2], a[3]); w.z = pk2(b2[0], b2[1]); w.w = pk2(b2[2], b2[3]); return (pg8::bf16x8)w; }
__device__ __forceinline__ pg8::bf16x8 ld8x2(const void* p0, const void* p1) { const u32x2 a = *(const u32x2*)p0, b2 = *(const u32x2*)p1; const u32x4 w = (u32x4){a.x, a.y, b2.x, b2.y}; return (pg8::bf16x8)w; }
__device__ __forceinline__ pg8::bf16x8 lds8x2(const LAS unsigned char* p0, const LAS unsigned char* p1) { const u32x2 a = *(const LAS u32x2*)p0, b2 = *(const LAS u32x2*)p1; const u32x4 w = (u32x4){a.x, a.y, b2.x, b2.y}; return (pg8::bf16x8)w; }
__device__ __forceinline__ void rwkv_scan_unit(int unit_, LAS unsigned char* lds_) {
    LOAD_CTX(); const int unit = UNI(unit_); LAS unsigned char* lds = UNI_LDS(lds_);
    const int tid = ltid(), lane = tid & 63, wave = UNI(tid >> 6);
    const int hsel = wave >> 2, bh = 2 * unit + hsel, vt = wave & 3, b = bh / NHR, h = bh % NHR;
    const int fr = lane & 15, g4 = lane >> 4, hl = tid & 255;
    const unsigned char* RAb = (const unsigned char*)((const float*)(C.ws + WS_RA) + (size_t)bh * LT * 384);
    const unsigned char* CHB = C.ws + WS_CHB + (size_t)bh * 257 * 1280;
    bf16* RY = (bf16*)(C.ws + WS_RY);
    constexpr int RS = 1040, SLOT = 16 * RS + 1280;
    LAS unsigned char* ring = lds + hsel * 4 * SLOT;
    const f32x4 zero4 = (f32x4){0.f, 0.f, 0.f, 0.f};
    f32x4 acc[4] = {zero4, zero4, zero4, zero4};
    u32x4 ga[5], gb[5];
#define CS_G(dst, c_) do { const unsigned char* rec = RAb + (size_t)(16 * (c_)) * 1536; const unsigned char* side = CHB + (c_) * 1280; \
        _Pragma("unroll") for (int i = 0; i < 5; ++i) { const int p = hl + 256 * i, rr = p >> 6, q = p & 63; \
            const unsigned char* src = p < 1024 ? rec + (size_t)rr * 1536 + (q < 48 ? 16 * q : 1280 + 16 * (q - 48)) : side + 16 * (p - 1024); \
            dst[i] = ((c_) < 257 && p < 1104) ? *(const u32x4*)src : (u32x4){0u, 0u, 0u, 0u}; } } while (0)
#define CS_S(src_, c_) do { LAS unsigned char* sl = ring + ((c_) & 3) * SLOT; \
        _Pragma("unroll") for (int i = 0; i < 5; ++i) { const int p = hl + 256 * i, rr = p >> 6, q = p & 63; \
            if (p < 1104) *(LAS u32x4*)(p < 1024 ? sl + rr * RS + 16 * q : sl + 16 * RS + 16 * (p - 1024)) = src_[i]; } } while (0)
#define CS_COMPUTE(c_) do { const LAS unsigned char* sl = ring + ((c_) & 3) * SLOT; const LAS unsigned char* rt = sl + fr * RS; const LAS unsigned char* side = sl + 16 * RS; \
        const pg8::bf16x8 Ab0 = lds8x2(rt + 8 * g4, rt + 32 + 8 * g4), Ab1 = lds8x2(rt + 64 + 8 * g4, rt + 96 + 8 * g4), Rb0 = lds8x2(rt + 128 + 8 * g4, rt + 160 + 8 * g4), Rb1 = lds8x2(rt + 192 + 8 * g4, rt + 224 + 8 * g4); \
        f32x4 P1, P2, Vd; \
        _Pragma("unroll") for (int r = 0; r < 4; ++r) { const LAS unsigned char* rr_ = sl + (4 * g4 + r) * RS; const int v = 16 * vt + fr; \
            P1[r] = bf2f(((const LAS unsigned short*)(rr_ + 256))[v]); P2[r] = bf2f(((const LAS unsigned short*)(rr_ + 384))[v]); Vd[r] = ((const LAS float*)(rr_ + 768))[v]; } \
        const u32x2 tw = *(const LAS u32x2*)(side + fr * 32 + 8 * g4), bw = *(const LAS u32x2*)(side + 512 + fr * 32 + 8 * g4); \
        const pg8::bf16x8 Tf = (pg8::bf16x8)((u32x4){tw.x, tw.y, 0u, 0u}), Bf = (pg8::bf16x8)((u32x4){bw.x, bw.y, 0u, 0u}); \
        const LAS unsigned char* pb = sl + (fr >> 3) * RS + 512 + (fr & 7) * 32 + 8 * g4; \
        const pg8::bf16x8 M0 = lds8x2(pb, pb + 8 * RS), M1 = lds8x2(pb + 2 * RS, pb + 10 * RS), M2 = lds8x2(pb + 4 * RS, pb + 12 * RS), M3 = lds8x2(pb + 6 * RS, pb + 14 * RS); \
        const f32x4 g0 = *(const LAS f32x4*)(side + 1024 + (4 * g4) * 4), g1 = *(const LAS f32x4*)(side + 1024 + (16 + 4 * g4) * 4), g2 = *(const LAS f32x4*)(side + 1024 + (32 + 4 * g4) * 4), g3 = *(const LAS f32x4*)(side + 1024 + (48 + 4 * g4) * 4); \
        const pg8::bf16x8 sB0 = pack8(acc[0], acc[1]), sB1 = pack8(acc[2], acc[3]); \
        f32x4 Wd = __builtin_amdgcn_mfma_f32_16x16x32_bf16(Ab0, sB0, zero4, 0, 0, 0); Wd = __builtin_amdgcn_mfma_f32_16x16x32_bf16(Ab1, sB1, Wd, 0, 0, 0); \
        f32x4 Yd = __builtin_amdgcn_mfma_f32_16x16x32_bf16(Rb0, sB0, P2, 0, 0, 0); Yd = __builtin_amdgcn_mfma_f32_16x16x32_bf16(Rb1, sB1, Yd, 0, 0, 0); \
        const f32x4 Ud = __builtin_amdgcn_mfma_f32_16x16x32_bf16(Tf, pack8(Wd + P1, zero4), zero4, 0, 0, 0); \
        Yd = __builtin_amdgcn_mfma_f32_16x16x32_bf16(Bf, pack8(Ud, zero4), Yd, 0, 0, 0); \
        const pg8::bf16x8 zB = pack8(Ud, Vd); \
        acc[0] = __builtin_amdgcn_mfma_f32_16x16x32_bf16(M0, zB, acc[0] * g0, 0, 0, 0); acc[1] = __builtin_amdgcn_mfma_f32_16x16x32_bf16(M1, zB, acc[1] * g1, 0, 0, 0); \
        acc[2] = __builtin_amdgcn_mfma_f32_16x16x32_bf16(M2, zB, acc[2] * g2, 0, 0, 0); acc[3] = __builtin_amdgcn_mfma_f32_16x16x32_bf16(M3, zB, acc[3] * g3, 0, 0, 0); \
        _Pragma("unroll") for (int r = 0; r < 4; ++r) RY[((size_t)b * LT + 16 * (c_) + 4 * g4 + r) * 1536 + h * 64 + 16 * vt + fr] = (bf16)f2bf(Yd[r]); } while (0)
    __syncthreads();
    CS_G(ga, 0); CS_G(gb, 1);
    CS_S(ga, 0); CS_S(gb, 1);
    CS_G(gb, 2);
    __syncthreads();
#pragma unroll 1
    for (int c = 0; c < 257; c += 2) {
        CS_G(ga, c + 3);
        CS_COMPUTE(c);
        CS_S(gb, c + 2);
        __syncthreads();
        if (c + 1 < 257) {
            CS_G(gb, c + 4);
            CS_COMPUTE(c + 1);
            CS_S(ga, c + 3);
            __syncthreads();
        }
    }
#undef CS_G
#undef CS_S
#undef CS_COMPUTE
}
__device__ __forceinline__ void hgrn_scan_slice(int sl_) {
    LOAD_CTX(); const int sl = UNI(sl_);
    const int tid = ltid();
    bf16* HDS = (bf16*)(C.ws + WS_HDS); const float* HED = (const float*)(C.ws + WS_HED);
    float S[4][4];
#pragma unroll
    for (int q = 0; q < 4; ++q) { S[q][0] = 0.f; S[q][1] = 0.f; S[q][2] = 0.f; S[q][3] = 0.f; }
    const int e0 = sl * 8192 + tid * 4, bh = e0 >> 14;
    for (int c = 1; c < NCH; ++c) {
        const size_t uc = (size_t)bh * NCH + c;
        u32x2 d[4]; float ed[4];
#pragma unroll
        for (int q = 0; q < 4; ++q) { const int kv = (e0 + q * 2048) & 16383; d[q] = *(const u32x2*)(HDS + uc * 16384 + kv); ed[q] = HED[uc * 128 + (kv >> 7)]; }
#pragma unroll
        for (int q = 0; q < 4; ++q) { const int kv = (e0 + q * 2048) & 16383;
            u32x2 o; o.x = pk2(S[q][0], S[q][1]); o.y = pk2(S[q][2], S[q][3]); *(u32x2*)(HDS + uc * 16384 + kv) = o;
            S[q][0] = S[q][0] * ed[q] + bf2f(d[q].x & 0xffffu); S[q][1] = S[q][1] * ed[q] + bf2f(d[q].x >> 16); S[q][2] = S[q][2] * ed[q] + bf2f(d[q].y & 0xffffu); S[q][3] = S[q][3] * ed[q] + bf2f(d[q].y >> 16); }
    }
}

__device__ __forceinline__ void rwkv_post_all(int l_) {
    LOAD_CTX(); const int l = UNI(l_);
    const int tid = ltid(), lane = tid & 63, wave = UNI(tid >> 6);
    const bf16* RY = (const bf16*)(C.ws + WS_RY); const bf16* RG = (const bf16*)(C.ws + WS_RG);
    const float* RA = (const float*)(C.ws + WS_RA);
    bf16* mixed = (bf16*)(C.ws + WS_Z);
    const float* lnw = C.in[I_LNW] + l * 1536; const float* lnb = C.in[I_LNB] + l * 1536; const float* rk = C.in[I_RK] + l * 1536;
    struct PostRegs { float y[4], g[4], kp[4], r[4], v[4], w_[4], b_[4], k_[4]; };
    auto pload = [&](PostRegs& R, int m, int hg) { const int b = m / LT, t = m - b * LT;
#pragma unroll
        for (int q = 0; q < 4; ++q) { const int h = hg * 4 + q, c = h * 64 + lane;
            const float* ra = RA + ((size_t)(b * NHR + h) * LT + t) * 384 + lane;
            R.y[q] = bf2f(RY[(size_t)m * 1536 + c]); R.g[q] = bf2f(RG[(size_t)m * 1536 + c]); R.kp[q] = ra[192]; R.r[q] = ra[256]; R.v[q] = ra[320];
            R.w_[q] = lnw[c]; R.b_[q] = lnb[c]; R.k_[q] = rk[c]; } };
    auto pfin = [&](const PostRegs& R, int m, int hg) { const int b = m / LT, t = m - b * LT;
#pragma unroll
        for (int q = 0; q < 4; ++q) { const int c = (hg * 4 + q) * 64 + lane;
            const float mean = wave_sum(R.y[q]) * (1.0f / 64.0f);
            const float dy = R.y[q] - mean;
            const float var = wave_sum(dy * dy) * (1.0f / 64.0f);
            const float yn = dy * rsqrtf(var + 64e-5f) * R.w_[q] + R.b_[q];
            const float bonus = wave_sum(R.r[q] * R.kp[q] * R.k_[q]) * R.v[q];
            const float mv = (yn + bonus) * R.g[q];
            if (t < NMETA) mixed[(size_t)ROWOF(b, t) * DM + c] = (bf16)f2bf(mv);
            (C.ws + WS_MX8)[(size_t)ROWOF(b, t) * DM + c] = fp8_1(mv * MX8_SCALE); } };
    const int stride = gridDim.x * 8;
    int m = blockIdx.x * 8 + wave, hg = 0;
    PostRegs A, B;
    if (m < TT) pload(A, m, hg);
#pragma unroll 1
    while (m < TT) {
        int m2 = m, hg2 = hg + 1; if (hg2 == 6) { hg2 = 0; m2 += stride; }
        if (m2 < TT) pload(B, m2, hg2);
        pfin(A, m, hg);
        if (m2 >= TT) break;
        int m3 = m2, hg3 = hg2 + 1; if (hg3 == 6) { hg3 = 0; m3 += stride; }
        if (m3 < TT) pload(A, m3, hg3);
        pfin(B, m2, hg2);
        m = m3; hg = hg3;
    }
}
__device__ __forceinline__ void hgrn_out_unit(int l_, int u_, LAS unsigned char* lds_) {
    LOAD_CTX(); const int l = UNI(l_), u = UNI(u_); LAS unsigned char* lds = UNI_LDS(lds_);
    const int tid = ltid(), lane = tid & 63, wave = UNI(tid >> 6);
    const int bh = u / 65, c = u % 65 + 1, b = bh >> 3, h = bh & 7;
    const bf16* proj = (const bf16*)(C.ws + WS_PROJ);
    const bf16* HDS = (const bf16*)(C.ws + WS_HDS); const bf16* HQG = (const bf16*)(C.ws + WS_HQG); const float* HAT = (const float*)(C.ws + WS_HAT);
    bf16* mixed = (bf16*)(C.ws + WS_Z);
    LAS bf16* Am = (LAS bf16*)lds;
    LAS bf16* Bt = (LAS bf16*)(lds + 25600);
    lfloat* ssum = (lfloat*)(lds + 25600 + 52224);
    const size_t uc = (size_t)bh * NCH + c;
    __syncthreads();
    for (int e = tid; e < 1024; e += 512) { const int t_ = e >> 4, s4 = 4 * (e & 15); const f32x4 a4 = *(const f32x4*)(HAT + uc * 4096 + t_ * 64 + s4);
        u32x2 w; w.x = pk2(a4[0], a4[1]); w.y = pk2(a4[2], a4[3]); *(LAS u32x2*)(Am + t_ * 200 + s4) = w; }
    for (int e = tid; e < 1024; e += 512) { const int t_ = e >> 4, ch = e & 15; *(LAS u32x4*)(Am + t_ * 200 + 64 + 8 * ch) = *(const u32x4*)(HQG + uc * 8192 + t_ * 128 + 8 * ch); }
    for (int e = tid; e < 1024; e += 512) { const int s_ = e >> 4, v8 = 8 * (e & 15), t = 64 * c + s_ - 112;
        u32x4 w = (u32x4){0u, 0u, 0u, 0u}; if (t >= 0 && t < LT) w = *(const u32x4*)(proj + (size_t)ROWOF(b, t) * PN + C_HI + h * 128 + v8);
        LAS bf16* bp_ = Bt + v8 * 204 + s_;
        bp_[0] = (bf16)(w.x & 0xffffu); bp_[204] = (bf16)(w.x >> 16); bp_[408] = (bf16)(w.y & 0xffffu); bp_[612] = (bf16)(w.y >> 16); bp_[816] = (bf16)(w.z & 0xffffu); bp_[1020] = (bf16)(w.z >> 16); bp_[1224] = (bf16)(w.w & 0xffffu); bp_[1428] = (bf16)(w.w >> 16); }
#pragma unroll
    for (int i = 0; i < 4; ++i) { const int e = tid + 512 * i, kx = e >> 4, v8 = 8 * (e & 15); const u32x4 w = *(const u32x4*)(HDS + uc * 16384 + kx * 128 + v8);
        LAS bf16* bp_ = Bt + v8 * 204 + 64 + kx;
        bp_[0] = (bf16)(w.x & 0xffffu); bp_[204] = (bf16)(w.x >> 16); bp_[408] = (bf16)(w.y & 0xffffu); bp_[612] = (bf16)(w.y >> 16); bp_[816] = (bf16)(w.z & 0xffffu); bp_[1020] = (bf16)(w.z >> 16); bp_[1224] = (bf16)(w.w & 0xffffu); bp_[1428] = (bf16)(w.w >> 16); }
    __syncthreads();
    const int fr = lane & 15, g4 = lane >> 4;
    pg8::bf16x8 Bf[6];
#pragma unroll
    for (int ks = 0; ks < 6; ++ks) { const LAS u32x2* bp = (const LAS u32x2*)(Bt + (16 * wave + fr) * 204 + 32 * ks + 8 * g4); const u32x2 lo = bp[0], hi = bp[1];
        const u32x4 w = (u32x4){lo.x, lo.y, hi.x, hi.y}; Bf[ks] = (pg8::bf16x8)w; }
    f32x4 o[4];
#pragma unroll
    for (int mt = 0; mt < 4; ++mt) { f32x4 d = (f32x4){0.f, 0.f, 0.f, 0.f};
#pragma unroll
        for (int ks = 0; ks < 6; ++ks) { const pg8::bf16x8 a = *(const LAS pg8::bf16x8*)(Am + (16 * mt + fr) * 200 + 32 * ks + 8 * g4); d = __builtin_amdgcn_mfma_f32_16x16x32_bf16(a, Bf[ks], d, 0, 0, 0); }
        o[mt] = d; }
#pragma unroll
    for (int mt = 0; mt < 4; ++mt)
#pragma unroll
        for (int r = 0; r < 4; ++r) { const float s = rowsum16(o[mt][r] * o[mt][r]); if (fr == 0) ssum[wave * 64 + 16 * mt + 4 * g4 + r] = s; }
    __syncthreads();
    const float gn = C.in[I_HNORM][l * 1024 + h * 128 + 16 * wave + fr];
#pragma unroll
    for (int mt = 0; mt < 4; ++mt)
#pragma unroll
        for (int r = 0; r < 4; ++r) { const int tl = 16 * mt + 4 * g4 + r, t = 64 * c + tl - 112;
            float ss = 0.f;
#pragma unroll
            for (int w8 = 0; w8 < 8; ++w8) ss += ssum[w8 * 64 + tl];
            if (t >= 0 && t < LT) { const size_t m = (size_t)ROWOF(b, t);
                const float gv = bf2f(proj[m * PN + C_HG + h * 128 + 16 * wave + fr]);
                const float mv = o[mt][r] * rsqrtf(ss * (1.0f / 128.0f) + 1e-5f) * gn * (gv * sigmoidf_(gv));
                if (t < NMETA) mixed[m * DM + 3072 + h * 128 + 16 * wave + fr] = (bf16)f2bf(mv);
                (C.ws + WS_MX8)[m * DM + 3072 + h * 128 + 16 * wave + fr] = fp8_1(mv * MX8_SCALE); } }
}

__device__ __forceinline__ unsigned ordkey(float v) { const unsigned b = __float_as_uint(v); return b ^ ((b >> 31) ? 0xFFFFFFFFu : 0x80000000u); }
__device__ __forceinline__ float unordkey(unsigned k) { const unsigned b = (k >> 31) ? (k ^ 0x80000000u) : ~k; return __uint_as_float(b); }
#define CE_U(a, b) do { const unsigned mx_ = (a) > (b) ? (a) : (b), mn_ = (a) > (b) ? (b) : (a); (a) = mx_; (b) = mn_; } while (0)
__device__ __forceinline__ void sort16_desc(unsigned (&k)[16]) {
#pragma unroll
    for (int size = 2; size <= 16; size <<= 1)
#pragma unroll
        for (int stride = size >> 1; stride > 0; stride >>= 1)
#pragma unroll
            for (int i = 0; i < 16; ++i) { const int j = i ^ stride; if (j > i) { if ((i & size) == 0) CE_U(k[i], k[j]); else CE_U(k[j], k[i]); } }
}
__device__ __forceinline__ void merge16_desc(unsigned (&top)[16], const unsigned (&blk)[16]) {
#pragma unroll
    for (int i = 0; i < 16; ++i) top[i] = top[i] > blk[15 - i] ? top[i] : blk[15 - i];
#pragma unroll
    for (int stride = 8; stride > 0; stride >>= 1)
#pragma unroll
        for (int i = 0; i < 16; ++i) { const int j = i ^ stride; if (j > i) CE_U(top[i], top[j]); }
}
#define CE_P(va, pa, vb, pb) do { const bool sw_ = (vb) > (va); const float tv_ = sw_ ? (vb) : (va), tw_ = sw_ ? (va) : (vb); const unsigned tp_ = sw_ ? (pb) : (pa), tq_ = sw_ ? (pa) : (pb); (va) = tv_; (vb) = tw_; (pa) = tp_; (pb) = tq_; } while (0)
__device__ __forceinline__ void sort16p_desc(float (&v)[16], unsigned (&p)[16]) {
#pragma unroll
    for (int size = 2; size <= 16; size <<= 1)
#pragma unroll
        for (int stride = size >> 1; stride > 0; stride >>= 1)
#pragma unroll
            for (int i = 0; i < 16; ++i) { const int j = i ^ stride; if (j > i) { if ((i & size) == 0) CE_P(v[i], p[i], v[j], p[j]); else CE_P(v[j], p[j], v[i], p[i]); } }
}
__device__ __forceinline__ void merge16p_desc(float (&tv)[16], unsigned (&tp)[16], const float (&bv)[16], const unsigned (&bp)[16]) {
#pragma unroll
    for (int i = 0; i < 16; ++i) { const bool tk = bv[15 - i] > tv[i]; tv[i] = tk ? bv[15 - i] : tv[i]; tp[i] = tk ? bp[15 - i] : tp[i]; }
#pragma unroll
    for (int stride = 8; stride > 0; stride >>= 1)
#pragma unroll
        for (int i = 0; i < 16; ++i) { const int j = i ^ stride; if (j > i) CE_P(tv[i], tp[i], tv[j], tp[j]); }
}
__device__ __forceinline__ void top16_half(const float* sc, int m0, int half, int lane, lfloat* stage, unsigned (&top)[16]) {
    f32x4 ld[4][8];
#pragma unroll
    for (int j = 0; j < 4; ++j)
#pragma unroll
        for (int i = 0; i < 8; ++i) { const int idx = lane + 64 * i, p = idx >> 3, part = idx & 7;
            ld[j][i] = *(const f32x4*)(sc + (size_t)(m0 + (p >> 3)) * 2048 + (p & 7) * 256 + half * 128 + 32 * j + 4 * part); }
#pragma unroll
    for (int j = 0; j < 4; ++j) {
#pragma unroll
        for (int i = 0; i < 8; ++i) { const int idx = lane + 64 * i, p = idx >> 3, part = idx & 7; lfloat* d = stage + p * 33 + 4 * part; d[0] = ld[j][i].x; d[1] = ld[j][i].y; d[2] = ld[j][i].z; d[3] = ld[j][i].w; }
        LDS_WAIT();
#pragma unroll
        for (int hb = 0; hb < 2; ++hb) {
            unsigned blk[16];
#pragma unroll
            for (int i = 0; i < 16; ++i) { const int n = 32 * j + 16 * hb + i; blk[i] = (ordkey(stage[lane * 33 + 16 * hb + i]) & ~127u) | (unsigned)(127 - n); }
            sort16_desc(blk);
            if (j == 0 && hb == 0) {
#pragma unroll
                for (int i = 0; i < 16; ++i) top[i] = blk[i];
            } else merge16_desc(top, blk);
        }
        LDS_WAIT();
    }
}
__device__ __forceinline__ void route_task(const Ctx& C, int wt, int lane, LAS unsigned char* wl) {
    const float* sc = (const float*)(C.ws + WS_SC);
    bf16* GG = (bf16*)(C.ws + WS_GG); unsigned* BMp = (unsigned*)(C.ws + WS_BM);
    lfloat* stage = (lfloat*)wl;
    LAS u32x2* ent = (LAS u32x2*)(wl + 8704);
    const int m0 = 8 * wt, tk = lane >> 3, h = lane & 7;
    unsigned s1[16], s2[16];
    top16_half(sc, m0, 0, lane, stage, s1);
    top16_half(sc, m0, 1, lane, stage, s2);
    LAS unsigned short* cid = (LAS unsigned short*)stage + lane * 66;
    unsigned top[16];
#define CAND(dst, slot, num, a, b) do { const float cv_ = unordkey(s1[a] & ~127u) + unordkey(s2[b] & ~127u); dst[slot] = (ordkey(cv_) & ~63u) | (unsigned)(63 - (num)); \
        cid[num] = (unsigned short)(((127u - (s1[a] & 127u)) << 7) | (127u - (s2[b] & 127u))); } while (0)
    {
#pragma unroll
        for (int b2 = 0; b2 < 16; ++b2) CAND(top, b2, b2, 0, b2);
        sort16_desc(top);
    }
    {
        unsigned blk[16];
#pragma unroll
        for (int b2 = 0; b2 < 8; ++b2) CAND(blk, b2, 16 + b2, 1, b2);
#pragma unroll
        for (int b2 = 0; b2 < 5; ++b2) CAND(blk, 8 + b2, 24 + b2, 2, b2);
        blk[13] = 0u; blk[14] = 0u; blk[15] = 0u;
        sort16_desc(blk); merge16_desc(top, blk);
    }
    {
        unsigned blk[16];
#pragma unroll
        for (int b2 = 0; b2 < 4; ++b2) CAND(blk, b2, 29 + b2, 3, b2);
#pragma unroll
        for (int b2 = 0; b2 < 3; ++b2) CAND(blk, 4 + b2, 33 + b2, 4, b2);
#pragma unroll
        for (int b2 = 0; b2 < 2; ++b2) { CAND(blk, 7 + b2, 36 + b2, 5, b2); CAND(blk, 9 + b2, 38 + b2, 6, b2); }
        blk[11] = 0u; blk[12] = 0u; blk[13] = 0u; blk[14] = 0u; blk[15] = 0u;
        sort16_desc(blk); merge16_desc(top, blk);
    }
    {
        unsigned blk[16];
        CAND(blk, 0, 40, 7, 0); CAND(blk, 1, 41, 7, 1);
#pragma unroll
        for (int a2 = 8; a2 < 16; ++a2) CAND(blk, a2 - 6, 34 + a2, a2, 0);
        blk[10] = 0u; blk[11] = 0u; blk[12] = 0u; blk[13] = 0u; blk[14] = 0u; blk[15] = 0u;
        sort16_desc(blk); merge16_desc(top, blk);
    }
#undef CAND
    LDS_WAIT();
    {
        const float v0 = unordkey(top[0] & ~63u);
        float e[16]; float sum = 0.f;
#pragma unroll
        for (int i = 0; i < 16; ++i) { e[i] = __expf(unordkey(top[i] & ~63u) - v0); sum += e[i]; }
        const float inv = 1.0f / sum;
#pragma unroll
        for (int i = 0; i < 16; ++i) { const unsigned id = cid[63u - (top[i] & 63u)]; ent[tk * 128 + h * 16 + i] = (u32x2){id, __float_as_uint(e[i] * inv)}; }
    }
    LDS_WAIT();
#pragma unroll 1
    for (int t8 = 0; t8 < 8; ++t8) {
        const LAS u32x2* en = ent + t8 * 128; const size_t m = (size_t)(m0 + t8);
        const int my0 = (int)en[lane].x, my1 = (int)en[lane + 64].x;
        float g0 = 0.f, g1 = 0.f; bool f0 = true, f1 = true;
#pragma unroll 8
        for (int i = 0; i < 128; ++i) { const u32x2 x = en[i]; const int id = (int)x.x; const float gv = __uint_as_float(x.y);
            if (id == my0) { g0 += gv; if (i < lane) f0 = false; }
            if (id == my1) { g1 += gv; if (i < lane + 64) f1 = false; } }
        *(u32x4*)(GG + m * NE + (my0 & ~7)) = (u32x4){0u, 0u, 0u, 0u}; *(u32x4*)(GG + m * NE + (my1 & ~7)) = (u32x4){0u, 0u, 0u, 0u};
        atomicOr(BMp + m * 64 + (my0 >> 8), 1u << ((my0 >> 3) & 31)); atomicOr(BMp + m * 64 + (my1 >> 8), 1u << ((my1 >> 3) & 31));
        asm volatile("s_waitcnt vmcnt(0)" ::: "memory");
        if (f0) GG[m * NE + my0] = (bf16)f2bf(g0);
        if (f1) GG[m * NE + my1] = (bf16)f2bf(g1);
    }
    LDS_WAIT();
}
__device__ __forceinline__ int mbcnt64(unsigned long long m) { return __builtin_amdgcn_mbcnt_hi((unsigned)(m >> 32), __builtin_amdgcn_mbcnt_lo((unsigned)m, 0u)); }
__device__ __forceinline__ void top16_of_128(float v0, float v1, int lane, lfloat* selv, LAS int* seli) {
    const unsigned k0 = (ordkey(v0) & ~127u) | (unsigned)(127 - lane), k1 = (ordkey(v1) & ~127u) | (unsigned)(63 - lane);
    unsigned thr = 0u;
    for (int bit = 31; bit >= 0; --bit) { const unsigned cand = thr | (1u << bit);
        const int cnt = __popcll(__ballot(k0 >= cand)) + __popcll(__ballot(k1 >= cand));
        if (cnt >= 16) { thr = cand; if (cnt == 16) break; } }
    const unsigned long long m0 = __ballot(k0 >= thr), m1 = __ballot(k1 >= thr);
    if (k0 >= thr) { const int s = mbcnt64(m0); if (s < 16) { selv[s] = v0; seli[s] = lane; } }
    if (k1 >= thr) { const int s = __popcll(m0) + mbcnt64(m1); if (s < 16) { selv[s] = v1; seli[s] = lane + 64; } }
}
__device__ __forceinline__ void route_token_bisect(const Ctx& C, int m, int lane, LAS unsigned char* wl) {
    const float* sc = (const float*)(C.ws + WS_SC) + (size_t)m * 2048;
    bf16* GG = (bf16*)(C.ws + WS_GG);
    lfloat* s1v = (lfloat*)wl; LAS int* s1i = (LAS int*)(wl + 64); lfloat* s2v = (lfloat*)(wl + 128); LAS int* s2i = (LAS int*)(wl + 192);
    lfloat* bv = (lfloat*)(wl + 256); LAS int* bi = (LAS int*)(wl + 320);
    LAS u32x2* ent = (LAS u32x2*)(wl + 384);
    float sv[8][4];
#pragma unroll
    for (int h = 0; h < 8; ++h) { sv[h][0] = sc[h * 256 + lane]; sv[h][1] = sc[h * 256 + 64 + lane]; sv[h][2] = sc[h * 256 + 128 + lane]; sv[h][3] = sc[h * 256 + 192 + lane]; }
#pragma unroll
    for (int h = 0; h < 8; ++h) {
        const float a0 = sv[h][0], a1 = sv[h][1], b0 = sv[h][2], b1 = sv[h][3];
        top16_of_128(a0, a1, lane, s1v, s1i);
        top16_of_128(b0, b1, lane, s2v, s2i);
        LDS_WAIT();
        const float sa = s1v[lane >> 2]; const f32x4 sb = *(const lf32x4*)(s2v + 4 * (lane & 3));
        const float cv[4] = {sa + sb.x, sa + sb.y, sa + sb.z, sa + sb.w};
        unsigned ck[4];
#pragma unroll
        for (int jj = 0; jj < 4; ++jj) ck[jj] = (ordkey(cv[jj]) & ~255u) | (unsigned)(255 - (4 * lane + jj));
        unsigned thr = 0u;
        for (int bit = 31; bit >= 0; --bit) { const unsigned cand = thr | (1u << bit);
            const int cnt = __popcll(__ballot(ck[0] >= cand)) + __popcll(__ballot(ck[1] >= cand)) + __popcll(__ballot(ck[2] >= cand)) + __popcll(__ballot(ck[3] >= cand));
            if (cnt >= 16) { thr = cand; if (cnt == 16) break; } }
        int base = 0;
        const int ia = s1i[lane >> 2];
#pragma unroll
        for (int jj = 0; jj < 4; ++jj) { const unsigned long long mk = __ballot(ck[jj] >= thr);
            if (ck[jj] >= thr) { const int s = base + mbcnt64(mk); if (s < 16) { bv[s] = cv[jj]; bi[s] = ia * 128 + s2i[4 * (lane & 3) + jj]; } }
            base += __popcll(mk); }
        LDS_WAIT();
        float mx = -3.0e38f;
#pragma unroll
        for (int i = 0; i < 16; ++i) mx = fmaxf(mx, bv[i]);
        float sum = 0.f;
#pragma unroll
        for (int i = 0; i < 16; ++i) sum += __expf(bv[i] - mx);
        if (lane < 16) ent[h * 16 + lane] = (u32x2){(unsigned)bi[lane], __float_as_uint(__expf(bv[lane] - mx) / sum)};
        LDS_WAIT();
    }
    u32x2* me = (u32x2*)(C.ws + WS_ME) + (size_t)(m - MAIN_ROWS) * 128;
    me[lane] = ent[lane]; me[lane + 64] = ent[lane + 64];
    LDS_WAIT();
}

__device__ __forceinline__ void route_all(int l_, LAS unsigned char* lds_) {
    LOAD_CTX(); const int l = UNI(l_); LAS unsigned char* lds = UNI_LDS(lds_);
    const int tid = ltid(), lane = tid & 63, wave = UNI(tid >> 6);
    __syncthreads();
    for (int wt = blockIdx.x * 8 + wave; wt < MAIN_ROWS / 8; wt += gridDim.x * 8) route_task(C, wt, lane, lds + wave * 17408);
    if (l == 0) for (int m = MAIN_ROWS + blockIdx.x * 8 + wave; m < TT; m += gridDim.x * 8) route_token_bisect(C, m, lane, lds + wave * 17408);
}
__device__ __forceinline__ void norm2_zero_all(int l_) {
    LOAD_CTX(); const int l = UNI(l_);
    const int tid = ltid(), lane = tid & 63, wave = UNI((int)(tid >> 6)), G = gridDim.x;
    unsigned char* ws = C.ws; bf16* Z = (bf16*)(ws + WS_Z); float* H = (float*)(ws + WS_H);
    unsigned char* HN8 = ws + WS_HN8;
    const int nrows = (l == 1) ? MAIN_ROWS : TT;
    {   f32x4 gn[16]; { const f32x4* gr = (const f32x4*)(C.in[I_NFFN] + l * DM) + lane;
#pragma unroll
            for (int j = 0; j < 16; ++j) gn[j] = gr[64 * j]; }
        rows_pipe(blockIdx.x * 8 + wave, G * 8, nrows, lane, [&](int m) -> const float* { return H + (size_t)m * DM; },
            [&](const f32x4 (&v)[16], int m) { norm_row_fin(v, gn, Z + (size_t)m * DM, nullptr, lane, HN8 + (size_t)m * DM); }); }
    for (int e = blockIdx.x * 512 + tid; e < (MP - TT) * DM / 16; e += G * 512) ((u32x4*)(HN8 + (size_t)TT * DM))[e] = (u32x4){0u, 0u, 0u, 0u};
    u32x4* gz = (u32x4*)(ws + WS_BM);
    const size_t n16 = (size_t)MAIN_ROWS * 64 * 4 / 16;
    for (size_t e = (size_t)blockIdx.x * 512 + tid; e < n16; e += (size_t)G * 512) gz[e] = (u32x4){0u, 0u, 0u, 0u};
}
__device__ __forceinline__ void final_norm_all() {
    LOAD_CTX();
    const int tid = ltid(), lane = tid & 63, wave = UNI((int)(tid >> 6)), G = gridDim.x;
    const float* H = (const float*)(C.ws + WS_H);
    f32x4 gn[16]; { const f32x4* gr = (const f32x4*)C.in[I_NFIN] + lane;
#pragma unroll
        for (int j = 0; j < 16; ++j) gn[j] = gr[64 * j]; }
    rows_pipe(blockIdx.x * 8 + wave, G * 8, NB * 4096, lane, [&](int m) -> const float* { return H + (size_t)m * DM; },
        [&](const f32x4 (&v)[16], int m) {
            float ss = 0.f;
#pragma unroll
            for (int j = 0; j < 16; ++j) ss += (v[j].x * v[j].x + v[j].y * v[j].y) + (v[j].z * v[j].z + v[j].w * v[j].w);
            ss = wave_sum(ss);
            const float rn = rsqrtf(ss * (1.0f / 4096.0f) + 1e-5f);
            f32x4* o = (f32x4*)(C.out + (size_t)m * DM) + lane;
#pragma unroll
            for (int j = 0; j < 16; ++j) o[64 * j] = v[j] * rn * gn[j]; });
}
constexpr int NPL = 11;
constexpr int HG_OUT_EARLY = 1568;
constexpr int NPH = 2 * NPL + 1;
template <int MODE> __device__ __forceinline__ void meta_gemm(const bf16* A, const bf16* Bt, int N, float* O, int ldo, LAS unsigned char* lds_) {
    LAS unsigned char* lds = UNI_LDS(lds_);
    const int tid = ltid(), lane = tid & 63, wave = UNI(tid >> 6), fr = lane & 15, g4 = lane >> 4;
    lfloat* part = (lfloat*)lds;
    for (int nt = blockIdx.x; nt < N / 16; nt += gridDim.x) {
        __syncthreads();
        f32x4 d = (f32x4){0.f, 0.f, 0.f, 0.f};
        const bf16* ap = A + (size_t)fr * DM + 512 * wave + 8 * g4; const bf16* bp = Bt + (size_t)(16 * nt + fr) * DM + 512 * wave + 8 * g4;
#pragma unroll
        for (int ks = 0; ks < 16; ++ks) d = __builtin_amdgcn_mfma_f32_16x16x32_bf16(*(const pg8::bf16x8*)(ap + 32 * ks), *(const pg8::bf16x8*)(bp + 32 * ks), d, 0, 0, 0);
#pragma unroll
        for (int r = 0; r < 4; ++r) part[wave * 256 + (4 * g4 + r) * 16 + fr] = d[r];
        __syncthreads();
        if (tid < 256) { const int t = tid >> 4, n = tid & 15; float s = 0.f;
#pragma unroll
            for (int w8 = 0; w8 < 8; ++w8) s += part[w8 * 256 + tid];
#pragma unroll
            for (int bb = 0; bb < 4; ++bb) { float* o = O + (size_t)(MAIN_ROWS + 16 * bb + t) * ldo + 16 * nt + n; if (MODE == 0) *o += s; else *o = s; } }
    }
}
__device__ __forceinline__ void meta_u_all(int l_) {
    LOAD_CTX(); const int l = UNI(l_);
    const int tid = ltid(), lane = tid & 63, wave = UNI(tid >> 6);
    const bf16* Z = (const bf16*)(C.ws + WS_Z); const float* pu = C.in[I_PU] + (size_t)l * NE * DM;
    const u32x2* me = (const u32x2*)(C.ws + WS_ME); float* HM = (float*)(C.ws + WS_HM);
    for (int task = blockIdx.x * 8 + wave; task < 16 * 128; task += gridDim.x * 8) {
        const int t = task >> 7, e = task & 127; const u32x2 en = me[t * 128 + e];
        const float* ur = pu + (size_t)en.x * DM + 4 * lane; const bf16* hr = Z + (size_t)(MAIN_ROWS + t) * DM + 4 * lane;
        float acc = 0.f;
#pragma unroll 8
        for (int i = 0; i < 16; ++i) { const f32x4 uu = *(const f32x4*)(ur + 256 * i); const u32x2 hh = *(const u32x2*)(hr + 256 * i);
            acc += uu.x * bf2f(hh.x & 0xffffu) + uu.y * bf2f(hh.x >> 16) + uu.z * bf2f(hh.y & 0xffffu) + uu.w * bf2f(hh.y >> 16); }
        acc = wave_sum(acc);
        if (lane == 0) HM[t * 128 + e] = __uint_as_float(en.y) * 0.5f * acc * (1.0f + erff(acc * 0.70710678118654752f));
    }
}
__device__ __forceinline__ void meta_v_all(int l_) {
    LOAD_CTX(); const int l = UNI(l_);
    const int tid = ltid(), lane = tid & 63, wave = UNI(tid >> 6);
    const float* pv = C.in[I_PV] + (size_t)l * NE * DM; float* H = (float*)(C.ws + WS_H);
    const u32x2* me = (const u32x2*)(C.ws + WS_ME); const float* HM = (const float*)(C.ws + WS_HM);
    for (int task = blockIdx.x * 8 + wave; task < 16 * 16; task += gridDim.x * 8) {
        const int t = task >> 4, n = 256 * (task & 15) + 4 * lane;
        f32x4 acc = (f32x4){0.f, 0.f, 0.f, 0.f};
#pragma unroll 8
        for (int e = 0; e < 128; ++e) { const unsigned id = me[t * 128 + e].x; const float hv = HM[t * 128 + e]; acc += *(const f32x4*)(pv + (size_t)id * DM + n) * hv; }
#pragma unroll
        for (int bb = 0; bb < 4; ++bb) { f32x4* o = (f32x4*)(H + (size_t)(MAIN_ROWS + 16 * bb + t) * DM + n); *o = *o + acc; }
    }
}

#if MK_ONE_LAUNCH
#define GRID_BAR() xcd_barrier(bar)
#else
#define GRID_BAR() do {} while (0)
#endif
#define IN(k) (lo <= (k) && (k) < hi)
#define SEAM(k) do { if (IN((k) + 1)) GRID_BAR(); } while (0)
#ifndef DUP_MASK
#define DUP_MASK 0u
#endif
#define REPS(k) ((((unsigned)DUP_MASK >> (k)) & 1u) ? 2 : 1)
template <int l> __device__ __forceinline__ void layer_phases(const int lo, const int hi, const int G, LAS unsigned char* lds, const XcdBarrier& bar) {
        const int p0 = l * NPL;
        if (IN(p0 + 0)) for (int rep = 0; rep < REPS(0); ++rep) { phase_conv_norm(l, lds); SEAM(p0 + 0); }
        if (IN(p0 + 1)) for (int rep = 0; rep < REPS(1); ++rep) {
            const Ctx Cq = load_ctx(); unsigned char* ws = Cq.ws; bf16* Z = (bf16*)(ws + WS_Z); float* H = (float*)(ws + WS_H); (void)Z; (void)H;
            pg8::Gemm g{(const pg8::bf16_t*)Z, (const pg8::bf16_t*)(ws + WS_WIN), MP, PN, DM}; pg8::StaticOrder S; S.init(MP, PN, G, (int)blockIdx.x);
            pg8::EpiBf16<0> E{(pg8::bf16_t*)(ws + WS_PROJ), PN, nullptr, 0, 0};
            pg8::gemm_phase<pg8::EpiBf16<0>, pg8::StaticOrder, false>(lds, g, S, E, nullptr);
            SEAM(p0 + 1);
        }
        if (IN(p0 + 2)) for (int rep = 0; rep < REPS(2); ++rep) {
            for (int u = blockIdx.x; u < 1028; u += G) rwkv_prep_unit(l, u, lds);
            for (int u = (blockIdx.x + G - 16) % G; u < 2080; u += G) hgrn_local_unit(l, u, lds);
            SEAM(p0 + 2);
        }
        if (IN(p0 + 3)) for (int rep = 0; rep < REPS(3); ++rep) {
            for (int r = blockIdx.x; r < 256; r += G) {
                if (r < 48) { rwkv_scan_unit(r, lds); continue; }
                const int q = r - 48;
                const bool split = (G == 256);
                unsigned* hgc = (unsigned*)(load_ctx().ws + WS_CTL) + CW_HG;
                if (q < 64 && rep == 0) {
                    hgrn_scan_slice(q);
                    if (split) {
                        asm volatile("s_waitcnt vmcnt(0)" ::: "memory"); __syncthreads();
                        if (threadIdx.x == 0) { __builtin_amdgcn_fence(__ATOMIC_RELEASE, "agent"); asm volatile("s_waitcnt vmcnt(0)" ::: "memory");
                            __hip_atomic_fetch_add(hgc, 1u, __ATOMIC_RELAXED, __HIP_MEMORY_SCOPE_AGENT); }
                    }
                }
                for (int u = q; u < 1548; u += 208) swa_unit(l, u, lds);
                if (split) {
                    if (threadIdx.x == 0) { unsigned sp = 0; const unsigned want = 64u * (unsigned)(l + 1);
                        while (__hip_atomic_load(hgc, __ATOMIC_RELAXED, __HIP_MEMORY_SCOPE_AGENT) < want) { __builtin_amdgcn_s_sleep(2); if (++sp > (1u << 22)) break; }
                        __builtin_amdgcn_fence(__ATOMIC_ACQUIRE, "agent"); asm volatile("s_waitcnt vmcnt(0)" ::: "memory"); }
                    __syncthreads();
                    for (int u = q; u < HG_OUT_EARLY; u += 208) hgrn_out_unit(l, u, lds);
                }
            }
            SEAM(p0 + 3);
        }
        if (IN(p0 + 4)) for (int rep = 0; rep < REPS(4); ++rep) {
            for (int u = ((G == 256) ? HG_OUT_EARLY : 0) + blockIdx.x; u < 2080; u += G) hgrn_out_unit(l, u, lds);
            rwkv_post_all(l);
            SEAM(p0 + 4);
        }
        if (IN(p0 + 5)) for (int rep = 0; rep < REPS(5); ++rep) {
            const Ctx Cq = load_ctx(); unsigned char* ws = Cq.ws; bf16* Z = (bf16*)(ws + WS_Z); float* H = (float*)(ws + WS_H); (void)Z; (void)H;
            constexpr int MR = MAIN_ROWS; pg8::Gemm8 g{ws + WS_MX8, ws + WS_WO8, MR, DM, DM, WO8_E8M0}; pg8::StaticOrder S; S.init(MR, DM, G, (int)blockIdx.x);
            pg8::EpiResF32 E{H, DM, (l == 0) ? Cq.in[I_X] : (const float*)H};
            pg8::gemm_phase8<pg8::EpiResF32, pg8::StaticOrder, false>(lds, g, S, E, nullptr);
            if (l == 0) meta_gemm<0>((const bf16*)Z + (size_t)MAIN_ROWS * DM, (const bf16*)(ws + WS_WO), DM, H, DM, lds);
            SEAM(p0 + 5);
        }
        if (IN(p0 + 6)) for (int rep = 0; rep < REPS(6); ++rep) { norm2_zero_all(l); SEAM(p0 + 6); }
        if (IN(p0 + 7)) for (int rep = 0; rep < REPS(7); ++rep) {
            const Ctx Cq = load_ctx(); unsigned char* ws = Cq.ws; bf16* Z = (bf16*)(ws + WS_Z); float* H = (float*)(ws + WS_H); (void)Z; (void)H;
            constexpr int MR = MAIN_ROWS; pg8::Gemm g{(const pg8::bf16_t*)Z, (const pg8::bf16_t*)(ws + WS_WS), MR, 2048, DM}; pg8::StaticOrder S; S.init(MR, 2048, G, (int)blockIdx.x);
            pg8::EpiF32 E{(float*)(ws + WS_SC), 2048, nullptr};
            pg8::gemm_phase<pg8::EpiF32, pg8::StaticOrder, false>(lds, g, S, E, nullptr);
            if (l == 0) meta_gemm<1>((const bf16*)Z + (size_t)MAIN_ROWS * DM, (const bf16*)(ws + WS_WS), 2048, (float*)(ws + WS_SC), 2048, lds);
            SEAM(p0 + 7);
        }
        if (IN(p0 + 8)) for (int rep = 0; rep < REPS(8); ++rep) { route_all(l, lds); SEAM(p0 + 8); }
        if (IN(p0 + 9)) for (int rep = 0; rep < REPS(9); ++rep) {
            const Ctx Cq = load_ctx(); unsigned char* ws = Cq.ws; bf16* Z = (bf16*)(ws + WS_Z); float* H = (float*)(ws + WS_H); (void)Z; (void)H;
            constexpr int MR = MAIN_ROWS; pg8::Gemm8 g{ws + WS_HN8, ws + WS_U, MR, NE, DM, U8_E8M0}; pg8::StaticOrder S; S.init(MR, NE, G, (int)blockIdx.x);
            pg8::EpiGate8 E{ws};
            pg8::gemm_phase8<pg8::EpiGate8, pg8::StaticOrder, false>(lds, g, S, E, nullptr);
            if (l == 0) meta_u_all(l);
            SEAM(p0 + 9);
        }
        if (IN(p0 + 10)) for (int rep = 0; rep < REPS(10); ++rep) {
            const Ctx Cq = load_ctx(); unsigned char* ws = Cq.ws; bf16* Z = (bf16*)(ws + WS_Z); float* H = (float*)(ws + WS_H); (void)Z; (void)H;
            constexpr int MR = MAIN_ROWS; pg8::Gemm8 g{ws + WS_HG8, ws + WS_VT, MR, DM, NE, V8_E8M0}; pg8::StaticOrder S; S.init(MR, DM, G, (int)blockIdx.x);
            pg8::EpiResF32 E{H, DM, (const float*)H};
            pg8::gemm_phase8<pg8::EpiResF32, pg8::StaticOrder, false>(lds, g, S, E, nullptr);
            if (l == 0) meta_v_all(l);
            SEAM(p0 + 10);
        }
}
__global__ void __launch_bounds__(512, 2) hybrid_fwd(Ctx C) {
    extern __shared__ __attribute__((aligned(16))) unsigned char lds_raw[];
    LAS unsigned char* lds = (LAS unsigned char*)lds_raw;
    const int tid = threadIdx.x, lane = tid & 63, wave = __builtin_amdgcn_readfirstlane(tid >> 6);
    const int G = gridDim.x;
    unsigned* ctl = (unsigned*)(C.ws + WS_CTL);
    volatile LAS unsigned* MISC = (volatile LAS unsigned*)(lds + LDS_MISC);
    if (tid < 64) MISC[tid] = 0u;
    __syncthreads();
#if MK_ONE_LAUNCH
    XcdBarrier bar = xcd_barrier_post(ctl + CW_BAR, MISC + 8);
#else
    XcdBarrier bar; bar.bar = ctl; bar.x = 0u; bar.st = MISC + 8;
#endif
    const int lo = C.ph_lo, hi = C.ph_hi;
    layer_phases<0>(lo, hi, G, lds, bar);
    layer_phases<1>(lo, hi, G, lds, bar);
    if (IN(2 * NPL)) final_norm_all();
}

extern "C" void kernel_launch(void* const* d_in, const int* in_sizes, int n_in, void* d_out, int out_size, void* d_ws, size_t ws_size, hipStream_t stream) {
    static int grid = 0;
    if (grid == 0) {
        if (n_in != 25 || ws_size < WS_END) { fprintf(stderr, "kernel_launch: need 25 inputs and %zu bytes of workspace (got %d, %zu)\n", (size_t)WS_END, n_in, ws_size); grid = -1; return; }
        int dev = 0, cus = 0, per_cu = 0;
        if (hipGetDevice(&dev) != hipSuccess || hipDeviceGetAttribute(&cus, hipDeviceAttributeMultiprocessorCount, dev) != hipSuccess) { grid = -1; return; }
        if (hipFuncSetAttribute((const void*)hybrid_fwd, hipFuncAttributeMaxDynamicSharedMemorySize, LDS_BYTES) != hipSuccess) { fprintf(stderr, "kernel_launch: hipFuncSetAttribute failed\n"); grid = -1; return; }
        if (hipOccupancyMaxActiveBlocksPerMultiprocessor(&per_cu, (const void*)hybrid_fwd, 512, LDS_BYTES) != hipSuccess || per_cu < 1) { fprintf(stderr, "kernel_launch: occupancy query says %d blocks per CU\n", per_cu); }
        (void)hipGetLastError();
        grid = cus;
    }
    if (grid < 0) return;
    (void)hipMemsetAsync((char*)d_ws + WS_CTL, 0, CTL_ZERO_BYTES, stream);
    Ctx c{};
    for (int i = 0; i < 25; ++i) c.in[i] = (const float*)d_in[i];
    c.out = (float*)d_out; c.ws = (unsigned char*)d_ws;
#if MK_ONE_LAUNCH
    c.ph_lo = 0; c.ph_hi = NPH;
    hipLaunchKernelGGL(hybrid_fwd, dim3(grid), dim3(512), LDS_BYTES, stream, c);
#else
    for (int p = 0; p < NPH; ++p) { c.ph_lo = p; c.ph_hi = p + 1; hipLaunchKernelGGL(hybrid_fwd, dim3(grid), dim3(512), LDS_BYTES, stream, c); }
#endif
}
```

```cpp
#include <hip/hip_runtime.h>
#include <cstdio>
#include <cstdint>
#ifndef MK_ONE_LAUNCH
#define MK_ONE_LAUNCH 1
#endif
namespace pg8 {
#define PG8_LAS __attribute__((address_space(3)))
typedef unsigned short bf16_t;
typedef short bf16x8 __attribute__((ext_vector_type(8)));
typedef float f32x4 __attribute__((ext_vector_type(4)));
typedef unsigned u32x4 __attribute__((ext_vector_type(4)));
constexpr int BM = 256, BK = 64, HALF = 128, HTB = HALF * BK * 2  , STAGE_BYTES = 8 * HTB, NXCD = 8, WGM = 8;

__host__ __device__ __forceinline__ int lds_byte(int r, int c) { const int st = (r >> 4) * 2 + (c >> 5), rr = r & 15, cc = c & 31, ob = rr * 64 + cc * 2; return st * 1024 + (ob ^ (((ob >> 9) & 1) << 5)); }
__host__ __device__ __forceinline__ void stage_rc(int b, int& R, int& C) { const int st = b / 1024, sb = b % 1024, swz = sb ^ (((sb >> 9) & 1) << 5); R = (st >> 1) * 16 + swz / 64; C = (st & 1) * 32 + (swz % 64) / 2; }
__host__ __device__ __forceinline__ int perm32(int rho) { const int n = rho >> 4, i = rho & 15; return 8 * (i >> 2) + 4 * n + (i & 3); }

struct Unit { int pm, pn; };
struct Gemm { const bf16_t* A; const bf16_t* Bt; int M, N, K; };

struct StaticOrder {
    int nM, nN, nwg, G, c;
    __host__ __device__ void init(int M, int N, int G_, int c_) { nM = M / BM; nN = N / BM; nwg = nM * nN; G = G_; c = c_; }
    __host__ __device__ bool next(int i, Unit& u) const {
        const long L = (long)i * G + c; if (L >= nwg) return false;
        int wgid = (int)L; { const int q = nwg / NXCD, r = nwg % NXCD, xcd = wgid % NXCD, off = wgid / NXCD; wgid = (xcd < r ? xcd * (q + 1) : r * (q + 1) + (xcd - r) * q) + off; }
        const int nig = WGM * nN, gid = wgid / nig, fm = gid * WGM, gsz = (nM - fm) < WGM ? (nM - fm) : WGM;
        u.pm = fm + ((wgid % nig) % gsz); u.pn = (wgid % nig) / gsz; return true;
    }
    __device__ __forceinline__ void a_ready(const Unit&) const {}
    __device__ __forceinline__ void done(const Unit&) const {}
};
__device__ __forceinline__ unsigned cvt_pk_bf16(float lo, float hi) { unsigned r; asm volatile("v_cvt_pk_bf16_f32 %0, %1, %2" : "=v"(r) : "v"(lo), "v"(hi)); return r; }
typedef float f32x2 __attribute__((ext_vector_type(2)));
__device__ __forceinline__ f32x2 gelu_pk(f32x2 v) {
    const f32x2 av = __builtin_elementwise_abs(v), d = av * 0.2316418882f + 1.0f;
    f32x2 t; t.x = __builtin_amdgcn_rcpf(d.x); t.y = __builtin_amdgcn_rcpf(d.y);
    f32x2 q = t * 0.5307027145f + (-0.7265760135f); q = q * t + 0.7107068705f; q = q * t + (-0.142248368f); q = q * t + 0.127414796f; q = q * t;
    const f32x2 s = (v * v) * (-0.72134752044f);
    f32x2 e; e.x = __builtin_amdgcn_exp2f(s.x); e.y = __builtin_amdgcn_exp2f(s.y);
    const f32x2 m = v * (q * e), r = v - m;
    f32x2 o; o.x = v.x < 0.f ? m.x : r.x; o.y = v.y < 0.f ? m.y : r.y; return o;
}
struct EpiF32 {
    static constexpr bool PERM = false, AFTER_DRAIN = false;
    float* C; int ldc; const float* bias;
    __device__ __forceinline__ void operator()(const f32x4 (&acc)[2][2][4][2], const Unit& u, int wr, int wc, int fr, int fq) const {
        const int row0 = u.pm * BM + wr * 64 + fr, col0 = u.pn * BM + wc * 32 + 4 * fq;
        f32x4 bv[2][2];
#pragma unroll
        for (int bj = 0; bj < 2; ++bj)
#pragma unroll
            for (int n = 0; n < 2; ++n) bv[bj][n] = bias ? *(const f32x4*)(bias + col0 + bj * HALF + n * 16) : (f32x4){0.f, 0.f, 0.f, 0.f};
#pragma unroll
        for (int ai = 0; ai < 2; ++ai)
#pragma unroll
            for (int m = 0; m < 4; ++m) { float* rowp = C + (size_t)(row0 + ai * HALF + m * 16) * ldc + col0;
#pragma unroll
                for (int bj = 0; bj < 2; ++bj)
#pragma unroll
                    for (int n = 0; n < 2; ++n) *(f32x4*)(rowp + bj * HALF + n * 16) = acc[ai][bj][m][n] + bv[bj][n]; }
    }
};
template <int ACT  > struct EpiBf16 {
    static constexpr bool PERM = true, AFTER_DRAIN = false;
    bf16_t* O; int ldc; const float* bias; int split_cols; size_t split_stride;
    __device__ __forceinline__ void operator()(const f32x4 (&acc)[2][2][4][2], const Unit& u, int wr, int wc, int fr, int fq) const {
        const int row0 = u.pm * BM + wr * 64 + fr; int colt = u.pn * BM; bf16_t* base = O;
        if (split_cols) { const int t = colt / split_cols; base += (size_t)t * split_stride; colt -= t * split_cols; }
        const int col0 = colt + wc * 32 + 8 * fq, bcol0 = u.pn * BM + wc * 32 + 8 * fq;
        f32x4 bv[2][2];
#pragma unroll
        for (int bj = 0; bj < 2; ++bj)
#pragma unroll
            for (int n = 0; n < 2; ++n) bv[bj][n] = bias ? *(const f32x4*)(bias + bcol0 + bj * HALF + 4 * n) : (f32x4){0.f, 0.f, 0.f, 0.f};
#pragma unroll
        for (int ai = 0; ai < 2; ++ai)
#pragma unroll
            for (int m = 0; m < 4; ++m) { bf16_t* rowp = base + (size_t)(row0 + ai * HALF + m * 16) * ldc + col0;
#pragma unroll
                for (int bj = 0; bj < 2; ++bj) { f32x4 v0 = acc[ai][bj][m][0] + bv[bj][0], v1 = acc[ai][bj][m][1] + bv[bj][1];
                    if (ACT == 1) { f32x2 a = gelu_pk((f32x2){v0[0], v0[1]}), b = gelu_pk((f32x2){v0[2], v0[3]}), c = gelu_pk((f32x2){v1[0], v1[1]}), d = gelu_pk((f32x2){v1[2], v1[3]});
                        v0 = (f32x4){a.x, a.y, b.x, b.y}; v1 = (f32x4){c.x, c.y, d.x, d.y}; }
                    if (ACT == 2) {
#pragma unroll
                        for (int j = 0; j < 4; ++j) { v0[j] = 0.5f * v0[j] * (1.0f + erff(v0[j] * 0.70710678f)); v1[j] = 0.5f * v1[j] * (1.0f + erff(v1[j] * 0.70710678f)); } }
                    u32x4 w; w.x = cvt_pk_bf16(v0[0], v0[1]); w.y = cvt_pk_bf16(v0[2], v0[3]); w.z = cvt_pk_bf16(v1[0], v1[1]); w.w = cvt_pk_bf16(v1[2], v1[3]);
                    *(u32x4*)(rowp + bj * HALF) = w; } }
    }
};
template <class Epi, class Sched, bool STAMP = false>
__device__ __forceinline__ void gemm_phase(PG8_LAS unsigned char* lds, const Gemm g, const Sched& S, const Epi& E, unsigned long long* stamps) {
    int tid_ = threadIdx.x; asm volatile("" : "+v"(tid_));
    const int tid = tid_, wid = __builtin_amdgcn_readfirstlane(tid >> 6), lane = tid & 63, wr = wid >> 2, wc = wid & 3, fr = lane & 15, fq = lane >> 4;
    const int K = g.K, nt = K / BK;
    int ts_lo = 0, ts_hi = 0, nts = 0; const unsigned long long rt_entry = STAMP ? (unsigned long long)wall_clock64() : 0ull;
#define PG8_STAMP() do { if (STAMP && wid == 0 && nts < 64) { const unsigned long long _c = (unsigned long long)clock64(); \
        ts_lo = (lane == nts) ? (int)(unsigned)_c : ts_lo; ts_hi = (lane == nts) ? (int)(unsigned)(_c >> 32) : ts_hi; ++nts; } } while (0)
    PG8_STAMP();
    unsigned voffA[2], voffB[2];
#pragma unroll
    for (int i = 0; i < 2; ++i) { int R, C; stage_rc(tid * 16 + i * 8192, R, C); const int Rb = Epi::PERM ? ((R & ~31) + perm32(R & 31)) : R;
        voffA[i] = (unsigned)(R * K + C) * 2u; voffB[i] = (unsigned)(Rb * K + C) * 2u; }
    const size_t kstep = (size_t)(BK * 2);
    const size_t hstep = (size_t)HALF * K * 2;
    const size_t tstep = 2 * hstep;
    const unsigned ldsw = (unsigned)wid * 1024u;
    const unsigned ldsdst = (unsigned)__builtin_amdgcn_readfirstlane((int)((unsigned)(size_t)lds + ldsw));
    const int aoff = lds_byte(wr * 64 + fr, fq * 8), boff = lds_byte(wc * 32 + fr, fq * 8);
#define PG8_SA(b, h) (((b) * 2 + (h)) * HTB)
#define PG8_SB(b, h) ((4 + (b) * 2 + (h)) * HTB)
#define PG8_STAGE(bufoff, gbase, voff) do { _Pragma("unroll") for (int _i = 0; _i < 2; ++_i) { unsigned keep_; \
        asm volatile("s_mov_b32 %0, m0\n\ts_mov_b32 m0, %3\n\ts_nop 0\n\tglobal_load_lds_dwordx4 %1, %2\n\ts_mov_b32 m0, %0" : "=&s"(keep_) : "v"((voff)[_i]), "s"((unsigned long long)(gbase)), "s"(ldsdst + (unsigned)((bufoff) + _i * 8192)) : "memory"); } } while (0)
#define PG8_LDA(dst, b, h) do { _Pragma("unroll") for (int m = 0; m < 4; ++m) _Pragma("unroll") for (int k = 0; k < 2; ++k) dst[m][k] = *(const PG8_LAS bf16x8*)(lds + PG8_SA(b, h) + aoff + m * 2048 + k * 1024); } while (0)
#define PG8_LDB(dst, b, h) do { _Pragma("unroll") for (int n = 0; n < 2; ++n) _Pragma("unroll") for (int k = 0; k < 2; ++k) dst[n][k] = *(const PG8_LAS bf16x8*)(lds + PG8_SB(b, h) + boff + n * 2048 + k * 1024); } while (0)
#define PG8_MMA(ai, bj, At, Bt) do { __builtin_amdgcn_s_setprio(1); _Pragma("unroll") for (int m = 0; m < 4; ++m) _Pragma("unroll") for (int n = 0; n < 2; ++n) _Pragma("unroll") for (int k = 0; k < 2; ++k) \
        acc[ai][bj][m][n] = __builtin_amdgcn_mfma_f32_16x16x32_bf16(Bt[n][k], At[m][k], acc[ai][bj][m][n], 0, 0, 0); __builtin_amdgcn_s_setprio(0); } while (0)
#define PG8_WAIT_V(n) asm volatile("s_waitcnt vmcnt(" #n ")" ::: "memory")
#define PG8_WAIT_L(n) asm volatile("s_waitcnt lgkmcnt(" #n ")" ::: "memory")
#define PG8_BAR __builtin_amdgcn_s_barrier()
#define PG8_SCHED __builtin_amdgcn_sched_barrier(0)
    Unit cur, nxt; int ui = 0;
    if (!S.next(0, cur)) return;
    f32x4 acc[2][2][4][2];
#pragma unroll
    for (int a = 0; a < 2; ++a)
#pragma unroll
        for (int b = 0; b < 2; ++b)
#pragma unroll
            for (int m = 0; m < 4; ++m)
#pragma unroll
                for (int n = 0; n < 2; ++n) acc[a][b][m][n] = (f32x4){0.f, 0.f, 0.f, 0.f};
    bf16x8 At[4][2], B0[2][2], B1[2][2];
    const char* cA = (const char*)g.A + (size_t)cur.pm * tstep; const char* cB = (const char*)g.Bt + (size_t)cur.pn * tstep;
    S.a_ready(cur);
    PG8_STAGE(PG8_SB(0, 0), cB, voffB); PG8_STAGE(PG8_SA(0, 0), cA, voffA); PG8_STAGE(PG8_SB(0, 1), cB + hstep, voffB); PG8_STAGE(PG8_SA(0, 1), cA + hstep, voffA);
    if (wr == 1) PG8_BAR;
    PG8_WAIT_V(4); PG8_BAR;
    PG8_STAGE(PG8_SB(1, 0), cB + kstep, voffB); PG8_STAGE(PG8_SA(1, 0), cA + kstep, voffA); PG8_STAGE(PG8_SB(1, 1), cB + hstep + kstep, voffB);
    PG8_WAIT_V(6); PG8_BAR;
    PG8_STAMP();
    for (;;) {
        const bool has_next = S.next(ui + 1, nxt);
        const char* nA = has_next ? (const char*)g.A + (size_t)nxt.pm * tstep : cA; const char* nB = has_next ? (const char*)g.Bt + (size_t)nxt.pn * tstep : cB;
        for (int t = 0; t < nt; t += 2) {
            const bool last = (t == nt - 2);
            const char* a1 = cA + (size_t)(t + 1) * kstep;
            const char* a2 = last ? nA : cA + (size_t)(t + 2) * kstep; const char* b2 = last ? nB : cB + (size_t)(t + 2) * kstep;
            const char* a3 = a2 + kstep; const char* b3 = b2 + kstep;
            if (last && has_next) S.a_ready(nxt);
            PG8_LDB(B0, 0, 0); PG8_SCHED; PG8_LDA(At, 0, 0); PG8_STAGE(PG8_SA(1, 1), a1 + hstep, voffA);
            PG8_WAIT_L(8); PG8_BAR; PG8_WAIT_L(0); PG8_MMA(0, 0, At, B0); PG8_BAR; PG8_SCHED;
            PG8_LDB(B1, 0, 1); PG8_STAGE(PG8_SB(0, 0), b2, voffB);
            PG8_BAR; PG8_WAIT_L(0); PG8_MMA(0, 1, At, B1); PG8_BAR;
            PG8_LDA(At, 0, 1); PG8_STAGE(PG8_SA(0, 0), a2, voffA);
            PG8_BAR; PG8_WAIT_L(0); PG8_MMA(1, 0, At, B0); PG8_BAR; PG8_SCHED;
            PG8_STAGE(PG8_SB(0, 1), b2 + hstep, voffB);
            PG8_WAIT_V(6); PG8_BAR; PG8_MMA(1, 1, At, B1); PG8_BAR;
            PG8_LDB(B0, 1, 0); PG8_SCHED; PG8_LDA(At, 1, 0); PG8_STAGE(PG8_SA(0, 1), a2 + hstep, voffA);
            PG8_WAIT_L(8); PG8_BAR; PG8_WAIT_L(0); PG8_MMA(0, 0, At, B0); PG8_BAR; PG8_SCHED;
            PG8_LDB(B1, 1, 1); PG8_STAGE(PG8_SB(1, 0), b3, voffB);
            PG8_BAR; PG8_WAIT_L(0); PG8_MMA(0, 1, At, B1); PG8_BAR;
            PG8_LDA(At, 1, 1); PG8_STAGE(PG8_SA(1, 0), a3, voffA);
            PG8_BAR; PG8_WAIT_L(0); PG8_MMA(1, 0, At, B0); PG8_BAR; PG8_SCHED;
            PG8_STAGE(PG8_SB(1, 1), b3 + hstep, voffB);
            PG8_WAIT_V(6); PG8_BAR; PG8_MMA(1, 1, At, B1); PG8_BAR;
        }
        PG8_STAMP();
        if constexpr (!Epi::AFTER_DRAIN) { E(acc, cur, wr, wc, fr, fq); S.done(cur); }
        PG8_STAMP();
        if (!has_next) break;
#pragma unroll
        for (int a = 0; a < 2; ++a)
#pragma unroll
            for (int b = 0; b < 2; ++b)
#pragma unroll
                for (int m = 0; m < 4; ++m)
#pragma unroll
                    for (int n = 0; n < 2; ++n) acc[a][b][m][n] = (f32x4){0.f, 0.f, 0.f, 0.f};
        cur = nxt; cA = nA; cB = nB; ++ui;
    }
    PG8_WAIT_V(0);
    if (wr == 0) PG8_BAR;
    PG8_BAR;
    if constexpr (Epi::AFTER_DRAIN) { E.fused(acc, cur, wr, wc, fr, fq, lds, wid, lane); S.done(cur); }
    PG8_STAMP();
    if (STAMP && wid == 0) { stamps[lane] = lane < nts ? (((unsigned long long)(unsigned)ts_hi << 32) | (unsigned)ts_lo) : 0ull;
        if (lane == 62) stamps[62] = rt_entry; if (lane == 63) stamps[63] = (unsigned long long)wall_clock64(); }
#undef PG8_STAMP
#undef PG8_SA
#undef PG8_SB
#undef PG8_STAGE
#undef PG8_LDA
#undef PG8_LDB
#undef PG8_MMA
#undef PG8_WAIT_V
#undef PG8_WAIT_L
#undef PG8_BAR
#undef PG8_SCHED
}
typedef int i32x4 __attribute__((ext_vector_type(4)));
typedef int i32x8 __attribute__((ext_vector_type(8)));
struct Gemm8 { const unsigned char* A; const unsigned char* Bt; int M, N, K; int scale; };
template <class Epi, class Sched, bool STAMP = false>
__device__ __forceinline__ void gemm_phase8(PG8_LAS unsigned char* lds, const Gemm8 g, const Sched& S, const Epi& E, unsigned long long* stamps) {
    int tid_ = threadIdx.x; asm volatile("" : "+v"(tid_));
    const int tid = tid_, wid = __builtin_amdgcn_readfirstlane(tid >> 6), lane = tid & 63, wr = wid >> 2, wc = wid & 3, fr = lane & 15, fq = lane >> 4;
    const int K = g.K  , nt = K / 128;
    int ts_lo = 0, ts_hi = 0, nts = 0; const unsigned long long rt_entry = STAMP ? (unsigned long long)wall_clock64() : 0ull;
#define PG8_STAMP() do { if (STAMP && wid == 0 && nts < 64) { const unsigned long long _c = (unsigned long long)clock64(); \
        ts_lo = (lane == nts) ? (int)(unsigned)_c : ts_lo; ts_hi = (lane == nts) ? (int)(unsigned)(_c >> 32) : ts_hi; ++nts; } } while (0)
    PG8_STAMP();
    unsigned voffA[2], voffB[2];
#pragma unroll
    for (int i = 0; i < 2; ++i) { int R, C; stage_rc(tid * 16 + i * 8192, R, C); const int Rb = Epi::PERM ? ((R & ~31) + perm32(R & 31)) : R;
        voffA[i] = (unsigned)(R * K + 2 * C); voffB[i] = (unsigned)(Rb * K + 2 * C); }
    const size_t kstep = (size_t)(BK * 2);
    const size_t hstep = (size_t)HALF * K;
    const size_t tstep = 2 * hstep;
    const unsigned ldsw = (unsigned)wid * 1024u;
    const unsigned ldsdst = (unsigned)__builtin_amdgcn_readfirstlane((int)((unsigned)(size_t)lds + ldsw));
    const int aoff = lds_byte(wr * 64 + fr, fq * 16), boff = lds_byte(wc * 32 + fr, fq * 16);
#define PG8_SA(b, h) (((b) * 2 + (h)) * HTB)
#define PG8_SB(b, h) ((4 + (b) * 2 + (h)) * HTB)
#define PG8_STAGE(bufoff, gbase, voff) do { _Pragma("unroll") for (int _i = 0; _i < 2; ++_i) { unsigned keep_; \
        asm volatile("s_mov_b32 %0, m0\n\ts_mov_b32 m0, %3\n\ts_nop 0\n\tglobal_load_lds_dwordx4 %1, %2\n\ts_mov_b32 m0, %0" : "=&s"(keep_) : "v"((voff)[_i]), "s"((unsigned long long)(gbase)), "s"(ldsdst + (unsigned)((bufoff) + _i * 8192)) : "memory"); } } while (0)
#define PG8_LDA(dst, b, h) do { _Pragma("unroll") for (int m = 0; m < 4; ++m) { const i32x4 lo_ = *(const PG8_LAS i32x4*)(lds + PG8_SA(b, h) + aoff + m * 2048), hi_ = *(const PG8_LAS i32x4*)(lds + PG8_SA(b, h) + aoff + m * 2048 + 16); dst[m] = __builtin_shufflevector(lo_, hi_, 0, 1, 2, 3, 4, 5, 6, 7); } } while (0)
#define PG8_LDB(dst, b, h) do { _Pragma("unroll") for (int n = 0; n < 2; ++n) { const i32x4 lo_ = *(const PG8_LAS i32x4*)(lds + PG8_SB(b, h) + boff + n * 2048), hi_ = *(const PG8_LAS i32x4*)(lds + PG8_SB(b, h) + boff + n * 2048 + 16); dst[n] = __builtin_shufflevector(lo_, hi_, 0, 1, 2, 3, 4, 5, 6, 7); } } while (0)
#define PG8_MMA(ai, bj, At, Bt) do { __builtin_amdgcn_s_setprio(1); _Pragma("unroll") for (int m = 0; m < 4; ++m) _Pragma("unroll") for (int n = 0; n < 2; ++n) \
        acc[ai][bj][m][n] = __builtin_amdgcn_mfma_scale_f32_16x16x128_f8f6f4(Bt[n], At[m], acc[ai][bj][m][n], 0, 0, 0, g.scale, 0, 0x7f7f7f7f); __builtin_amdgcn_s_setprio(0); } while (0)
#define PG8_WAIT_V(n) asm volatile("s_waitcnt vmcnt(" #n ")" ::: "memory")
#define PG8_WAIT_L(n) asm volatile("s_waitcnt lgkmcnt(" #n ")" ::: "memory")
#define PG8_BAR __builtin_amdgcn_s_barrier()
#define PG8_SCHED __builtin_amdgcn_sched_barrier(0)
    Unit cur, nxt; int ui = 0;
    if (!S.next(0, cur)) return;
    f32x4 acc[2][2][4][2];
#pragma unroll
    for (int a = 0; a < 2; ++a)
#pragma unroll
        for (int b = 0; b < 2; ++b)
#pragma unroll
            for (int m = 0; m < 4; ++m)
#pragma unroll
                for (int n = 0; n < 2; ++n) acc[a][b][m][n] = (f32x4){0.f, 0.f, 0.f, 0.f};
    i32x8 At[4], B0[2], B1[2];
    const char* cA = (const char*)g.A + (size_t)cur.pm * tstep; const char* cB = (const char*)g.Bt + (size_t)cur.pn * tstep;
    S.a_ready(cur);
    PG8_STAGE(PG8_SB(0, 0), cB, voffB); PG8_STAGE(PG8_SA(0, 0), cA, voffA); PG8_STAGE(PG8_SB(0, 1), cB + hstep, voffB); PG8_STAGE(PG8_SA(0, 1), cA + hstep, voffA);
    if (wr == 1) PG8_BAR;
    PG8_WAIT_V(4); PG8_BAR;
    PG8_STAGE(PG8_SB(1, 0), cB + kstep, voffB); PG8_STAGE(PG8_SA(1, 0), cA + kstep, voffA); PG8_STAGE(PG8_SB(1, 1), cB + hstep + kstep, voffB);
    PG8_WAIT_V(6); PG8_BAR;
    PG8_STAMP();
    for (;;) {
        const bool has_next = S.next(ui + 1, nxt);
        const char* nA = has_next ? (const char*)g.A + (size_t)nxt.pm * tstep : cA; const char* nB = has_next ? (const char*)g.Bt + (size_t)nxt.pn * tstep : cB;
        for (int t = 0; t < nt; t += 2) {
            const bool last = (t == nt - 2);
            const char* a1 = cA + (size_t)(t + 1) * kstep;
            const char* a2 = last ? nA : cA + (size_t)(t + 2) * kstep; const char* b2 = last ? nB : cB + (size_t)(t + 2) * kstep;
            const char* a3 = a2 + kstep; const char* b3 = b2 + kstep;
            if (last && has_next) S.a_ready(nxt);
            PG8_LDB(B0, 0, 0); PG8_SCHED; PG8_LDA(At, 0, 0); PG8_STAGE(PG8_SA(1, 1), a1 + hstep, voffA);
            PG8_WAIT_L(8); PG8_BAR; PG8_WAIT_L(0); PG8_MMA(0, 0, At, B0); PG8_BAR; PG8_SCHED;
            PG8_LDB(B1, 0, 1); PG8_STAGE(PG8_SB(0, 0), b2, voffB);
            PG8_BAR; PG8_WAIT_L(0); PG8_MMA(0, 1, At, B1); PG8_BAR;
            PG8_LDA(At, 0, 1); PG8_STAGE(PG8_SA(0, 0), a2, voffA);
            PG8_BAR; PG8_WAIT_L(0); PG8_MMA(1, 0, At, B0); PG8_BAR; PG8_SCHED;
            PG8_STAGE(PG8_SB(0, 1), b2 + hstep, voffB);
            PG8_WAIT_V(6); PG8_BAR; PG8_MMA(1, 1, At, B1); PG8_BAR;
            PG8_LDB(B0, 1, 0); PG8_SCHED; PG8_LDA(At, 1, 0); PG8_STAGE(PG8_SA(0, 1), a2 + hstep, voffA);
            PG8_WAIT_L(8); PG8_BAR; PG8_WAIT_L(0); PG8_MMA(0, 0, At, B0); PG8_BAR; PG8_SCHED;
            PG8_LDB(B1, 1, 1); PG8_STAGE(PG8_SB(1, 0), b3, voffB);
            PG8_BAR; PG8_WAIT_L(0); PG8_MMA(0, 1, At, B1); PG8_BAR;
            PG8_LDA(At, 1, 1); PG8_STAGE(PG8_SA(1, 0), a3, voffA);
            PG8_BAR; PG8_WAIT_L(0); PG8_MMA(1, 0, At, B0); PG8_BAR; PG8_SCHED;
            PG8_STAGE(PG8_SB(1, 1), b3 + hstep, voffB);
            PG8_WAIT_V(6); PG8_BAR; PG8_MMA(1, 1, At, B1); PG8_BAR;
        }
        PG8_STAMP();
        if constexpr (!Epi::AFTER_DRAIN) { E(acc, cur, wr, wc, fr, fq); S.done(cur); }
        PG8_STAMP();
        if (!has_next) break;
#pragma unroll
        for (int a = 0; a < 2; ++a)
#pragma unroll
            for (int b = 0; b < 2; ++b)
#pragma unroll
                for (int m = 0; m < 4; ++m)
#pragma unroll
                    for (int n = 0; n < 2; ++n) acc[a][b][m][n] = (f32x4){0.f, 0.f, 0.f, 0.f};
        cur = nxt; cA = nA; cB = nB; ++ui;
    }
    PG8_WAIT_V(0);
    if (wr == 0) PG8_BAR;
    PG8_BAR;
    if constexpr (Epi::AFTER_DRAIN) { E.fused(acc, cur, wr, wc, fr, fq, lds, wid, lane); S.done(cur); }
    PG8_STAMP();
    if (STAMP && wid == 0) { stamps[lane] = lane < nts ? (((unsigned long long)(unsigned)ts_hi << 32) | (unsigned)ts_lo) : 0ull;
        if (lane == 62) stamps[62] = rt_entry; if (lane == 63) stamps[63] = (unsigned long long)wall_clock64(); }
#undef PG8_STAMP
#undef PG8_SA
#undef PG8_SB
#undef PG8_STAGE
#undef PG8_LDA
#undef PG8_LDB
#undef PG8_MMA
#undef PG8_WAIT_V
#undef PG8_WAIT_L
#undef PG8_BAR
#undef PG8_SCHED
}
}
#define XB_TMO      128
#define XB_XCNT(j)  (256  + 64 * (j))
#define XB_XSUB(j)  (1280 + 64 * (j))
#define XB_XGEN(j)  (2304 + 64 * (j))
#define XB_TOP      3328
#define XB_TOPGEN   3392
#define XCD_BAR_WORDS 3456
#define XB_SPIN_CAP (1u << 23)
#define LAS __attribute__((address_space(3)))

__device__ __forceinline__ unsigned xb_ld(unsigned* p)              { return __hip_atomic_load(p, __ATOMIC_RELAXED, __HIP_MEMORY_SCOPE_AGENT); }
__device__ __forceinline__ unsigned xb_add(unsigned* p, unsigned v) { return __hip_atomic_fetch_add(p, v, __ATOMIC_RELAXED, __HIP_MEMORY_SCOPE_AGENT); }
__device__ __forceinline__ unsigned xb_xcc_id() { return (unsigned)__builtin_amdgcn_s_getreg((3 << 11) | 20) & 0xFu; }
#define XB_SPIN(cond, bar) do { unsigned _sp = 0; while (cond) { __builtin_amdgcn_s_sleep(1); \
    if ((++_sp & 255u) == 0u) { if (xb_ld(&(bar)[XB_TMO])) break; if (_sp > XB_SPIN_CAP) { atomicAdd(&(bar)[XB_TMO], 1u); break; } } } } while (0)

struct XcdBarrier {
    unsigned* bar; unsigned x;
    volatile LAS unsigned* st;
};

__device__ __forceinline__ XcdBarrier xcd_barrier_post(unsigned* bar, volatile LAS unsigned* st) {
    XcdBarrier b; b.bar = bar; b.x = xb_xcc_id(); b.st = st;
    if (threadIdx.x == 0) (void)xb_add(&bar[XB_XCNT(b.x)], 1u);
    return b;
}
__device__ __forceinline__ void xcd_barrier_complete(unsigned* bar, unsigned x, unsigned& nloc, unsigned& nx) {
    const unsigned G = gridDim.x * gridDim.y * gridDim.z;
    unsigned sum, cnt, mine, sp = 0u;
    for (;;) {
        sum = 0u; cnt = 0u; mine = 0u;
#pragma unroll
        for (unsigned j = 0; j < 16; ++j) { const unsigned c = xb_ld(&bar[XB_XCNT(j)]); sum += c; cnt += (c > 0u) ? 1u : 0u; mine = (j == x) ? c : mine; }
        if (sum == G) break;
        __builtin_amdgcn_s_sleep(1);
        if ((++sp & 255u) == 0u) { if (xb_ld(&bar[XB_TMO])) break; if (sp > XB_SPIN_CAP) { atomicAdd(&bar[XB_TMO], 1u); break; } }
    }
    nloc = mine > 0u ? mine : 1u; nx = cnt > 0u ? cnt : 1u;
}

__device__ __forceinline__ void xcd_barrier(const XcdBarrier& b) {
    asm volatile("s_waitcnt vmcnt(0)" ::: "memory");
    __syncthreads();
    if (threadIdx.x == 0) {
        unsigned* bar = b.bar; asm volatile("" : "+s"(bar));
        __builtin_amdgcn_s_waitcnt(0);
        unsigned nloc = b.st[0], nx = b.st[1];
        if (nloc == 0u) { xcd_barrier_complete(bar, b.x, nloc, nx); b.st[0] = nloc; b.st[1] = nx; }
        const unsigned old = xb_add(&bar[XB_XSUB(b.x)], 1u);
        const unsigned gen = old / nloc;
        if (old + 1u == (gen + 1u) * nloc) {
            __builtin_amdgcn_fence(__ATOMIC_RELEASE, "agent");
            asm volatile("s_waitcnt vmcnt(0)" ::: "memory");
            const unsigned og = xb_add(&bar[XB_TOP], 1u);
            const unsigned tg = og / nx;
            if (og + 1u == (tg + 1u) * nx) xb_add(&bar[XB_TOPGEN], 1u);
            else XB_SPIN(xb_ld(&bar[XB_TOPGEN]) == tg, bar);
            __builtin_amdgcn_fence(__ATOMIC_ACQUIRE, "agent");
            xb_add(&bar[XB_XGEN(b.x)], 1u);
            asm volatile("s_waitcnt vmcnt(0)" ::: "memory");
        } else {
            XB_SPIN(xb_ld(&bar[XB_XGEN(b.x)]) == gen, bar);
            __builtin_amdgcn_fence(__ATOMIC_ACQUIRE, "agent");
            asm volatile("s_waitcnt vmcnt(0)" ::: "memory");
        }
    }
    __syncthreads();
}
#define GAS __attribute__((address_space(1)))
typedef unsigned short bf16;
typedef float f32x4 __attribute__((ext_vector_type(4)));
typedef unsigned u32x4 __attribute__((ext_vector_type(4)));
typedef unsigned u32x2 __attribute__((ext_vector_type(2)));
typedef LAS float lfloat;
typedef LAS f32x4 lf32x4;

constexpr int DM = 4096, NB = 4, NMETA = 16, LT = 4112, TT = NB * LT  , MP = 16640  ;
constexpr int PN = 11008;
constexpr int C_R = 0, C_K = 1536, C_V = 3072, C_WL = 4608, C_SQ = 4864, C_SK = 6400, C_SV = 6592, C_HQ = 6912, C_HF = 7936, C_HI = 8960, C_HG = 9984;
constexpr int NE = 16384;
constexpr int NHR = 24;
constexpr int NCH = 66;

constexpr size_t MiB = 1ull << 20;
constexpr size_t WS_CTL = 0, WS_WIN = 2 * MiB, WS_WO = 88 * MiB, WS_WS = 120 * MiB, WS_U = 136 * MiB  , WS_VT = 200 * MiB  , WS_HN8 = 264 * MiB  , WS_H = 392 * MiB, WS_Z = 652 * MiB, WS_R = 782 * MiB;
constexpr size_t WS_PROJ = WS_R, WS_RA = 1132 * MiB, WS_RG = 1711 * MiB, WS_RY = 1760 * MiB, WS_HDS = 1809 * MiB, WS_HQG = 1875 * MiB, WS_HAT = 1908 * MiB, WS_HED = 1941 * MiB, WS_END = 1975 * MiB;
constexpr size_t WS_CHB = 1943 * MiB;
constexpr size_t WS_ME = 1 * MiB + 832 * 1024;
constexpr size_t WS_HM = WS_ME + 64 * 1024;
constexpr size_t WS_LW = 1 * MiB;
constexpr size_t WS_GG = WS_R, WS_SC = 1302 * MiB, WS_HG8 = 1432 * MiB  ;
constexpr size_t WS_BM = 1700 * MiB;
static_assert(WS_WIN + (size_t)PN * DM * 2 <= WS_WO && WS_WO + (size_t)DM * DM * 2 <= WS_WS && WS_WS + (size_t)2048 * DM * 2 <= WS_U && WS_U + (size_t)NE * DM <= WS_VT && WS_VT + (size_t)NE * DM <= WS_HN8 && WS_HN8 + (size_t)MP * DM <= WS_H, "ws map 1");
static_assert(WS_H + (size_t)MP * DM * 4 <= WS_Z && WS_Z + (size_t)MP * DM * 2 <= WS_R, "ws map 2");
static_assert(WS_PROJ + (size_t)MP * PN * 2 <= WS_RA && WS_RA + (size_t)96 * LT * 384 * 4 <= WS_RG && WS_RG + (size_t)TT * 1536 * 2 <= WS_RY && WS_RY + (size_t)TT * 1536 * 2 <= WS_HDS, "ws map 3");
static_assert(WS_HDS + (size_t)32 * NCH * 16384 * 2 <= WS_HQG && WS_HQG + (size_t)32 * NCH * 8192 * 2 <= WS_HAT && WS_HAT + (size_t)32 * NCH * 4096 * 4 <= WS_HED && WS_HED + (size_t)32 * NCH * 128 * 4 <= WS_END, "ws map 4");
static_assert(WS_GG + (size_t)MP * NE * 2 <= WS_SC && WS_SC + (size_t)MP * 2048 * 4 <= WS_HG8 && WS_HG8 + (size_t)MP * NE <= WS_BM && WS_BM + (size_t)16384 * 64 * 4 <= WS_END, "ws map 5");

constexpr int LDS_BYTES = 147456;
constexpr int LDS_MISC = 143360;
constexpr int CW_BAR = 4096;
constexpr int CW_HL = 8192 + 128;
constexpr int CW_HG = 8192;
constexpr size_t CTL_ZERO_BYTES = 64 * 1024;

__device__ __forceinline__ float bf2f(unsigned b) { return __uint_as_float(b << 16); }
typedef __bf16 bf16x2_t __attribute__((ext_vector_type(2)));
typedef float f32x2_t __attribute__((ext_vector_type(2)));
__device__ __forceinline__ unsigned pk2(float lo, float hi) { const f32x2_t v = {lo, hi}; const bf16x2_t r = __builtin_convertvector(v, bf16x2_t); return __builtin_bit_cast(unsigned, r); }
__device__ __forceinline__ unsigned f2bf(float f) { return pk2(f, 0.0f) & 0xffffu; }
__device__ __forceinline__ unsigned pk4_fp8(float a, float b, float c, float d) {
    a = __builtin_amdgcn_fmed3f(a, -448.f, 448.f); b = __builtin_amdgcn_fmed3f(b, -448.f, 448.f); c = __builtin_amdgcn_fmed3f(c, -448.f, 448.f); d = __builtin_amdgcn_fmed3f(d, -448.f, 448.f);
    int v = __builtin_amdgcn_cvt_pk_fp8_f32(a, b, 0, false); v = __builtin_amdgcn_cvt_pk_fp8_f32(c, d, v, true); return (unsigned)v;
}
constexpr float U8_SCALE = 64.f, V8_SCALE = 8.f, HG8_SCALE = 64.f;
constexpr int U8_E8M0 = 0x79797979  , V8_E8M0 = 0x76767676  ;
constexpr float MX8_SCALE = 8.f, WO8_SCALE = 128.f; constexpr int WO8_E8M0 = 0x75757575  ;
constexpr size_t WS_MX8 = WS_HN8  , WS_WO8 = 332 * MiB  ;
static_assert(WS_HN8 + (size_t)MP * DM <= WS_WO8 && WS_WO8 + (size_t)DM * DM <= WS_H, "ws map 6");
__device__ __forceinline__ unsigned char fp8_1(float a) { a = __builtin_amdgcn_fmed3f(a, -448.f, 448.f); return (unsigned char)(__builtin_amdgcn_cvt_pk_fp8_f32(a, 0.f, 0, false) & 0xff); }
#define LDS_WAIT() asm volatile("s_waitcnt lgkmcnt(0)" ::: "memory")
__device__ __forceinline__ float wave_sum(float v) {
#pragma unroll
    for (int o = 1; o < 64; o <<= 1) v += __shfl_xor(v, o);
    return v;
}
template <int CTRL> __device__ __forceinline__ float dpp_mov(float x) { return __int_as_float(__builtin_amdgcn_update_dpp(0, __float_as_int(x), CTRL, 0xF, 0xF, false)); }
__device__ __forceinline__ float rowsum16(float x) {
    x += dpp_mov<0xB1>(x); x += dpp_mov<0x4E>(x); x += dpp_mov<0x141>(x); x += dpp_mov<0x140>(x); return x;
}
__device__ __forceinline__ void rope_sc(float pos, int j, float& sn, float& cs) {
    const float ang = pos * exp2f(-(float)j * 2.3664460711655218f);
    float rev = ang * 0.15915494309189535f; rev = rev - floorf(rev);
    sn = __builtin_amdgcn_sinf(rev); cs = __builtin_amdgcn_cosf(rev);
}
__device__ __forceinline__ float sigmoidf_(float x) { return 1.0f / (1.0f + __expf(-x)); }

__device__ __forceinline__ int ltid() { int t = threadIdx.x; asm volatile("" : "+v"(t)); return t; }
__device__ __forceinline__ int ROWOF(int b, int t) { return t >= NMETA ? b * 4096 + (t - NMETA) : 16384 + b * NMETA + t; }
constexpr int MAIN_ROWS = 16384;
struct Ctx {
    const float* in[25];
    float* out;
    unsigned char* ws;
    int ph_lo, ph_hi;
};
typedef const __attribute__((address_space(4))) Ctx CtxK;
__device__ __forceinline__ Ctx load_ctx() { CtxK* p = (CtxK*)__builtin_amdgcn_kernarg_segment_ptr(); asm volatile("" : "+s"(p)); Ctx c;
#pragma unroll
    for (int i = 0; i < 25; ++i) c.in[i] = p->in[i];
    c.out = p->out; c.ws = p->ws; c.ph_lo = p->ph_lo; c.ph_hi = p->ph_hi; return c; }
#define LOAD_CTX() const Ctx C = load_ctx()
__device__ __forceinline__ int uni_launder(int x) { int y = __builtin_amdgcn_readfirstlane(x); asm volatile("" : "+s"(y)); return y; }
#define UNI(x) uni_launder(x)
#define UNI_LDS(p) ((LAS unsigned char*)(uintptr_t)(unsigned)__builtin_amdgcn_readfirstlane((int)(unsigned)(uintptr_t)(p)))
enum { I_X = 0, I_META, I_NMIX, I_NFFN, I_NFIN, I_WIN, I_WOUT, I_MU, I_W0, I_W2, I_A0, I_A2, I_G2, I_KK, I_KA, I_RK, I_LNW, I_LNB, I_SINK, I_HLB, I_HNORM, I_WQ, I_KEYS, I_PU, I_PV };

namespace pg8 {
struct EpiResF32 {
    static constexpr bool PERM = false, AFTER_DRAIN = false;
    float* H; int ldc; const float* Src;
    __device__ __forceinline__ void operator()(const f32x4 (&acc)[2][2][4][2], const Unit& u, int wr, int wc, int fr, int fq) const {
        const int row0 = u.pm * BM + wr * 64 + fr, col0 = u.pn * BM + wc * 32 + 4 * fq;
#pragma unroll
        for (int ai = 0; ai < 2; ++ai)
#pragma unroll
            for (int m = 0; m < 4; ++m) { float* rowp = H + (size_t)(row0 + ai * HALF + m * 16) * ldc + col0; const float* srcp = Src + (size_t)(row0 + ai * HALF + m * 16) * ldc + col0;
                f32x4 old[2][2];
#pragma unroll
                for (int bj = 0; bj < 2; ++bj)
#pragma unroll
                    for (int n = 0; n < 2; ++n) old[bj][n] = *(const f32x4*)(srcp + bj * HALF + n * 16);
#pragma unroll
                for (int bj = 0; bj < 2; ++bj)
#pragma unroll
                    for (int n = 0; n < 2; ++n) *(f32x4*)(rowp + bj * HALF + n * 16) = old[bj][n] + acc[ai][bj][m][n]; }
    }
};
struct EpiGate8 {
    static constexpr bool PERM = true, AFTER_DRAIN = false;
    unsigned char* wsb;
    __device__ __forceinline__ void operator()(const f32x4 (&acc)[2][2][4][2], const Unit& u, int wr, int wc, int fr_, int fq_) const {
        (void)fr_; (void)fq_; int ln = (int)__builtin_amdgcn_workitem_id_x() & 63; asm volatile("" : "+v"(ln)); const int fr = ln & 15, fq = ln >> 4;
        const bf16_t* G = (const bf16_t*)(wsb + WS_GG); unsigned char* Hg = wsb + WS_HG8; const unsigned* Bm = (const unsigned*)(wsb + WS_BM); constexpr int ldc = NE;
        const int row0 = u.pm * BM + wr * 64 + fr, col0 = u.pn * BM + wc * 32 + 8 * fq;
#pragma unroll
        for (int ai = 0; ai < 2; ++ai)
#pragma unroll
            for (int m = 0; m < 4; ++m) { const size_t ro = (size_t)(row0 + ai * HALF + m * 16) * ldc + col0;
                const unsigned bits = Bm[(size_t)(row0 + ai * HALF + m * 16) * 64 + u.pn];
#pragma unroll
                for (int bj = 0; bj < 2; ++bj) {
                    u32x2 w = (u32x2){0u, 0u};
                    if ((bits >> (16 * bj + 4 * wc + fq)) & 1u) {
                        const u32x4 g = *(const u32x4*)(G + ro + bj * HALF);
                        const f32x4 v0 = acc[ai][bj][m][0], v1 = acc[ai][bj][m][1];
                        const f32x2 a = gelu_pk((f32x2){v0[0], v0[1]}), b = gelu_pk((f32x2){v0[2], v0[3]}), c = gelu_pk((f32x2){v1[0], v1[1]}), d = gelu_pk((f32x2){v1[2], v1[3]});
                        w.x = pk4_fp8(64.f * a.x * __uint_as_float(g.x << 16), 64.f * a.y * __uint_as_float(g.x & 0xffff0000u), 64.f * b.x * __uint_as_float(g.y << 16), 64.f * b.y * __uint_as_float(g.y & 0xffff0000u));
                        w.y = pk4_fp8(64.f * c.x * __uint_as_float(g.z << 16), 64.f * c.y * __uint_as_float(g.z & 0xffff0000u), 64.f * d.x * __uint_as_float(g.w << 16), 64.f * d.y * __uint_as_float(g.w & 0xffff0000u));
                    }
                    *(u32x2*)(Hg + ro + bj * HALF) = w;
                }
                __builtin_amdgcn_sched_barrier(0); }
    }
};
}

__device__ __forceinline__ void tr_load_tile(const float* W, int N, int k0, int n0, lfloat* scr, int lane) {
    const int q = lane & 15, r = lane >> 4;
    f32x4 v[16];
#pragma unroll
    for (int i = 0; i < 16; ++i) v[i] = *(const f32x4*)(W + (size_t)(k0 + r + 4 * i) * N + n0 + 4 * q);
#pragma unroll
    for (int i = 0; i < 16; ++i) { lfloat* d = scr + (r + 4 * i) * 65 + 4 * q; d[0] = v[i].x; d[1] = v[i].y; d[2] = v[i].z; d[3] = v[i].w; }
    LDS_WAIT();
}
__device__ __forceinline__ void transpose_item(const float* W, int N, bf16* WT, int Kp, int k0, int n0, int dst_row0, lfloat* scr, int lane) {
    tr_load_tile(W, N, k0, n0, scr, lane);
    const int c = lane & 7, nn = lane >> 3;
#pragma unroll
    for (int p = 0; p < 8; ++p) { const int n = 8 * p + nn; const lfloat* s = scr + (8 * c) * 65 + n;
        u32x4 o; o.x = pk2(s[0 * 65], s[1 * 65]); o.y = pk2(s[2 * 65], s[3 * 65]); o.z = pk2(s[4 * 65], s[5 * 65]); o.w = pk2(s[6 * 65], s[7 * 65]);
        *(u32x4*)(WT + (size_t)(dst_row0 + n) * Kp + k0 + 8 * c) = o; }
    LDS_WAIT();
}
__device__ __forceinline__ void transpose_item8(const float* W, int N, unsigned char* WT, int Kp, int k0, int n0, float sc, lfloat* scr, int lane) {
    tr_load_tile(W, N, k0, n0, scr, lane);
    const int c = lane & 3, nn = lane >> 2;
#pragma unroll
    for (int p = 0; p < 4; ++p) { const int n = 16 * p + nn; const lfloat* s = scr + (16 * c) * 65 + n;
        u32x4 o; o.x = pk4_fp8(s[0 * 65] * sc, s[1 * 65] * sc, s[2 * 65] * sc, s[3 * 65] * sc); o.y = pk4_fp8(s[4 * 65] * sc, s[5 * 65] * sc, s[6 * 65] * sc, s[7 * 65] * sc);
        o.z = pk4_fp8(s[8 * 65] * sc, s[9 * 65] * sc, s[10 * 65] * sc, s[11 * 65] * sc); o.w = pk4_fp8(s[12 * 65] * sc, s[13 * 65] * sc, s[14 * 65] * sc, s[15 * 65] * sc);
        *(u32x4*)(WT + (size_t)(n0 + n) * Kp + k0 + 16 * c) = o; }
    LDS_WAIT();
}
__device__ __forceinline__ void norm_row(const float* src, const float* gain, bf16* dst, float* hdst, int lane, unsigned char* dst8 = nullptr) {
    const f32x4* xr = (const f32x4*)src + lane;
    f32x4 v[16]; float ss = 0.f;
#pragma unroll
    for (int j = 0; j < 16; ++j) { v[j] = xr[64 * j]; ss += (v[j].x * v[j].x + v[j].y * v[j].y) + (v[j].z * v[j].z + v[j].w * v[j].w); }
    ss = wave_sum(ss);
    const float r = rsqrtf(ss * (1.0f / 4096.0f) + 1e-5f);
    const f32x4* gr = (const f32x4*)gain + lane;
    u32x2* o8 = (u32x2*)dst + lane;
#pragma unroll
    for (int j = 0; j < 16; ++j) { const f32x4 g = gr[64 * j]; const f32x4 y = (f32x4){v[j].x * r * g.x, v[j].y * r * g.y, v[j].z * r * g.z, v[j].w * r * g.w};
        u32x2 o; o.x = pk2(y.x, y.y); o.y = pk2(y.z, y.w); o8[64 * j] = o;
        if (dst8) ((unsigned*)dst8)[lane + 64 * j] = pk4_fp8(y.x, y.y, y.z, y.w); }
    if (hdst) { f32x4* hr = (f32x4*)hdst + lane;
#pragma unroll
        for (int j = 0; j < 16; ++j) hr[64 * j] = v[j]; }
}

#define ROW_LOAD16(v_, p_) do { const f32x4* xr_ = (const f32x4*)(p_) + lane; _Pragma("unroll") for (int j_ = 0; j_ < 16; ++j_) v_[j_] = xr_[64 * j_]; } while (0)
__device__ __forceinline__ void norm_row_fin(const f32x4 (&v)[16], const f32x4 (&gn)[16], bf16* dst, float* hdst, int lane, unsigned char* dst8) {
    float ss = 0.f;
#pragma unroll
    for (int j = 0; j < 16; ++j) ss += (v[j].x * v[j].x + v[j].y * v[j].y) + (v[j].z * v[j].z + v[j].w * v[j].w);
    ss = wave_sum(ss);
    const float r = rsqrtf(ss * (1.0f / 4096.0f) + 1e-5f);
    u32x2* o8 = (u32x2*)dst + lane;
#pragma unroll
    for (int j = 0; j < 16; ++j) { const f32x4 g = gn[j]; const f32x4 y = (f32x4){v[j].x * r * g.x, v[j].y * r * g.y, v[j].z * r * g.z, v[j].w * r * g.w};
        u32x2 o; o.x = pk2(y.x, y.y); o.y = pk2(y.z, y.w); o8[64 * j] = o;
        if (dst8) ((unsigned*)dst8)[lane + 64 * j] = pk4_fp8(y.x, y.y, y.z, y.w); }
    if (hdst) { f32x4* hr = (f32x4*)hdst + lane;
#pragma unroll
        for (int j = 0; j < 16; ++j) hr[64 * j] = v[j]; }
}
template <class SrcOf, class Fin>
__device__ __forceinline__ void rows_pipe(int first, int stride, int n, int lane, SrcOf src_of, Fin fin) {
    f32x4 va[16], vb[16];
    int m = first;
    if (m < n) ROW_LOAD16(va, src_of(m));
    while (m < n) {
        const int m2 = m + stride;
        if (m2 < n) ROW_LOAD16(vb, src_of(m2));
        fin(va, m);
        if (m2 >= n) break;
        const int m3 = m2 + stride;
        if (m3 < n) ROW_LOAD16(va, src_of(m3));
        fin(vb, m2);
        m = m3;
    }
}

__device__ __forceinline__ void phase_conv_norm(int l_, LAS unsigned char* lds_) {
    LOAD_CTX(); const int l = UNI(l_); LAS unsigned char* lds = UNI_LDS(lds_);
    const int tid = ltid(), lane = tid & 63, wave = tid >> 6;
    const int gw = blockIdx.x * 8 + wave, NGW = gridDim.x * 8;
    unsigned char* ws = C.ws;
    bf16* WinT = (bf16*)(ws + WS_WIN); bf16* WoT = (bf16*)(ws + WS_WO); bf16* WsT = (bf16*)(ws + WS_WS); unsigned char* U8 = ws + WS_U; unsigned char* VT8 = ws + WS_VT;
    float* H = (float*)(ws + WS_H); bf16* Z = (bf16*)(ws + WS_Z);
    const float* w_in = C.in[I_WIN] + (size_t)l * DM * 10880;
    const float* w_out = C.in[I_WOUT] + (size_t)l * DM * DM;
    const float* wq = C.in[I_WQ] + (size_t)l * DM * 2048;
    const float* keys = C.in[I_KEYS] + (size_t)l * 16 * 128 * 128;
    const float* pu = C.in[I_PU] + (size_t)l * NE * DM;
    const float* pv = C.in[I_PV] + (size_t)l * NE * DM;
    lfloat* scr = (lfloat*)(lds + wave * 16896);
    constexpr int I_WIN_N = 64 * 170, I_WO_N = 64 * 64, I_VT_N = 256 * 64, I_U_N = 8192, I_ZW_N = 64, I_NORM_N = TT, I_ZP_N = MP - TT;
    constexpr int NITEMS = I_WIN_N + I_WO_N + I_VT_N + I_U_N + I_ZW_N + I_NORM_N + I_ZP_N;
    {
        const int gwu = UNI(gw);
        f32x4 gn[16]; { const f32x4* gr = (const f32x4*)(C.in[I_NMIX] + (l == 0 ? 0 : DM)) + lane;
#pragma unroll
            for (int j = 0; j < 16; ++j) gn[j] = gr[64 * j]; }
        rows_pipe(gwu, NGW, I_NORM_N, lane,
            [&](int m) -> const float* { if (l != 0) return H + (size_t)m * DM;
                const int b = m < MAIN_ROWS ? (m >> 12) : ((m - MAIN_ROWS) >> 4), t = m < MAIN_ROWS ? (m & 4095) + NMETA : ((m - MAIN_ROWS) & 15);
                return (t < NMETA) ? C.in[I_META] + (size_t)t * DM : C.in[I_X] + ((size_t)b * 4096 + (t - NMETA)) * DM; },
            [&](const f32x4 (&v)[16], int m) { norm_row_fin(v, gn, Z + (size_t)m * DM, (l == 0 && m >= MAIN_ROWS) ? H + (size_t)m * DM : nullptr, lane, nullptr); });
    }
    int it0 = gw; while (it0 < I_NORM_N) it0 += NGW;
    for (int it = it0; it < NITEMS; it += NGW) {
        int r = it;
        r -= I_NORM_N;
        if (r < I_ZP_N) {
            const int m = TT + r; u32x4* z = (u32x4*)(Z + (size_t)m * DM) + lane;
#pragma unroll
            for (int j = 0; j < 8; ++j) z[64 * j] = (u32x4){0u, 0u, 0u, 0u};
            if (l == 0) { f32x4* hz = (f32x4*)(H + (size_t)m * DM) + lane;
#pragma unroll
                for (int j = 0; j < 16; ++j) hz[64 * j] = (f32x4){0.f, 0.f, 0.f, 0.f}; }
            continue; }
        r -= I_ZP_N;
        if (r < I_WIN_N) { const int kb = r / 170, nb = r % 170, n0 = 64 * nb; transpose_item(w_in, 10880, WinT, DM, 64 * kb, n0, n0 < 6784 ? n0 : n0 + 128, scr, lane); continue; }
        r -= I_WIN_N;
        if (r < I_WO_N) { const int kb = r / 64, nb = r % 64; transpose_item8(w_out, DM, ws + WS_WO8, DM, 64 * kb, 64 * nb, WO8_SCALE, scr, lane);
            if (l == 0) transpose_item(w_out, DM, WoT, DM, 64 * kb, 64 * nb, 64 * nb, scr, lane);
            continue; }
        r -= I_WO_N;
        if (r < I_VT_N) { const int kb = r / 64, nb = r % 64; transpose_item8(pv, DM, VT8, NE, 64 * kb, 64 * nb, V8_SCALE, scr, lane); continue; }
        r -= I_VT_N;
        if (r < I_U_N) {
            const size_t e0 = (size_t)r * 8192;
#pragma unroll 2
            for (int j = 0; j < 8; ++j) { const size_t e = e0 + (size_t)(j * 64 + lane) * 16;
                const f32x4 a = *(const f32x4*)(pu + e), b2 = *(const f32x4*)(pu + e + 4), c2 = *(const f32x4*)(pu + e + 8), d2 = *(const f32x4*)(pu + e + 12);
                u32x4 o; o.x = pk4_fp8(a.x * U8_SCALE, a.y * U8_SCALE, a.z * U8_SCALE, a.w * U8_SCALE); o.y = pk4_fp8(b2.x * U8_SCALE, b2.y * U8_SCALE, b2.z * U8_SCALE, b2.w * U8_SCALE);
                o.z = pk4_fp8(c2.x * U8_SCALE, c2.y * U8_SCALE, c2.z * U8_SCALE, c2.w * U8_SCALE); o.w = pk4_fp8(d2.x * U8_SCALE, d2.y * U8_SCALE, d2.z * U8_SCALE, d2.w * U8_SCALE);
                *(u32x4*)(U8 + e) = o; }
            continue; }
        r -= I_U_N;
        {
            u32x4* z = (u32x4*)(WinT + (size_t)6784 * DM) + (size_t)r * 1024 + lane;
#pragma unroll
            for (int j = 0; j < 16; ++j) z[64 * j] = (u32x4){0u, 0u, 0u, 0u};
        }
    }
    {
        bf16* LW = (bf16*)(ws + WS_LW);
        const float* w2 = C.in[I_W2] + (size_t)l * 64 * 1536; const float* a2 = C.in[I_A2] + (size_t)l * 64 * 1536; const float* g2 = C.in[I_G2] + (size_t)l * 128 * 1536;
        for (int e = blockIdx.x * 512 + tid; e < 256 * 1536; e += gridDim.x * 512) { const int k = e / 1536, n = e - k * 1536;
            const float v = k < 64 ? w2[k * 1536 + n] : (k < 128 ? a2[(k - 64) * 1536 + n] : g2[(k - 128) * 1536 + n]);
            LW[n * 256 + k] = (bf16)f2bf(v); }
    }
    {
        const int wv = UNI(tid >> 6), fr = lane & 15, g4 = lane >> 4;
        for (int u = blockIdx.x; u < 1024; u += gridDim.x) {
            const int hc = u >> 6, k0 = (u & 63) * 64;
            const float* kp_ = keys + (size_t)hc * 16384 + (size_t)(16 * wv + fr) * 128 + 8 * g4;
            pg8::bf16x8 Af[4];
#pragma unroll
            for (int ks = 0; ks < 4; ++ks) { const f32x4 x = *(const f32x4*)(kp_ + 32 * ks), y = *(const f32x4*)(kp_ + 32 * ks + 4);
                const u32x4 wq_ = (u32x4){pk2(x.x, x.y), pk2(x.z, x.w), pk2(y.x, y.y), pk2(y.z, y.w)}; Af[ks] = (pg8::bf16x8)wq_; }
#pragma unroll
            for (int nt = 0; nt < 4; ++nt) {
                const float* wp = wq + (size_t)(k0 + 16 * nt + fr) * 2048 + hc * 128 + 8 * g4;
                f32x4 d = (f32x4){0.f, 0.f, 0.f, 0.f};
#pragma unroll
                for (int ks = 0; ks < 4; ++ks) { const f32x4 x = *(const f32x4*)(wp + 32 * ks), y = *(const f32x4*)(wp + 32 * ks + 4);
                    const u32x4 bw = (u32x4){pk2(x.x, x.y), pk2(x.z, x.w), pk2(y.x, y.y), pk2(y.z, y.w)};
                    d = __builtin_amdgcn_mfma_f32_16x16x32_bf16(Af[ks], (pg8::bf16x8)bw, d, 0, 0, 0); }
#pragma unroll
                for (int r = 0; r < 4; ++r) WsT[(size_t)(hc * 128 + 16 * wv + 4 * g4 + r) * DM + k0 + 16 * nt + fr] = (bf16)f2bf(d[r]);
            }
        }
    }
}

__device__ __forceinline__ void swa_unit(int l_, int u_, LAS unsigned char* lds_) {
    LOAD_CTX(); const int l = UNI(l_), u = UNI(u_); LAS unsigned char* lds = UNI_LDS(lds_);
    const int tid = ltid(), lane = tid & 63, wave = UNI(tid >> 6);
    const int qtile = u % 129, hk = (u / 129) % 3, b = u / 387;
    const int t0 = qtile * 32, lo = t0 - 127;
    const bf16* proj = (const bf16*)(C.ws + WS_PROJ);
    bf16* mixed = (bf16*)(C.ws + WS_Z);
    LAS bf16* Ks = (LAS bf16*)lds;
    LAS bf16* Vt = (LAS bf16*)(lds + 27648);
    LAS bf16* Qs = (LAS bf16*)(lds + 53248);
    __syncthreads();
#define SWA_ROPE8(dst, x, y, pos, first) do { _Pragma("unroll") for (int j_ = 0; j_ < 8; ++j_) { float sn_, cs_; rope_sc((float)(pos), j_, sn_, cs_); dst[j_] = (first) ? x[j_] * cs_ - y[j_] * sn_ : x[j_] * cs_ + y[j_] * sn_; } } while (0)
#define SWA_UNPK(dst, vec_) do { dst[0] = bf2f(vec_.x & 0xffffu); dst[1] = bf2f(vec_.x >> 16); dst[2] = bf2f(vec_.y & 0xffffu); dst[3] = bf2f(vec_.y >> 16); dst[4] = bf2f(vec_.z & 0xffffu); dst[5] = bf2f(vec_.z >> 16); dst[6] = bf2f(vec_.w & 0xffffu); dst[7] = bf2f(vec_.w >> 16); } while (0)
#pragma unroll
    for (int i = 0; i < 3; ++i) {
        const int task = tid + 512 * i, s = task >> 3, c = task & 7;
        const int ut = s < 16 ? s : lo + s - 16;
        const bool ok = (s < 16) || (s < 176 && ut >= 16 && ut < LT);
        u32x4 w = (u32x4){0u, 0u, 0u, 0u};
        if (ok) { const bf16* pr = proj + (size_t)ROWOF(b, ut) * PN + C_SK + hk * 64;
            w = *(const u32x4*)(pr + 8 * c);
            if (c < 2) { const u32x4 wo = *(const u32x4*)(pr + 8 * (c ^ 1)); float x[8], y[8], z[8]; SWA_UNPK(x, w); SWA_UNPK(y, wo); SWA_ROPE8(z, x, y, ut, c == 0);
                w.x = pk2(z[0], z[1]); w.y = pk2(z[2], z[3]); w.z = pk2(z[4], z[5]); w.w = pk2(z[6], z[7]); } }
        *(LAS u32x4*)(Ks + s * 72 + 8 * c) = w;
    }
#pragma unroll
    for (int i = 0; i < 3; ++i) {
        const int task = tid + 512 * i, s = task >> 3, c = task & 7;
        const int ut = s < 16 ? s : lo + s - 16;
        const bool ok = (s < 16) || (s < 176 && ut >= 16 && ut < LT);
        u32x4 w = (u32x4){0u, 0u, 0u, 0u};
        if (ok) w = *(const u32x4*)(proj + (size_t)ROWOF(b, ut) * PN + C_SV + hk * 64 + 8 * c);
        LAS bf16* vp = Vt + (8 * c) * 200 + s;
        vp[0] = (bf16)(w.x & 0xffffu); vp[200] = (bf16)(w.x >> 16); vp[400] = (bf16)(w.y & 0xffffu); vp[600] = (bf16)(w.y >> 16);
        vp[800] = (bf16)(w.z & 0xffffu); vp[1000] = (bf16)(w.z >> 16); vp[1200] = (bf16)(w.w & 0xffffu); vp[1400] = (bf16)(w.w >> 16);
    }
#pragma unroll
    for (int i = 0; i < 4; ++i) {
        const int task = tid + 512 * i, row = task >> 3, c = task & 7, g = row >> 5, t = t0 + (row & 31);
        u32x4 w = (u32x4){0u, 0u, 0u, 0u};
        if (t < LT) { const bf16* qp = proj + (size_t)ROWOF(b, t) * PN + C_SQ + (hk * 8 + g) * 64;
            w = *(const u32x4*)(qp + 8 * c);
            float x[8], z[8]; SWA_UNPK(x, w);
            if (c < 2) { const u32x4 wo = *(const u32x4*)(qp + 8 * (c ^ 1)); float y[8]; SWA_UNPK(y, wo); SWA_ROPE8(z, x, y, t, c == 0); }
            else {
#pragma unroll
                for (int j = 0; j < 8; ++j) z[j] = x[j]; }
            w.x = pk2(z[0] * 0.125f, z[1] * 0.125f); w.y = pk2(z[2] * 0.125f, z[3] * 0.125f); w.z = pk2(z[4] * 0.125f, z[5] * 0.125f); w.w = pk2(z[6] * 0.125f, z[7] * 0.125f); }
        *(LAS u32x4*)(Qs + row * 72 + 8 * c) = w;
    }
#undef SWA_ROPE8
#undef SWA_UNPK
    __syncthreads();
    const int fr = lane & 15, g4 = lane >> 4;
    const int hq = hk * 8 + wave;
    const float sink = C.in[I_SINK][l * 24 + hq];
    pg8::bf16x8 Qf[2][2];
#pragma unroll
    for (int qt = 0; qt < 2; ++qt)
#pragma unroll
        for (int ks = 0; ks < 2; ++ks) Qf[qt][ks] = *(const LAS pg8::bf16x8*)(Qs + (wave * 32 + 16 * qt + fr) * 72 + 32 * ks + 8 * g4);
    f32x4 sc[12][2];
#pragma unroll
    for (int kt = 0; kt < 12; ++kt) {
        const pg8::bf16x8 k0 = *(const LAS pg8::bf16x8*)(Ks + (16 * kt + fr) * 72 + 8 * g4), k1 = *(const LAS pg8::bf16x8*)(Ks + (16 * kt + fr) * 72 + 32 + 8 * g4);
#pragma unroll
        for (int qt = 0; qt < 2; ++qt) { f32x4 a = (f32x4){0.f, 0.f, 0.f, 0.f};
            a = __builtin_amdgcn_mfma_f32_16x16x32_bf16(k0, Qf[qt][0], a, 0, 0, 0); a = __builtin_amdgcn_mfma_f32_16x16x32_bf16(k1, Qf[qt][1], a, 0, 0, 0); sc[kt][qt] = a; }
    }
    float inv[2];
    pg8::bf16x8 Pf[2][6];
#pragma unroll
    for (int qt = 0; qt < 2; ++qt) {
        const int t = t0 + 16 * qt + fr; const bool tv = t < LT;
        float m = sink;
#pragma unroll
        for (int kt = 0; kt < 12; ++kt)
#pragma unroll
            for (int r = 0; r < 4; ++r) { const int s = 16 * kt + 4 * g4 + r; const int uu = lo + s - 16;
                const bool ok = tv && (kt == 0 ? (s <= t) : (uu >= 16 && uu <= t && uu >= t - 127));
                const float v = ok ? sc[kt][qt][r] : -1.0e30f; sc[kt][qt][r] = v; m = fmaxf(m, v); }
        m = fmaxf(m, __shfl_xor(m, 16)); m = fmaxf(m, __shfl_xor(m, 32));
        float ls = 0.f;
#pragma unroll
        for (int kt = 0; kt < 12; ++kt)
#pragma unroll
            for (int r = 0; r < 4; ++r) { const float p = __expf(sc[kt][qt][r] - m); sc[kt][qt][r] = p; ls += p; }
        ls += __shfl_xor(ls, 16); ls += __shfl_xor(ls, 32);
        ls += __expf(sink - m);
        inv[qt] = 1.0f / ls;
#pragma unroll
        for (int s2 = 0; s2 < 6; ++s2) { const f32x4 pa = sc[2 * s2][qt], pb = sc[2 * s2 + 1][qt];
            u32x4 w; w.x = pk2(pa[0], pa[1]); w.y = pk2(pa[2], pa[3]); w.z = pk2(pb[0], pb[1]); w.w = pk2(pb[2], pb[3]);
            Pf[qt][s2] = (pg8::bf16x8)w; }
    }
    f32x4 o[4][2];
#pragma unroll
    for (int dt = 0; dt < 4; ++dt) { o[dt][0] = (f32x4){0.f, 0.f, 0.f, 0.f}; o[dt][1] = (f32x4){0.f, 0.f, 0.f, 0.f}; }
#pragma unroll
    for (int dt = 0; dt < 4; ++dt)
#pragma unroll
        for (int s2 = 0; s2 < 6; ++s2) {
            const u32x2 va = *(const LAS u32x2*)(Vt + (16 * dt + fr) * 200 + 32 * s2 + 4 * g4), vb = *(const LAS u32x2*)(Vt + (16 * dt + fr) * 200 + 32 * s2 + 16 + 4 * g4);
            const u32x4 vw = (u32x4){va.x, va.y, vb.x, vb.y};
            const pg8::bf16x8 vf = (pg8::bf16x8)vw;
            o[dt][0] = __builtin_amdgcn_mfma_f32_16x16x32_bf16(vf, Pf[0][s2], o[dt][0], 0, 0, 0);
            o[dt][1] = __builtin_amdgcn_mfma_f32_16x16x32_bf16(vf, Pf[1][s2], o[dt][1], 0, 0, 0);
        }
#pragma unroll
    for (int qt = 0; qt < 2; ++qt) { const int t = t0 + 16 * qt + fr;
        if (t < LT) { bf16* op = mixed + (size_t)ROWOF(b, t) * DM + 1536 + hq * 64 + 4 * g4;
#pragma unroll
            for (int dt = 0; dt < 4; ++dt) { const f32x4 v = o[dt][qt] * inv[qt]; if (t < NMETA) { u32x2 w; w.x = pk2(v[0], v[1]); w.y = pk2(v[2], v[3]); *(u32x2*)(op + 16 * dt) = w; }
                *(unsigned*)(C.ws + WS_MX8 + (size_t)ROWOF(b, t) * DM + 1536 + hq * 64 + 4 * g4 + 16 * dt) = pk4_fp8(v[0] * MX8_SCALE, v[1] * MX8_SCALE, v[2] * MX8_SCALE, v[3] * MX8_SCALE); } }
    }
}

__device__ __forceinline__ void hgrn_local_unit(int l_, int u_, LAS unsigned char* lds_) {
    LOAD_CTX(); const int l = UNI(l_), u = UNI(u_); LAS unsigned char* lds = UNI_LDS(lds_);
    const int tid = ltid(), lane = tid & 63, wave = UNI(tid >> 6);
    const int bh = u / 65, c = u % 65 + 1, b = bh >> 3, h = bh & 7;
    const bf16* proj = (const bf16*)(C.ws + WS_PROJ);
    bf16* HDS = (bf16*)(C.ws + WS_HDS); bf16* HQG = (bf16*)(C.ws + WS_HQG); float* HAT = (float*)(C.ws + WS_HAT); float* HED = (float*)(C.ws + WS_HED);
    lfloat* qs = (lfloat*)lds; lfloat* kvs = qs + 8192; lfloat* Gs = qs + 16384;
    LAS bf16* iT = (LAS bf16*)(lds + 98304);
    LAS unsigned char* shr = lds + 116736;
    lfloat* segtot = (lfloat*)shr; LAS bf16* QK = (LAS bf16*)shr; LAS bf16* kdT = (LAS bf16*)shr;
    const int k = tid & 127, seg = tid >> 7;
    const int fr = lane & 15, g4 = lane >> 4;
    float lb = 0.f;
    if (l == 1) { const float a0 = C.in[I_HLB][h * 128 + k], a1 = C.in[I_HLB][1024 + h * 128 + k]; lb = 1.0f / (1.0f + __expf(a0 - a1)); }
    __syncthreads();
    float gl[16]; float run = 0.f;
#pragma unroll
    for (int r = 0; r < 16; ++r) {
        const int tl = 16 * seg + r, t = 64 * c + tl - 112;
        float qv = 0.f, kv = 0.f, lf = 0.f; unsigned ib = 0u;
        if (t >= 0 && t < LT) { const bf16* pr = proj + (size_t)ROWOF(b, t) * PN + h * 128 + k;
            qv = bf2f(pr[C_HQ]); const float frw = bf2f(pr[C_HF]); ib = pr[C_HI];
            const float f = lb + (1.0f - lb) * sigmoidf_(frw); lf = __logf(f); kv = 1.0f - f; }
        run += lf; gl[r] = run;
        qs[tl * 128 + k] = qv; kvs[tl * 128 + k] = kv; iT[k * 72 + tl] = (bf16)ib;
    }
    segtot[seg * 128 + k] = run;
    __syncthreads();
    float off = 0.f;
    for (int s2 = 0; s2 < seg; ++s2) off += segtot[s2 * 128 + k];
#pragma unroll
    for (int r = 0; r < 16; ++r) Gs[(16 * seg + r) * 128 + k] = gl[r] + off;
    __syncthreads();
    const size_t uc = (size_t)bh * NCH + c;
    float* at = HAT + uc * 4096;
    for (int e = tid; e < 4096; e += 512) { const int t_ = e >> 6, s_ = e & 63; if (s_ > t_) at[e] = 0.f; }
    if (tid < 480) {
        const int blk = tid / 120, q = tid - blk * 120;
        int tt = (int)((1.0f + sqrtf(1.0f + 8.0f * (float)q)) * 0.5f);
        if (tt * (tt - 1) / 2 > q) --tt; if ((tt + 1) * tt / 2 <= q) ++tt;
        const int ss = q - tt * (tt - 1) / 2, t_ = 16 * blk + tt, s_ = 16 * blk + ss;
        float acc = 0.f;
        for (int kk = 0; kk < 128; ++kk) { const int k2 = (kk + lane) & 127;
            acc += qs[t_ * 128 + k2] * kvs[s_ * 128 + k2] * __expf(Gs[t_ * 128 + k2] - Gs[s_ * 128 + k2]); }
        at[t_ * 64 + s_] = acc;
    }
    if (tid >= 448) {
        const int t_ = tid - 448; float acc = 0.f;
        for (int kk = 0; kk < 128; ++kk) { const int k2 = (kk + lane) & 127; acc += qs[t_ * 128 + k2] * kvs[t_ * 128 + k2]; }
        at[t_ * 64 + t_] = acc;
    }
#pragma unroll 1
    for (int pass = 0; pass < 2; ++pass) {
        __syncthreads();
#pragma unroll 4
        for (int i = 0; i < 16; ++i) { const int e = tid + 512 * i, row = e >> 7, kx = e & 127;
            int src, ref; bool isq = row < 32;
            if (pass == 0) { src = isq ? 32 + row : row - 32; ref = 31; }
            else { const int r16 = row & 15, hi = (row >> 4) & 1; src = isq ? (hi ? 48 + r16 : 16 + r16) : (hi ? 32 + r16 : r16); ref = hi ? 47 : 15; }
            const float gr = Gs[ref * 128 + kx], gs_ = Gs[src * 128 + kx];
            const float v = isq ? qs[src * 128 + kx] * __expf(gs_ - gr) : kvs[src * 128 + kx] * __expf(gr - gs_);
            QK[row * 136 + kx] = (bf16)f2bf(v); }
        __syncthreads();
        const int ntile = pass == 0 ? 4 : 2;
        if (wave < ntile) {
            const int qrow = pass == 0 ? 16 * (wave >> 1) : 16 * wave, krow = pass == 0 ? 32 + 16 * (wave & 1) : 32 + 16 * wave;
            const int I = pass == 0 ? 2 + (wave >> 1) : (wave == 0 ? 1 : 3), J = pass == 0 ? (wave & 1) : (wave == 0 ? 0 : 2);
            f32x4 d = (f32x4){0.f, 0.f, 0.f, 0.f};
#pragma unroll
            for (int ks = 0; ks < 4; ++ks) { const pg8::bf16x8 a = *(const LAS pg8::bf16x8*)(QK + (qrow + fr) * 136 + 32 * ks + 8 * g4), bb = *(const LAS pg8::bf16x8*)(QK + (krow + fr) * 136 + 32 * ks + 8 * g4);
                d = __builtin_amdgcn_mfma_f32_16x16x32_bf16(a, bb, d, 0, 0, 0); }
#pragma unroll
            for (int r = 0; r < 4; ++r) at[(16 * I + 4 * g4 + r) * 64 + 16 * J + fr] = d[r];
        }
    }
    __syncthreads();
    for (int e = tid; e < 8192; e += 512) { const int s_ = e >> 7, kx = e & 127; const float ge = Gs[e];
        HQG[uc * 8192 + e] = (bf16)f2bf(qs[e] * __expf(ge));
        kdT[kx * 72 + s_] = (bf16)f2bf(kvs[e] * __expf(Gs[63 * 128 + kx] - ge)); }
    if (tid < 128) HED[uc * 128 + tid] = __expf(Gs[63 * 128 + tid]);
    __syncthreads();
    {
        const pg8::bf16x8 a0 = *(const LAS pg8::bf16x8*)(kdT + (16 * wave + fr) * 72 + 8 * g4), a1 = *(const LAS pg8::bf16x8*)(kdT + (16 * wave + fr) * 72 + 32 + 8 * g4);
        f32x4 dd[8];
#pragma unroll
        for (int nt = 0; nt < 8; ++nt) {
            const pg8::bf16x8 b0 = *(const LAS pg8::bf16x8*)(iT + (8 * fr + nt) * 72 + 8 * g4), b1 = *(const LAS pg8::bf16x8*)(iT + (8 * fr + nt) * 72 + 32 + 8 * g4);
            f32x4 d = (f32x4){0.f, 0.f, 0.f, 0.f};
            d = __builtin_amdgcn_mfma_f32_16x16x32_bf16(a0, b0, d, 0, 0, 0); d = __builtin_amdgcn_mfma_f32_16x16x32_bf16(a1, b1, d, 0, 0, 0);
            dd[nt] = d;
        }
#pragma unroll
        for (int r = 0; r < 4; ++r) { u32x4 w; w.x = pk2(dd[0][r], dd[1][r]); w.y = pk2(dd[2][r], dd[3][r]); w.z = pk2(dd[4][r], dd[5][r]); w.w = pk2(dd[6][r], dd[7][r]);
            *(u32x4*)(HDS + (uc * 128 + 16 * wave + 4 * g4 + r) * 128 + 8 * fr) = w; }
    }
}

__device__ __forceinline__ void rwkv_chunk_prep(const Ctx& C, int bh, int c, int lane, LAS unsigned char* wl) {
    float* RAc = (float*)(C.ws + WS_RA) + ((size_t)bh * LT + 16 * c) * 384;
    unsigned char* chb = C.ws + WS_CHB + ((size_t)bh * 257 + c) * 1280;
    LAS bf16* AbS = (LAS bf16*)(wl + 4608); LAS bf16* RbS = AbS + 16 * 72; LAS bf16* BtS = RbS + 16 * 72; LAS bf16* KtS = BtS + 16 * 72;
    float kk[16], w[16], ka[16], kp[16], rr[16], vv[16];
#pragma unroll
    for (int i = 0; i < 16; ++i) { const float* p = RAc + i * 384 + lane; kk[i] = p[0]; w[i] = p[64]; ka[i] = p[128]; kp[i] = p[192]; rr[i] = p[256]; vv[i] = p[320]; }
    float g = 1.0f; float bp[16], kq[16];
#pragma unroll
    for (int i = 0; i < 16; ++i) { const float gprev = g; g *= w[i]; const float ig = 1.0f / g;
        const float ab = -kk[i] * gprev, rb = rr[i] * g, bt = ka[i] * ig, kt = kp[i] * ig;
        AbS[i * 72 + lane] = (bf16)f2bf(ab); RbS[i * 72 + lane] = (bf16)f2bf(rb); BtS[i * 72 + lane] = (bf16)f2bf(bt); KtS[i * 72 + lane] = (bf16)f2bf(kt);
        bp[i] = bt; kq[i] = kt;
        unsigned short* rec = (unsigned short*)(RAc + i * 384);
        rec[lane] = (unsigned short)f2bf(ab); rec[64 + lane] = (unsigned short)f2bf(rb); }
    const float gC = g;
    {
        u32x4 o0, o1, q0, q1;
        o0.x = pk2(bp[0] * gC, bp[1] * gC); o0.y = pk2(bp[2] * gC, bp[3] * gC); o0.z = pk2(bp[4] * gC, bp[5] * gC); o0.w = pk2(bp[6] * gC, bp[7] * gC);
        o1.x = pk2(bp[8] * gC, bp[9] * gC); o1.y = pk2(bp[10] * gC, bp[11] * gC); o1.z = pk2(bp[12] * gC, bp[13] * gC); o1.w = pk2(bp[14] * gC, bp[15] * gC);
        q0.x = pk2(kq[0] * gC, kq[1] * gC); q0.y = pk2(kq[2] * gC, kq[3] * gC); q0.z = pk2(kq[4] * gC, kq[5] * gC); q0.w = pk2(kq[6] * gC, kq[7] * gC);
        q1.x = pk2(kq[8] * gC, kq[9] * gC); q1.y = pk2(kq[10] * gC, kq[11] * gC); q1.z = pk2(kq[12] * gC, kq[13] * gC); q1.w = pk2(kq[14] * gC, kq[15] * gC);
        unsigned char* rb_ = (unsigned char*)(RAc + (lane >> 3) * 384) + 512 + (lane & 7) * 32;
        *(u32x4*)rb_ = o0; *(u32x4*)(rb_ + 16) = o1;
        unsigned char* rk_ = (unsigned char*)(RAc + (8 + (lane >> 3)) * 384) + 512 + (lane & 7) * 32;
        *(u32x4*)rk_ = q0; *(u32x4*)(rk_ + 16) = q1;
        ((float*)(chb + 1024))[lane] = gC;
    }
    LDS_WAIT();
    const int fr = lane & 15, g4 = lane >> 4;
    lfloat* AabM = (lfloat*)wl; lfloat* AakM = AabM + 16 * 17; lfloat* BrkM = AakM + 16 * 17; lfloat* TM = BrkM + 16 * 17;
    {
        const pg8::bf16x8 a0 = *(const LAS pg8::bf16x8*)(AbS + fr * 72 + 8 * g4), a1 = *(const LAS pg8::bf16x8*)(AbS + fr * 72 + 32 + 8 * g4);
        const pg8::bf16x8 r0 = *(const LAS pg8::bf16x8*)(RbS + fr * 72 + 8 * g4), r1 = *(const LAS pg8::bf16x8*)(RbS + fr * 72 + 32 + 8 * g4);
        const pg8::bf16x8 b0 = *(const LAS pg8::bf16x8*)(BtS + fr * 72 + 8 * g4), b1 = *(const LAS pg8::bf16x8*)(BtS + fr * 72 + 32 + 8 * g4);
        const pg8::bf16x8 k0 = *(const LAS pg8::bf16x8*)(KtS + fr * 72 + 8 * g4), k1 = *(const LAS pg8::bf16x8*)(KtS + fr * 72 + 32 + 8 * g4);
        const f32x4 z = (f32x4){0.f, 0.f, 0.f, 0.f};
        f32x4 aab = __builtin_amdgcn_mfma_f32_16x16x32_bf16(a0, b0, z, 0, 0, 0); aab = __builtin_amdgcn_mfma_f32_16x16x32_bf16(a1, b1, aab, 0, 0, 0);
        f32x4 aak = __builtin_amdgcn_mfma_f32_16x16x32_bf16(a0, k0, z, 0, 0, 0); aak = __builtin_amdgcn_mfma_f32_16x16x32_bf16(a1, k1, aak, 0, 0, 0);
        f32x4 brb = __builtin_amdgcn_mfma_f32_16x16x32_bf16(r0, b0, z, 0, 0, 0); brb = __builtin_amdgcn_mfma_f32_16x16x32_bf16(r1, b1, brb, 0, 0, 0);
        f32x4 brk = __builtin_amdgcn_mfma_f32_16x16x32_bf16(r0, k0, z, 0, 0, 0); brk = __builtin_amdgcn_mfma_f32_16x16x32_bf16(r1, k1, brk, 0, 0, 0);
#pragma unroll
        for (int r = 0; r < 4; ++r) { const int t = 4 * g4 + r, s = fr;
            AabM[t * 17 + s] = s < t ? aab[r] : 0.f; AakM[t * 17 + s] = s < t ? aak[r] : 0.f; BrkM[t * 17 + s] = s <= t ? brk[r] : 0.f;
            *(unsigned short*)(chb + 512 + t * 32 + s * 2) = (unsigned short)f2bf(s <= t ? brb[r] : 0.f); }
    }
    const int t_ = lane >> 2, s0 = 4 * (lane & 3);
    LDS_WAIT();
    if (lane < 16) {
        float tc[16];
#pragma unroll
        for (int t = 0; t < 16; ++t) { float acc = (t == lane) ? 1.0f : 0.0f;
#pragma unroll
            for (int s = 0; s < t; ++s) acc += AabM[t * 17 + s] * tc[s];
            tc[t] = acc; TM[t * 17 + lane] = acc; }
    }
    LDS_WAIT();
    { u32x2 wv; wv.x = pk2(TM[t_ * 17 + s0], TM[t_ * 17 + s0 + 1]); wv.y = pk2(TM[t_ * 17 + s0 + 2], TM[t_ * 17 + s0 + 3]); *(u32x2*)(chb + t_ * 32 + s0 * 2) = wv; }
#pragma unroll
    for (int t = 0; t < 16; ++t) { float p1 = 0.f, p2 = 0.f;
#pragma unroll
        for (int s = 0; s <= t; ++s) { if (s < t) p1 += AakM[t * 17 + s] * vv[s]; p2 += BrkM[t * 17 + s] * vv[s]; }
        unsigned short* rec = (unsigned short*)(RAc + t * 384);
        rec[128 + lane] = (unsigned short)f2bf(p1); rec[192 + lane] = (unsigned short)f2bf(p2); }
    LDS_WAIT();
}

__device__ __forceinline__ void rwkv_prep_unit(int l_, int u_, LAS unsigned char* lds_) {
    LOAD_CTX(); const int l = UNI(l_), u = UNI(u_); LAS unsigned char* lds = UNI_LDS(lds_);
    const int tid = ltid(), lane = tid & 63, wave = UNI(tid >> 6);
    const int b = u / 257, t0 = (u % 257) * 16;
    const bf16* proj = (const bf16*)(C.ws + WS_PROJ);
    float* RA = (float*)(C.ws + WS_RA); bf16* RG = (bf16*)(C.ws + WS_RG);
    const bf16* LW = (const bf16*)(C.ws + WS_LW);
    const float* mu = C.in[I_MU] + l * 4864;
    LAS bf16* featb = (LAS bf16*)lds;
    const size_t row0 = (size_t)ROWOF(b, t0), rowp = (size_t)ROWOF(b, t0 > 0 ? t0 - 1 : 0);
    __syncthreads();
#pragma unroll
    for (int j = 0; j < 8; ++j) { const int e = tid + 512 * j, tok = e >> 8, f = e & 255, t = t0 + tok; const size_t m = row0 + tok;
        const float cur = bf2f(proj[m * PN + C_WL + f]); const float prev = t > 0 ? bf2f(proj[(tok > 0 ? m - 1 : rowp) * PN + C_WL + f]) : 0.f;
        const float xs = cur + (prev - cur) * mu[C_WL + f];
        featb[tok * 264 + f] = (bf16)f2bf(f < 64 ? tanhf(xs) : (f < 128 ? xs : sigmoidf_(xs))); }
    __syncthreads();
    const int fr = lane & 15, kc = lane >> 4;
    pg8::bf16x8 Af[8];
#pragma unroll
    for (int ks = 0; ks < 8; ++ks) Af[ks] = *(const LAS pg8::bf16x8*)(featb + fr * 264 + 32 * ks + 8 * kc);
#pragma unroll 1
    for (int hh = 0; hh < 3; ++hh) {
        const int ch0 = 192 * wave + 64 * hh, h = ch0 >> 6;
        f32x4 aw[4], aa[4], ag[4];
#pragma unroll
        for (int nt = 0; nt < 4; ++nt) {
            const bf16* bp = LW + (size_t)(ch0 + 4 * fr + nt) * 256 + 8 * kc;
            pg8::bf16x8 Bf[8];
#pragma unroll
            for (int ks = 0; ks < 8; ++ks) Bf[ks] = *(const pg8::bf16x8*)(bp + 32 * ks);
            f32x4 z = (f32x4){0.f, 0.f, 0.f, 0.f};
            aw[nt] = __builtin_amdgcn_mfma_f32_16x16x32_bf16(Af[0], Bf[0], z, 0, 0, 0); aw[nt] = __builtin_amdgcn_mfma_f32_16x16x32_bf16(Af[1], Bf[1], aw[nt], 0, 0, 0);
            aa[nt] = __builtin_amdgcn_mfma_f32_16x16x32_bf16(Af[2], Bf[2], z, 0, 0, 0); aa[nt] = __builtin_amdgcn_mfma_f32_16x16x32_bf16(Af[3], Bf[3], aa[nt], 0, 0, 0);
            ag[nt] = __builtin_amdgcn_mfma_f32_16x16x32_bf16(Af[4], Bf[4], z, 0, 0, 0); ag[nt] = __builtin_amdgcn_mfma_f32_16x16x32_bf16(Af[5], Bf[5], ag[nt], 0, 0, 0);
            ag[nt] = __builtin_amdgcn_mfma_f32_16x16x32_bf16(Af[6], Bf[6], ag[nt], 0, 0, 0); ag[nt] = __builtin_amdgcn_mfma_f32_16x16x32_bf16(Af[7], Bf[7], ag[nt], 0, 0, 0);
        }
        const int cb = ch0 + 4 * fr;
        const f32x4 mur = *(const f32x4*)(mu + C_R + cb), muk = *(const f32x4*)(mu + C_K + cb), muv = *(const f32x4*)(mu + C_V + cb);
        const f32x4 w0c = *(const f32x4*)(C.in[I_W0] + l * 1536 + cb), a0c = *(const f32x4*)(C.in[I_A0] + l * 1536 + cb), kkc = *(const f32x4*)(C.in[I_KK] + l * 1536 + cb), kac = *(const f32x4*)(C.in[I_KA] + l * 1536 + cb);
        f32x4 pr, pk, pv;
#define PREP_LD4(dst, p_) do { const u32x2 w_ = *(const u32x2*)(p_); dst = (f32x4){bf2f(w_.x & 0xffffu), bf2f(w_.x >> 16), bf2f(w_.y & 0xffffu), bf2f(w_.y >> 16)}; } while (0)
        {
            const bool has = (kc > 0) || (t0 > 0);
            const bf16* pp = proj + (kc > 0 ? row0 + 4 * kc - 1 : rowp) * PN + cb;
            const f32x4 z4 = (f32x4){0.f, 0.f, 0.f, 0.f};
            if (has) { PREP_LD4(pr, pp + C_R); PREP_LD4(pk, pp + C_K); PREP_LD4(pv, pp + C_V); } else { pr = z4; pk = z4; pv = z4; }
        }
#pragma unroll
        for (int r = 0; r < 4; ++r) {
            const int tok = 4 * kc + r, t = t0 + tok;
            const bf16* pc = proj + (row0 + tok) * PN + cb;
            f32x4 cr, ck, cv; PREP_LD4(cr, pc + C_R); PREP_LD4(ck, pc + C_K); PREP_LD4(cv, pc + C_V);
            const f32x4 xr = cr + (pr - cr) * mur, xk = ck + (pk - ck) * muk, xv = cv + (pv - cv) * muv;
            pr = cr; pk = ck; pv = cv;
            const f32x4 kkr = xk * kkc;
            float ss = (kkr[0] * kkr[0] + kkr[1] * kkr[1]) + (kkr[2] * kkr[2] + kkr[3] * kkr[3]);
            ss = rowsum16(ss);
            const float rn = 1.0f / fmaxf(sqrtf(ss), 1e-12f);
            f32x4 dec, av, gv4;
#pragma unroll
            for (int nt = 0; nt < 4; ++nt) {
                const float x = -(w0c[nt] + aw[nt][r]);
                const float sp = fmaxf(x, 0.f) + __logf(1.0f + __expf(-fabsf(x)));
                dec[nt] = __expf(-__expf(-sp - 0.5f)); av[nt] = sigmoidf_(a0c[nt] + aa[nt][r]); gv4[nt] = ag[nt][r]; }
            const f32x4 kkn = kkr * rn;
            float* ra = RA + ((size_t)(b * NHR + h) * LT + t) * 384 + 4 * fr;
            *(f32x4*)(ra) = kkn; *(f32x4*)(ra + 64) = dec; *(f32x4*)(ra + 128) = kkn * av; *(f32x4*)(ra + 192) = xk * ((av - 1.0f) * kac + 1.0f); *(f32x4*)(ra + 256) = xr; *(f32x4*)(ra + 320) = xv;
            u32x2 gw; gw.x = pk2(gv4[0], gv4[1]); gw.y = pk2(gv4[2], gv4[3]);
            *(u32x2*)(RG + ((size_t)b * LT + t) * 1536 + cb) = gw;
        }
#undef PREP_LD4
    }
    asm volatile("s_waitcnt vmcnt(0)" ::: "memory"); __syncthreads();
#pragma unroll 1
    for (int hh = 0; hh < 3; ++hh) rwkv_chunk_prep(C, b * NHR + 3 * wave + hh, t0 >> 4, lane, lds + wave * 16640);
}

__device__ __forceinline__ pg8::bf16x8 pack8(const f32x4 a, const f32x4 b2) { u32x4 w; w.x = pk2(a[0], a[1]); w.y = pk2(a[2], a[3]); w.z = pk2(b2[0], b2[1]); w.w = pk2(b2[2], b2[3]); return (pg8::bf16x8)w; }
__device__ __forceinline__ pg8::bf16x8 ld8x2(const void* p0, const void* p1) { const u32x2 a = *(const u32x2*)p0, b2 = *(const u32x2*)p1; const u32x4 w = (u32x4){a.x, a.y, b2.x, b2.y}; return (pg8::bf16x8)w; }
__device__ __forceinline__ pg8::bf16x8 lds8x2(const LAS unsigned char* p0, const LAS unsigned char* p1) { const u32x2 a = *(const LAS u32x2*)p0, b2 = *(const LAS u32x2*)p1; const u32x4 w = (u32x4){a.x, a.y, b2.x, b2.y}; return (pg8::bf16x8)w; }
__device__ __forceinline__ void rwkv_scan_unit(int unit_, LAS unsigned char* lds_) {
    LOAD_CTX(); const int unit = UNI(unit_); LAS unsigned char* lds = UNI_LDS(lds_);
    const int tid = ltid(), lane = tid & 63, wave = UNI(tid >> 6);
    const int hsel = wave >> 2, bh = 2 * unit + hsel, vt = wave & 3, b = bh / NHR, h = bh % NHR;
    const int fr = lane & 15, g4 = lane >> 4, hl = tid & 255;
    const unsigned char* RAb = (const unsigned char*)((const float*)(C.ws + WS_RA) + (size_t)bh * LT * 384);
    const unsigned char* CHB = C.ws + WS_CHB + (size_t)bh * 257 * 1280;
    bf16* RY = (bf16*)(C.ws + WS_RY);
    constexpr int RS = 1040, SLOT = 16 * RS + 1280;
    LAS unsigned char* ring = lds + hsel * 4 * SLOT;
    const f32x4 zero4 = (f32x4){0.f, 0.f, 0.f, 0.f};
    f32x4 acc[4] = {zero4, zero4, zero4, zero4};
    u32x4 ga[5], gb[5];
#define CS_G(dst, c_) do { const unsigned char* rec = RAb + (size_t)(16 * (c_)) * 1536; const unsigned char* side = CHB + (c_) * 1280; \
        _Pragma("unroll") for (int i = 0; i < 5; ++i) { const int p = hl + 256 * i, rr = p >> 6, q = p & 63; \
            const unsigned char* src = p < 1024 ? rec + (size_t)rr * 1536 + (q < 48 ? 16 * q : 1280 + 16 * (q - 48)) : side + 16 * (p - 1024); \
            dst[i] = ((c_) < 257 && p < 1104) ? *(const u32x4*)src : (u32x4){0u, 0u, 0u, 0u}; } } while (0)
#define CS_S(src_, c_) do { LAS unsigned char* sl = ring + ((c_) & 3) * SLOT; \
        _Pragma("unroll") for (int i = 0; i < 5; ++i) { const int p = hl + 256 * i, rr = p >> 6, q = p & 63; \
            if (p < 1104) *(LAS u32x4*)(p < 1024 ? sl + rr * RS + 16 * q : sl + 16 * RS + 16 * (p - 1024)) = src_[i]; } } while (0)
#define CS_COMPUTE(c_) do { const LAS unsigned char* sl = ring + ((c_) & 3) * SLOT; const LAS unsigned char* rt = sl + fr * RS; const LAS unsigned char* side = sl + 16 * RS; \
        const pg8::bf16x8 Ab0 = lds8x2(rt + 8 * g4, rt + 32 + 8 * g4), Ab1 = lds8x2(rt + 64 + 8 * g4, rt + 96 + 8 * g4), Rb0 = lds8x2(rt + 128 + 8 * g4, rt + 160 + 8 * g4), Rb1 = lds8x2(rt + 192 + 8 * g4, rt + 224 + 8 * g4); \
        f32x4 P1, P2, Vd; \
        _Pragma("unroll") for (int r = 0; r < 4; ++r) { const LAS unsigned char* rr_ = sl + (4 * g4 + r) * RS; const int v = 16 * vt + fr; \
            P1[r] = bf2f(((const LAS unsigned short*)(rr_ + 256))[v]); P2[r] = bf2f(((const LAS unsigned short*)(rr_ + 384))[v]); Vd[r] = ((const LAS float*)(rr_ + 768))[v]; } \
        const u32x2 tw = *(const LAS u32x2*)(side + fr * 32 + 8 * g4), bw = *(const LAS u32x2*)(side + 512 + fr * 32 + 8 * g4); \
        const pg8::bf16x8 Tf = (pg8::bf16x8)((u32x4){tw.x, tw.y, 0u, 0u}), Bf = (pg8::bf16x8)((u32x4){bw.x, bw.y, 0u, 0u}); \
        const LAS unsigned char* pb = sl + (fr >> 3) * RS + 512 + (fr & 7) * 32 + 8 * g4; \
        const pg8::bf16x8 M0 = lds8x2(pb, pb + 8 * RS), M1 = lds8x2(pb + 2 * RS, pb + 10 * RS), M2 = lds8x2(pb + 4 * RS, pb + 12 * RS), M3 = lds8x2(pb + 6 * RS, pb + 14 * RS); \
        const f32x4 g0 = *(const LAS f32x4*)(side + 1024 + (4 * g4) * 4), g1 = *(const LAS f32x4*)(side + 1024 + (16 + 4 * g4) * 4), g2 = *(const LAS f32x4*)(side + 1024 + (32 + 4 * g4) * 4), g3 = *(const LAS f32x4*)(side + 1024 + (48 + 4 * g4) * 4); \
        const pg8::bf16x8 sB0 = pack8(acc[0], acc[1]), sB1 = pack8(acc[2], acc[3]); \
        f32x4 Wd = __builtin_amdgcn_mfma_f32_16x16x32_bf16(Ab0, sB0, zero4, 0, 0, 0); Wd = __builtin_amdgcn_mfma_f32_16x16x32_bf16(Ab1, sB1, Wd, 0, 0, 0); \
        f32x4 Yd = __builtin_amdgcn_mfma_f32_16x16x32_bf16(Rb0, sB0, P2, 0, 0, 0); Yd = __builtin_amdgcn_mfma_f32_16x16x32_bf16(Rb1, sB1, Yd, 0, 0, 0); \
        const f32x4 Ud = __builtin_amdgcn_mfma_f32_16x16x32_bf16(Tf, pack8(Wd + P1, zero4), zero4, 0, 0, 0); \
        Yd = __builtin_amdgcn_mfma_f32_16x16x32_bf16(Bf, pack8(Ud, zero4), Yd, 0, 0, 0); \
        const pg8::bf16x8 zB = pack8(Ud, Vd); \
        acc[0] = __builtin_amdgcn_mfma_f32_16x16x32_bf16(M0, zB, acc[0] * g0, 0, 0, 0); acc[1] = __builtin_amdgcn_mfma_f32_16x16x32_bf16(M1, zB, acc[1] * g1, 0, 0, 0); \
        acc[2] = __builtin_amdgcn_mfma_f32_16x16x32_bf16(M2, zB, acc[2] * g2, 0, 0, 0); acc[3] = __builtin_amdgcn_mfma_f32_16x16x32_bf16(M3, zB, acc[3] * g3, 0, 0, 0); \
        _Pragma("unroll") for (int r = 0; r < 4; ++r) RY[((size_t)b * LT + 16 * (c_) + 4 * g4 + r) * 1536 + h * 64 + 16 * vt + fr] = (bf16)f2bf(Yd[r]); } while (0)
    __syncthreads();
    CS_G(ga, 0); CS_G(gb, 1);
    CS_S(ga, 0); CS_S(gb, 1);
    CS_G(gb, 2);
    __syncthreads();
#pragma unroll 1
    for (int c = 0; c < 257; c += 2) {
        CS_G(ga, c + 3);
        CS_COMPUTE(c);
        CS_S(gb, c + 2);
        __syncthreads();
        if (c + 1 < 257) {
            CS_G(gb, c + 4);
            CS_COMPUTE(c + 1);
            CS_S(ga, c + 3);
            __syncthreads();
        }
    }
#undef CS_G
#undef CS_S
#undef CS_COMPUTE
}
__device__ __forceinline__ void hgrn_scan_slice(int sl_) {
    LOAD_CTX(); const int sl = UNI(sl_);
    const int tid = ltid();
    bf16* HDS = (bf16*)(C.ws + WS_HDS); const float* HED = (const float*)(C.ws + WS_HED);
    float S[4][4];
#pragma unroll
    for (int q = 0; q < 4; ++q) { S[q][0] = 0.f; S[q][1] = 0.f; S[q][2] = 0.f; S[q][3] = 0.f; }
    const int e0 = sl * 8192 + tid * 4, bh = e0 >> 14;
    for (int c = 1; c < NCH; ++c) {
        const size_t uc = (size_t)bh * NCH + c;
        u32x2 d[4]; float ed[4];
#pragma unroll
        for (int q = 0; q < 4; ++q) { const int kv = (e0 + q * 2048) & 16383; d[q] = *(const u32x2*)(HDS + uc * 16384 + kv); ed[q] = HED[uc * 128 + (kv >> 7)]; }
#pragma unroll
        for (int q = 0; q < 4; ++q) { const int kv = (e0 + q * 2048) & 16383;
            u32x2 o; o.x = pk2(S[q][0], S[q][1]); o.y = pk2(S[q][2], S[q][3]); *(u32x2*)(HDS + uc * 16384 + kv) = o;
            S[q][0] = S[q][0] * ed[q] + bf2f(d[q].x & 0xffffu); S[q][1] = S[q][1] * ed[q] + bf2f(d[q].x >> 16); S[q][2] = S[q][2] * ed[q] + bf2f(d[q].y & 0xffffu); S[q][3] = S[q][3] * ed[q] + bf2f(d[q].y >> 16); }
    }
}

__device__ __forceinline__ void rwkv_post_all(int l_) {
    LOAD_CTX(); const int l = UNI(l_);
    const int tid = ltid(), lane = tid & 63, wave = UNI(tid >> 6);
    const bf16* RY = (const bf16*)(C.ws + WS_RY); const bf16* RG = (const bf16*)(C.ws + WS_RG);
    const float* RA = (const float*)(C.ws + WS_RA);
    bf16* mixed = (bf16*)(C.ws + WS_Z);
    const float* lnw = C.in[I_LNW] + l * 1536; const float* lnb = C.in[I_LNB] + l * 1536; const float* rk = C.in[I_RK] + l * 1536;
    for (int m = blockIdx.x * 8 + wave; m < TT; m += gridDim.x * 8) {
        const int b = m / LT, t = m - b * LT;
#pragma unroll 1
        for (int hg = 0; hg < 6; ++hg) {
            float y[4], g[4], kp[4], r[4], v[4], w_[4], b_[4], k_[4];
#pragma unroll
            for (int q = 0; q < 4; ++q) { const int h = hg * 4 + q, c = h * 64 + lane;
                const float* ra = RA + ((size_t)(b * NHR + h) * LT + t) * 384 + lane;
                y[q] = bf2f(RY[(size_t)m * 1536 + c]); g[q] = bf2f(RG[(size_t)m * 1536 + c]); kp[q] = ra[192]; r[q] = ra[256]; v[q] = ra[320];
                w_[q] = lnw[c]; b_[q] = lnb[c]; k_[q] = rk[c]; }
#pragma unroll
            for (int q = 0; q < 4; ++q) { const int c = (hg * 4 + q) * 64 + lane;
                const float mean = wave_sum(y[q]) * (1.0f / 64.0f);
                const float dy = y[q] - mean;
                const float var = wave_sum(dy * dy) * (1.0f / 64.0f);
                const float yn = dy * rsqrtf(var + 64e-5f) * w_[q] + b_[q];
                const float bonus = wave_sum(r[q] * kp[q] * k_[q]) * v[q];
                const float mv = (yn + bonus) * g[q];
                if (t < NMETA) mixed[(size_t)ROWOF(b, t) * DM + c] = (bf16)f2bf(mv);
                (C.ws + WS_MX8)[(size_t)ROWOF(b, t) * DM + c] = fp8_1(mv * MX8_SCALE); }
        }
    }
}
__device__ __forceinline__ void hgrn_out_unit(int l_, int u_, LAS unsigned char* lds_) {
    LOAD_CTX(); const int l = UNI(l_), u = UNI(u_); LAS unsigned char* lds = UNI_LDS(lds_);
    const int tid = ltid(), lane = tid & 63, wave = UNI(tid >> 6);
    const int bh = u / 65, c = u % 65 + 1, b = bh >> 3, h = bh & 7;
    const bf16* proj = (const bf16*)(C.ws + WS_PROJ);
    const bf16* HDS = (const bf16*)(C.ws + WS_HDS); const bf16* HQG = (const bf16*)(C.ws + WS_HQG); const float* HAT = (const float*)(C.ws + WS_HAT);
    bf16* mixed = (bf16*)(C.ws + WS_Z);
    LAS bf16* Am = (LAS bf16*)lds;
    LAS bf16* Bt = (LAS bf16*)(lds + 25600);
    lfloat* ssum = (lfloat*)(lds + 25600 + 52224);
    const size_t uc = (size_t)bh * NCH + c;
    __syncthreads();
    for (int e = tid; e < 1024; e += 512) { const int t_ = e >> 4, s4 = 4 * (e & 15); const f32x4 a4 = *(const f32x4*)(HAT + uc * 4096 + t_ * 64 + s4);
        u32x2 w; w.x = pk2(a4[0], a4[1]); w.y = pk2(a4[2], a4[3]); *(LAS u32x2*)(Am + t_ * 200 + s4) = w; }
    for (int e = tid; e < 1024; e += 512) { const int t_ = e >> 4, ch = e & 15; *(LAS u32x4*)(Am + t_ * 200 + 64 + 8 * ch) = *(const u32x4*)(HQG + uc * 8192 + t_ * 128 + 8 * ch); }
    for (int e = tid; e < 1024; e += 512) { const int s_ = e >> 4, v8 = 8 * (e & 15), t = 64 * c + s_ - 112;
        u32x4 w = (u32x4){0u, 0u, 0u, 0u}; if (t >= 0 && t < LT) w = *(const u32x4*)(proj + (size_t)ROWOF(b, t) * PN + C_HI + h * 128 + v8);
        LAS bf16* bp_ = Bt + v8 * 204 + s_;
        bp_[0] = (bf16)(w.x & 0xffffu); bp_[204] = (bf16)(w.x >> 16); bp_[408] = (bf16)(w.y & 0xffffu); bp_[612] = (bf16)(w.y >> 16); bp_[816] = (bf16)(w.z & 0xffffu); bp_[1020] = (bf16)(w.z >> 16); bp_[1224] = (bf16)(w.w & 0xffffu); bp_[1428] = (bf16)(w.w >> 16); }
#pragma unroll
    for (int i = 0; i < 4; ++i) { const int e = tid + 512 * i, kx = e >> 4, v8 = 8 * (e & 15); const u32x4 w = *(const u32x4*)(HDS + uc * 16384 + kx * 128 + v8);
        LAS bf16* bp_ = Bt + v8 * 204 + 64 + kx;
        bp_[0] = (bf16)(w.x & 0xffffu); bp_[204] = (bf16)(w.x >> 16); bp_[408] = (bf16)(w.y & 0xffffu); bp_[612] = (bf16)(w.y >> 16); bp_[816] = (bf16)(w.z & 0xffffu); bp_[1020] = (bf16)(w.z >> 16); bp_[1224] = (bf16)(w.w & 0xffffu); bp_[1428] = (bf16)(w.w >> 16); }
    __syncthreads();
    const int fr = lane & 15, g4 = lane >> 4;
    pg8::bf16x8 Bf[6];
#pragma unroll
    for (int ks = 0; ks < 6; ++ks) { const LAS u32x2* bp = (const LAS u32x2*)(Bt + (16 * wave + fr) * 204 + 32 * ks + 8 * g4); const u32x2 lo = bp[0], hi = bp[1];
        const u32x4 w = (u32x4){lo.x, lo.y, hi.x, hi.y}; Bf[ks] = (pg8::bf16x8)w; }
    f32x4 o[4];
#pragma unroll
    for (int mt = 0; mt < 4; ++mt) { f32x4 d = (f32x4){0.f, 0.f, 0.f, 0.f};
#pragma unroll
        for (int ks = 0; ks < 6; ++ks) { const pg8::bf16x8 a = *(const LAS pg8::bf16x8*)(Am + (16 * mt + fr) * 200 + 32 * ks + 8 * g4); d = __builtin_amdgcn_mfma_f32_16x16x32_bf16(a, Bf[ks], d, 0, 0, 0); }
        o[mt] = d; }
#pragma unroll
    for (int mt = 0; mt < 4; ++mt)
#pragma unroll
        for (int r = 0; r < 4; ++r) { const float s = rowsum16(o[mt][r] * o[mt][r]); if (fr == 0) ssum[wave * 64 + 16 * mt + 4 * g4 + r] = s; }
    __syncthreads();
    const float gn = C.in[I_HNORM][l * 1024 + h * 128 + 16 * wave + fr];
#pragma unroll
    for (int mt = 0; mt < 4; ++mt)
#pragma unroll
        for (int r = 0; r < 4; ++r) { const int tl = 16 * mt + 4 * g4 + r, t = 64 * c + tl - 112;
            float ss = 0.f;
#pragma unroll
            for (int w8 = 0; w8 < 8; ++w8) ss += ssum[w8 * 64 + tl];
            if (t >= 0 && t < LT) { const size_t m = (size_t)ROWOF(b, t);
                const float gv = bf2f(proj[m * PN + C_HG + h * 128 + 16 * wave + fr]);
                const float mv = o[mt][r] * rsqrtf(ss * (1.0f / 128.0f) + 1e-5f) * gn * (gv * sigmoidf_(gv));
                if (t < NMETA) mixed[m * DM + 3072 + h * 128 + 16 * wave + fr] = (bf16)f2bf(mv);
                (C.ws + WS_MX8)[m * DM + 3072 + h * 128 + 16 * wave + fr] = fp8_1(mv * MX8_SCALE); } }
}

__device__ __forceinline__ unsigned ordkey(float v) { const unsigned b = __float_as_uint(v); return b ^ ((b >> 31) ? 0xFFFFFFFFu : 0x80000000u); }
__device__ __forceinline__ float unordkey(unsigned k) { const unsigned b = (k >> 31) ? (k ^ 0x80000000u) : ~k; return __uint_as_float(b); }
#define CE_U(a, b) do { const unsigned mx_ = (a) > (b) ? (a) : (b), mn_ = (a) > (b) ? (b) : (a); (a) = mx_; (b) = mn_; } while (0)
__device__ __forceinline__ void sort16_desc(unsigned (&k)[16]) {
#pragma unroll
    for (int size = 2; size <= 16; size <<= 1)
#pragma unroll
        for (int stride = size >> 1; stride > 0; stride >>= 1)
#pragma unroll
            for (int i = 0; i < 16; ++i) { const int j = i ^ stride; if (j > i) { if ((i & size) == 0) CE_U(k[i], k[j]); else CE_U(k[j], k[i]); } }
}
__device__ __forceinline__ void merge16_desc(unsigned (&top)[16], const unsigned (&blk)[16]) {
#pragma unroll
    for (int i = 0; i < 16; ++i) top[i] = top[i] > blk[15 - i] ? top[i] : blk[15 - i];
#pragma unroll
    for (int stride = 8; stride > 0; stride >>= 1)
#pragma unroll
        for (int i = 0; i < 16; ++i) { const int j = i ^ stride; if (j > i) CE_U(top[i], top[j]); }
}
#define CE_P(va, pa, vb, pb) do { const bool sw_ = (vb) > (va); const float tv_ = sw_ ? (vb) : (va), tw_ = sw_ ? (va) : (vb); const unsigned tp_ = sw_ ? (pb) : (pa), tq_ = sw_ ? (pa) : (pb); (va) = tv_; (vb) = tw_; (pa) = tp_; (pb) = tq_; } while (0)
__device__ __forceinline__ void sort16p_desc(float (&v)[16], unsigned (&p)[16]) {
#pragma unroll
    for (int size = 2; size <= 16; size <<= 1)
#pragma unroll
        for (int stride = size >> 1; stride > 0; stride >>= 1)
#pragma unroll
            for (int i = 0; i < 16; ++i) { const int j = i ^ stride; if (j > i) { if ((i & size) == 0) CE_P(v[i], p[i], v[j], p[j]); else CE_P(v[j], p[j], v[i], p[i]); } }
}
__device__ __forceinline__ void merge16p_desc(float (&tv)[16], unsigned (&tp)[16], const float (&bv)[16], const unsigned (&bp)[16]) {
#pragma unroll
    for (int i = 0; i < 16; ++i) { const bool tk = bv[15 - i] > tv[i]; tv[i] = tk ? bv[15 - i] : tv[i]; tp[i] = tk ? bp[15 - i] : tp[i]; }
#pragma unroll
    for (int stride = 8; stride > 0; stride >>= 1)
#pragma unroll
        for (int i = 0; i < 16; ++i) { const int j = i ^ stride; if (j > i) CE_P(tv[i], tp[i], tv[j], tp[j]); }
}
__device__ __forceinline__ void top16_half(const float* sc, int m0, int half, int lane, lfloat* stage, unsigned (&top)[16]) {
    f32x4 ld[4][8];
#pragma unroll
    for (int j = 0; j < 4; ++j)
#pragma unroll
        for (int i = 0; i < 8; ++i) { const int idx = lane + 64 * i, p = idx >> 3, part = idx & 7;
            ld[j][i] = *(const f32x4*)(sc + (size_t)(m0 + (p >> 3)) * 2048 + (p & 7) * 256 + half * 128 + 32 * j + 4 * part); }
#pragma unroll
    for (int j = 0; j < 4; ++j) {
#pragma unroll
        for (int i = 0; i < 8; ++i) { const int idx = lane + 64 * i, p = idx >> 3, part = idx & 7; lfloat* d = stage + p * 33 + 4 * part; d[0] = ld[j][i].x; d[1] = ld[j][i].y; d[2] = ld[j][i].z; d[3] = ld[j][i].w; }
        LDS_WAIT();
#pragma unroll
        for (int hb = 0; hb < 2; ++hb) {
            unsigned blk[16];
#pragma unroll
            for (int i = 0; i < 16; ++i) { const int n = 32 * j + 16 * hb + i; blk[i] = (ordkey(stage[lane * 33 + 16 * hb + i]) & ~127u) | (unsigned)(127 - n); }
            sort16_desc(blk);
            if (j == 0 && hb == 0) {
#pragma unroll
                for (int i = 0; i < 16; ++i) top[i] = blk[i];
            } else merge16_desc(top, blk);
        }
        LDS_WAIT();
    }
}
__device__ __forceinline__ void route_task(const Ctx& C, int wt, int lane, LAS unsigned char* wl) {
    const float* sc = (const float*)(C.ws + WS_SC);
    bf16* GG = (bf16*)(C.ws + WS_GG); unsigned* BMp = (unsigned*)(C.ws + WS_BM);
    lfloat* stage = (lfloat*)wl;
    LAS u32x2* ent = (LAS u32x2*)(wl + 8704);
    const int m0 = 8 * wt, tk = lane >> 3, h = lane & 7;
    unsigned s1[16], s2[16];
    top16_half(sc, m0, 0, lane, stage, s1);
    top16_half(sc, m0, 1, lane, stage, s2);
    LAS unsigned short* cid = (LAS unsigned short*)stage + lane * 66;
    unsigned top[16];
#define CAND(dst, slot, num, a, b) do { const float cv_ = unordkey(s1[a] & ~127u) + unordkey(s2[b] & ~127u); dst[slot] = (ordkey(cv_) & ~63u) | (unsigned)(63 - (num)); \
        cid[num] = (unsigned short)(((127u - (s1[a] & 127u)) << 7) | (127u - (s2[b] & 127u))); } while (0)
    {
#pragma unroll
        for (int b2 = 0; b2 < 16; ++b2) CAND(top, b2, b2, 0, b2);
        sort16_desc(top);
    }
    {
        unsigned blk[16];
#pragma unroll
        for (int b2 = 0; b2 < 8; ++b2) CAND(blk, b2, 16 + b2, 1, b2);
#pragma unroll
        for (int b2 = 0; b2 < 5; ++b2) CAND(blk, 8 + b2, 24 + b2, 2, b2);
        blk[13] = 0u; blk[14] = 0u; blk[15] = 0u;
        sort16_desc(blk); merge16_desc(top, blk);
    }
    {
        unsigned blk[16];
#pragma unroll
        for (int b2 = 0; b2 < 4; ++b2) CAND(blk, b2, 29 + b2, 3, b2);
#pragma unroll
        for (int b2 = 0; b2 < 3; ++b2) CAND(blk, 4 + b2, 33 + b2, 4, b2);
#pragma unroll
        for (int b2 = 0; b2 < 2; ++b2) { CAND(blk, 7 + b2, 36 + b2, 5, b2); CAND(blk, 9 + b2, 38 + b2, 6, b2); }
        blk[11] = 0u; blk[12] = 0u; blk[13] = 0u; blk[14] = 0u; blk[15] = 0u;
        sort16_desc(blk); merge16_desc(top, blk);
    }
    {
        unsigned blk[16];
        CAND(blk, 0, 40, 7, 0); CAND(blk, 1, 41, 7, 1);
#pragma unroll
        for (int a2 = 8; a2 < 16; ++a2) CAND(blk, a2 - 6, 34 + a2, a2, 0);
        blk[10] = 0u; blk[11] = 0u; blk[12] = 0u; blk[13] = 0u; blk[14] = 0u; blk[15] = 0u;
        sort16_desc(blk); merge16_desc(top, blk);
    }
#undef CAND
    LDS_WAIT();
    {
        const float v0 = unordkey(top[0] & ~63u);
        float e[16]; float sum = 0.f;
#pragma unroll
        for (int i = 0; i < 16; ++i) { e[i] = __expf(unordkey(top[i] & ~63u) - v0); sum += e[i]; }
        const float inv = 1.0f / sum;
#pragma unroll
        for (int i = 0; i < 16; ++i) { const unsigned id = cid[63u - (top[i] & 63u)]; ent[tk * 128 + h * 16 + i] = (u32x2){id, __float_as_uint(e[i] * inv)}; }
    }
    LDS_WAIT();
#pragma unroll 1
    for (int t8 = 0; t8 < 8; ++t8) {
        const LAS u32x2* en = ent + t8 * 128; const size_t m = (size_t)(m0 + t8);
        const int my0 = (int)en[lane].x, my1 = (int)en[lane + 64].x;
        float g0 = 0.f, g1 = 0.f; bool f0 = true, f1 = true;
#pragma unroll 8
        for (int i = 0; i < 128; ++i) { const u32x2 x = en[i]; const int id = (int)x.x; const float gv = __uint_as_float(x.y);
            if (id == my0) { g0 += gv; if (i < lane) f0 = false; }
            if (id == my1) { g1 += gv; if (i < lane + 64) f1 = false; } }
        *(u32x4*)(GG + m * NE + (my0 & ~7)) = (u32x4){0u, 0u, 0u, 0u}; *(u32x4*)(GG + m * NE + (my1 & ~7)) = (u32x4){0u, 0u, 0u, 0u};
        atomicOr(BMp + m * 64 + (my0 >> 8), 1u << ((my0 >> 3) & 31)); atomicOr(BMp + m * 64 + (my1 >> 8), 1u << ((my1 >> 3) & 31));
        asm volatile("s_waitcnt vmcnt(0)" ::: "memory");
        if (f0) GG[m * NE + my0] = (bf16)f2bf(g0);
        if (f1) GG[m * NE + my1] = (bf16)f2bf(g1);
    }
    LDS_WAIT();
}
__device__ __forceinline__ int mbcnt64(unsigned long long m) { return __builtin_amdgcn_mbcnt_hi((unsigned)(m >> 32), __builtin_amdgcn_mbcnt_lo((unsigned)m, 0u)); }
__device__ __forceinline__ void top16_of_128(float v0, float v1, int lane, lfloat* selv, LAS int* seli) {
    const unsigned k0 = (ordkey(v0) & ~127u) | (unsigned)(127 - lane), k1 = (ordkey(v1) & ~127u) | (unsigned)(63 - lane);
    unsigned thr = 0u;
    for (int bit = 31; bit >= 0; --bit) { const unsigned cand = thr | (1u << bit);
        const int cnt = __popcll(__ballot(k0 >= cand)) + __popcll(__ballot(k1 >= cand));
        if (cnt >= 16) { thr = cand; if (cnt == 16) break; } }
    const unsigned long long m0 = __ballot(k0 >= thr), m1 = __ballot(k1 >= thr);
    if (k0 >= thr) { const int s = mbcnt64(m0); if (s < 16) { selv[s] = v0; seli[s] = lane; } }
    if (k1 >= thr) { const int s = __popcll(m0) + mbcnt64(m1); if (s < 16) { selv[s] = v1; seli[s] = lane + 64; } }
}
__device__ __forceinline__ void route_token_bisect(const Ctx& C, int m, int lane, LAS unsigned char* wl) {
    const float* sc = (const float*)(C.ws + WS_SC) + (size_t)m * 2048;
    bf16* GG = (bf16*)(C.ws + WS_GG);
    lfloat* s1v = (lfloat*)wl; LAS int* s1i = (LAS int*)(wl + 64); lfloat* s2v = (lfloat*)(wl + 128); LAS int* s2i = (LAS int*)(wl + 192);
    lfloat* bv = (lfloat*)(wl + 256); LAS int* bi = (LAS int*)(wl + 320);
    LAS u32x2* ent = (LAS u32x2*)(wl + 384);
    float sv[8][4];
#pragma unroll
    for (int h = 0; h < 8; ++h) { sv[h][0] = sc[h * 256 + lane]; sv[h][1] = sc[h * 256 + 64 + lane]; sv[h][2] = sc[h * 256 + 128 + lane]; sv[h][3] = sc[h * 256 + 192 + lane]; }
#pragma unroll
    for (int h = 0; h < 8; ++h) {
        const float a0 = sv[h][0], a1 = sv[h][1], b0 = sv[h][2], b1 = sv[h][3];
        top16_of_128(a0, a1, lane, s1v, s1i);
        top16_of_128(b0, b1, lane, s2v, s2i);
        LDS_WAIT();
        const float sa = s1v[lane >> 2]; const f32x4 sb = *(const lf32x4*)(s2v + 4 * (lane & 3));
        const float cv[4] = {sa + sb.x, sa + sb.y, sa + sb.z, sa + sb.w};
        unsigned ck[4];
#pragma unroll
        for (int jj = 0; jj < 4; ++jj) ck[jj] = (ordkey(cv[jj]) & ~255u) | (unsigned)(255 - (4 * lane + jj));
        unsigned thr = 0u;
        for (int bit = 31; bit >= 0; --bit) { const unsigned cand = thr | (1u << bit);
            const int cnt = __popcll(__ballot(ck[0] >= cand)) + __popcll(__ballot(ck[1] >= cand)) + __popcll(__ballot(ck[2] >= cand)) + __popcll(__ballot(ck[3] >= cand));
            if (cnt >= 16) { thr = cand; if (cnt == 16) break; } }
        int base = 0;
        const int ia = s1i[lane >> 2];
#pragma unroll
        for (int jj = 0; jj < 4; ++jj) { const unsigned long long mk = __ballot(ck[jj] >= thr);
            if (ck[jj] >= thr) { const int s = base + mbcnt64(mk); if (s < 16) { bv[s] = cv[jj]; bi[s] = ia * 128 + s2i[4 * (lane & 3) + jj]; } }
            base += __popcll(mk); }
        LDS_WAIT();
        float mx = -3.0e38f;
#pragma unroll
        for (int i = 0; i < 16; ++i) mx = fmaxf(mx, bv[i]);
        float sum = 0.f;
#pragma unroll
        for (int i = 0; i < 16; ++i) sum += __expf(bv[i] - mx);
        if (lane < 16) ent[h * 16 + lane] = (u32x2){(unsigned)bi[lane], __float_as_uint(__expf(bv[lane] - mx) / sum)};
        LDS_WAIT();
    }
    u32x2* me = (u32x2*)(C.ws + WS_ME) + (size_t)(m - MAIN_ROWS) * 128;
    me[lane] = ent[lane]; me[lane + 64] = ent[lane + 64];
    LDS_WAIT();
}

__device__ __forceinline__ void route_all(int l_, LAS unsigned char* lds_) {
    LOAD_CTX(); const int l = UNI(l_); LAS unsigned char* lds = UNI_LDS(lds_);
    const int tid = ltid(), lane = tid & 63, wave = UNI(tid >> 6);
    __syncthreads();
    for (int wt = blockIdx.x * 8 + wave; wt < MAIN_ROWS / 8; wt += gridDim.x * 8) route_task(C, wt, lane, lds + wave * 17408);
    if (l == 0) for (int m = MAIN_ROWS + blockIdx.x * 8 + wave; m < TT; m += gridDim.x * 8) route_token_bisect(C, m, lane, lds + wave * 17408);
}
__device__ __forceinline__ void norm2_zero_all(int l_) {
    LOAD_CTX(); const int l = UNI(l_);
    const int tid = ltid(), lane = tid & 63, wave = UNI((int)(tid >> 6)), G = gridDim.x;
    unsigned char* ws = C.ws; bf16* Z = (bf16*)(ws + WS_Z); float* H = (float*)(ws + WS_H);
    unsigned char* HN8 = ws + WS_HN8;
    const int nrows = (l == 1) ? MAIN_ROWS : TT;
    {   f32x4 gn[16]; { const f32x4* gr = (const f32x4*)(C.in[I_NFFN] + l * DM) + lane;
#pragma unroll
            for (int j = 0; j < 16; ++j) gn[j] = gr[64 * j]; }
        rows_pipe(blockIdx.x * 8 + wave, G * 8, nrows, lane, [&](int m) -> const float* { return H + (size_t)m * DM; },
            [&](const f32x4 (&v)[16], int m) { norm_row_fin(v, gn, Z + (size_t)m * DM, nullptr, lane, HN8 + (size_t)m * DM); }); }
    for (int e = blockIdx.x * 512 + tid; e < (MP - TT) * DM / 16; e += G * 512) ((u32x4*)(HN8 + (size_t)TT * DM))[e] = (u32x4){0u, 0u, 0u, 0u};
    u32x4* gz = (u32x4*)(ws + WS_BM);
    const size_t n16 = (size_t)MAIN_ROWS * 64 * 4 / 16;
    for (size_t e = (size_t)blockIdx.x * 512 + tid; e < n16; e += (size_t)G * 512) gz[e] = (u32x4){0u, 0u, 0u, 0u};
}
__device__ __forceinline__ void final_norm_all() {
    LOAD_CTX();
    const int tid = ltid(), lane = tid & 63, wave = UNI((int)(tid >> 6)), G = gridDim.x;
    const float* H = (const float*)(C.ws + WS_H);
    f32x4 gn[16]; { const f32x4* gr = (const f32x4*)C.in[I_NFIN] + lane;
#pragma unroll
        for (int j = 0; j < 16; ++j) gn[j] = gr[64 * j]; }
    rows_pipe(blockIdx.x * 8 + wave, G * 8, NB * 4096, lane, [&](int m) -> const float* { return H + (size_t)m * DM; },
        [&](const f32x4 (&v)[16], int m) {
            float ss = 0.f;
#pragma unroll
            for (int j = 0; j < 16; ++j) ss += (v[j].x * v[j].x + v[j].y * v[j].y) + (v[j].z * v[j].z + v[j].w * v[j].w);
            ss = wave_sum(ss);
            const float rn = rsqrtf(ss * (1.0f / 4096.0f) + 1e-5f);
            f32x4* o = (f32x4*)(C.out + (size_t)m * DM) + lane;
#pragma unroll
            for (int j = 0; j < 16; ++j) o[64 * j] = v[j] * rn * gn[j]; });
}
constexpr int NPL = 11;
constexpr int HG_OUT_EARLY = 1568;
constexpr int NPH = 2 * NPL + 1;
template <int MODE> __device__ __forceinline__ void meta_gemm(const bf16* A, const bf16* Bt, int N, float* O, int ldo, LAS unsigned char* lds_) {
    LAS unsigned char* lds = UNI_LDS(lds_);
    const int tid = ltid(), lane = tid & 63, wave = UNI(tid >> 6), fr = lane & 15, g4 = lane >> 4;
    lfloat* part = (lfloat*)lds;
    for (int nt = blockIdx.x; nt < N / 16; nt += gridDim.x) {
        __syncthreads();
        f32x4 d = (f32x4){0.f, 0.f, 0.f, 0.f};
        const bf16* ap = A + (size_t)fr * DM + 512 * wave + 8 * g4; const bf16* bp = Bt + (size_t)(16 * nt + fr) * DM + 512 * wave + 8 * g4;
#pragma unroll
        for (int ks = 0; ks < 16; ++ks) d = __builtin_amdgcn_mfma_f32_16x16x32_bf16(*(const pg8::bf16x8*)(ap + 32 * ks), *(const pg8::bf16x8*)(bp + 32 * ks), d, 0, 0, 0);
#pragma unroll
        for (int r = 0; r < 4; ++r) part[wave * 256 + (4 * g4 + r) * 16 + fr] = d[r];
        __syncthreads();
        if (tid < 256) { const int t = tid >> 4, n = tid & 15; float s = 0.f;
#pragma unroll
            for (int w8 = 0; w8 < 8; ++w8) s += part[w8 * 256 + tid];
#pragma unroll
            for (int bb = 0; bb < 4; ++bb) { float* o = O + (size_t)(MAIN_ROWS + 16 * bb + t) * ldo + 16 * nt + n; if (MODE == 0) *o += s; else *o = s; } }
    }
}
__device__ __forceinline__ void meta_u_all(int l_) {
    LOAD_CTX(); const int l = UNI(l_);
    const int tid = ltid(), lane = tid & 63, wave = UNI(tid >> 6);
    const bf16* Z = (const bf16*)(C.ws + WS_Z); const float* pu = C.in[I_PU] + (size_t)l * NE * DM;
    const u32x2* me = (const u32x2*)(C.ws + WS_ME); float* HM = (float*)(C.ws + WS_HM);
    for (int task = blockIdx.x * 8 + wave; task < 16 * 128; task += gridDim.x * 8) {
        const int t = task >> 7, e = task & 127; const u32x2 en = me[t * 128 + e];
        const float* ur = pu + (size_t)en.x * DM + 4 * lane; const bf16* hr = Z + (size_t)(MAIN_ROWS + t) * DM + 4 * lane;
        float acc = 0.f;
#pragma unroll 8
        for (int i = 0; i < 16; ++i) { const f32x4 uu = *(const f32x4*)(ur + 256 * i); const u32x2 hh = *(const u32x2*)(hr + 256 * i);
            acc += uu.x * bf2f(hh.x & 0xffffu) + uu.y * bf2f(hh.x >> 16) + uu.z * bf2f(hh.y & 0xffffu) + uu.w * bf2f(hh.y >> 16); }
        acc = wave_sum(acc);
        if (lane == 0) HM[t * 128 + e] = __uint_as_float(en.y) * 0.5f * acc * (1.0f + erff(acc * 0.70710678118654752f));
    }
}
__device__ __forceinline__ void meta_v_all(int l_) {
    LOAD_CTX(); const int l = UNI(l_);
    const int tid = ltid(), lane = tid & 63, wave = UNI(tid >> 6);
    const float* pv = C.in[I_PV] + (size_t)l * NE * DM; float* H = (float*)(C.ws + WS_H);
    const u32x2* me = (const u32x2*)(C.ws + WS_ME); const float* HM = (const float*)(C.ws + WS_HM);
    for (int task = blockIdx.x * 8 + wave; task < 16 * 16; task += gridDim.x * 8) {
        const int t = task >> 4, n = 256 * (task & 15) + 4 * lane;
        f32x4 acc = (f32x4){0.f, 0.f, 0.f, 0.f};
#pragma unroll 8
        for (int e = 0; e < 128; ++e) { const unsigned id = me[t * 128 + e].x; const float hv = HM[t * 128 + e]; acc += *(const f32x4*)(pv + (size_t)id * DM + n) * hv; }
#pragma unroll
        for (int bb = 0; bb < 4; ++bb) { f32x4* o = (f32x4*)(H + (size_t)(MAIN_ROWS + 16 * bb + t) * DM + n); *o = *o + acc; }
    }
}

#if MK_ONE_LAUNCH
#define GRID_BAR() xcd_barrier(bar)
#else
#define GRID_BAR() do {} while (0)
#endif
#define IN(k) (lo <= (k) && (k) < hi)
#define SEAM(k) do { if (IN((k) + 1)) GRID_BAR(); } while (0)
#ifndef DUP_MASK
#define DUP_MASK 0u
#endif
#define REPS(k) ((((unsigned)DUP_MASK >> (k)) & 1u) ? 2 : 1)
template <int l> __device__ __forceinline__ void layer_phases(const int lo, const int hi, const int G, LAS unsigned char* lds, const XcdBarrier& bar) {
        const int p0 = l * NPL;
        if (IN(p0 + 0)) for (int rep = 0; rep < REPS(0); ++rep) { phase_conv_norm(l, lds); SEAM(p0 + 0); }
        if (IN(p0 + 1)) for (int rep = 0; rep < REPS(1); ++rep) {
            const Ctx Cq = load_ctx(); unsigned char* ws = Cq.ws; bf16* Z = (bf16*)(ws + WS_Z); float* H = (float*)(ws + WS_H); (void)Z; (void)H;
            pg8::Gemm g{(const pg8::bf16_t*)Z, (const pg8::bf16_t*)(ws + WS_WIN), MP, PN, DM}; pg8::StaticOrder S; S.init(MP, PN, G, (int)blockIdx.x);
            pg8::EpiBf16<0> E{(pg8::bf16_t*)(ws + WS_PROJ), PN, nullptr, 0, 0};
            pg8::gemm_phase<pg8::EpiBf16<0>, pg8::StaticOrder, false>(lds, g, S, E, nullptr);
            SEAM(p0 + 1);
        }
        if (IN(p0 + 2)) for (int rep = 0; rep < REPS(2); ++rep) {
            for (int u = blockIdx.x; u < 1028; u += G) rwkv_prep_unit(l, u, lds);
            if (G == 256 && rep == 0) {
                unsigned* qc = (unsigned*)(load_ctx().ws + WS_CTL) + CW_HL + 64 * l;
                volatile LAS unsigned* slot = (volatile LAS unsigned*)(lds + LDS_MISC) + 16;
                unsigned nxt = 0u;
                if (threadIdx.x == 0) nxt = __hip_atomic_fetch_add(qc, 1u, __ATOMIC_RELAXED, __HIP_MEMORY_SCOPE_AGENT);
                for (;;) {
                    if (threadIdx.x == 0) *slot = nxt;
                    __syncthreads();
                    const int u = __builtin_amdgcn_readfirstlane((int)*slot);
                    __syncthreads();
                    if (u >= 2080) break;
                    if (threadIdx.x == 0) nxt = __hip_atomic_fetch_add(qc, 1u, __ATOMIC_RELAXED, __HIP_MEMORY_SCOPE_AGENT);
                    hgrn_local_unit(l, u, lds);
                }
            } else
            for (int u = (blockIdx.x + G - 16) % G; u < 2080; u += G) hgrn_local_unit(l, u, lds);
            SEAM(p0 + 2);
        }
        if (IN(p0 + 3)) for (int rep = 0; rep < REPS(3); ++rep) {
            for (int r = blockIdx.x; r < 256; r += G) {
                if (r < 48) { rwkv_scan_unit(r, lds); continue; }
                const int q = r - 48;
                const bool split = (G == 256);
                unsigned* hgc = (unsigned*)(load_ctx().ws + WS_CTL) + CW_HG;
                if (q < 64 && rep == 0) {
                    hgrn_scan_slice(q);
                    if (split) {
                        asm volatile("s_waitcnt vmcnt(0)" ::: "memory"); __syncthreads();
                        if (threadIdx.x == 0) { __builtin_amdgcn_fence(__ATOMIC_RELEASE, "agent"); asm volatile("s_waitcnt vmcnt(0)" ::: "memory");
                            __hip_atomic_fetch_add(hgc, 1u, __ATOMIC_RELAXED, __HIP_MEMORY_SCOPE_AGENT); }
                    }
                }
                for (int u = q; u < 1548; u += 208) swa_unit(l, u, lds);
                if (split) {
                    if (threadIdx.x == 0) { unsigned sp = 0; const unsigned want = 64u * (unsigned)(l + 1);
                        while (__hip_atomic_load(hgc, __ATOMIC_RELAXED, __HIP_MEMORY_SCOPE_AGENT) < want) { __builtin_amdgcn_s_sleep(2); if (++sp > (1u << 22)) break; }
                        __builtin_amdgcn_fence(__ATOMIC_ACQUIRE, "agent"); asm volatile("s_waitcnt vmcnt(0)" ::: "memory"); }
                    __syncthreads();
                    for (int u = q; u < HG_OUT_EARLY; u += 208) hgrn_out_unit(l, u, lds);
                }
            }
            SEAM(p0 + 3);
        }
        if (IN(p0 + 4)) for (int rep = 0; rep < REPS(4); ++rep) {
            for (int u = ((G == 256) ? HG_OUT_EARLY : 0) + blockIdx.x; u < 2080; u += G) hgrn_out_unit(l, u, lds);
            rwkv_post_all(l);
            SEAM(p0 + 4);
        }
        if (IN(p0 + 5)) for (int rep = 0; rep < REPS(5); ++rep) {
            const Ctx Cq = load_ctx(); unsigned char* ws = Cq.ws; bf16* Z = (bf16*)(ws + WS_Z); float* H = (float*)(ws + WS_H); (void)Z; (void)H;
            constexpr int MR = MAIN_ROWS; pg8::Gemm8 g{ws + WS_MX8, ws + WS_WO8, MR, DM, DM, WO8_E8M0}; pg8::StaticOrder S; S.init(MR, DM, G, (int)blockIdx.x);
            pg8::EpiResF32 E{H, DM, (l == 0) ? Cq.in[I_X] : (const float*)H};
            pg8::gemm_phase8<pg8::EpiResF32, pg8::StaticOrder, false>(lds, g, S, E, nullptr);
            if (l == 0) meta_gemm<0>((const bf16*)Z + (size_t)MAIN_ROWS * DM, (const bf16*)(ws + WS_WO), DM, H, DM, lds);
            SEAM(p0 + 5);
        }
        if (IN(p0 + 6)) for (int rep = 0; rep < REPS(6); ++rep) { norm2_zero_all(l); SEAM(p0 + 6); }
        if (IN(p0 + 7)) for (int rep = 0; rep < REPS(7); ++rep) {
            const Ctx Cq = load_ctx(); unsigned char* ws = Cq.ws; bf16* Z = (bf16*)(ws + WS_Z); float* H = (float*)(ws + WS_H); (void)Z; (void)H;
            constexpr int MR = MAIN_ROWS; pg8::Gemm g{(const pg8::bf16_t*)Z, (const pg8::bf16_t*)(ws + WS_WS), MR, 2048, DM}; pg8::StaticOrder S; S.init(MR, 2048, G, (int)blockIdx.x);
            pg8::EpiF32 E{(float*)(ws + WS_SC), 2048, nullptr};
            pg8::gemm_phase<pg8::EpiF32, pg8::StaticOrder, false>(lds, g, S, E, nullptr);
            if (l == 0) meta_gemm<1>((const bf16*)Z + (size_t)MAIN_ROWS * DM, (const bf16*)(ws + WS_WS), 2048, (float*)(ws + WS_SC), 2048, lds);
            SEAM(p0 + 7);
        }
        if (IN(p0 + 8)) for (int rep = 0; rep < REPS(8); ++rep) { route_all(l, lds); SEAM(p0 + 8); }
        if (IN(p0 + 9)) for (int rep = 0; rep < REPS(9); ++rep) {
            const Ctx Cq = load_ctx(); unsigned char* ws = Cq.ws; bf16* Z = (bf16*)(ws + WS_Z); float* H = (float*)(ws + WS_H); (void)Z; (void)H;
            constexpr int MR = MAIN_ROWS; pg8::Gemm8 g{ws + WS_HN8, ws + WS_U, MR, NE, DM, U8_E8M0}; pg8::StaticOrder S; S.init(MR, NE, G, (int)blockIdx.x);
            pg8::EpiGate8 E{ws};
            pg8::gemm_phase8<pg8::EpiGate8, pg8::StaticOrder, false>(lds, g, S, E, nullptr);
            if (l == 0) meta_u_all(l);
            SEAM(p0 + 9);
        }
        if (IN(p0 + 10)) for (int rep = 0; rep < REPS(10); ++rep) {
            const Ctx Cq = load_ctx(); unsigned char* ws = Cq.ws; bf16* Z = (bf16*)(ws + WS_Z); float* H = (float*)(ws + WS_H); (void)Z; (void)H;
            constexpr int MR = MAIN_ROWS; pg8::Gemm8 g{ws + WS_HG8, ws + WS_VT, MR, DM, NE, V8_E8M0}; pg8::StaticOrder S; S.init(MR, DM, G, (int)blockIdx.x);
            pg8::EpiResF32 E{H, DM, (const float*)H};
            pg8::gemm_phase8<pg8::EpiResF32, pg8::StaticOrder, false>(lds, g, S, E, nullptr);
            if (l == 0) meta_v_all(l);
            SEAM(p0 + 10);
        }
}
__global__ void __launch_bounds__(512, 2) hybrid_fwd(Ctx C) {
    extern __shared__ __attribute__((aligned(16))) unsigned char lds_raw[];
    LAS unsigned char* lds = (LAS unsigned char*)lds_raw;
    const int tid = threadIdx.x, lane = tid & 63, wave = __builtin_amdgcn_readfirstlane(tid >> 6);
    const int G = gridDim.x;
    unsigned* ctl = (unsigned*)(C.ws + WS_CTL);
    volatile LAS unsigned* MISC = (volatile LAS unsigned*)(lds + LDS_MISC);
    if (tid < 64) MISC[tid] = 0u;
    __syncthreads();
#if MK_ONE_LAUNCH
    XcdBarrier bar = xcd_barrier_post(ctl + CW_BAR, MISC + 8);
#else
    XcdBarrier bar; bar.bar = ctl; bar.x = 0u; bar.st = MISC + 8;
#endif
    const int lo = C.ph_lo, hi = C.ph_hi;
    layer_phases<0>(lo, hi, G, lds, bar);
    layer_phases<1>(lo, hi, G, lds, bar);
    if (IN(2 * NPL)) final_norm_all();
}

extern "C" void kernel_launch(void* const* d_in, const int* in_sizes, int n_in, void* d_out, int out_size, void* d_ws, size_t ws_size, hipStream_t stream) {
    static int grid = 0;
    if (grid == 0) {
        if (n_in != 25 || ws_size < WS_END) { fprintf(stderr, "kernel_launch: need 25 inputs and %zu bytes of workspace (got %d, %zu)\n", (size_t)WS_END, n_in, ws_size); grid = -1; return; }
        int dev = 0, cus = 0, per_cu = 0;
        if (hipGetDevice(&dev) != hipSuccess || hipDeviceGetAttribute(&cus, hipDeviceAttributeMultiprocessorCount, dev) != hipSuccess) { grid = -1; return; }
        if (hipFuncSetAttribute((const void*)hybrid_fwd, hipFuncAttributeMaxDynamicSharedMemorySize, LDS_BYTES) != hipSuccess) { fprintf(stderr, "kernel_launch: hipFuncSetAttribute failed\n"); grid = -1; return; }
        if (hipOccupancyMaxActiveBlocksPerMultiprocessor(&per_cu, (const void*)hybrid_fwd, 512, LDS_BYTES) != hipSuccess || per_cu < 1) { fprintf(stderr, "kernel_launch: occupancy query says %d blocks per CU\n", per_cu); }
        (void)hipGetLastError();
        grid = cus;
    }
    if (grid < 0) return;
    (void)hipMemsetAsync((char*)d_ws + WS_CTL, 0, CTL_ZERO_BYTES, stream);
    Ctx c{};
    for (int i = 0; i < 25; ++i) c.in[i] = (const float*)d_in[i];
    c.out = (float*)d_out; c.ws = (unsigned char*)d_ws;
#if MK_ONE_LAUNCH
    c.ph_lo = 0; c.ph_hi = NPH;
    hipLaunchKernelGGL(hybrid_fwd, dim3(grid), dim3(512), LDS_BYTES, stream, c);
#else
    for (int p = 0; p < NPH; ++p) { c.ph_lo = p; c.ph_hi = p + 1; hipLaunchKernelGGL(hybrid_fwd, dim3(grid), dim3(512), LDS_BYTES, stream, c); }
#endif
}
```

```cpp
#include <hip/hip_runtime.h>
#include <cstdio>
#include <cstdint>
#ifndef MK_ONE_LAUNCH
#define MK_ONE_LAUNCH 1
#endif
namespace pg8 {
#define PG8_LAS __attribute__((address_space(3)))
typedef unsigned short bf16_t;
typedef short bf16x8 __attribute__((ext_vector_type(8)));
typedef float f32x4 __attribute__((ext_vector_type(4)));
typedef unsigned u32x4 __attribute__((ext_vector_type(4)));
constexpr int BM = 256, BK = 64, HALF = 128, HTB = HALF * BK * 2  , STAGE_BYTES = 8 * HTB, NXCD = 8, WGM = 8;

__host__ __device__ __forceinline__ int lds_byte(int r, int c) { const int st = (r >> 4) * 2 + (c >> 5), rr = r & 15, cc = c & 31, ob = rr * 64 + cc * 2; return st * 1024 + (ob ^ (((ob >> 9) & 1) << 5)); }
__host__ __device__ __forceinline__ void stage_rc(int b, int& R, int& C) { const int st = b / 1024, sb = b % 1024, swz = sb ^ (((sb >> 9) & 1) << 5); R = (st >> 1) * 16 + swz / 64; C = (st & 1) * 32 + (swz % 64) / 2; }
__host__ __device__ __forceinline__ int perm32(int rho) { const int n = rho >> 4, i = rho & 15; return 8 * (i >> 2) + 4 * n + (i & 3); }

struct Unit { int pm, pn; };
struct Gemm { const bf16_t* A; const bf16_t* Bt; int M, N, K; };

struct StaticOrder {
    int nM, nN, nwg, G, c;
    __host__ __device__ void init(int M, int N, int G_, int c_) { nM = M / BM; nN = N / BM; nwg = nM * nN; G = G_; c = c_; }
    __host__ __device__ bool next(int i, Unit& u) const {
        const long L = (long)i * G + c; if (L >= nwg) return false;
        int wgid = (int)L; { const int q = nwg / NXCD, r = nwg % NXCD, xcd = wgid % NXCD, off = wgid / NXCD; wgid = (xcd < r ? xcd * (q + 1) : r * (q + 1) + (xcd - r) * q) + off; }
        const int nig = WGM * nN, gid = wgid / nig, fm = gid * WGM, gsz = (nM - fm) < WGM ? (nM - fm) : WGM;
        u.pm = fm + ((wgid % nig) % gsz); u.pn = (wgid % nig) / gsz; return true;
    }
    __device__ __forceinline__ void a_ready(const Unit&) const {}
    __device__ __forceinline__ void done(const Unit&) const {}
};
__device__ __forceinline__ unsigned cvt_pk_bf16(float lo, float hi) { unsigned r; asm volatile("v_cvt_pk_bf16_f32 %0, %1, %2" : "=v"(r) : "v"(lo), "v"(hi)); return r; }
typedef float f32x2 __attribute__((ext_vector_type(2)));
__device__ __forceinline__ f32x2 gelu_pk(f32x2 v) {
    const f32x2 av = __builtin_elementwise_abs(v), d = av * 0.2316418882f + 1.0f;
    f32x2 t; t.x = __builtin_amdgcn_rcpf(d.x); t.y = __builtin_amdgcn_rcpf(d.y);
    f32x2 q = t * 0.5307027145f + (-0.7265760135f); q = q * t + 0.7107068705f; q = q * t + (-0.142248368f); q = q * t + 0.127414796f; q = q * t;
    const f32x2 s = (v * v) * (-0.72134752044f);
    f32x2 e; e.x = __builtin_amdgcn_exp2f(s.x); e.y = __builtin_amdgcn_exp2f(s.y);
    const f32x2 m = v * (q * e), r = v - m;
    f32x2 o; o.x = v.x < 0.f ? m.x : r.x; o.y = v.y < 0.f ? m.y : r.y; return o;
}
struct EpiF32 {
    static constexpr bool PERM = false, AFTER_DRAIN = false;
    float* C; int ldc; const float* bias;
    __device__ __forceinline__ void operator()(const f32x4 (&acc)[2][2][4][2], const Unit& u, int wr, int wc, int fr, int fq) const {
        const int row0 = u.pm * BM + wr * 64 + fr, col0 = u.pn * BM + wc * 32 + 4 * fq;
        f32x4 bv[2][2];
#pragma unroll
        for (int bj = 0; bj < 2; ++bj)
#pragma unroll
            for (int n = 0; n < 2; ++n) bv[bj][n] = bias ? *(const f32x4*)(bias + col0 + bj * HALF + n * 16) : (f32x4){0.f, 0.f, 0.f, 0.f};
#pragma unroll
        for (int ai = 0; ai < 2; ++ai)
#pragma unroll
            for (int m = 0; m < 4; ++m) { float* rowp = C + (size_t)(row0 + ai * HALF + m * 16) * ldc + col0;
#pragma unroll
                for (int bj = 0; bj < 2; ++bj)
#pragma unroll
                    for (int n = 0; n < 2; ++n) *(f32x4*)(rowp + bj * HALF + n * 16) = acc[ai][bj][m][n] + bv[bj][n]; }
    }
};
template <int ACT  > struct EpiBf16 {
    static constexpr bool PERM = true, AFTER_DRAIN = false;
    bf16_t* O; int ldc; const float* bias; int split_cols; size_t split_stride;
    __device__ __forceinline__ void operator()(const f32x4 (&acc)[2][2][4][2], const Unit& u, int wr, int wc, int fr, int fq) const {
        const int row0 = u.pm * BM + wr * 64 + fr; int colt = u.pn * BM; bf16_t* base = O;
        if (split_cols) { const int t = colt / split_cols; base += (size_t)t * split_stride; colt -= t * split_cols; }
        const int col0 = colt + wc * 32 + 8 * fq, bcol0 = u.pn * BM + wc * 32 + 8 * fq;
        f32x4 bv[2][2];
#pragma unroll
        for (int bj = 0; bj < 2; ++bj)
#pragma unroll
            for (int n = 0; n < 2; ++n) bv[bj][n] = bias ? *(const f32x4*)(bias + bcol0 + bj * HALF + 4 * n) : (f32x4){0.f, 0.f, 0.f, 0.f};
#pragma unroll
        for (int ai = 0; ai < 2; ++ai)
#pragma unroll
            for (int m = 0; m < 4; ++m) { bf16_t* rowp = base + (size_t)(row0 + ai * HALF + m * 16) * ldc + col0;
#pragma unroll
                for (int bj = 0; bj < 2; ++bj) { f32x4 v0 = acc[ai][bj][m][0] + bv[bj][0], v1 = acc[ai][bj][m][1] + bv[bj][1];
                    if (ACT == 1) { f32x2 a = gelu_pk((f32x2){v0[0], v0[1]}), b = gelu_pk((f32x2){v0[2], v0[3]}), c = gelu_pk((f32x2){v1[0], v1[1]}), d = gelu_pk((f32x2){v1[2], v1[3]});
                        v0 = (f32x4){a.x, a.y, b.x, b.y}; v1 = (f32x4){c.x, c.y, d.x, d.y}; }
                    if (ACT == 2) {
#pragma unroll
                        for (int j = 0; j < 4; ++j) { v0[j] = 0.5f * v0[j] * (1.0f + erff(v0[j] * 0.70710678f)); v1[j] = 0.5f * v1[j] * (1.0f + erff(v1[j] * 0.70710678f)); } }
                    u32x4 w; w.x = cvt_pk_bf16(v0[0], v0[1]); w.y = cvt_pk_bf16(v0[2], v0[3]); w.z = cvt_pk_bf16(v1[0], v1[1]); w.w = cvt_pk_bf16(v1[2], v1[3]);
                    *(u32x4*)(rowp + bj * HALF) = w; } }
    }
};
template <class Epi, class Sched, bool STAMP = false>
__device__ __forceinline__ void gemm_phase(PG8_LAS unsigned char* lds, const Gemm g, const Sched& S, const Epi& E, unsigned long long* stamps) {
    int tid_ = threadIdx.x; asm volatile("" : "+v"(tid_));
    const int tid = tid_, wid = __builtin_amdgcn_readfirstlane(tid >> 6), lane = tid & 63, wr = wid >> 2, wc = wid & 3, fr = lane & 15, fq = lane >> 4;
    const int K = g.K, nt = K / BK;
    int ts_lo = 0, ts_hi = 0, nts = 0; const unsigned long long rt_entry = STAMP ? (unsigned long long)wall_clock64() : 0ull;
#define PG8_STAMP() do { if (STAMP && wid == 0 && nts < 64) { const unsigned long long _c = (unsigned long long)clock64(); \
        ts_lo = (lane == nts) ? (int)(unsigned)_c : ts_lo; ts_hi = (lane == nts) ? (int)(unsigned)(_c >> 32) : ts_hi; ++nts; } } while (0)
    PG8_STAMP();
    unsigned voffA[2], voffB[2];
#pragma unroll
    for (int i = 0; i < 2; ++i) { int R, C; stage_rc(tid * 16 + i * 8192, R, C); const int Rb = Epi::PERM ? ((R & ~31) + perm32(R & 31)) : R;
        voffA[i] = (unsigned)(R * K + C) * 2u; voffB[i] = (unsigned)(Rb * K + C) * 2u; }
    const size_t kstep = (size_t)(BK * 2);
    const size_t hstep = (size_t)HALF * K * 2;
    const size_t tstep = 2 * hstep;
    const unsigned ldsw = (unsigned)wid * 1024u;
    const unsigned ldsdst = (unsigned)__builtin_amdgcn_readfirstlane((int)((unsigned)(size_t)lds + ldsw));
    const int aoff = lds_byte(wr * 64 + fr, fq * 8), boff = lds_byte(wc * 32 + fr, fq * 8);
#define PG8_SA(b, h) (((b) * 2 + (h)) * HTB)
#define PG8_SB(b, h) ((4 + (b) * 2 + (h)) * HTB)
#define PG8_STAGE(bufoff, gbase, voff) do { _Pragma("unroll") for (int _i = 0; _i < 2; ++_i) { unsigned keep_; \
        asm volatile("s_mov_b32 %0, m0\n\ts_mov_b32 m0, %3\n\ts_nop 0\n\tglobal_load_lds_dwordx4 %1, %2\n\ts_mov_b32 m0, %0" : "=&s"(keep_) : "v"((voff)[_i]), "s"((unsigned long long)(gbase)), "s"(ldsdst + (unsigned)((bufoff) + _i * 8192)) : "memory"); } } while (0)
#define PG8_LDA(dst, b, h) do { _Pragma("unroll") for (int m = 0; m < 4; ++m) _Pragma("unroll") for (int k = 0; k < 2; ++k) dst[m][k] = *(const PG8_LAS bf16x8*)(lds + PG8_SA(b, h) + aoff + m * 2048 + k * 1024); } while (0)
#define PG8_LDB(dst, b, h) do { _Pragma("unroll") for (int n = 0; n < 2; ++n) _Pragma("unroll") for (int k = 0; k < 2; ++k) dst[n][k] = *(const PG8_LAS bf16x8*)(lds + PG8_SB(b, h) + boff + n * 2048 + k * 1024); } while (0)
#define PG8_MMA(ai, bj, At, Bt) do { __builtin_amdgcn_s_setprio(1); _Pragma("unroll") for (int m = 0; m < 4; ++m) _Pragma("unroll") for (int n = 0; n < 2; ++n) _Pragma("unroll") for (int k = 0; k < 2; ++k) \
        acc[ai][bj][m][n] = __builtin_amdgcn_mfma_f32_16x16x32_bf16(Bt[n][k], At[m][k], acc[ai][bj][m][n], 0, 0, 0); __builtin_amdgcn_s_setprio(0); } while (0)
#define PG8_WAIT_V(n) asm volatile("s_waitcnt vmcnt(" #n ")" ::: "memory")
#define PG8_WAIT_L(n) asm volatile("s_waitcnt lgkmcnt(" #n ")" ::: "memory")
#define PG8_BAR __builtin_amdgcn_s_barrier()
#define PG8_SCHED __builtin_amdgcn_sched_barrier(0)
    Unit cur, nxt; int ui = 0;
    if (!S.next(0, cur)) return;
    f32x4 acc[2][2][4][2];
#pragma unroll
    for (int a = 0; a < 2; ++a)
#pragma unroll
        for (int b = 0; b < 2; ++b)
#pragma unroll
            for (int m = 0; m < 4; ++m)
#pragma unroll
                for (int n = 0; n < 2; ++n) acc[a][b][m][n] = (f32x4){0.f, 0.f, 0.f, 0.f};
    bf16x8 At[4][2], B0[2][2], B1[2][2];
    const char* cA = (const char*)g.A + (size_t)cur.pm * tstep; const char* cB = (const char*)g.Bt + (size_t)cur.pn * tstep;
    S.a_ready(cur);
    PG8_STAGE(PG8_SB(0, 0), cB, voffB); PG8_STAGE(PG8_SA(0, 0), cA, voffA); PG8_STAGE(PG8_SB(0, 1), cB + hstep, voffB); PG8_STAGE(PG8_SA(0, 1), cA + hstep, voffA);
    if (wr == 1) PG8_BAR;
    PG8_WAIT_V(4); PG8_BAR;
    PG8_STAGE(PG8_SB(1, 0), cB + kstep, voffB); PG8_STAGE(PG8_SA(1, 0), cA + kstep, voffA); PG8_STAGE(PG8_SB(1, 1), cB + hstep + kstep, voffB);
    PG8_WAIT_V(6); PG8_BAR;
    PG8_STAMP();
    for (;;) {
        const bool has_next = S.next(ui + 1, nxt);
        const char* nA = has_next ? (const char*)g.A + (size_t)nxt.pm * tstep : cA; const char* nB = has_next ? (const char*)g.Bt + (size_t)nxt.pn * tstep : cB;
        for (int t = 0; t < nt; t += 2) {
            const bool last = (t == nt - 2);
            const char* a1 = cA + (size_t)(t + 1) * kstep;
            const char* a2 = last ? nA : cA + (size_t)(t + 2) * kstep; const char* b2 = last ? nB : cB + (size_t)(t + 2) * kstep;
            const char* a3 = a2 + kstep; const char* b3 = b2 + kstep;
            if (last && has_next) S.a_ready(nxt);
            PG8_LDB(B0, 0, 0); PG8_SCHED; PG8_LDA(At, 0, 0); PG8_STAGE(PG8_SA(1, 1), a1 + hstep, voffA);
            PG8_WAIT_L(8); PG8_BAR; PG8_WAIT_L(0); PG8_MMA(0, 0, At, B0); PG8_BAR; PG8_SCHED;
            PG8_LDB(B1, 0, 1); PG8_STAGE(PG8_SB(0, 0), b2, voffB);
            PG8_BAR; PG8_WAIT_L(0); PG8_MMA(0, 1, At, B1); PG8_BAR;
            PG8_LDA(At, 0, 1); PG8_STAGE(PG8_SA(0, 0), a2, voffA);
            PG8_BAR; PG8_WAIT_L(0); PG8_MMA(1, 0, At, B0); PG8_BAR; PG8_SCHED;
            PG8_STAGE(PG8_SB(0, 1), b2 + hstep, voffB);
            PG8_WAIT_V(6); PG8_BAR; PG8_MMA(1, 1, At, B1); PG8_BAR;
            PG8_LDB(B0, 1, 0); PG8_SCHED; PG8_LDA(At, 1, 0); PG8_STAGE(PG8_SA(0, 1), a2 + hstep, voffA);
            PG8_WAIT_L(8); PG8_BAR; PG8_WAIT_L(0); PG8_MMA(0, 0, At, B0); PG8_BAR; PG8_SCHED;
            PG8_LDB(B1, 1, 1); PG8_STAGE(PG8_SB(1, 0), b3, voffB);
            PG8_BAR; PG8_WAIT_L(0); PG8_MMA(0, 1, At, B1); PG8_BAR;
            PG8_LDA(At, 1, 1); PG8_STAGE(PG8_SA(1, 0), a3, voffA);
            PG8_BAR; PG8_WAIT_L(0); PG8_MMA(1, 0, At, B0); PG8_BAR; PG8_SCHED;
            PG8_STAGE(PG8_SB(1, 1), b3 + hstep, voffB);
            PG8_WAIT_V(6); PG8_BAR; PG8_MMA(1, 1, At, B1); PG8_BAR;
        }
        PG8_STAMP();
        if constexpr (!Epi::AFTER_DRAIN) { E(acc, cur, wr, wc, fr, fq); S.done(cur); }
        PG8_STAMP();
        if (!has_next) break;
#pragma unroll
        for (int a = 0; a < 2; ++a)
#pragma unroll
            for (int b = 0; b < 2; ++b)
#pragma unroll
                for (int m = 0; m < 4; ++m)
#pragma unroll
                    for (int n = 0; n < 2; ++n) acc[a][b][m][n] = (f32x4){0.f, 0.f, 0.f, 0.f};
        cur = nxt; cA = nA; cB = nB; ++ui;
    }
    PG8_WAIT_V(0);
    if (wr == 0) PG8_BAR;
    PG8_BAR;
    if constexpr (Epi::AFTER_DRAIN) { E.fused(acc, cur, wr, wc, fr, fq, lds, wid, lane); S.done(cur); }
    PG8_STAMP();
    if (STAMP && wid == 0) { stamps[lane] = lane < nts ? (((unsigned long long)(unsigned)ts_hi << 32) | (unsigned)ts_lo) : 0ull;
        if (lane == 62) stamps[62] = rt_entry; if (lane == 63) stamps[63] = (unsigned long long)wall_clock64(); }
#undef PG8_STAMP
#undef PG8_SA
#undef PG8_SB
#undef PG8_STAGE
#undef PG8_LDA
#undef PG8_LDB
#undef PG8_MMA
#undef PG8_WAIT_V
#undef PG8_WAIT_L
#undef PG8_BAR
#undef PG8_SCHED
}
typedef int i32x4 __attribute__((ext_vector_type(4)));
typedef int i32x8 __attribute__((ext_vector_type(8)));
struct Gemm8 { const unsigned char* A; const unsigned char* Bt; int M, N, K; int scale; };
template <class Epi, class Sched, bool STAMP = false>
__device__ __forceinline__ void gemm_phase8(PG8_LAS unsigned char* lds, const Gemm8 g, const Sched& S, const Epi& E, unsigned long long* stamps) {
    int tid_ = threadIdx.x; asm volatile("" : "+v"(tid_));
    const int tid = tid_, wid = __builtin_amdgcn_readfirstlane(tid >> 6), lane = tid & 63, wr = wid >> 2, wc = wid & 3, fr = lane & 15, fq = lane >> 4;
    const int K = g.K  , nt = K / 128;
    int ts_lo = 0, ts_hi = 0, nts = 0; const unsigned long long rt_entry = STAMP ? (unsigned long long)wall_clock64() : 0ull;
#define PG8_STAMP() do { if (STAMP && wid == 0 && nts < 64) { const unsigned long long _c = (unsigned long long)clock64(); \
        ts_lo = (lane == nts) ? (int)(unsigned)_c : ts_lo; ts_hi = (lane == nts) ? (int)(unsigned)(_c >> 32) : ts_hi; ++nts; } } while (0)
    PG8_STAMP();
    unsigned voffA[2], voffB[2];
#pragma unroll
    for (int i = 0; i < 2; ++i) { int R, C; stage_rc(tid * 16 + i * 8192, R, C); const int Rb = Epi::PERM ? ((R & ~31) + perm32(R & 31)) : R;
        voffA[i] = (unsigned)(R * K + 2 * C); voffB[i] = (unsigned)(Rb * K + 2 * C); }
    const size_t kstep = (size_t)(BK * 2);
    const size_t hstep = (size_t)HALF * K;
    const size_t tstep = 2 * hstep;
    const unsigned ldsw = (unsigned)wid * 1024u;
    const unsigned ldsdst = (unsigned)__builtin_amdgcn_readfirstlane((int)((unsigned)(size_t)lds + ldsw));
    const int aoff = lds_byte(wr * 64 + fr, fq * 16), boff = lds_byte(wc * 32 + fr, fq * 16);
#define PG8_SA(b, h) (((b) * 2 + (h)) * HTB)
#define PG8_SB(b, h) ((4 + (b) * 2 + (h)) * HTB)
#define PG8_STAGE(bufoff, gbase, voff) do { _Pragma("unroll") for (int _i = 0; _i < 2; ++_i) { unsigned keep_; \
        asm volatile("s_mov_b32 %0, m0\n\ts_mov_b32 m0, %3\n\ts_nop 0\n\tglobal_load_lds_dwordx4 %1, %2\n\ts_mov_b32 m0, %0" : "=&s"(keep_) : "v"((voff)[_i]), "s"((unsigned long long)(gbase)), "s"(ldsdst + (unsigned)((bufoff) + _i * 8192)) : "memory"); } } while (0)
#define PG8_LDA(dst, b, h) do { _Pragma("unroll") for (int m = 0; m < 4; ++m) { const i32x4 lo_ = *(const PG8_LAS i32x4*)(lds + PG8_SA(b, h) + aoff + m * 2048), hi_ = *(const PG8_LAS i32x4*)(lds + PG8_SA(b, h) + aoff + m * 2048 + 16); dst[m] = __builtin_shufflevector(lo_, hi_, 0, 1, 2, 3, 4, 5, 6, 7); } } while (0)
#define PG8_LDB(dst, b, h) do { _Pragma("unroll") for (int n = 0; n < 2; ++n) { const i32x4 lo_ = *(const PG8_LAS i32x4*)(lds + PG8_SB(b, h) + boff + n * 2048), hi_ = *(const PG8_LAS i32x4*)(lds + PG8_SB(b, h) + boff + n * 2048 + 16); dst[n] = __builtin_shufflevector(lo_, hi_, 0, 1, 2, 3, 4, 5, 6, 7); } } while (0)
#define PG8_MMA(ai, bj, At, Bt) do { __builtin_amdgcn_s_setprio(1); _Pragma("unroll") for (int m = 0; m < 4; ++m) _Pragma("unroll") for (int n = 0; n < 2; ++n) \
        acc[ai][bj][m][n] = __builtin_amdgcn_mfma_scale_f32_16x16x128_f8f6f4(Bt[n], At[m], acc[ai][bj][m][n], 0, 0, 0, g.scale, 0, 0x7f7f7f7f); __builtin_amdgcn_s_setprio(0); } while (0)
#define PG8_WAIT_V(n) asm volatile("s_waitcnt vmcnt(" #n ")" ::: "memory")
#define PG8_WAIT_L(n) asm volatile("s_waitcnt lgkmcnt(" #n ")" ::: "memory")
#define PG8_BAR __builtin_amdgcn_s_barrier()
#define PG8_SCHED __builtin_amdgcn_sched_barrier(0)
    Unit cur, nxt; int ui = 0;
    if (!S.next(0, cur)) return;
    f32x4 acc[2][2][4][2];
#pragma unroll
    for (int a = 0; a < 2; ++a)
#pragma unroll
        for (int b = 0; b < 2; ++b)
#pragma unroll
            for (int m = 0; m < 4; ++m)
#pragma unroll
                for (int n = 0; n < 2; ++n) acc[a][b][m][n] = (f32x4){0.f, 0.f, 0.f, 0.f};
    i32x8 At[4], B0[2], B1[2];
    const char* cA = (const char*)g.A + (size_t)cur.pm * tstep; const char* cB = (const char*)g.Bt + (size_t)cur.pn * tstep;
    S.a_ready(cur);
    PG8_STAGE(PG8_SB(0, 0), cB, voffB); PG8_STAGE(PG8_SA(0, 0), cA, voffA); PG8_STAGE(PG8_SB(0, 1), cB + hstep, voffB); PG8_STAGE(PG8_SA(0, 1), cA + hstep, voffA);
    if (wr == 1) PG8_BAR;
    PG8_WAIT_V(4); PG8_BAR;
    PG8_STAGE(PG8_SB(1, 0), cB + kstep, voffB); PG8_STAGE(PG8_SA(1, 0), cA + kstep, voffA); PG8_STAGE(PG8_SB(1, 1), cB + hstep + kstep, voffB);
    PG8_WAIT_V(6); PG8_BAR;
    PG8_STAMP();
    for (;;) {
        const bool has_next = S.next(ui + 1, nxt);
        const char* nA = has_next ? (const char*)g.A + (size_t)nxt.pm * tstep : cA; const char* nB = has_next ? (const char*)g.Bt + (size_t)nxt.pn * tstep : cB;
        for (int t = 0; t < nt; t += 2) {
            const bool last = (t == nt - 2);
            const char* a1 = cA + (size_t)(t + 1) * kstep;
            const char* a2 = last ? nA : cA + (size_t)(t + 2) * kstep; const char* b2 = last ? nB : cB + (size_t)(t + 2) * kstep;
            const char* a3 = a2 + kstep; const char* b3 = b2 + kstep;
            if (last && has_next) S.a_ready(nxt);
            PG8_LDB(B0, 0, 0); PG8_SCHED; PG8_LDA(At, 0, 0); PG8_STAGE(PG8_SA(1, 1), a1 + hstep, voffA);
            PG8_WAIT_L(8); PG8_BAR; PG8_WAIT_L(0); PG8_MMA(0, 0, At, B0); PG8_BAR; PG8_SCHED;
            PG8_LDB(B1, 0, 1); PG8_STAGE(PG8_SB(0, 0), b2, voffB);
            PG8_BAR; PG8_WAIT_L(0); PG8_MMA(0, 1, At, B1); PG8_BAR;
            PG8_LDA(At, 0, 1); PG8_STAGE(PG8_SA(0, 0), a2, voffA);
            PG8_BAR; PG8_WAIT_L(0); PG8_MMA(1, 0, At, B0); PG8_BAR; PG8_SCHED;
            PG8_STAGE(PG8_SB(0, 1), b2 + hstep, voffB);
            PG8_WAIT_V(6); PG8_BAR; PG8_MMA(1, 1, At, B1); PG8_BAR;
            PG8_LDB(B0, 1, 0); PG8_SCHED; PG8_LDA(At, 1, 0); PG8_STAGE(PG8_SA(0, 1), a2 + hstep, voffA);
            PG8_WAIT_L(8); PG8_BAR; PG8_WAIT_L(0); PG8_MMA(0, 0, At, B0); PG8_BAR; PG8_SCHED;
            PG8_LDB(B1, 1, 1); PG8_STAGE(PG8_SB(1, 0), b3, voffB);
            PG8_BAR; PG8_WAIT_L(0); PG8_MMA(0, 1, At, B1); PG8_BAR;
            PG8_LDA(At, 1, 1); PG8_STAGE(PG8_SA(1, 0), a3, voffA);
            PG8_BAR; PG8_WAIT_L(0); PG8_MMA(1, 0, At, B0); PG8_BAR; PG8_SCHED;
            PG8_STAGE(PG8_SB(1, 1), b3 + hstep, voffB);
            PG8_WAIT_V(6); PG8_BAR; PG8_MMA(1, 1, At, B1); PG8_BAR;
        }
        PG8_STAMP();
        if constexpr (!Epi::AFTER_DRAIN) { E(acc, cur, wr, wc, fr, fq); S.done(cur); }
        PG8_STAMP();
        if (!has_next) break;
#pragma unroll
        for (int a = 0; a < 2; ++a)
#pragma unroll
            for (int b = 0; b < 2; ++b)
#pragma unroll
                for (int m = 0; m < 4; ++m)
#pragma unroll
                    for (int n = 0; n < 2; ++n) acc[a][b][m][n] = (f32x4){0.f, 0.f, 0.f, 0.f};
        cur = nxt; cA = nA; cB = nB; ++ui;
    }
    PG8_WAIT_V(0);
    if (wr == 0) PG8_BAR;
    PG8_BAR;
    if constexpr (Epi::AFTER_DRAIN) { E.fused(acc, cur, wr, wc, fr, fq, lds, wid, lane); S.done(cur); }
    PG8_STAMP();
    if (STAMP && wid == 0) { stamps[lane] = lane < nts ? (((unsigned long long)(unsigned)ts_hi << 32) | (unsigned)ts_lo) : 0ull;
        if (lane == 62) stamps[62] = rt_entry; if (lane == 63) stamps[63] = (unsigned long long)wall_clock64(); }
#undef PG8_STAMP
#undef PG8_SA
#undef PG8_SB
#undef PG8_STAGE
#undef PG8_LDA
#undef PG8_LDB
#undef PG8_MMA
#undef PG8_WAIT_V
#undef PG8_WAIT_L
#undef PG8_BAR
#undef PG8_SCHED
}
}
#define XB_TMO      128
#define XB_XCNT(j)  (256  + 64 * (j))
#define XB_XSUB(j)  (1280 + 64 * (j))
#define XB_XGEN(j)  (2304 + 64 * (j))
#define XB_TOP      3328
#define XB_TOPGEN   3392
#define XCD_BAR_WORDS 3456
#define XB_SPIN_CAP (1u << 23)
#define LAS __attribute__((address_space(3)))

__device__ __forceinline__ unsigned xb_ld(unsigned* p)              { return __hip_atomic_load(p, __ATOMIC_RELAXED, __HIP_MEMORY_SCOPE_AGENT); }
__device__ __forceinline__ unsigned xb_add(unsigned* p, unsigned v) { return __hip_atomic_fetch_add(p, v, __ATOMIC_RELAXED, __HIP_MEMORY_SCOPE_AGENT); }
__device__ __forceinline__ unsigned xb_xcc_id() { return (unsigned)__builtin_amdgcn_s_getreg((3 << 11) | 20) & 0xFu; }
#define XB_SPIN(cond, bar) do { unsigned _sp = 0; while (cond) { __builtin_amdgcn_s_sleep(1); \
    if ((++_sp & 255u) == 0u) { if (xb_ld(&(bar)[XB_TMO])) break; if (_sp > XB_SPIN_CAP) { atomicAdd(&(bar)[XB_TMO], 1u); break; } } } } while (0)

struct XcdBarrier {
    unsigned* bar; unsigned x;
    volatile LAS unsigned* st;
};

__device__ __forceinline__ XcdBarrier xcd_barrier_post(unsigned* bar, volatile LAS unsigned* st) {
    XcdBarrier b; b.bar = bar; b.x = xb_xcc_id(); b.st = st;
    if (threadIdx.x == 0) (void)xb_add(&bar[XB_XCNT(b.x)], 1u);
    return b;
}
__device__ __forceinline__ void xcd_barrier_complete(unsigned* bar, unsigned x, unsigned& nloc, unsigned& nx) {
    const unsigned G = gridDim.x * gridDim.y * gridDim.z;
    unsigned sum, cnt, mine, sp = 0u;
    for (;;) {
        sum = 0u; cnt = 0u; mine = 0u;
#pragma unroll
        for (unsigned j = 0; j < 16; ++j) { const unsigned c = xb_ld(&bar[XB_XCNT(j)]); sum += c; cnt += (c > 0u) ? 1u : 0u; mine = (j == x) ? c : mine; }
        if (sum == G) break;
        __builtin_amdgcn_s_sleep(1);
        if ((++sp & 255u) == 0u) { if (xb_ld(&bar[XB_TMO])) break; if (sp > XB_SPIN_CAP) { atomicAdd(&bar[XB_TMO], 1u); break; } }
    }
    nloc = mine > 0u ? mine : 1u; nx = cnt > 0u ? cnt : 1u;
}

__device__ __forceinline__ void xcd_barrier(const XcdBarrier& b) {
    asm volatile("s_waitcnt vmcnt(0)" ::: "memory");
    __syncthreads();
    if (threadIdx.x == 0) {
        unsigned* bar = b.bar; asm volatile("" : "+s"(bar));
        __builtin_amdgcn_s_waitcnt(0);
        unsigned nloc = b.st[0], nx = b.st[1];
        if (nloc == 0u) { xcd_barrier_complete(bar, b.x, nloc, nx); b.st[0] = nloc; b.st[1] = nx; }
        const unsigned old = xb_add(&bar[XB_XSUB(b.x)], 1u);
        const unsigned gen = old / nloc;
        if (old + 1u == (gen + 1u) * nloc) {
            __builtin_amdgcn_fence(__ATOMIC_RELEASE, "agent");
            asm volatile("s_waitcnt vmcnt(0)" ::: "memory");
            const unsigned og = xb_add(&bar[XB_TOP], 1u);
            const unsigned tg = og / nx;
            if (og + 1u == (tg + 1u) * nx) xb_add(&bar[XB_TOPGEN], 1u);
            else XB_SPIN(xb_ld(&bar[XB_TOPGEN]) == tg, bar);
            __builtin_amdgcn_fence(__ATOMIC_ACQUIRE, "agent");
            xb_add(&bar[XB_XGEN(b.x)], 1u);
            asm volatile("s_waitcnt vmcnt(0)" ::: "memory");
        } else {
            XB_SPIN(xb_ld(&bar[XB_XGEN(b.x)]) == gen, bar);
            __builtin_amdgcn_fence(__ATOMIC_ACQUIRE, "agent");
            asm volatile("s_waitcnt vmcnt(0)" ::: "memory");
        }
    }
    __syncthreads();
}
#define GAS __attribute__((address_space(1)))
typedef unsigned short bf16;
typedef float f32x4 __attribute__((ext_vector_type(4)));
typedef unsigned u32x4 __attribute__((ext_vector_type(4)));
typedef unsigned u32x2 __attribute__((ext_vector_type(2)));
typedef LAS float lfloat;
typedef LAS f32x4 lf32x4;

constexpr int DM = 4096, NB = 4, NMETA = 16, LT = 4112, TT = NB * LT  , MP = 16640  ;
constexpr int PN = 11008;
constexpr int C_R = 0, C_K = 1536, C_V = 3072, C_WL = 4608, C_SQ = 4864, C_SK = 6400, C_SV = 6592, C_HQ = 6912, C_HF = 7936, C_HI = 8960, C_HG = 9984;
constexpr int NE = 16384;
constexpr int NHR = 24;
constexpr int NCH = 66;

constexpr size_t MiB = 1ull << 20;
constexpr size_t WS_CTL = 0, WS_WIN = 2 * MiB, WS_WO = 88 * MiB, WS_WS = 120 * MiB, WS_U = 136 * MiB  , WS_VT = 200 * MiB  , WS_HN8 = 264 * MiB  , WS_H = 392 * MiB, WS_Z = 652 * MiB, WS_R = 782 * MiB;
constexpr size_t WS_PROJ = WS_R, WS_RA = 1132 * MiB, WS_RG = 1711 * MiB, WS_RY = 1760 * MiB, WS_HDS = 1809 * MiB, WS_HQG = 1875 * MiB, WS_HAT = 1908 * MiB, WS_HED = 1941 * MiB, WS_END = 1975 * MiB;
constexpr size_t WS_CHB = 1943 * MiB;
constexpr size_t WS_ME = 1 * MiB + 832 * 1024;
constexpr size_t WS_HM = WS_ME + 64 * 1024;
constexpr size_t WS_LW = 1 * MiB;
constexpr size_t WS_GG = WS_R, WS_SC = 1302 * MiB, WS_HG8 = 1432 * MiB  ;
constexpr size_t WS_BM = 1700 * MiB;
static_assert(WS_WIN + (size_t)PN * DM * 2 <= WS_WO && WS_WO + (size_t)DM * DM * 2 <= WS_WS && WS_WS + (size_t)2048 * DM * 2 <= WS_U && WS_U + (size_t)NE * DM <= WS_VT && WS_VT + (size_t)NE * DM <= WS_HN8 && WS_HN8 + (size_t)MP * DM <= WS_H, "ws map 1");
static_assert(WS_H + (size_t)MP * DM * 4 <= WS_Z && WS_Z + (size_t)MP * DM * 2 <= WS_R, "ws map 2");
static_assert(WS_PROJ + (size_t)MP * PN * 2 <= WS_RA && WS_RA + (size_t)96 * LT * 384 * 4 <= WS_RG && WS_RG + (size_t)TT * 1536 * 2 <= WS_RY && WS_RY + (size_t)TT * 1536 * 2 <= WS_HDS, "ws map 3");
static_assert(WS_HDS + (size_t)32 * NCH * 16384 * 2 <= WS_HQG && WS_HQG + (size_t)32 * NCH * 8192 * 2 <= WS_HAT && WS_HAT + (size_t)32 * NCH * 4096 * 4 <= WS_HED && WS_HED + (size_t)32 * NCH * 128 * 4 <= WS_END, "ws map 4");
static_assert(WS_GG + (size_t)MP * NE * 2 <= WS_SC && WS_SC + (size_t)MP * 2048 * 4 <= WS_HG8 && WS_HG8 + (size_t)MP * NE <= WS_BM && WS_BM + (size_t)16384 * 64 * 4 <= WS_END, "ws map 5");

constexpr int LDS_BYTES = 147456;
constexpr int LDS_MISC = 143360;
constexpr int CW_BAR = 4096;
constexpr int CW_HL = 8192 + 128;
constexpr int CW_M2 = 8192 + 512;
constexpr int CW_HG = 8192;
constexpr size_t CTL_ZERO_BYTES = 64 * 1024;

__device__ __forceinline__ float bf2f(unsigned b) { return __uint_as_float(b << 16); }
typedef __bf16 bf16x2_t __attribute__((ext_vector_type(2)));
typedef float f32x2_t __attribute__((ext_vector_type(2)));
__device__ __forceinline__ unsigned pk2(float lo, float hi) { const f32x2_t v = {lo, hi}; const bf16x2_t r = __builtin_convertvector(v, bf16x2_t); return __builtin_bit_cast(unsigned, r); }
__device__ __forceinline__ unsigned f2bf(float f) { return pk2(f, 0.0f) & 0xffffu; }
__device__ __forceinline__ unsigned pk4_fp8(float a, float b, float c, float d) {
    a = __builtin_amdgcn_fmed3f(a, -448.f, 448.f); b = __builtin_amdgcn_fmed3f(b, -448.f, 448.f); c = __builtin_amdgcn_fmed3f(c, -448.f, 448.f); d = __builtin_amdgcn_fmed3f(d, -448.f, 448.f);
    int v = __builtin_amdgcn_cvt_pk_fp8_f32(a, b, 0, false); v = __builtin_amdgcn_cvt_pk_fp8_f32(c, d, v, true); return (unsigned)v;
}
constexpr float U8_SCALE = 64.f, V8_SCALE = 8.f, HG8_SCALE = 64.f;
constexpr int U8_E8M0 = 0x79797979  , V8_E8M0 = 0x76767676  ;
constexpr float MX8_SCALE = 8.f, WO8_SCALE = 128.f; constexpr int WO8_E8M0 = 0x75757575  ;
constexpr size_t WS_MX8 = WS_HN8  , WS_WO8 = 332 * MiB  ;
static_assert(WS_HN8 + (size_t)MP * DM <= WS_WO8 && WS_WO8 + (size_t)DM * DM <= WS_H, "ws map 6");
__device__ __forceinline__ unsigned char fp8_1(float a) { a = __builtin_amdgcn_fmed3f(a, -448.f, 448.f); return (unsigned char)(__builtin_amdgcn_cvt_pk_fp8_f32(a, 0.f, 0, false) & 0xff); }
#define LDS_WAIT() asm volatile("s_waitcnt lgkmcnt(0)" ::: "memory")
__device__ __forceinline__ float wave_sum(float v) {
#pragma unroll
    for (int o = 1; o < 64; o <<= 1) v += __shfl_xor(v, o);
    return v;
}
template <int CTRL> __device__ __forceinline__ float dpp_mov(float x) { return __int_as_float(__builtin_amdgcn_update_dpp(0, __float_as_int(x), CTRL, 0xF, 0xF, false)); }
__device__ __forceinline__ float rowsum16(float x) {
    x += dpp_mov<0xB1>(x); x += dpp_mov<0x4E>(x); x += dpp_mov<0x141>(x); x += dpp_mov<0x140>(x); return x;
}
__device__ __forceinline__ void rope_sc(float pos, int j, float& sn, float& cs) {
    const float ang = pos * exp2f(-(float)j * 2.3664460711655218f);
    float rev = ang * 0.15915494309189535f; rev = rev - floorf(rev);
    sn = __builtin_amdgcn_sinf(rev); cs = __builtin_amdgcn_cosf(rev);
}
__device__ __forceinline__ float sigmoidf_(float x) { return 1.0f / (1.0f + __expf(-x)); }

__device__ __forceinline__ int ltid() { int t = threadIdx.x; asm volatile("" : "+v"(t)); return t; }
__device__ __forceinline__ int ROWOF(int b, int t) { return t >= NMETA ? b * 4096 + (t - NMETA) : 16384 + b * NMETA + t; }
constexpr int MAIN_ROWS = 16384;
struct Ctx {
    const float* in[25];
    float* out;
    unsigned char* ws;
    int ph_lo, ph_hi;
};
typedef const __attribute__((address_space(4))) Ctx CtxK;
__device__ __forceinline__ Ctx load_ctx() { CtxK* p = (CtxK*)__builtin_amdgcn_kernarg_segment_ptr(); asm volatile("" : "+s"(p)); Ctx c;
#pragma unroll
    for (int i = 0; i < 25; ++i) c.in[i] = p->in[i];
    c.out = p->out; c.ws = p->ws; c.ph_lo = p->ph_lo; c.ph_hi = p->ph_hi; return c; }
#define LOAD_CTX() const Ctx C = load_ctx()
__device__ __forceinline__ int uni_launder(int x) { int y = __builtin_amdgcn_readfirstlane(x); asm volatile("" : "+s"(y)); return y; }
#define UNI(x) uni_launder(x)
#define UNI_LDS(p) ((LAS unsigned char*)(uintptr_t)(unsigned)__builtin_amdgcn_readfirstlane((int)(unsigned)(uintptr_t)(p)))
enum { I_X = 0, I_META, I_NMIX, I_NFFN, I_NFIN, I_WIN, I_WOUT, I_MU, I_W0, I_W2, I_A0, I_A2, I_G2, I_KK, I_KA, I_RK, I_LNW, I_LNB, I_SINK, I_HLB, I_HNORM, I_WQ, I_KEYS, I_PU, I_PV };

namespace pg8 {
struct EpiResF32 {
    static constexpr bool PERM = false, AFTER_DRAIN = false;
    float* H; int ldc; const float* Src;
    __device__ __forceinline__ void operator()(const f32x4 (&acc)[2][2][4][2], const Unit& u, int wr, int wc, int fr, int fq) const {
        const int row0 = u.pm * BM + wr * 64 + fr, col0 = u.pn * BM + wc * 32 + 4 * fq;
#pragma unroll
        for (int ai = 0; ai < 2; ++ai)
#pragma unroll
            for (int m = 0; m < 4; ++m) { float* rowp = H + (size_t)(row0 + ai * HALF + m * 16) * ldc + col0; const float* srcp = Src + (size_t)(row0 + ai * HALF + m * 16) * ldc + col0;
                f32x4 old[2][2];
#pragma unroll
                for (int bj = 0; bj < 2; ++bj)
#pragma unroll
                    for (int n = 0; n < 2; ++n) old[bj][n] = *(const f32x4*)(srcp + bj * HALF + n * 16);
#pragma unroll
                for (int bj = 0; bj < 2; ++bj)
#pragma unroll
                    for (int n = 0; n < 2; ++n) *(f32x4*)(rowp + bj * HALF + n * 16) = old[bj][n] + acc[ai][bj][m][n]; }
    }
};
struct EpiGate8 {
    static constexpr bool PERM = true, AFTER_DRAIN = false;
    unsigned char* wsb;
    __device__ __forceinline__ void operator()(const f32x4 (&acc)[2][2][4][2], const Unit& u, int wr, int wc, int fr_, int fq_) const {
        (void)fr_; (void)fq_; int ln = (int)__builtin_amdgcn_workitem_id_x() & 63; asm volatile("" : "+v"(ln)); const int fr = ln & 15, fq = ln >> 4;
        const bf16_t* G = (const bf16_t*)(wsb + WS_GG); unsigned char* Hg = wsb + WS_HG8; const unsigned* Bm = (const unsigned*)(wsb + WS_BM); constexpr int ldc = NE;
        const int row0 = u.pm * BM + wr * 64 + fr, col0 = u.pn * BM + wc * 32 + 8 * fq;
#pragma unroll
        for (int ai = 0; ai < 2; ++ai)
#pragma unroll
            for (int m = 0; m < 4; ++m) { const size_t ro = (size_t)(row0 + ai * HALF + m * 16) * ldc + col0;
                const unsigned bits = Bm[(size_t)(row0 + ai * HALF + m * 16) * 64 + u.pn];
#pragma unroll
                for (int bj = 0; bj < 2; ++bj) {
                    u32x2 w = (u32x2){0u, 0u};
                    if ((bits >> (16 * bj + 4 * wc + fq)) & 1u) {
                        const u32x4 g = *(const u32x4*)(G + ro + bj * HALF);
                        const f32x4 v0 = acc[ai][bj][m][0], v1 = acc[ai][bj][m][1];
                        const f32x2 a = gelu_pk((f32x2){v0[0], v0[1]}), b = gelu_pk((f32x2){v0[2], v0[3]}), c = gelu_pk((f32x2){v1[0], v1[1]}), d = gelu_pk((f32x2){v1[2], v1[3]});
                        w.x = pk4_fp8(64.f * a.x * __uint_as_float(g.x << 16), 64.f * a.y * __uint_as_float(g.x & 0xffff0000u), 64.f * b.x * __uint_as_float(g.y << 16), 64.f * b.y * __uint_as_float(g.y & 0xffff0000u));
                        w.y = pk4_fp8(64.f * c.x * __uint_as_float(g.z << 16), 64.f * c.y * __uint_as_float(g.z & 0xffff0000u), 64.f * d.x * __uint_as_float(g.w << 16), 64.f * d.y * __uint_as_float(g.w & 0xffff0000u));
                    }
                    *(u32x2*)(Hg + ro + bj * HALF) = w;
                }
                __builtin_amdgcn_sched_barrier(0); }
    }
};
}

__device__ __forceinline__ void tr_load_tile(const float* W, int N, int k0, int n0, lfloat* scr, int lane) {
    const int q = lane & 15, r = lane >> 4;
    f32x4 v[16];
#pragma unroll
    for (int i = 0; i < 16; ++i) v[i] = *(const f32x4*)(W + (size_t)(k0 + r + 4 * i) * N + n0 + 4 * q);
#pragma unroll
    for (int i = 0; i < 16; ++i) { lfloat* d = scr + (r + 4 * i) * 65 + 4 * q; d[0] = v[i].x; d[1] = v[i].y; d[2] = v[i].z; d[3] = v[i].w; }
    LDS_WAIT();
}
__device__ __forceinline__ void transpose_item(const float* W, int N, bf16* WT, int Kp, int k0, int n0, int dst_row0, lfloat* scr, int lane) {
    tr_load_tile(W, N, k0, n0, scr, lane);
    const int c = lane & 7, nn = lane >> 3;
#pragma unroll
    for (int p = 0; p < 8; ++p) { const int n = 8 * p + nn; const lfloat* s = scr + (8 * c) * 65 + n;
        u32x4 o; o.x = pk2(s[0 * 65], s[1 * 65]); o.y = pk2(s[2 * 65], s[3 * 65]); o.z = pk2(s[4 * 65], s[5 * 65]); o.w = pk2(s[6 * 65], s[7 * 65]);
        *(u32x4*)(WT + (size_t)(dst_row0 + n) * Kp + k0 + 8 * c) = o; }
    LDS_WAIT();
}
__device__ __forceinline__ void transpose_item8(const float* W, int N, unsigned char* WT, int Kp, int k0, int n0, float sc, lfloat* scr, int lane) {
    tr_load_tile(W, N, k0, n0, scr, lane);
    const int c = lane & 3, nn = lane >> 2;
#pragma unroll
    for (int p = 0; p < 4; ++p) { const int n = 16 * p + nn; const lfloat* s = scr + (16 * c) * 65 + n;
        u32x4 o; o.x = pk4_fp8(s[0 * 65] * sc, s[1 * 65] * sc, s[2 * 65] * sc, s[3 * 65] * sc); o.y = pk4_fp8(s[4 * 65] * sc, s[5 * 65] * sc, s[6 * 65] * sc, s[7 * 65] * sc);
        o.z = pk4_fp8(s[8 * 65] * sc, s[9 * 65] * sc, s[10 * 65] * sc, s[11 * 65] * sc); o.w = pk4_fp8(s[12 * 65] * sc, s[13 * 65] * sc, s[14 * 65] * sc, s[15 * 65] * sc);
        *(u32x4*)(WT + (size_t)(n0 + n) * Kp + k0 + 16 * c) = o; }
    LDS_WAIT();
}
__device__ __forceinline__ void norm_row(const float* src, const float* gain, bf16* dst, float* hdst, int lane, unsigned char* dst8 = nullptr) {
    const f32x4* xr = (const f32x4*)src + lane;
    f32x4 v[16]; float ss = 0.f;
#pragma unroll
    for (int j = 0; j < 16; ++j) { v[j] = xr[64 * j]; ss += (v[j].x * v[j].x + v[j].y * v[j].y) + (v[j].z * v[j].z + v[j].w * v[j].w); }
    ss = wave_sum(ss);
    const float r = rsqrtf(ss * (1.0f / 4096.0f) + 1e-5f);
    const f32x4* gr = (const f32x4*)gain + lane;
    u32x2* o8 = (u32x2*)dst + lane;
#pragma unroll
    for (int j = 0; j < 16; ++j) { const f32x4 g = gr[64 * j]; const f32x4 y = (f32x4){v[j].x * r * g.x, v[j].y * r * g.y, v[j].z * r * g.z, v[j].w * r * g.w};
        u32x2 o; o.x = pk2(y.x, y.y); o.y = pk2(y.z, y.w); o8[64 * j] = o;
        if (dst8) ((unsigned*)dst8)[lane + 64 * j] = pk4_fp8(y.x, y.y, y.z, y.w); }
    if (hdst) { f32x4* hr = (f32x4*)hdst + lane;
#pragma unroll
        for (int j = 0; j < 16; ++j) hr[64 * j] = v[j]; }
}

#define ROW_LOAD16(v_, p_) do { const f32x4* xr_ = (const f32x4*)(p_) + lane; _Pragma("unroll") for (int j_ = 0; j_ < 16; ++j_) v_[j_] = xr_[64 * j_]; } while (0)
__device__ __forceinline__ void norm_row_fin(const f32x4 (&v)[16], const f32x4 (&gn)[16], bf16* dst, float* hdst, int lane, unsigned char* dst8) {
    float ss = 0.f;
#pragma unroll
    for (int j = 0; j < 16; ++j) ss += (v[j].x * v[j].x + v[j].y * v[j].y) + (v[j].z * v[j].z + v[j].w * v[j].w);
    ss = wave_sum(ss);
    const float r = rsqrtf(ss * (1.0f / 4096.0f) + 1e-5f);
    u32x2* o8 = (u32x2*)dst + lane;
#pragma unroll
    for (int j = 0; j < 16; ++j) { const f32x4 g = gn[j]; const f32x4 y = (f32x4){v[j].x * r * g.x, v[j].y * r * g.y, v[j].z * r * g.z, v[j].w * r * g.w};
        u32x2 o; o.x = pk2(y.x, y.y); o.y = pk2(y.z, y.w); o8[64 * j] = o;
        if (dst8) ((unsigned*)dst8)[lane + 64 * j] = pk4_fp8(y.x, y.y, y.z, y.w); }
    if (hdst) { f32x4* hr = (f32x4*)hdst + lane;
#pragma unroll
        for (int j = 0; j < 16; ++j) hr[64 * j] = v[j]; }
}
template <class SrcOf, class Fin>
__device__ __forceinline__ void rows_pipe(int first, int stride, int n, int lane, SrcOf src_of, Fin fin) {
    f32x4 va[16], vb[16];
    int m = first;
    if (m < n) ROW_LOAD16(va, src_of(m));
    while (m < n) {
        const int m2 = m + stride;
        if (m2 < n) ROW_LOAD16(vb, src_of(m2));
        fin(va, m);
        if (m2 >= n) break;
        const int m3 = m2 + stride;
        if (m3 < n) ROW_LOAD16(va, src_of(m3));
        fin(vb, m2);
        m = m3;
    }
}

__device__ __forceinline__ void phase_conv_norm(int l_, LAS unsigned char* lds_) {
    LOAD_CTX(); const int l = UNI(l_); LAS unsigned char* lds = UNI_LDS(lds_);
    const int tid = ltid(), lane = tid & 63, wave = tid >> 6;
    const int gw = blockIdx.x * 8 + wave, NGW = gridDim.x * 8;
    unsigned char* ws = C.ws;
    bf16* WinT = (bf16*)(ws + WS_WIN); bf16* WoT = (bf16*)(ws + WS_WO); bf16* WsT = (bf16*)(ws + WS_WS); unsigned char* U8 = ws + WS_U; unsigned char* VT8 = ws + WS_VT;
    float* H = (float*)(ws + WS_H); bf16* Z = (bf16*)(ws + WS_Z);
    const float* w_in = C.in[I_WIN] + (size_t)l * DM * 10880;
    const float* w_out = C.in[I_WOUT] + (size_t)l * DM * DM;
    const float* wq = C.in[I_WQ] + (size_t)l * DM * 2048;
    const float* keys = C.in[I_KEYS] + (size_t)l * 16 * 128 * 128;
    const float* pu = C.in[I_PU] + (size_t)l * NE * DM;
    const float* pv = C.in[I_PV] + (size_t)l * NE * DM;
    lfloat* scr = (lfloat*)(lds + wave * 16896);
    constexpr int I_WIN_N = 64 * 170, I_WO_N = 64 * 64, I_VT_N = 256 * 64, I_U_N = 8192, I_ZW_N = 64, I_NORM_N = TT, I_ZP_N = MP - TT;
    constexpr int NITEMS = I_WIN_N + I_WO_N + I_VT_N + I_U_N + I_ZW_N + I_NORM_N + I_ZP_N;
    {
        const int gwu = UNI(gw);
        f32x4 gn[16]; { const f32x4* gr = (const f32x4*)(C.in[I_NMIX] + (l == 0 ? 0 : DM)) + lane;
#pragma unroll
            for (int j = 0; j < 16; ++j) gn[j] = gr[64 * j]; }
        rows_pipe(gwu, NGW, I_NORM_N, lane,
            [&](int m) -> const float* { if (l != 0) return H + (size_t)m * DM;
                const int b = m < MAIN_ROWS ? (m >> 12) : ((m - MAIN_ROWS) >> 4), t = m < MAIN_ROWS ? (m & 4095) + NMETA : ((m - MAIN_ROWS) & 15);
                return (t < NMETA) ? C.in[I_META] + (size_t)t * DM : C.in[I_X] + ((size_t)b * 4096 + (t - NMETA)) * DM; },
            [&](const f32x4 (&v)[16], int m) { norm_row_fin(v, gn, Z + (size_t)m * DM, (l == 0 && m >= MAIN_ROWS) ? H + (size_t)m * DM : nullptr, lane, nullptr); });
    }
    int it0 = gw; while (it0 < I_NORM_N) it0 += NGW;
    for (int it = it0; it < NITEMS; it += NGW) {
        int r = it;
        r -= I_NORM_N;
        if (r < I_ZP_N) {
            const int m = TT + r; u32x4* z = (u32x4*)(Z + (size_t)m * DM) + lane;
#pragma unroll
            for (int j = 0; j < 8; ++j) z[64 * j] = (u32x4){0u, 0u, 0u, 0u};
            if (l == 0) { f32x4* hz = (f32x4*)(H + (size_t)m * DM) + lane;
#pragma unroll
                for (int j = 0; j < 16; ++j) hz[64 * j] = (f32x4){0.f, 0.f, 0.f, 0.f}; }
            continue; }
        r -= I_ZP_N;
        if (r < I_WIN_N) { const int kb = r / 170, nb = r % 170, n0 = 64 * nb; transpose_item(w_in, 10880, WinT, DM, 64 * kb, n0, n0 < 6784 ? n0 : n0 + 128, scr, lane); continue; }
        r -= I_WIN_N;
        if (r < I_WO_N) { const int kb = r / 64, nb = r % 64; transpose_item8(w_out, DM, ws + WS_WO8, DM, 64 * kb, 64 * nb, WO8_SCALE, scr, lane);
            if (l == 0) transpose_item(w_out, DM, WoT, DM, 64 * kb, 64 * nb, 64 * nb, scr, lane);
            continue; }
        r -= I_WO_N;
        if (r < I_VT_N) { const int kb = r / 64, nb = r % 64; transpose_item8(pv, DM, VT8, NE, 64 * kb, 64 * nb, V8_SCALE, scr, lane); continue; }
        r -= I_VT_N;
        if (r < I_U_N) {
            const size_t e0 = (size_t)r * 8192;
#pragma unroll 2
            for (int j = 0; j < 8; ++j) { const size_t e = e0 + (size_t)(j * 64 + lane) * 16;
                const f32x4 a = *(const f32x4*)(pu + e), b2 = *(const f32x4*)(pu + e + 4), c2 = *(const f32x4*)(pu + e + 8), d2 = *(const f32x4*)(pu + e + 12);
                u32x4 o; o.x = pk4_fp8(a.x * U8_SCALE, a.y * U8_SCALE, a.z * U8_SCALE, a.w * U8_SCALE); o.y = pk4_fp8(b2.x * U8_SCALE, b2.y * U8_SCALE, b2.z * U8_SCALE, b2.w * U8_SCALE);
                o.z = pk4_fp8(c2.x * U8_SCALE, c2.y * U8_SCALE, c2.z * U8_SCALE, c2.w * U8_SCALE); o.w = pk4_fp8(d2.x * U8_SCALE, d2.y * U8_SCALE, d2.z * U8_SCALE, d2.w * U8_SCALE);
                *(u32x4*)(U8 + e) = o; }
            continue; }
        r -= I_U_N;
        {
            u32x4* z = (u32x4*)(WinT + (size_t)6784 * DM) + (size_t)r * 1024 + lane;
#pragma unroll
            for (int j = 0; j < 16; ++j) z[64 * j] = (u32x4){0u, 0u, 0u, 0u};
        }
    }
    {
        bf16* LW = (bf16*)(ws + WS_LW);
        const float* w2 = C.in[I_W2] + (size_t)l * 64 * 1536; const float* a2 = C.in[I_A2] + (size_t)l * 64 * 1536; const float* g2 = C.in[I_G2] + (size_t)l * 128 * 1536;
        for (int e = blockIdx.x * 512 + tid; e < 256 * 1536; e += gridDim.x * 512) { const int k = e / 1536, n = e - k * 1536;
            const float v = k < 64 ? w2[k * 1536 + n] : (k < 128 ? a2[(k - 64) * 1536 + n] : g2[(k - 128) * 1536 + n]);
            LW[n * 256 + k] = (bf16)f2bf(v); }
    }
    {
        const int wv = UNI(tid >> 6), fr = lane & 15, g4 = lane >> 4;
        for (int u = blockIdx.x; u < 1024; u += gridDim.x) {
            const int hc = u >> 6, k0 = (u & 63) * 64;
            const float* kp_ = keys + (size_t)hc * 16384 + (size_t)(16 * wv + fr) * 128 + 8 * g4;
            pg8::bf16x8 Af[4];
#pragma unroll
            for (int ks = 0; ks < 4; ++ks) { const f32x4 x = *(const f32x4*)(kp_ + 32 * ks), y = *(const f32x4*)(kp_ + 32 * ks + 4);
                const u32x4 wq_ = (u32x4){pk2(x.x, x.y), pk2(x.z, x.w), pk2(y.x, y.y), pk2(y.z, y.w)}; Af[ks] = (pg8::bf16x8)wq_; }
#pragma unroll
            for (int nt = 0; nt < 4; ++nt) {
                const float* wp = wq + (size_t)(k0 + 16 * nt + fr) * 2048 + hc * 128 + 8 * g4;
                f32x4 d = (f32x4){0.f, 0.f, 0.f, 0.f};
#pragma unroll
                for (int ks = 0; ks < 4; ++ks) { const f32x4 x = *(const f32x4*)(wp + 32 * ks), y = *(const f32x4*)(wp + 32 * ks + 4);
                    const u32x4 bw = (u32x4){pk2(x.x, x.y), pk2(x.z, x.w), pk2(y.x, y.y), pk2(y.z, y.w)};
                    d = __builtin_amdgcn_mfma_f32_16x16x32_bf16(Af[ks], (pg8::bf16x8)bw, d, 0, 0, 0); }
#pragma unroll
                for (int r = 0; r < 4; ++r) WsT[(size_t)(hc * 128 + 16 * wv + 4 * g4 + r) * DM + k0 + 16 * nt + fr] = (bf16)f2bf(d[r]);
            }
        }
    }
}

__device__ __forceinline__ void swa_unit(int l_, int u_, LAS unsigned char* lds_) {
    LOAD_CTX(); const int l = UNI(l_), u = UNI(u_); LAS unsigned char* lds = UNI_LDS(lds_);
    const int tid = ltid(), lane = tid & 63, wave = UNI(tid >> 6);
    const int qtile = u % 129, hk = (u / 129) % 3, b = u / 387;
    const int t0 = qtile * 32, lo = t0 - 127;
    const bf16* proj = (const bf16*)(C.ws + WS_PROJ);
    bf16* mixed = (bf16*)(C.ws + WS_Z);
    LAS bf16* Ks = (LAS bf16*)lds;
    LAS bf16* Vt = (LAS bf16*)(lds + 27648);
    LAS bf16* Qs = (LAS bf16*)(lds + 53248);
    __syncthreads();
#define SWA_ROPE8(dst, x, y, pos, first) do { _Pragma("unroll") for (int j_ = 0; j_ < 8; ++j_) { float sn_, cs_; rope_sc((float)(pos), j_, sn_, cs_); dst[j_] = (first) ? x[j_] * cs_ - y[j_] * sn_ : x[j_] * cs_ + y[j_] * sn_; } } while (0)
#define SWA_UNPK(dst, vec_) do { dst[0] = bf2f(vec_.x & 0xffffu); dst[1] = bf2f(vec_.x >> 16); dst[2] = bf2f(vec_.y & 0xffffu); dst[3] = bf2f(vec_.y >> 16); dst[4] = bf2f(vec_.z & 0xffffu); dst[5] = bf2f(vec_.z >> 16); dst[6] = bf2f(vec_.w & 0xffffu); dst[7] = bf2f(vec_.w >> 16); } while (0)
#pragma unroll
    for (int i = 0; i < 3; ++i) {
        const int task = tid + 512 * i, s = task >> 3, c = task & 7;
        const int ut = s < 16 ? s : lo + s - 16;
        const bool ok = (s < 16) || (s < 176 && ut >= 16 && ut < LT);
        u32x4 w = (u32x4){0u, 0u, 0u, 0u};
        if (ok) { const bf16* pr = proj + (size_t)ROWOF(b, ut) * PN + C_SK + hk * 64;
            w = *(const u32x4*)(pr + 8 * c);
            if (c < 2) { const u32x4 wo = *(const u32x4*)(pr + 8 * (c ^ 1)); float x[8], y[8], z[8]; SWA_UNPK(x, w); SWA_UNPK(y, wo); SWA_ROPE8(z, x, y, ut, c == 0);
                w.x = pk2(z[0], z[1]); w.y = pk2(z[2], z[3]); w.z = pk2(z[4], z[5]); w.w = pk2(z[6], z[7]); } }
        *(LAS u32x4*)(Ks + s * 72 + 8 * c) = w;
    }
#pragma unroll
    for (int i = 0; i < 3; ++i) {
        const int task = tid + 512 * i, s = task >> 3, c = task & 7;
        const int ut = s < 16 ? s : lo + s - 16;
        const bool ok = (s < 16) || (s < 176 && ut >= 16 && ut < LT);
        u32x4 w = (u32x4){0u, 0u, 0u, 0u};
        if (ok) w = *(const u32x4*)(proj + (size_t)ROWOF(b, ut) * PN + C_SV + hk * 64 + 8 * c);
        LAS bf16* vp = Vt + (8 * c) * 200 + s;
        vp[0] = (bf16)(w.x & 0xffffu); vp[200] = (bf16)(w.x >> 16); vp[400] = (bf16)(w.y & 0xffffu); vp[600] = (bf16)(w.y >> 16);
        vp[800] = (bf16)(w.z & 0xffffu); vp[1000] = (bf16)(w.z >> 16); vp[1200] = (bf16)(w.w & 0xffffu); vp[1400] = (bf16)(w.w >> 16);
    }
#pragma unroll
    for (int i = 0; i < 4; ++i) {
        const int task = tid + 512 * i, row = task >> 3, c = task & 7, g = row >> 5, t = t0 + (row & 31);
        u32x4 w = (u32x4){0u, 0u, 0u, 0u};
        if (t < LT) { const bf16* qp = proj + (size_t)ROWOF(b, t) * PN + C_SQ + (hk * 8 + g) * 64;
            w = *(const u32x4*)(qp + 8 * c);
            float x[8], z[8]; SWA_UNPK(x, w);
            if (c < 2) { const u32x4 wo = *(const u32x4*)(qp + 8 * (c ^ 1)); float y[8]; SWA_UNPK(y, wo); SWA_ROPE8(z, x, y, t, c == 0); }
            else {
#pragma unroll
                for (int j = 0; j < 8; ++j) z[j] = x[j]; }
            w.x = pk2(z[0] * 0.125f, z[1] * 0.125f); w.y = pk2(z[2] * 0.125f, z[3] * 0.125f); w.z = pk2(z[4] * 0.125f, z[5] * 0.125f); w.w = pk2(z[6] * 0.125f, z[7] * 0.125f); }
        *(LAS u32x4*)(Qs + row * 72 + 8 * c) = w;
    }
#undef SWA_ROPE8
#undef SWA_UNPK
    __syncthreads();
    const int fr = lane & 15, g4 = lane >> 4;
    const int hq = hk * 8 + wave;
    const float sink = C.in[I_SINK][l * 24 + hq];
    pg8::bf16x8 Qf[2][2];
#pragma unroll
    for (int qt = 0; qt < 2; ++qt)
#pragma unroll
        for (int ks = 0; ks < 2; ++ks) Qf[qt][ks] = *(const LAS pg8::bf16x8*)(Qs + (wave * 32 + 16 * qt + fr) * 72 + 32 * ks + 8 * g4);
    f32x4 sc[12][2];
#pragma unroll
    for (int kt = 0; kt < 12; ++kt) {
        const pg8::bf16x8 k0 = *(const LAS pg8::bf16x8*)(Ks + (16 * kt + fr) * 72 + 8 * g4), k1 = *(const LAS pg8::bf16x8*)(Ks + (16 * kt + fr) * 72 + 32 + 8 * g4);
#pragma unroll
        for (int qt = 0; qt < 2; ++qt) { f32x4 a = (f32x4){0.f, 0.f, 0.f, 0.f};
            a = __builtin_amdgcn_mfma_f32_16x16x32_bf16(k0, Qf[qt][0], a, 0, 0, 0); a = __builtin_amdgcn_mfma_f32_16x16x32_bf16(k1, Qf[qt][1], a, 0, 0, 0); sc[kt][qt] = a; }
    }
    float inv[2];
    pg8::bf16x8 Pf[2][6];
#pragma unroll
    for (int qt = 0; qt < 2; ++qt) {
        const int t = t0 + 16 * qt + fr; const bool tv = t < LT;
        float m = sink;
#pragma unroll
        for (int kt = 0; kt < 12; ++kt)
#pragma unroll
            for (int r = 0; r < 4; ++r) { const int s = 16 * kt + 4 * g4 + r; const int uu = lo + s - 16;
                const bool ok = tv && (kt == 0 ? (s <= t) : (uu >= 16 && uu <= t && uu >= t - 127));
                const float v = ok ? sc[kt][qt][r] : -1.0e30f; sc[kt][qt][r] = v; m = fmaxf(m, v); }
        m = fmaxf(m, __shfl_xor(m, 16)); m = fmaxf(m, __shfl_xor(m, 32));
        float ls = 0.f;
#pragma unroll
        for (int kt = 0; kt < 12; ++kt)
#pragma unroll
            for (int r = 0; r < 4; ++r) { const float p = __expf(sc[kt][qt][r] - m); sc[kt][qt][r] = p; ls += p; }
        ls += __shfl_xor(ls, 16); ls += __shfl_xor(ls, 32);
        ls += __expf(sink - m);
        inv[qt] = 1.0f / ls;
#pragma unroll
        for (int s2 = 0; s2 < 6; ++s2) { const f32x4 pa = sc[2 * s2][qt], pb = sc[2 * s2 + 1][qt];
            u32x4 w; w.x = pk2(pa[0], pa[1]); w.y = pk2(pa[2], pa[3]); w.z = pk2(pb[0], pb[1]); w.w = pk2(pb[2], pb[3]);
            Pf[qt][s2] = (pg8::bf16x8)w; }
    }
    f32x4 o[4][2];
#pragma unroll
    for (int dt = 0; dt < 4; ++dt) { o[dt][0] = (f32x4){0.f, 0.f, 0.f, 0.f}; o[dt][1] = (f32x4){0.f, 0.f, 0.f, 0.f}; }
#pragma unroll
    for (int dt = 0; dt < 4; ++dt)
#pragma unroll
        for (int s2 = 0; s2 < 6; ++s2) {
            const u32x2 va = *(const LAS u32x2*)(Vt + (16 * dt + fr) * 200 + 32 * s2 + 4 * g4), vb = *(const LAS u32x2*)(Vt + (16 * dt + fr) * 200 + 32 * s2 + 16 + 4 * g4);
            const u32x4 vw = (u32x4){va.x, va.y, vb.x, vb.y};
            const pg8::bf16x8 vf = (pg8::bf16x8)vw;
            o[dt][0] = __builtin_amdgcn_mfma_f32_16x16x32_bf16(vf, Pf[0][s2], o[dt][0], 0, 0, 0);
            o[dt][1] = __builtin_amdgcn_mfma_f32_16x16x32_bf16(vf, Pf[1][s2], o[dt][1], 0, 0, 0);
        }
#pragma unroll
    for (int qt = 0; qt < 2; ++qt) { const int t = t0 + 16 * qt + fr;
        if (t < LT) { bf16* op = mixed + (size_t)ROWOF(b, t) * DM + 1536 + hq * 64 + 4 * g4;
#pragma unroll
            for (int dt = 0; dt < 4; ++dt) { const f32x4 v = o[dt][qt] * inv[qt]; if (t < NMETA) { u32x2 w; w.x = pk2(v[0], v[1]); w.y = pk2(v[2], v[3]); *(u32x2*)(op + 16 * dt) = w; }
                *(unsigned*)(C.ws + WS_MX8 + (size_t)ROWOF(b, t) * DM + 1536 + hq * 64 + 4 * g4 + 16 * dt) = pk4_fp8(v[0] * MX8_SCALE, v[1] * MX8_SCALE, v[2] * MX8_SCALE, v[3] * MX8_SCALE); } }
    }
}

__device__ __forceinline__ void hgrn_local_unit(int l_, int u_, LAS unsigned char* lds_) {
    LOAD_CTX(); const int l = UNI(l_), u = UNI(u_); LAS unsigned char* lds = UNI_LDS(lds_);
    const int tid = ltid(), lane = tid & 63, wave = UNI(tid >> 6);
    const int bh = u / 65, c = u % 65 + 1, b = bh >> 3, h = bh & 7;
    const bf16* proj = (const bf16*)(C.ws + WS_PROJ);
    bf16* HDS = (bf16*)(C.ws + WS_HDS); bf16* HQG = (bf16*)(C.ws + WS_HQG); float* HAT = (float*)(C.ws + WS_HAT); float* HED = (float*)(C.ws + WS_HED);
    lfloat* qs = (lfloat*)lds; lfloat* kvs = qs + 8192; lfloat* Gs = qs + 16384;
    LAS bf16* iT = (LAS bf16*)(lds + 98304);
    LAS unsigned char* shr = lds + 116736;
    lfloat* segtot = (lfloat*)shr; LAS bf16* QK = (LAS bf16*)shr; LAS bf16* kdT = (LAS bf16*)shr;
    const int k = tid & 127, seg = tid >> 7;
    const int fr = lane & 15, g4 = lane >> 4;
    float lb = 0.f;
    if (l == 1) { const float a0 = C.in[I_HLB][h * 128 + k], a1 = C.in[I_HLB][1024 + h * 128 + k]; lb = 1.0f / (1.0f + __expf(a0 - a1)); }
    __syncthreads();
    float gl[16]; float run = 0.f;
#pragma unroll
    for (int r = 0; r < 16; ++r) {
        const int tl = 16 * seg + r, t = 64 * c + tl - 112;
        float qv = 0.f, kv = 0.f, lf = 0.f; unsigned ib = 0u;
        if (t >= 0 && t < LT) { const bf16* pr = proj + (size_t)ROWOF(b, t) * PN + h * 128 + k;
            qv = bf2f(pr[C_HQ]); const float frw = bf2f(pr[C_HF]); ib = pr[C_HI];
            const float f = lb + (1.0f - lb) * sigmoidf_(frw); lf = __logf(f); kv = 1.0f - f; }
        run += lf; gl[r] = run;
        qs[tl * 128 + k] = qv; kvs[tl * 128 + k] = kv; iT[k * 72 + tl] = (bf16)ib;
    }
    segtot[seg * 128 + k] = run;
    __syncthreads();
    float off = 0.f;
    for (int s2 = 0; s2 < seg; ++s2) off += segtot[s2 * 128 + k];
#pragma unroll
    for (int r = 0; r < 16; ++r) Gs[(16 * seg + r) * 128 + k] = gl[r] + off;
    __syncthreads();
    const size_t uc = (size_t)bh * NCH + c;
    float* at = HAT + uc * 4096;
    for (int e = tid; e < 4096; e += 512) { const int t_ = e >> 6, s_ = e & 63; if (s_ > t_) at[e] = 0.f; }
    if (tid < 480) {
        const int blk = tid / 120, q = tid - blk * 120;
        int tt = (int)((1.0f + sqrtf(1.0f + 8.0f * (float)q)) * 0.5f);
        if (tt * (tt - 1) / 2 > q) --tt; if ((tt + 1) * tt / 2 <= q) ++tt;
        const int ss = q - tt * (tt - 1) / 2, t_ = 16 * blk + tt, s_ = 16 * blk + ss;
        float acc = 0.f;
        for (int kk = 0; kk < 128; ++kk) { const int k2 = (kk + lane) & 127;
            acc += qs[t_ * 128 + k2] * kvs[s_ * 128 + k2] * __expf(Gs[t_ * 128 + k2] - Gs[s_ * 128 + k2]); }
        at[t_ * 64 + s_] = acc;
    }
    if (tid >= 448) {
        const int t_ = tid - 448; float acc = 0.f;
        for (int kk = 0; kk < 128; ++kk) { const int k2 = (kk + lane) & 127; acc += qs[t_ * 128 + k2] * kvs[t_ * 128 + k2]; }
        at[t_ * 64 + t_] = acc;
    }
#pragma unroll 1
    for (int pass = 0; pass < 2; ++pass) {
        __syncthreads();
#pragma unroll 4
        for (int i = 0; i < 16; ++i) { const int e = tid + 512 * i, row = e >> 7, kx = e & 127;
            int src, ref; bool isq = row < 32;
            if (pass == 0) { src = isq ? 32 + row : row - 32; ref = 31; }
            else { const int r16 = row & 15, hi = (row >> 4) & 1; src = isq ? (hi ? 48 + r16 : 16 + r16) : (hi ? 32 + r16 : r16); ref = hi ? 47 : 15; }
            const float gr = Gs[ref * 128 + kx], gs_ = Gs[src * 128 + kx];
            const float v = isq ? qs[src * 128 + kx] * __expf(gs_ - gr) : kvs[src * 128 + kx] * __expf(gr - gs_);
            QK[row * 136 + kx] = (bf16)f2bf(v); }
        __syncthreads();
        const int ntile = pass == 0 ? 4 : 2;
        if (wave < ntile) {
            const int qrow = pass == 0 ? 16 * (wave >> 1) : 16 * wave, krow = pass == 0 ? 32 + 16 * (wave & 1) : 32 + 16 * wave;
            const int I = pass == 0 ? 2 + (wave >> 1) : (wave == 0 ? 1 : 3), J = pass == 0 ? (wave & 1) : (wave == 0 ? 0 : 2);
            f32x4 d = (f32x4){0.f, 0.f, 0.f, 0.f};
#pragma unroll
            for (int ks = 0; ks < 4; ++ks) { const pg8::bf16x8 a = *(const LAS pg8::bf16x8*)(QK + (qrow + fr) * 136 + 32 * ks + 8 * g4), bb = *(const LAS pg8::bf16x8*)(QK + (krow + fr) * 136 + 32 * ks + 8 * g4);
                d = __builtin_amdgcn_mfma_f32_16x16x32_bf16(a, bb, d, 0, 0, 0); }
#pragma unroll
            for (int r = 0; r < 4; ++r) at[(16 * I + 4 * g4 + r) * 64 + 16 * J + fr] = d[r];
        }
    }
    __syncthreads();
    for (int e = tid; e < 8192; e += 512) { const int s_ = e >> 7, kx = e & 127; const float ge = Gs[e];
        HQG[uc * 8192 + e] = (bf16)f2bf(qs[e] * __expf(ge));
        kdT[kx * 72 + s_] = (bf16)f2bf(kvs[e] * __expf(Gs[63 * 128 + kx] - ge)); }
    if (tid < 128) HED[uc * 128 + tid] = __expf(Gs[63 * 128 + tid]);
    __syncthreads();
    {
        const pg8::bf16x8 a0 = *(const LAS pg8::bf16x8*)(kdT + (16 * wave + fr) * 72 + 8 * g4), a1 = *(const LAS pg8::bf16x8*)(kdT + (16 * wave + fr) * 72 + 32 + 8 * g4);
        f32x4 dd[8];
#pragma unroll
        for (int nt = 0; nt < 8; ++nt) {
            const pg8::bf16x8 b0 = *(const LAS pg8::bf16x8*)(iT + (8 * fr + nt) * 72 + 8 * g4), b1 = *(const LAS pg8::bf16x8*)(iT + (8 * fr + nt) * 72 + 32 + 8 * g4);
            f32x4 d = (f32x4){0.f, 0.f, 0.f, 0.f};
            d = __builtin_amdgcn_mfma_f32_16x16x32_bf16(a0, b0, d, 0, 0, 0); d = __builtin_amdgcn_mfma_f32_16x16x32_bf16(a1, b1, d, 0, 0, 0);
            dd[nt] = d;
        }
#pragma unroll
        for (int r = 0; r < 4; ++r) { u32x4 w; w.x = pk2(dd[0][r], dd[1][r]); w.y = pk2(dd[2][r], dd[3][r]); w.z = pk2(dd[4][r], dd[5][r]); w.w = pk2(dd[6][r], dd[7][r]);
            *(u32x4*)(HDS + (uc * 128 + 16 * wave + 4 * g4 + r) * 128 + 8 * fr) = w; }
    }
}

__device__ __forceinline__ void rwkv_chunk_prep(const Ctx& C, int bh, int c, int lane, LAS unsigned char* wl) {
    float* RAc = (float*)(C.ws + WS_RA) + ((size_t)bh * LT + 16 * c) * 384;
    unsigned char* chb = C.ws + WS_CHB + ((size_t)bh * 257 + c) * 1280;
    LAS bf16* AbS = (LAS bf16*)(wl + 4608); LAS bf16* RbS = AbS + 16 * 72; LAS bf16* BtS = RbS + 16 * 72; LAS bf16* KtS = BtS + 16 * 72;
    float kk[16], w[16], ka[16], kp[16], rr[16], vv[16];
#pragma unroll
    for (int i = 0; i < 16; ++i) { const float* p = RAc + i * 384 + lane; kk[i] = p[0]; w[i] = p[64]; ka[i] = p[128]; kp[i] = p[192]; rr[i] = p[256]; vv[i] = p[320]; }
    float g = 1.0f; float bp[16], kq[16];
#pragma unroll
    for (int i = 0; i < 16; ++i) { const float gprev = g; g *= w[i]; const float ig = 1.0f / g;
        const float ab = -kk[i] * gprev, rb = rr[i] * g, bt = ka[i] * ig, kt = kp[i] * ig;
        AbS[i * 72 + lane] = (bf16)f2bf(ab); RbS[i * 72 + lane] = (bf16)f2bf(rb); BtS[i * 72 + lane] = (bf16)f2bf(bt); KtS[i * 72 + lane] = (bf16)f2bf(kt);
        bp[i] = bt; kq[i] = kt;
        unsigned short* rec = (unsigned short*)(RAc + i * 384);
        rec[lane] = (unsigned short)f2bf(ab); rec[64 + lane] = (unsigned short)f2bf(rb); }
    const float gC = g;
    {
        u32x4 o0, o1, q0, q1;
        o0.x = pk2(bp[0] * gC, bp[1] * gC); o0.y = pk2(bp[2] * gC, bp[3] * gC); o0.z = pk2(bp[4] * gC, bp[5] * gC); o0.w = pk2(bp[6] * gC, bp[7] * gC);
        o1.x = pk2(bp[8] * gC, bp[9] * gC); o1.y = pk2(bp[10] * gC, bp[11] * gC); o1.z = pk2(bp[12] * gC, bp[13] * gC); o1.w = pk2(bp[14] * gC, bp[15] * gC);
        q0.x = pk2(kq[0] * gC, kq[1] * gC); q0.y = pk2(kq[2] * gC, kq[3] * gC); q0.z = pk2(kq[4] * gC, kq[5] * gC); q0.w = pk2(kq[6] * gC, kq[7] * gC);
        q1.x = pk2(kq[8] * gC, kq[9] * gC); q1.y = pk2(kq[10] * gC, kq[11] * gC); q1.z = pk2(kq[12] * gC, kq[13] * gC); q1.w = pk2(kq[14] * gC, kq[15] * gC);
        unsigned char* rb_ = (unsigned char*)(RAc + (lane >> 3) * 384) + 512 + (lane & 7) * 32;
        *(u32x4*)rb_ = o0; *(u32x4*)(rb_ + 16) = o1;
        unsigned char* rk_ = (unsigned char*)(RAc + (8 + (lane >> 3)) * 384) + 512 + (lane & 7) * 32;
        *(u32x4*)rk_ = q0; *(u32x4*)(rk_ + 16) = q1;
        ((float*)(chb + 1024))[lane] = gC;
    }
    LDS_WAIT();
    const int fr = lane & 15, g4 = lane >> 4;
    lfloat* AabM = (lfloat*)wl; lfloat* AakM = AabM + 16 * 17; lfloat* BrkM = AakM + 16 * 17; lfloat* TM = BrkM + 16 * 17;
    {
        const pg8::bf16x8 a0 = *(const LAS pg8::bf16x8*)(AbS + fr * 72 + 8 * g4), a1 = *(const LAS pg8::bf16x8*)(AbS + fr * 72 + 32 + 8 * g4);
        const pg8::bf16x8 r0 = *(const LAS pg8::bf16x8*)(RbS + fr * 72 + 8 * g4), r1 = *(const LAS pg8::bf16x8*)(RbS + fr * 72 + 32 + 8 * g4);
        const pg8::bf16x8 b0 = *(const LAS pg8::bf16x8*)(BtS + fr * 72 + 8 * g4), b1 = *(const LAS pg8::bf16x8*)(BtS + fr * 72 + 32 + 8 * g4);
        const pg8::bf16x8 k0 = *(const LAS pg8::bf16x8*)(KtS + fr * 72 + 8 * g4), k1 = *(const LAS pg8::bf16x8*)(KtS + fr * 72 + 32 + 8 * g4);
        const f32x4 z = (f32x4){0.f, 0.f, 0.f, 0.f};
        f32x4 aab = __builtin_amdgcn_mfma_f32_16x16x32_bf16(a0, b0, z, 0, 0, 0); aab = __builtin_amdgcn_mfma_f32_16x16x32_bf16(a1, b1, aab, 0, 0, 0);
        f32x4 aak = __builtin_amdgcn_mfma_f32_16x16x32_bf16(a0, k0, z, 0, 0, 0); aak = __builtin_amdgcn_mfma_f32_16x16x32_bf16(a1, k1, aak, 0, 0, 0);
        f32x4 brb = __builtin_amdgcn_mfma_f32_16x16x32_bf16(r0, b0, z, 0, 0, 0); brb = __builtin_amdgcn_mfma_f32_16x16x32_bf16(r1, b1, brb, 0, 0, 0);
        f32x4 brk = __builtin_amdgcn_mfma_f32_16x16x32_bf16(r0, k0, z, 0, 0, 0); brk = __builtin_amdgcn_mfma_f32_16x16x32_bf16(r1, k1, brk, 0, 0, 0);
#pragma unroll
        for (int r = 0; r < 4; ++r) { const int t = 4 * g4 + r, s = fr;
            AabM[t * 17 + s] = s < t ? aab[r] : 0.f; AakM[t * 17 + s] = s < t ? aak[r] : 0.f; BrkM[t * 17 + s] = s <= t ? brk[r] : 0.f;
            *(unsigned short*)(chb + 512 + t * 32 + s * 2) = (unsigned short)f2bf(s <= t ? brb[r] : 0.f); }
    }
    const int t_ = lane >> 2, s0 = 4 * (lane & 3);
    LDS_WAIT();
    if (lane < 16) {
        float tc[16];
#pragma unroll
        for (int t = 0; t < 16; ++t) { float acc = (t == lane) ? 1.0f : 0.0f;
#pragma unroll
            for (int s = 0; s < t; ++s) acc += AabM[t * 17 + s] * tc[s];
            tc[t] = acc; TM[t * 17 + lane] = acc; }
    }
    LDS_WAIT();
    { u32x2 wv; wv.x = pk2(TM[t_ * 17 + s0], TM[t_ * 17 + s0 + 1]); wv.y = pk2(TM[t_ * 17 + s0 + 2], TM[t_ * 17 + s0 + 3]); *(u32x2*)(chb + t_ * 32 + s0 * 2) = wv; }
#pragma unroll
    for (int t = 0; t < 16; ++t) { float p1 = 0.f, p2 = 0.f;
#pragma unroll
        for (int s = 0; s <= t; ++s) { if (s < t) p1 += AakM[t * 17 + s] * vv[s]; p2 += BrkM[t * 17 + s] * vv[s]; }
        unsigned short* rec = (unsigned short*)(RAc + t * 384);
        rec[128 + lane] = (unsigned short)f2bf(p1); rec[192 + lane] = (unsigned short)f2bf(p2); }
    LDS_WAIT();
}

__device__ __forceinline__ void rwkv_prep_unit(int l_, int u_, LAS unsigned char* lds_) {
    LOAD_CTX(); const int l = UNI(l_), u = UNI(u_); LAS unsigned char* lds = UNI_LDS(lds_);
    const int tid = ltid(), lane = tid & 63, wave = UNI(tid >> 6);
    const int b = u / 257, t0 = (u % 257) * 16;
    const bf16* proj = (const bf16*)(C.ws + WS_PROJ);
    float* RA = (float*)(C.ws + WS_RA); bf16* RG = (bf16*)(C.ws + WS_RG);
    const bf16* LW = (const bf16*)(C.ws + WS_LW);
    const float* mu = C.in[I_MU] + l * 4864;
    LAS bf16* featb = (LAS bf16*)lds;
    const size_t row0 = (size_t)ROWOF(b, t0), rowp = (size_t)ROWOF(b, t0 > 0 ? t0 - 1 : 0);
    __syncthreads();
#pragma unroll
    for (int j = 0; j < 8; ++j) { const int e = tid + 512 * j, tok = e >> 8, f = e & 255, t = t0 + tok; const size_t m = row0 + tok;
        const float cur = bf2f(proj[m * PN + C_WL + f]); const float prev = t > 0 ? bf2f(proj[(tok > 0 ? m - 1 : rowp) * PN + C_WL + f]) : 0.f;
        const float xs = cur + (prev - cur) * mu[C_WL + f];
        featb[tok * 264 + f] = (bf16)f2bf(f < 64 ? tanhf(xs) : (f < 128 ? xs : sigmoidf_(xs))); }
    __syncthreads();
    const int fr = lane & 15, kc = lane >> 4;
    pg8::bf16x8 Af[8];
#pragma unroll
    for (int ks = 0; ks < 8; ++ks) Af[ks] = *(const LAS pg8::bf16x8*)(featb + fr * 264 + 32 * ks + 8 * kc);
#pragma unroll 1
    for (int hh = 0; hh < 3; ++hh) {
        const int ch0 = 192 * wave + 64 * hh, h = ch0 >> 6;
        f32x4 aw[4], aa[4], ag[4];
#pragma unroll
        for (int nt = 0; nt < 4; ++nt) {
            const bf16* bp = LW + (size_t)(ch0 + 4 * fr + nt) * 256 + 8 * kc;
            pg8::bf16x8 Bf[8];
#pragma unroll
            for (int ks = 0; ks < 8; ++ks) Bf[ks] = *(const pg8::bf16x8*)(bp + 32 * ks);
            f32x4 z = (f32x4){0.f, 0.f, 0.f, 0.f};
            aw[nt] = __builtin_amdgcn_mfma_f32_16x16x32_bf16(Af[0], Bf[0], z, 0, 0, 0); aw[nt] = __builtin_amdgcn_mfma_f32_16x16x32_bf16(Af[1], Bf[1], aw[nt], 0, 0, 0);
            aa[nt] = __builtin_amdgcn_mfma_f32_16x16x32_bf16(Af[2], Bf[2], z, 0, 0, 0); aa[nt] = __builtin_amdgcn_mfma_f32_16x16x32_bf16(Af[3], Bf[3], aa[nt], 0, 0, 0);
            ag[nt] = __builtin_amdgcn_mfma_f32_16x16x32_bf16(Af[4], Bf[4], z, 0, 0, 0); ag[nt] = __builtin_amdgcn_mfma_f32_16x16x32_bf16(Af[5], Bf[5], ag[nt], 0, 0, 0);
            ag[nt] = __builtin_amdgcn_mfma_f32_16x16x32_bf16(Af[6], Bf[6], ag[nt], 0, 0, 0); ag[nt] = __builtin_amdgcn_mfma_f32_16x16x32_bf16(Af[7], Bf[7], ag[nt], 0, 0, 0);
        }
        const int cb = ch0 + 4 * fr;
        const f32x4 mur = *(const f32x4*)(mu + C_R + cb), muk = *(const f32x4*)(mu + C_K + cb), muv = *(const f32x4*)(mu + C_V + cb);
        const f32x4 w0c = *(const f32x4*)(C.in[I_W0] + l * 1536 + cb), a0c = *(const f32x4*)(C.in[I_A0] + l * 1536 + cb), kkc = *(const f32x4*)(C.in[I_KK] + l * 1536 + cb), kac = *(const f32x4*)(C.in[I_KA] + l * 1536 + cb);
        f32x4 pr, pk, pv;
#define PREP_LD4(dst, p_) do { const u32x2 w_ = *(const u32x2*)(p_); dst = (f32x4){bf2f(w_.x & 0xffffu), bf2f(w_.x >> 16), bf2f(w_.y & 0xffffu), bf2f(w_.y >> 16)}; } while (0)
        {
            const bool has = (kc > 0) || (t0 > 0);
            const bf16* pp = proj + (kc > 0 ? row0 + 4 * kc - 1 : rowp) * PN + cb;
            const f32x4 z4 = (f32x4){0.f, 0.f, 0.f, 0.f};
            if (has) { PREP_LD4(pr, pp + C_R); PREP_LD4(pk, pp + C_K); PREP_LD4(pv, pp + C_V); } else { pr = z4; pk = z4; pv = z4; }
        }
#pragma unroll
        for (int r = 0; r < 4; ++r) {
            const int tok = 4 * kc + r, t = t0 + tok;
            const bf16* pc = proj + (row0 + tok) * PN + cb;
            f32x4 cr, ck, cv; PREP_LD4(cr, pc + C_R); PREP_LD4(ck, pc + C_K); PREP_LD4(cv, pc + C_V);
            const f32x4 xr = cr + (pr - cr) * mur, xk = ck + (pk - ck) * muk, xv = cv + (pv - cv) * muv;
            pr = cr; pk = ck; pv = cv;
            const f32x4 kkr = xk * kkc;
            float ss = (kkr[0] * kkr[0] + kkr[1] * kkr[1]) + (kkr[2] * kkr[2] + kkr[3] * kkr[3]);
            ss = rowsum16(ss);
            const float rn = 1.0f / fmaxf(sqrtf(ss), 1e-12f);
            f32x4 dec, av, gv4;
#pragma unroll
            for (int nt = 0; nt < 4; ++nt) {
                const float x = -(w0c[nt] + aw[nt][r]);
                const float sp = fmaxf(x, 0.f) + __logf(1.0f + __expf(-fabsf(x)));
                dec[nt] = __expf(-__expf(-sp - 0.5f)); av[nt] = sigmoidf_(a0c[nt] + aa[nt][r]); gv4[nt] = ag[nt][r]; }
            const f32x4 kkn = kkr * rn;
            float* ra = RA + ((size_t)(b * NHR + h) * LT + t) * 384 + 4 * fr;
            *(f32x4*)(ra) = kkn; *(f32x4*)(ra + 64) = dec; *(f32x4*)(ra + 128) = kkn * av; *(f32x4*)(ra + 192) = xk * ((av - 1.0f) * kac + 1.0f); *(f32x4*)(ra + 256) = xr; *(f32x4*)(ra + 320) = xv;
            u32x2 gw; gw.x = pk2(gv4[0], gv4[1]); gw.y = pk2(gv4[2], gv4[3]);
            *(u32x2*)(RG + ((size_t)b * LT + t) * 1536 + cb) = gw;
        }
#undef PREP_LD4
    }
    asm volatile("s_waitcnt vmcnt(0)" ::: "memory"); __syncthreads();
#pragma unroll 1
    for (int hh = 0; hh < 3; ++hh) rwkv_chunk_prep(C, b * NHR + 3 * wave + hh, t0 >> 4, lane, lds + wave * 16640);
}

__device__ __forceinline__ pg8::bf16x8 pack8(const f32x4 a, const f32x4 b2) { u32x4 w; w.x = pk2(a[0], a[1]); w.y = pk2(a[2], a[3]); w.z = pk2(b2[0], b2[1]); w.w = pk2(b2[2], b2[3]); return (pg8::bf16x8)w; }
__device__ __forceinline__ pg8::bf16x8 ld8x2(const void* p0, const void* p1) { const u32x2 a = *(const u32x2*)p0, b2 = *(const u32x2*)p1; const u32x4 w = (u32x4){a.x, a.y, b2.x, b2.y}; return (pg8::bf16x8)w; }
__device__ __forceinline__ pg8::bf16x8 lds8x2(const LAS unsigned char* p0, const LAS unsigned char* p1) { const u32x2 a = *(const LAS u32x2*)p0, b2 = *(const LAS u32x2*)p1; const u32x4 w = (u32x4){a.x, a.y, b2.x, b2.y}; return (pg8::bf16x8)w; }
__device__ __forceinline__ void rwkv_scan_unit(int unit_, LAS unsigned char* lds_) {
    LOAD_CTX(); const int unit = UNI(unit_); LAS unsigned char* lds = UNI_LDS(lds_);
    const int tid = ltid(), lane = tid & 63, wave = UNI(tid >> 6);
    const int hsel = wave >> 2, bh = 2 * unit + hsel, vt = wave & 3, b = bh / NHR, h = bh % NHR;
    const int fr = lane & 15, g4 = lane >> 4, hl = tid & 255;
    const unsigned char* RAb = (const unsigned char*)((const float*)(C.ws + WS_RA) + (size_t)bh * LT * 384);
    const unsigned char* CHB = C.ws + WS_CHB + (size_t)bh * 257 * 1280;
    bf16* RY = (bf16*)(C.ws + WS_RY);
    constexpr int RS = 1040, SLOT = 16 * RS + 1280;
    LAS unsigned char* ring = lds + hsel * 4 * SLOT;
    const f32x4 zero4 = (f32x4){0.f, 0.f, 0.f, 0.f};
    f32x4 acc[4] = {zero4, zero4, zero4, zero4};
    u32x4 ga[5], gb[5];
#define CS_G(dst, c_) do { const unsigned char* rec = RAb + (size_t)(16 * (c_)) * 1536; const unsigned char* side = CHB + (c_) * 1280; \
        _Pragma("unroll") for (int i = 0; i < 5; ++i) { const int p = hl + 256 * i, rr = p >> 6, q = p & 63; \
            const unsigned char* src = p < 1024 ? rec + (size_t)rr * 1536 + (q < 48 ? 16 * q : 1280 + 16 * (q - 48)) : side + 16 * (p - 1024); \
            dst[i] = ((c_) < 257 && p < 1104) ? *(const u32x4*)src : (u32x4){0u, 0u, 0u, 0u}; } } while (0)
#define CS_S(src_, c_) do { LAS unsigned char* sl = ring + ((c_) & 3) * SLOT; \
        _Pragma("unroll") for (int i = 0; i < 5; ++i) { const int p = hl + 256 * i, rr = p >> 6, q = p & 63; \
            if (p < 1104) *(LAS u32x4*)(p < 1024 ? sl + rr * RS + 16 * q : sl + 16 * RS + 16 * (p - 1024)) = src_[i]; } } while (0)
#define CS_COMPUTE(c_) do { const LAS unsigned char* sl = ring + ((c_) & 3) * SLOT; const LAS unsigned char* rt = sl + fr * RS; const LAS unsigned char* side = sl + 16 * RS; \
        const pg8::bf16x8 Ab0 = lds8x2(rt + 8 * g4, rt + 32 + 8 * g4), Ab1 = lds8x2(rt + 64 + 8 * g4, rt + 96 + 8 * g4), Rb0 = lds8x2(rt + 128 + 8 * g4, rt + 160 + 8 * g4), Rb1 = lds8x2(rt + 192 + 8 * g4, rt + 224 + 8 * g4); \
        f32x4 P1, P2, Vd; \
        _Pragma("unroll") for (int r = 0; r < 4; ++r) { const LAS unsigned char* rr_ = sl + (4 * g4 + r) * RS; const int v = 16 * vt + fr; \
            P1[r] = bf2f(((const LAS unsigned short*)(rr_ + 256))[v]); P2[r] = bf2f(((const LAS unsigned short*)(rr_ + 384))[v]); Vd[r] = ((const LAS float*)(rr_ + 768))[v]; } \
        const u32x2 tw = *(const LAS u32x2*)(side + fr * 32 + 8 * g4), bw = *(const LAS u32x2*)(side + 512 + fr * 32 + 8 * g4); \
        const pg8::bf16x8 Tf = (pg8::bf16x8)((u32x4){tw.x, tw.y, 0u, 0u}), Bf = (pg8::bf16x8)((u32x4){bw.x, bw.y, 0u, 0u}); \
        const LAS unsigned char* pb = sl + (fr >> 3) * RS + 512 + (fr & 7) * 32 + 8 * g4; \
        const pg8::bf16x8 M0 = lds8x2(pb, pb + 8 * RS), M1 = lds8x2(pb + 2 * RS, pb + 10 * RS), M2 = lds8x2(pb + 4 * RS, pb + 12 * RS), M3 = lds8x2(pb + 6 * RS, pb + 14 * RS); \
        const f32x4 g0 = *(const LAS f32x4*)(side + 1024 + (4 * g4) * 4), g1 = *(const LAS f32x4*)(side + 1024 + (16 + 4 * g4) * 4), g2 = *(const LAS f32x4*)(side + 1024 + (32 + 4 * g4) * 4), g3 = *(const LAS f32x4*)(side + 1024 + (48 + 4 * g4) * 4); \
        const pg8::bf16x8 sB0 = pack8(acc[0], acc[1]), sB1 = pack8(acc[2], acc[3]); \
        f32x4 Wd = __builtin_amdgcn_mfma_f32_16x16x32_bf16(Ab0, sB0, zero4, 0, 0, 0); Wd = __builtin_amdgcn_mfma_f32_16x16x32_bf16(Ab1, sB1, Wd, 0, 0, 0); \
        f32x4 Yd = __builtin_amdgcn_mfma_f32_16x16x32_bf16(Rb0, sB0, P2, 0, 0, 0); Yd = __builtin_amdgcn_mfma_f32_16x16x32_bf16(Rb1, sB1, Yd, 0, 0, 0); \
        const f32x4 Ud = __builtin_amdgcn_mfma_f32_16x16x32_bf16(Tf, pack8(Wd + P1, zero4), zero4, 0, 0, 0); \
        Yd = __builtin_amdgcn_mfma_f32_16x16x32_bf16(Bf, pack8(Ud, zero4), Yd, 0, 0, 0); \
        const pg8::bf16x8 zB = pack8(Ud, Vd); \
        acc[0] = __builtin_amdgcn_mfma_f32_16x16x32_bf16(M0, zB, acc[0] * g0, 0, 0, 0); acc[1] = __builtin_amdgcn_mfma_f32_16x16x32_bf16(M1, zB, acc[1] * g1, 0, 0, 0); \
        acc[2] = __builtin_amdgcn_mfma_f32_16x16x32_bf16(M2, zB, acc[2] * g2, 0, 0, 0); acc[3] = __builtin_amdgcn_mfma_f32_16x16x32_bf16(M3, zB, acc[3] * g3, 0, 0, 0); \
        _Pragma("unroll") for (int r = 0; r < 4; ++r) RY[((size_t)b * LT + 16 * (c_) + 4 * g4 + r) * 1536 + h * 64 + 16 * vt + fr] = (bf16)f2bf(Yd[r]); } while (0)
    __syncthreads();
    CS_G(ga, 0); CS_G(gb, 1);
    CS_S(ga, 0); CS_S(gb, 1);
    CS_G(gb, 2);
    __syncthreads();
#pragma unroll 1
    for (int c = 0; c < 257; c += 2) {
        CS_G(ga, c + 3);
        CS_COMPUTE(c);
        CS_S(gb, c + 2);
        __syncthreads();
        if (c + 1 < 257) {
            CS_G(gb, c + 4);
            CS_COMPUTE(c + 1);
            CS_S(ga, c + 3);
            __syncthreads();
        }
    }
#undef CS_G
#undef CS_S
#undef CS_COMPUTE
}
__device__ __forceinline__ void hgrn_scan_slice(int sl_) {
    LOAD_CTX(); const int sl = UNI(sl_);
    const int tid = ltid();
    bf16* HDS = (bf16*)(C.ws + WS_HDS); const float* HED = (const float*)(C.ws + WS_HED);
    float S[4][4];
#pragma unroll
    for (int q = 0; q < 4; ++q) { S[q][0] = 0.f; S[q][1] = 0.f; S[q][2] = 0.f; S[q][3] = 0.f; }
    const int e0 = sl * 8192 + tid * 4, bh = e0 >> 14;
    for (int c = 1; c < NCH; ++c) {
        const size_t uc = (size_t)bh * NCH + c;
        u32x2 d[4]; float ed[4];
#pragma unroll
        for (int q = 0; q < 4; ++q) { const int kv = (e0 + q * 2048) & 16383; d[q] = *(const u32x2*)(HDS + uc * 16384 + kv); ed[q] = HED[uc * 128 + (kv >> 7)]; }
#pragma unroll
        for (int q = 0; q < 4; ++q) { const int kv = (e0 + q * 2048) & 16383;
            u32x2 o; o.x = pk2(S[q][0], S[q][1]); o.y = pk2(S[q][2], S[q][3]); *(u32x2*)(HDS + uc * 16384 + kv) = o;
            S[q][0] = S[q][0] * ed[q] + bf2f(d[q].x & 0xffffu); S[q][1] = S[q][1] * ed[q] + bf2f(d[q].x >> 16); S[q][2] = S[q][2] * ed[q] + bf2f(d[q].y & 0xffffu); S[q][3] = S[q][3] * ed[q] + bf2f(d[q].y >> 16); }
    }
}

__device__ __forceinline__ void rwkv_post_all(int l_) {
    LOAD_CTX(); const int l = UNI(l_);
    const int tid = ltid(), lane = tid & 63, wave = UNI(tid >> 6);
    const bf16* RY = (const bf16*)(C.ws + WS_RY); const bf16* RG = (const bf16*)(C.ws + WS_RG);
    const float* RA = (const float*)(C.ws + WS_RA);
    bf16* mixed = (bf16*)(C.ws + WS_Z);
    const float* lnw = C.in[I_LNW] + l * 1536; const float* lnb = C.in[I_LNB] + l * 1536; const float* rk = C.in[I_RK] + l * 1536;
    for (int m = blockIdx.x * 8 + wave; m < TT; m += gridDim.x * 8) {
        const int b = m / LT, t = m - b * LT;
#pragma unroll 1
        for (int hg = 0; hg < 6; ++hg) {
            float y[4], g[4], kp[4], r[4], v[4], w_[4], b_[4], k_[4];
#pragma unroll
            for (int q = 0; q < 4; ++q) { const int h = hg * 4 + q, c = h * 64 + lane;
                const float* ra = RA + ((size_t)(b * NHR + h) * LT + t) * 384 + lane;
                y[q] = bf2f(RY[(size_t)m * 1536 + c]); g[q] = bf2f(RG[(size_t)m * 1536 + c]); kp[q] = ra[192]; r[q] = ra[256]; v[q] = ra[320];
                w_[q] = lnw[c]; b_[q] = lnb[c]; k_[q] = rk[c]; }
#pragma unroll
            for (int q = 0; q < 4; ++q) { const int c = (hg * 4 + q) * 64 + lane;
                const float mean = wave_sum(y[q]) * (1.0f / 64.0f);
                const float dy = y[q] - mean;
                const float var = wave_sum(dy * dy) * (1.0f / 64.0f);
                const float yn = dy * rsqrtf(var + 64e-5f) * w_[q] + b_[q];
                const float bonus = wave_sum(r[q] * kp[q] * k_[q]) * v[q];
                const float mv = (yn + bonus) * g[q];
                if (t < NMETA) mixed[(size_t)ROWOF(b, t) * DM + c] = (bf16)f2bf(mv);
                (C.ws + WS_MX8)[(size_t)ROWOF(b, t) * DM + c] = fp8_1(mv * MX8_SCALE); }
        }
    }
}
__device__ __forceinline__ void hgrn_out_unit(int l_, int u_, LAS unsigned char* lds_) {
    LOAD_CTX(); const int l = UNI(l_), u = UNI(u_); LAS unsigned char* lds = UNI_LDS(lds_);
    const int tid = ltid(), lane = tid & 63, wave = UNI(tid >> 6);
    const int bh = u / 65, c = u % 65 + 1, b = bh >> 3, h = bh & 7;
    const bf16* proj = (const bf16*)(C.ws + WS_PROJ);
    const bf16* HDS = (const bf16*)(C.ws + WS_HDS); const bf16* HQG = (const bf16*)(C.ws + WS_HQG); const float* HAT = (const float*)(C.ws + WS_HAT);
    bf16* mixed = (bf16*)(C.ws + WS_Z);
    LAS bf16* Am = (LAS bf16*)lds;
    LAS bf16* Bt = (LAS bf16*)(lds + 25600);
    lfloat* ssum = (lfloat*)(lds + 25600 + 52224);
    const size_t uc = (size_t)bh * NCH + c;
    __syncthreads();
    for (int e = tid; e < 1024; e += 512) { const int t_ = e >> 4, s4 = 4 * (e & 15); const f32x4 a4 = *(const f32x4*)(HAT + uc * 4096 + t_ * 64 + s4);
        u32x2 w; w.x = pk2(a4[0], a4[1]); w.y = pk2(a4[2], a4[3]); *(LAS u32x2*)(Am + t_ * 200 + s4) = w; }
    for (int e = tid; e < 1024; e += 512) { const int t_ = e >> 4, ch = e & 15; *(LAS u32x4*)(Am + t_ * 200 + 64 + 8 * ch) = *(const u32x4*)(HQG + uc * 8192 + t_ * 128 + 8 * ch); }
    for (int e = tid; e < 1024; e += 512) { const int s_ = e >> 4, v8 = 8 * (e & 15), t = 64 * c + s_ - 112;
        u32x4 w = (u32x4){0u, 0u, 0u, 0u}; if (t >= 0 && t < LT) w = *(const u32x4*)(proj + (size_t)ROWOF(b, t) * PN + C_HI + h * 128 + v8);
        LAS bf16* bp_ = Bt + v8 * 204 + s_;
        bp_[0] = (bf16)(w.x & 0xffffu); bp_[204] = (bf16)(w.x >> 16); bp_[408] = (bf16)(w.y & 0xffffu); bp_[612] = (bf16)(w.y >> 16); bp_[816] = (bf16)(w.z & 0xffffu); bp_[1020] = (bf16)(w.z >> 16); bp_[1224] = (bf16)(w.w & 0xffffu); bp_[1428] = (bf16)(w.w >> 16); }
#pragma unroll
    for (int i = 0; i < 4; ++i) { const int e = tid + 512 * i, kx = e >> 4, v8 = 8 * (e & 15); const u32x4 w = *(const u32x4*)(HDS + uc * 16384 + kx * 128 + v8);
        LAS bf16* bp_ = Bt + v8 * 204 + 64 + kx;
        bp_[0] = (bf16)(w.x & 0xffffu); bp_[204] = (bf16)(w.x >> 16); bp_[408] = (bf16)(w.y & 0xffffu); bp_[612] = (bf16)(w.y >> 16); bp_[816] = (bf16)(w.z & 0xffffu); bp_[1020] = (bf16)(w.z >> 16); bp_[1224] = (bf16)(w.w & 0xffffu); bp_[1428] = (bf16)(w.w >> 16); }
    __syncthreads();
    const int fr = lane & 15, g4 = lane >> 4;
    pg8::bf16x8 Bf[6];
#pragma unroll
    for (int ks = 0; ks < 6; ++ks) { const LAS u32x2* bp = (const LAS u32x2*)(Bt + (16 * wave + fr) * 204 + 32 * ks + 8 * g4); const u32x2 lo = bp[0], hi = bp[1];
        const u32x4 w = (u32x4){lo.x, lo.y, hi.x, hi.y}; Bf[ks] = (pg8::bf16x8)w; }
    f32x4 o[4];
#pragma unroll
    for (int mt = 0; mt < 4; ++mt) { f32x4 d = (f32x4){0.f, 0.f, 0.f, 0.f};
#pragma unroll
        for (int ks = 0; ks < 6; ++ks) { const pg8::bf16x8 a = *(const LAS pg8::bf16x8*)(Am + (16 * mt + fr) * 200 + 32 * ks + 8 * g4); d = __builtin_amdgcn_mfma_f32_16x16x32_bf16(a, Bf[ks], d, 0, 0, 0); }
        o[mt] = d; }
#pragma unroll
    for (int mt = 0; mt < 4; ++mt)
#pragma unroll
        for (int r = 0; r < 4; ++r) { const float s = rowsum16(o[mt][r] * o[mt][r]); if (fr == 0) ssum[wave * 64 + 16 * mt + 4 * g4 + r] = s; }
    __syncthreads();
    const float gn = C.in[I_HNORM][l * 1024 + h * 128 + 16 * wave + fr];
#pragma unroll
    for (int mt = 0; mt < 4; ++mt)
#pragma unroll
        for (int r = 0; r < 4; ++r) { const int tl = 16 * mt + 4 * g4 + r, t = 64 * c + tl - 112;
            float ss = 0.f;
#pragma unroll
            for (int w8 = 0; w8 < 8; ++w8) ss += ssum[w8 * 64 + tl];
            if (t >= 0 && t < LT) { const size_t m = (size_t)ROWOF(b, t);
                const float gv = bf2f(proj[m * PN + C_HG + h * 128 + 16 * wave + fr]);
                const float mv = o[mt][r] * rsqrtf(ss * (1.0f / 128.0f) + 1e-5f) * gn * (gv * sigmoidf_(gv));
                if (t < NMETA) mixed[m * DM + 3072 + h * 128 + 16 * wave + fr] = (bf16)f2bf(mv);
                (C.ws + WS_MX8)[m * DM + 3072 + h * 128 + 16 * wave + fr] = fp8_1(mv * MX8_SCALE); } }
}

__device__ __forceinline__ unsigned ordkey(float v) { const unsigned b = __float_as_uint(v); return b ^ ((b >> 31) ? 0xFFFFFFFFu : 0x80000000u); }
__device__ __forceinline__ float unordkey(unsigned k) { const unsigned b = (k >> 31) ? (k ^ 0x80000000u) : ~k; return __uint_as_float(b); }
#define CE_U(a, b) do { const unsigned mx_ = (a) > (b) ? (a) : (b), mn_ = (a) > (b) ? (b) : (a); (a) = mx_; (b) = mn_; } while (0)
__device__ __forceinline__ void sort16_desc(unsigned (&k)[16]) {
#pragma unroll
    for (int size = 2; size <= 16; size <<= 1)
#pragma unroll
        for (int stride = size >> 1; stride > 0; stride >>= 1)
#pragma unroll
            for (int i = 0; i < 16; ++i) { const int j = i ^ stride; if (j > i) { if ((i & size) == 0) CE_U(k[i], k[j]); else CE_U(k[j], k[i]); } }
}
__device__ __forceinline__ void merge16_desc(unsigned (&top)[16], const unsigned (&blk)[16]) {
#pragma unroll
    for (int i = 0; i < 16; ++i) top[i] = top[i] > blk[15 - i] ? top[i] : blk[15 - i];
#pragma unroll
    for (int stride = 8; stride > 0; stride >>= 1)
#pragma unroll
        for (int i = 0; i < 16; ++i) { const int j = i ^ stride; if (j > i) CE_U(top[i], top[j]); }
}
#define CE_P(va, pa, vb, pb) do { const bool sw_ = (vb) > (va); const float tv_ = sw_ ? (vb) : (va), tw_ = sw_ ? (va) : (vb); const unsigned tp_ = sw_ ? (pb) : (pa), tq_ = sw_ ? (pa) : (pb); (va) = tv_; (vb) = tw_; (pa) = tp_; (pb) = tq_; } while (0)
__device__ __forceinline__ void sort16p_desc(float (&v)[16], unsigned (&p)[16]) {
#pragma unroll
    for (int size = 2; size <= 16; size <<= 1)
#pragma unroll
        for (int stride = size >> 1; stride > 0; stride >>= 1)
#pragma unroll
            for (int i = 0; i < 16; ++i) { const int j = i ^ stride; if (j > i) { if ((i & size) == 0) CE_P(v[i], p[i], v[j], p[j]); else CE_P(v[j], p[j], v[i], p[i]); } }
}
__device__ __forceinline__ void merge16p_desc(float (&tv)[16], unsigned (&tp)[16], const float (&bv)[16], const unsigned (&bp)[16]) {
#pragma unroll
    for (int i = 0; i < 16; ++i) { const bool tk = bv[15 - i] > tv[i]; tv[i] = tk ? bv[15 - i] : tv[i]; tp[i] = tk ? bp[15 - i] : tp[i]; }
#pragma unroll
    for (int stride = 8; stride > 0; stride >>= 1)
#pragma unroll
        for (int i = 0; i < 16; ++i) { const int j = i ^ stride; if (j > i) CE_P(tv[i], tp[i], tv[j], tp[j]); }
}
__device__ __forceinline__ void top16_half(const float* sc, int m0, int half, int lane, lfloat* stage, unsigned (&top)[16]) {
    f32x4 ld[4][8];
#pragma unroll
    for (int j = 0; j < 4; ++j)
#pragma unroll
        for (int i = 0; i < 8; ++i) { const int idx = lane + 64 * i, p = idx >> 3, part = idx & 7;
            ld[j][i] = *(const f32x4*)(sc + (size_t)(m0 + (p >> 3)) * 2048 + (p & 7) * 256 + half * 128 + 32 * j + 4 * part); }
#pragma unroll
    for (int j = 0; j < 4; ++j) {
#pragma unroll
        for (int i = 0; i < 8; ++i) { const int idx = lane + 64 * i, p = idx >> 3, part = idx & 7; lfloat* d = stage + p * 33 + 4 * part; d[0] = ld[j][i].x; d[1] = ld[j][i].y; d[2] = ld[j][i].z; d[3] = ld[j][i].w; }
        LDS_WAIT();
#pragma unroll
        for (int hb = 0; hb < 2; ++hb) {
            unsigned blk[16];
#pragma unroll
            for (int i = 0; i < 16; ++i) { const int n = 32 * j + 16 * hb + i; blk[i] = (ordkey(stage[lane * 33 + 16 * hb + i]) & ~127u) | (unsigned)(127 - n); }
            sort16_desc(blk);
            if (j == 0 && hb == 0) {
#pragma unroll
                for (int i = 0; i < 16; ++i) top[i] = blk[i];
            } else merge16_desc(top, blk);
        }
        LDS_WAIT();
    }
}
__device__ __forceinline__ void route_task(const Ctx& C, int wt, int lane, LAS unsigned char* wl) {
    const float* sc = (const float*)(C.ws + WS_SC);
    bf16* GG = (bf16*)(C.ws + WS_GG); unsigned* BMp = (unsigned*)(C.ws + WS_BM);
    lfloat* stage = (lfloat*)wl;
    LAS u32x2* ent = (LAS u32x2*)(wl + 8704);
    const int m0 = 8 * wt, tk = lane >> 3, h = lane & 7;
    unsigned s1[16], s2[16];
    top16_half(sc, m0, 0, lane, stage, s1);
    top16_half(sc, m0, 1, lane, stage, s2);
    LAS unsigned short* cid = (LAS unsigned short*)stage + lane * 66;
    unsigned top[16];
#define CAND(dst, slot, num, a, b) do { const float cv_ = unordkey(s1[a] & ~127u) + unordkey(s2[b] & ~127u); dst[slot] = (ordkey(cv_) & ~63u) | (unsigned)(63 - (num)); \
        cid[num] = (unsigned short)(((127u - (s1[a] & 127u)) << 7) | (127u - (s2[b] & 127u))); } while (0)
    {
#pragma unroll
        for (int b2 = 0; b2 < 16; ++b2) CAND(top, b2, b2, 0, b2);
        sort16_desc(top);
    }
    {
        unsigned blk[16];
#pragma unroll
        for (int b2 = 0; b2 < 8; ++b2) CAND(blk, b2, 16 + b2, 1, b2);
#pragma unroll
        for (int b2 = 0; b2 < 5; ++b2) CAND(blk, 8 + b2, 24 + b2, 2, b2);
        blk[13] = 0u; blk[14] = 0u; blk[15] = 0u;
        sort16_desc(blk); merge16_desc(top, blk);
    }
    {
        unsigned blk[16];
#pragma unroll
        for (int b2 = 0; b2 < 4; ++b2) CAND(blk, b2, 29 + b2, 3, b2);
#pragma unroll
        for (int b2 = 0; b2 < 3; ++b2) CAND(blk, 4 + b2, 33 + b2, 4, b2);
#pragma unroll
        for (int b2 = 0; b2 < 2; ++b2) { CAND(blk, 7 + b2, 36 + b2, 5, b2); CAND(blk, 9 + b2, 38 + b2, 6, b2); }
        blk[11] = 0u; blk[12] = 0u; blk[13] = 0u; blk[14] = 0u; blk[15] = 0u;
        sort16_desc(blk); merge16_desc(top, blk);
    }
    {
        unsigned blk[16];
        CAND(blk, 0, 40, 7, 0); CAND(blk, 1, 41, 7, 1);
#pragma unroll
        for (int a2 = 8; a2 < 16; ++a2) CAND(blk, a2 - 6, 34 + a2, a2, 0);
        blk[10] = 0u; blk[11] = 0u; blk[12] = 0u; blk[13] = 0u; blk[14] = 0u; blk[15] = 0u;
        sort16_desc(blk); merge16_desc(top, blk);
    }
#undef CAND
    LDS_WAIT();
    {
        const float v0 = unordkey(top[0] & ~63u);
        float e[16]; float sum = 0.f;
#pragma unroll
        for (int i = 0; i < 16; ++i) { e[i] = __expf(unordkey(top[i] & ~63u) - v0); sum += e[i]; }
        const float inv = 1.0f / sum;
#pragma unroll
        for (int i = 0; i < 16; ++i) { const unsigned id = cid[63u - (top[i] & 63u)]; ent[tk * 128 + h * 16 + i] = (u32x2){id, __float_as_uint(e[i] * inv)}; }
    }
    LDS_WAIT();
#pragma unroll 1
    for (int t8 = 0; t8 < 8; ++t8) {
        const LAS u32x2* en = ent + t8 * 128; const size_t m = (size_t)(m0 + t8);
        const int my0 = (int)en[lane].x, my1 = (int)en[lane + 64].x;
        float g0 = 0.f, g1 = 0.f; bool f0 = true, f1 = true;
#pragma unroll 8
        for (int i = 0; i < 128; ++i) { const u32x2 x = en[i]; const int id = (int)x.x; const float gv = __uint_as_float(x.y);
            if (id == my0) { g0 += gv; if (i < lane) f0 = false; }
            if (id == my1) { g1 += gv; if (i < lane + 64) f1 = false; } }
        *(u32x4*)(GG + m * NE + (my0 & ~7)) = (u32x4){0u, 0u, 0u, 0u}; *(u32x4*)(GG + m * NE + (my1 & ~7)) = (u32x4){0u, 0u, 0u, 0u};
        atomicOr(BMp + m * 64 + (my0 >> 8), 1u << ((my0 >> 3) & 31)); atomicOr(BMp + m * 64 + (my1 >> 8), 1u << ((my1 >> 3) & 31));
        asm volatile("s_waitcnt vmcnt(0)" ::: "memory");
        if (f0) GG[m * NE + my0] = (bf16)f2bf(g0);
        if (f1) GG[m * NE + my1] = (bf16)f2bf(g1);
    }
    LDS_WAIT();
}
__device__ __forceinline__ int mbcnt64(unsigned long long m) { return __builtin_amdgcn_mbcnt_hi((unsigned)(m >> 32), __builtin_amdgcn_mbcnt_lo((unsigned)m, 0u)); }
__device__ __forceinline__ void top16_of_128(float v0, float v1, int lane, lfloat* selv, LAS int* seli) {
    const unsigned k0 = (ordkey(v0) & ~127u) | (unsigned)(127 - lane), k1 = (ordkey(v1) & ~127u) | (unsigned)(63 - lane);
    unsigned thr = 0u;
    for (int bit = 31; bit >= 0; --bit) { const unsigned cand = thr | (1u << bit);
        const int cnt = __popcll(__ballot(k0 >= cand)) + __popcll(__ballot(k1 >= cand));
        if (cnt >= 16) { thr = cand; if (cnt == 16) break; } }
    const unsigned long long m0 = __ballot(k0 >= thr), m1 = __ballot(k1 >= thr);
    if (k0 >= thr) { const int s = mbcnt64(m0); if (s < 16) { selv[s] = v0; seli[s] = lane; } }
    if (k1 >= thr) { const int s = __popcll(m0) + mbcnt64(m1); if (s < 16) { selv[s] = v1; seli[s] = lane + 64; } }
}
__device__ __forceinline__ void route_token_bisect(const Ctx& C, int m, int lane, LAS unsigned char* wl) {
    const float* sc = (const float*)(C.ws + WS_SC) + (size_t)m * 2048;
    bf16* GG = (bf16*)(C.ws + WS_GG);
    lfloat* s1v = (lfloat*)wl; LAS int* s1i = (LAS int*)(wl + 64); lfloat* s2v = (lfloat*)(wl + 128); LAS int* s2i = (LAS int*)(wl + 192);
    lfloat* bv = (lfloat*)(wl + 256); LAS int* bi = (LAS int*)(wl + 320);
    LAS u32x2* ent = (LAS u32x2*)(wl + 384);
    float sv[8][4];
#pragma unroll
    for (int h = 0; h < 8; ++h) { sv[h][0] = sc[h * 256 + lane]; sv[h][1] = sc[h * 256 + 64 + lane]; sv[h][2] = sc[h * 256 + 128 + lane]; sv[h][3] = sc[h * 256 + 192 + lane]; }
#pragma unroll
    for (int h = 0; h < 8; ++h) {
        const float a0 = sv[h][0], a1 = sv[h][1], b0 = sv[h][2], b1 = sv[h][3];
        top16_of_128(a0, a1, lane, s1v, s1i);
        top16_of_128(b0, b1, lane, s2v, s2i);
        LDS_WAIT();
        const float sa = s1v[lane >> 2]; const f32x4 sb = *(const lf32x4*)(s2v + 4 * (lane & 3));
        const float cv[4] = {sa + sb.x, sa + sb.y, sa + sb.z, sa + sb.w};
        unsigned ck[4];
#pragma unroll
        for (int jj = 0; jj < 4; ++jj) ck[jj] = (ordkey(cv[jj]) & ~255u) | (unsigned)(255 - (4 * lane + jj));
        unsigned thr = 0u;
        for (int bit = 31; bit >= 0; --bit) { const unsigned cand = thr | (1u << bit);
            const int cnt = __popcll(__ballot(ck[0] >= cand)) + __popcll(__ballot(ck[1] >= cand)) + __popcll(__ballot(ck[2] >= cand)) + __popcll(__ballot(ck[3] >= cand));
            if (cnt >= 16) { thr = cand; if (cnt == 16) break; } }
        int base = 0;
        const int ia = s1i[lane >> 2];
#pragma unroll
        for (int jj = 0; jj < 4; ++jj) { const unsigned long long mk = __ballot(ck[jj] >= thr);
            if (ck[jj] >= thr) { const int s = base + mbcnt64(mk); if (s < 16) { bv[s] = cv[jj]; bi[s] = ia * 128 + s2i[4 * (lane & 3) + jj]; } }
            base += __popcll(mk); }
        LDS_WAIT();
        float mx = -3.0e38f;
#pragma unroll
        for (int i = 0; i < 16; ++i) mx = fmaxf(mx, bv[i]);
        float sum = 0.f;
#pragma unroll
        for (int i = 0; i < 16; ++i) sum += __expf(bv[i] - mx);
        if (lane < 16) ent[h * 16 + lane] = (u32x2){(unsigned)bi[lane], __float_as_uint(__expf(bv[lane] - mx) / sum)};
        LDS_WAIT();
    }
    u32x2* me = (u32x2*)(C.ws + WS_ME) + (size_t)(m - MAIN_ROWS) * 128;
    me[lane] = ent[lane]; me[lane + 64] = ent[lane + 64];
    LDS_WAIT();
}

__device__ __forceinline__ void route_all(int l_, LAS unsigned char* lds_) {
    LOAD_CTX(); const int l = UNI(l_); LAS unsigned char* lds = UNI_LDS(lds_);
    const int tid = ltid(), lane = tid & 63, wave = UNI(tid >> 6);
    __syncthreads();
    for (int wt = blockIdx.x * 8 + wave; wt < MAIN_ROWS / 8; wt += gridDim.x * 8) route_task(C, wt, lane, lds + wave * 17408);
    if (l == 0) for (int m = MAIN_ROWS + blockIdx.x * 8 + wave; m < TT; m += gridDim.x * 8) route_token_bisect(C, m, lane, lds + wave * 17408);
}
__device__ __forceinline__ void norm2_zero_all(int l_) {
    LOAD_CTX(); const int l = UNI(l_);
    const int tid = ltid(), lane = tid & 63, wave = UNI((int)(tid >> 6)), G = gridDim.x;
    unsigned char* ws = C.ws; bf16* Z = (bf16*)(ws + WS_Z); float* H = (float*)(ws + WS_H);
    unsigned char* HN8 = ws + WS_HN8;
    const int nrows = (l == 1) ? MAIN_ROWS : TT;
    {   f32x4 gn[16]; { const f32x4* gr = (const f32x4*)(C.in[I_NFFN] + l * DM) + lane;
#pragma unroll
            for (int j = 0; j < 16; ++j) gn[j] = gr[64 * j]; }
        rows_pipe(blockIdx.x * 8 + wave, G * 8, nrows, lane, [&](int m) -> const float* { return H + (size_t)m * DM; },
            [&](const f32x4 (&v)[16], int m) { norm_row_fin(v, gn, Z + (size_t)m * DM, nullptr, lane, HN8 + (size_t)m * DM); }); }
    for (int e = blockIdx.x * 512 + tid; e < (MP - TT) * DM / 16; e += G * 512) ((u32x4*)(HN8 + (size_t)TT * DM))[e] = (u32x4){0u, 0u, 0u, 0u};
    u32x4* gz = (u32x4*)(ws + WS_BM);
    const size_t n16 = (size_t)MAIN_ROWS * 64 * 4 / 16;
    for (size_t e = (size_t)blockIdx.x * 512 + tid; e < n16; e += (size_t)G * 512) gz[e] = (u32x4){0u, 0u, 0u, 0u};
}
__device__ __forceinline__ void final_norm_all() {
    LOAD_CTX();
    const int tid = ltid(), lane = tid & 63, wave = UNI((int)(tid >> 6)), G = gridDim.x;
    const float* H = (const float*)(C.ws + WS_H);
    f32x4 gn[16]; { const f32x4* gr = (const f32x4*)C.in[I_NFIN] + lane;
#pragma unroll
        for (int j = 0; j < 16; ++j) gn[j] = gr[64 * j]; }
    rows_pipe(blockIdx.x * 8 + wave, G * 8, NB * 4096, lane, [&](int m) -> const float* { return H + (size_t)m * DM; },
        [&](const f32x4 (&v)[16], int m) {
            float ss = 0.f;
#pragma unroll
            for (int j = 0; j < 16; ++j) ss += (v[j].x * v[j].x + v[j].y * v[j].y) + (v[j].z * v[j].z + v[j].w * v[j].w);
            ss = wave_sum(ss);
            const float rn = rsqrtf(ss * (1.0f / 4096.0f) + 1e-5f);
            f32x4* o = (f32x4*)(C.out + (size_t)m * DM) + lane;
#pragma unroll
            for (int j = 0; j < 16; ++j) o[64 * j] = v[j] * rn * gn[j]; });
}
constexpr int NPL = 11;
constexpr int HG_OUT_EARLY = 2080;
constexpr int NPH = 2 * NPL + 1;
template <int MODE> __device__ __forceinline__ void meta_gemm(const bf16* A, const bf16* Bt, int N, float* O, int ldo, LAS unsigned char* lds_) {
    LAS unsigned char* lds = UNI_LDS(lds_);
    const int tid = ltid(), lane = tid & 63, wave = UNI(tid >> 6), fr = lane & 15, g4 = lane >> 4;
    lfloat* part = (lfloat*)lds;
    for (int nt = blockIdx.x; nt < N / 16; nt += gridDim.x) {
        __syncthreads();
        f32x4 d = (f32x4){0.f, 0.f, 0.f, 0.f};
        const bf16* ap = A + (size_t)fr * DM + 512 * wave + 8 * g4; const bf16* bp = Bt + (size_t)(16 * nt + fr) * DM + 512 * wave + 8 * g4;
#pragma unroll
        for (int ks = 0; ks < 16; ++ks) d = __builtin_amdgcn_mfma_f32_16x16x32_bf16(*(const pg8::bf16x8*)(ap + 32 * ks), *(const pg8::bf16x8*)(bp + 32 * ks), d, 0, 0, 0);
#pragma unroll
        for (int r = 0; r < 4; ++r) part[wave * 256 + (4 * g4 + r) * 16 + fr] = d[r];
        __syncthreads();
        if (tid < 256) { const int t = tid >> 4, n = tid & 15; float s = 0.f;
#pragma unroll
            for (int w8 = 0; w8 < 8; ++w8) s += part[w8 * 256 + tid];
#pragma unroll
            for (int bb = 0; bb < 4; ++bb) { float* o = O + (size_t)(MAIN_ROWS + 16 * bb + t) * ldo + 16 * nt + n; if (MODE == 0) *o += s; else *o = s; } }
    }
}
__device__ __forceinline__ void meta_u_all(int l_) {
    LOAD_CTX(); const int l = UNI(l_);
    const int tid = ltid(), lane = tid & 63, wave = UNI(tid >> 6);
    const bf16* Z = (const bf16*)(C.ws + WS_Z); const float* pu = C.in[I_PU] + (size_t)l * NE * DM;
    const u32x2* me = (const u32x2*)(C.ws + WS_ME); float* HM = (float*)(C.ws + WS_HM);
    for (int task = blockIdx.x * 8 + wave; task < 16 * 128; task += gridDim.x * 8) {
        const int t = task >> 7, e = task & 127; const u32x2 en = me[t * 128 + e];
        const float* ur = pu + (size_t)en.x * DM + 4 * lane; const bf16* hr = Z + (size_t)(MAIN_ROWS + t) * DM + 4 * lane;
        float acc = 0.f;
#pragma unroll 8
        for (int i = 0; i < 16; ++i) { const f32x4 uu = *(const f32x4*)(ur + 256 * i); const u32x2 hh = *(const u32x2*)(hr + 256 * i);
            acc += uu.x * bf2f(hh.x & 0xffffu) + uu.y * bf2f(hh.x >> 16) + uu.z * bf2f(hh.y & 0xffffu) + uu.w * bf2f(hh.y >> 16); }
        acc = wave_sum(acc);
        if (lane == 0) HM[t * 128 + e] = __uint_as_float(en.y) * 0.5f * acc * (1.0f + erff(acc * 0.70710678118654752f));
    }
}
__device__ __forceinline__ void meta_v_all(int l_) {
    LOAD_CTX(); const int l = UNI(l_);
    const int tid = ltid(), lane = tid & 63, wave = UNI(tid >> 6);
    const float* pv = C.in[I_PV] + (size_t)l * NE * DM; float* H = (float*)(C.ws + WS_H);
    const u32x2* me = (const u32x2*)(C.ws + WS_ME); const float* HM = (const float*)(C.ws + WS_HM);
    for (int task = blockIdx.x * 8 + wave; task < 16 * 16; task += gridDim.x * 8) {
        const int t = task >> 4, n = 256 * (task & 15) + 4 * lane;
        f32x4 acc = (f32x4){0.f, 0.f, 0.f, 0.f};
#pragma unroll 8
        for (int e = 0; e < 128; ++e) { const unsigned id = me[t * 128 + e].x; const float hv = HM[t * 128 + e]; acc += *(const f32x4*)(pv + (size_t)id * DM + n) * hv; }
#pragma unroll
        for (int bb = 0; bb < 4; ++bb) { f32x4* o = (f32x4*)(H + (size_t)(MAIN_ROWS + 16 * bb + t) * DM + n); *o = *o + acc; }
    }
}

#if MK_ONE_LAUNCH
#define GRID_BAR() xcd_barrier(bar)
#else
#define GRID_BAR() do {} while (0)
#endif
#define IN(k) (lo <= (k) && (k) < hi)
#define SEAM(k) do { if (IN((k) + 1)) GRID_BAR(); } while (0)
#ifndef DUP_MASK
#define DUP_MASK 0u
#endif
#define REPS(k) ((((unsigned)DUP_MASK >> (k)) & 1u) ? 2 : 1)
template <int l> __device__ __forceinline__ void layer_phases(const int lo, const int hi, const int G, LAS unsigned char* lds, const XcdBarrier& bar) {
        const int p0 = l * NPL;
        if (IN(p0 + 0)) for (int rep = 0; rep < REPS(0); ++rep) { phase_conv_norm(l, lds); SEAM(p0 + 0); }
        if (IN(p0 + 1)) for (int rep = 0; rep < REPS(1); ++rep) {
            const Ctx Cq = load_ctx(); unsigned char* ws = Cq.ws; bf16* Z = (bf16*)(ws + WS_Z); float* H = (float*)(ws + WS_H); (void)Z; (void)H;
            pg8::Gemm g{(const pg8::bf16_t*)Z, (const pg8::bf16_t*)(ws + WS_WIN), MP, PN, DM}; pg8::StaticOrder S; S.init(MP, PN, G, (int)blockIdx.x);
            pg8::EpiBf16<0> E{(pg8::bf16_t*)(ws + WS_PROJ), PN, nullptr, 0, 0};
            pg8::gemm_phase<pg8::EpiBf16<0>, pg8::StaticOrder, false>(lds, g, S, E, nullptr);
            SEAM(p0 + 1);
        }
        if (IN(p0 + 2)) for (int rep = 0; rep < REPS(2); ++rep) {
            for (int u = blockIdx.x; u < 1028; u += G) rwkv_prep_unit(l, u, lds);
            if (G == 256 && rep == 0) {
                unsigned* qc = (unsigned*)(load_ctx().ws + WS_CTL) + CW_HL + 64 * l;
                volatile LAS unsigned* slot = (volatile LAS unsigned*)(lds + LDS_MISC) + 16;
                unsigned nxt = 0u;
                if (threadIdx.x == 0) nxt = __hip_atomic_fetch_add(qc, 1u, __ATOMIC_RELAXED, __HIP_MEMORY_SCOPE_AGENT);
                for (;;) {
                    if (threadIdx.x == 0) *slot = nxt;
                    __syncthreads();
                    const int u = __builtin_amdgcn_readfirstlane((int)*slot);
                    __syncthreads();
                    if (u >= 2080) break;
                    if (threadIdx.x == 0) nxt = __hip_atomic_fetch_add(qc, 1u, __ATOMIC_RELAXED, __HIP_MEMORY_SCOPE_AGENT);
                    hgrn_local_unit(l, u, lds);
                }
            } else
            for (int u = (blockIdx.x + G - 16) % G; u < 2080; u += G) hgrn_local_unit(l, u, lds);
            SEAM(p0 + 2);
        }
        if (IN(p0 + 3)) for (int rep = 0; rep < REPS(3); ++rep) {
            if (G == 256 && rep == 0) {
                const int r = blockIdx.x, q = r - 48;
                unsigned* ctlw = (unsigned*)(load_ctx().ws + WS_CTL);
                unsigned* hgc = ctlw + CW_HG; unsigned* qc = ctlw + CW_M2 + 64 * l;
                if (r < 48) rwkv_scan_unit(r, lds);
                else if (q < 64) {
                    hgrn_scan_slice(q);
                    asm volatile("s_waitcnt vmcnt(0)" ::: "memory"); __syncthreads();
                    if (threadIdx.x == 0) { __builtin_amdgcn_fence(__ATOMIC_RELEASE, "agent"); asm volatile("s_waitcnt vmcnt(0)" ::: "memory");
                        __hip_atomic_fetch_add(hgc, 1u, __ATOMIC_RELAXED, __HIP_MEMORY_SCOPE_AGENT); }
                }
                volatile LAS unsigned* slot = (volatile LAS unsigned*)(lds + LDS_MISC) + 16;
                unsigned nxt = 0u; bool waited = false;
                if (threadIdx.x == 0) nxt = __hip_atomic_fetch_add(qc, 1u, __ATOMIC_RELAXED, __HIP_MEMORY_SCOPE_AGENT);
                for (;;) {
                    __syncthreads();
                    if (threadIdx.x == 0) *slot = nxt;
                    __syncthreads();
                    const int t = __builtin_amdgcn_readfirstlane((int)*slot);
                    if (t >= 1548 + 2080) break;
                    if (threadIdx.x == 0) nxt = __hip_atomic_fetch_add(qc, 1u, __ATOMIC_RELAXED, __HIP_MEMORY_SCOPE_AGENT);
                    if (t < 1548) swa_unit(l, t, lds);
                    else {
                        if (!waited) {
                            if (threadIdx.x == 0) { unsigned sp = 0; const unsigned want = 64u * (unsigned)(l + 1);
                                while (__hip_atomic_load(hgc, __ATOMIC_RELAXED, __HIP_MEMORY_SCOPE_AGENT) < want) { __builtin_amdgcn_s_sleep(2); if (++sp > (1u << 22)) break; }
                                __builtin_amdgcn_fence(__ATOMIC_ACQUIRE, "agent"); asm volatile("s_waitcnt vmcnt(0)" ::: "memory"); }
                            __syncthreads();
                            waited = true;
                        }
                        hgrn_out_unit(l, t - 1548, lds);
                    }
                }
            } else
            for (int r = blockIdx.x; r < 256; r += G) {
                if (r < 48) { rwkv_scan_unit(r, lds); continue; }
                const int q = r - 48;
                const bool split = (G == 256);
                unsigned* hgc = (unsigned*)(load_ctx().ws + WS_CTL) + CW_HG;
                if (q < 64 && rep == 0) {
                    hgrn_scan_slice(q);
                    if (split) {
                        asm volatile("s_waitcnt vmcnt(0)" ::: "memory"); __syncthreads();
                        if (threadIdx.x == 0) { __builtin_amdgcn_fence(__ATOMIC_RELEASE, "agent"); asm volatile("s_waitcnt vmcnt(0)" ::: "memory");
                            __hip_atomic_fetch_add(hgc, 1u, __ATOMIC_RELAXED, __HIP_MEMORY_SCOPE_AGENT); }
                    }
                }
                for (int u = q; u < 1548; u += 208) swa_unit(l, u, lds);
                if (split) {
                    if (threadIdx.x == 0) { unsigned sp = 0; const unsigned want = 64u * (unsigned)(l + 1);
                        while (__hip_atomic_load(hgc, __ATOMIC_RELAXED, __HIP_MEMORY_SCOPE_AGENT) < want) { __builtin_amdgcn_s_sleep(2); if (++sp > (1u << 22)) break; }
                        __builtin_amdgcn_fence(__ATOMIC_ACQUIRE, "agent"); asm volatile("s_waitcnt vmcnt(0)" ::: "memory"); }
                    __syncthreads();
                    for (int u = q; u < HG_OUT_EARLY; u += 208) hgrn_out_unit(l, u, lds);
                }
            }
            SEAM(p0 + 3);
        }
        if (IN(p0 + 4)) for (int rep = 0; rep < REPS(4); ++rep) {
            for (int u = ((G == 256) ? HG_OUT_EARLY : 0) + blockIdx.x; u < 2080; u += G) hgrn_out_unit(l, u, lds);
            rwkv_post_all(l);
            SEAM(p0 + 4);
        }
        if (IN(p0 + 5)) for (int rep = 0; rep < REPS(5); ++rep) {
            const Ctx Cq = load_ctx(); unsigned char* ws = Cq.ws; bf16* Z = (bf16*)(ws + WS_Z); float* H = (float*)(ws + WS_H); (void)Z; (void)H;
            constexpr int MR = MAIN_ROWS; pg8::Gemm8 g{ws + WS_MX8, ws + WS_WO8, MR, DM, DM, WO8_E8M0}; pg8::StaticOrder S; S.init(MR, DM, G, (int)blockIdx.x);
            pg8::EpiResF32 E{H, DM, (l == 0) ? Cq.in[I_X] : (const float*)H};
            pg8::gemm_phase8<pg8::EpiResF32, pg8::StaticOrder, false>(lds, g, S, E, nullptr);
            if (l == 0) meta_gemm<0>((const bf16*)Z + (size_t)MAIN_ROWS * DM, (const bf16*)(ws + WS_WO), DM, H, DM, lds);
            SEAM(p0 + 5);
        }
        if (IN(p0 + 6)) for (int rep = 0; rep < REPS(6); ++rep) { norm2_zero_all(l); SEAM(p0 + 6); }
        if (IN(p0 + 7)) for (int rep = 0; rep < REPS(7); ++rep) {
            const Ctx Cq = load_ctx(); unsigned char* ws = Cq.ws; bf16* Z = (bf16*)(ws + WS_Z); float* H = (float*)(ws + WS_H); (void)Z; (void)H;
            constexpr int MR = MAIN_ROWS; pg8::Gemm g{(const pg8::bf16_t*)Z, (const pg8::bf16_t*)(ws + WS_WS), MR, 2048, DM}; pg8::StaticOrder S; S.init(MR, 2048, G, (int)blockIdx.x);
            pg8::EpiF32 E{(float*)(ws + WS_SC), 2048, nullptr};
            pg8::gemm_phase<pg8::EpiF32, pg8::StaticOrder, false>(lds, g, S, E, nullptr);
            if (l == 0) meta_gemm<1>((const bf16*)Z + (size_t)MAIN_ROWS * DM, (const bf16*)(ws + WS_WS), 2048, (float*)(ws + WS_SC), 2048, lds);
            SEAM(p0 + 7);
        }
        if (IN(p0 + 8)) for (int rep = 0; rep < REPS(8); ++rep) { route_all(l, lds); SEAM(p0 + 8); }
        if (IN(p0 + 9)) for (int rep = 0; rep < REPS(9); ++rep) {
            const Ctx Cq = load_ctx(); unsigned char* ws = Cq.ws; bf16* Z = (bf16*)(ws + WS_Z); float* H = (float*)(ws + WS_H); (void)Z; (void)H;
            constexpr int MR = MAIN_ROWS; pg8::Gemm8 g{ws + WS_HN8, ws + WS_U, MR, NE, DM, U8_E8M0}; pg8::StaticOrder S; S.init(MR, NE, G, (int)blockIdx.x);
            pg8::EpiGate8 E{ws};
            pg8::gemm_phase8<pg8::EpiGate8, pg8::StaticOrder, false>(lds, g, S, E, nullptr);
            if (l == 0) meta_u_all(l);
            SEAM(p0 + 9);
        }
        if (IN(p0 + 10)) for (int rep = 0; rep < REPS(10); ++rep) {
            const Ctx Cq = load_ctx(); unsigned char* ws = Cq.ws; bf16* Z = (bf16*)(ws + WS_Z); float* H = (float*)(ws + WS_H); (void)Z; (void)H;
            constexpr int MR = MAIN_ROWS; pg8::Gemm8 g{ws + WS_HG8, ws + WS_VT, MR, DM, NE, V8_E8M0}; pg8::StaticOrder S; S.init(MR, DM, G, (int)blockIdx.x);
            pg8::EpiResF32 E{H, DM, (const float*)H};
            pg8::gemm_phase8<pg8::EpiResF32, pg8::StaticOrder, false>(lds, g, S, E, nullptr);
            if (l == 0) meta_v_all(l);
            SEAM(p0 + 10);
        }
}
__global__ void __launch_bounds__(512, 2) hybrid_fwd(Ctx C) {
    extern __shared__ __attribute__((aligned(16))) unsigned char lds_raw[];
    LAS unsigned char* lds = (LAS unsigned char*)lds_raw;
    const int tid = threadIdx.x, lane = tid & 63, wave = __builtin_amdgcn_readfirstlane(tid >> 6);
    const int G = gridDim.x;
    unsigned* ctl = (unsigned*)(C.ws + WS_CTL);
    volatile LAS unsigned* MISC = (volatile LAS unsigned*)(lds + LDS_MISC);
    if (tid < 64) MISC[tid] = 0u;
    __syncthreads();
#if MK_ONE_LAUNCH
    XcdBarrier bar = xcd_barrier_post(ctl + CW_BAR, MISC + 8);
#else
    XcdBarrier bar; bar.bar = ctl; bar.x = 0u; bar.st = MISC + 8;
#endif
    const int lo = C.ph_lo, hi = C.ph_hi;
    layer_phases<0>(lo, hi, G, lds, bar);
    layer_phases<1>(lo, hi, G, lds, bar);
    if (IN(2 * NPL)) final_norm_all();
}

extern "C" void kernel_launch(void* const* d_in, const int* in_sizes, int n_in, void* d_out, int out_size, void* d_ws, size_t ws_size, hipStream_t stream) {
    static int grid = 0;
    if (grid == 0) {
        if (n_in != 25 || ws_size < WS_END) { fprintf(stderr, "kernel_launch: need 25 inputs and %zu bytes of workspace (got %d, %zu)\n", (size_t)WS_END, n_in, ws_size); grid = -1; return; }
        int dev = 0, cus = 0, per_cu = 0;
        if (hipGetDevice(&dev) != hipSuccess || hipDeviceGetAttribute(&cus, hipDeviceAttributeMultiprocessorCount, dev) != hipSuccess) { grid = -1; return; }
        if (hipFuncSetAttribute((const void*)hybrid_fwd, hipFuncAttributeMaxDynamicSharedMemorySize, LDS_BYTES) != hipSuccess) { fprintf(stderr, "kernel_launch: hipFuncSetAttribute failed\n"); grid = -1; return; }
        if (hipOccupancyMaxActiveBlocksPerMultiprocessor(&per_cu, (const void*)hybrid_fwd, 512, LDS_BYTES) != hipSuccess || per_cu < 1) { fprintf(stderr, "kernel_launch: occupancy query says %d blocks per CU\n", per_cu); }
        (void)hipGetLastError();
        grid = cus;
    }
    if (grid < 0) return;
    (void)hipMemsetAsync((char*)d_ws + WS_CTL, 0, CTL_ZERO_BYTES, stream);
    Ctx c{};
    for (int i = 0; i < 25; ++i) c.in[i] = (const float*)d_in[i];
    c.out = (float*)d_out; c.ws = (unsigned char*)d_ws;
#if MK_ONE_LAUNCH
    c.ph_lo = 0; c.ph_hi = NPH;
    hipLaunchKernelGGL(hybrid_fwd, dim3(grid), dim3(512), LDS_BYTES, stream, c);
#else
    for (int p = 0; p < NPH; ++p) { c.ph_lo = p; c.ph_hi = p + 1; hipLaunchKernelGGL(hybrid_fwd, dim3(grid), dim3(512), LDS_BYTES, stream, c); }
#endif
}
```

```cpp
#include <hip/hip_runtime.h>
#include <cstdio>
#include <cstdint>
#ifndef MK_ONE_LAUNCH
#define MK_ONE_LAUNCH 1
#endif
namespace pg8 {
#define PG8_LAS __attribute__((address_space(3)))
typedef unsigned short bf16_t;
typedef short bf16x8 __attribute__((ext_vector_type(8)));
typedef float f32x4 __attribute__((ext_vector_type(4)));
typedef unsigned u32x4 __attribute__((ext_vector_type(4)));
constexpr int BM = 256, BK = 64, HALF = 128, HTB = HALF * BK * 2  , STAGE_BYTES = 8 * HTB, NXCD = 8, WGM = 8;

__host__ __device__ __forceinline__ int lds_byte(int r, int c) { const int st = (r >> 4) * 2 + (c >> 5), rr = r & 15, cc = c & 31, ob = rr * 64 + cc * 2; return st * 1024 + (ob ^ (((ob >> 9) & 1) << 5)); }
__host__ __device__ __forceinline__ void stage_rc(int b, int& R, int& C) { const int st = b / 1024, sb = b % 1024, swz = sb ^ (((sb >> 9) & 1) << 5); R = (st >> 1) * 16 + swz / 64; C = (st & 1) * 32 + (swz % 64) / 2; }
__host__ __device__ __forceinline__ int perm32(int rho) { const int n = rho >> 4, i = rho & 15; return 8 * (i >> 2) + 4 * n + (i & 3); }

struct Unit { int pm, pn; };
struct Gemm { const bf16_t* A; const bf16_t* Bt; int M, N, K; };

struct StaticOrder {
    int nM, nN, nwg, G, c;
    __host__ __device__ void init(int M, int N, int G_, int c_) { nM = M / BM; nN = N / BM; nwg = nM * nN; G = G_; c = c_; }
    __host__ __device__ bool next(int i, Unit& u) const {
        const long L = (long)i * G + c; if (L >= nwg) return false;
        int wgid = (int)L; { const int q = nwg / NXCD, r = nwg % NXCD, xcd = wgid % NXCD, off = wgid / NXCD; wgid = (xcd < r ? xcd * (q + 1) : r * (q + 1) + (xcd - r) * q) + off; }
        const int nig = WGM * nN, gid = wgid / nig, fm = gid * WGM, gsz = (nM - fm) < WGM ? (nM - fm) : WGM;
        u.pm = fm + ((wgid % nig) % gsz); u.pn = (wgid % nig) / gsz; return true;
    }
    __device__ __forceinline__ void a_ready(const Unit&) const {}
    __device__ __forceinline__ void done(const Unit&) const {}
};
__device__ __forceinline__ unsigned cvt_pk_bf16(float lo, float hi) { unsigned r; asm volatile("v_cvt_pk_bf16_f32 %0, %1, %2" : "=v"(r) : "v"(lo), "v"(hi)); return r; }
typedef float f32x2 __attribute__((ext_vector_type(2)));
__device__ __forceinline__ f32x2 gelu_pk(f32x2 v) {
    const f32x2 av = __builtin_elementwise_abs(v), d = av * 0.2316418882f + 1.0f;
    f32x2 t; t.x = __builtin_amdgcn_rcpf(d.x); t.y = __builtin_amdgcn_rcpf(d.y);
    f32x2 q = t * 0.5307027145f + (-0.7265760135f); q = q * t + 0.7107068705f; q = q * t + (-0.142248368f); q = q * t + 0.127414796f; q = q * t;
    const f32x2 s = (v * v) * (-0.72134752044f);
    f32x2 e; e.x = __builtin_amdgcn_exp2f(s.x); e.y = __builtin_amdgcn_exp2f(s.y);
    const f32x2 m = v * (q * e), r = v - m;
    f32x2 o; o.x = v.x < 0.f ? m.x : r.x; o.y = v.y < 0.f ? m.y : r.y; return o;
}
struct EpiF32 {
    static constexpr bool PERM = false, AFTER_DRAIN = false;
    float* C; int ldc; const float* bias;
    __device__ __forceinline__ void operator()(const f32x4 (&acc)[2][2][4][2], const Unit& u, int wr, int wc, int fr, int fq) const {
        const int row0 = u.pm * BM + wr * 64 + fr, col0 = u.pn * BM + wc * 32 + 4 * fq;
        f32x4 bv[2][2];
#pragma unroll
        for (int bj = 0; bj < 2; ++bj)
#pragma unroll
            for (int n = 0; n < 2; ++n) bv[bj][n] = bias ? *(const f32x4*)(bias + col0 + bj * HALF + n * 16) : (f32x4){0.f, 0.f, 0.f, 0.f};
#pragma unroll
        for (int ai = 0; ai < 2; ++ai)
#pragma unroll
            for (int m = 0; m < 4; ++m) { float* rowp = C + (size_t)(row0 + ai * HALF + m * 16) * ldc + col0;
#pragma unroll
                for (int bj = 0; bj < 2; ++bj)
#pragma unroll
                    for (int n = 0; n < 2; ++n) *(f32x4*)(rowp + bj * HALF + n * 16) = acc[ai][bj][m][n] + bv[bj][n]; }
    }
};
template <int ACT  > struct EpiBf16 {
    static constexpr bool PERM = true, AFTER_DRAIN = false;
    bf16_t* O; int ldc; const float* bias; int split_cols; size_t split_stride;
    __device__ __forceinline__ void operator()(const f32x4 (&acc)[2][2][4][2], const Unit& u, int wr, int wc, int fr, int fq) const {
        const int row0 = u.pm * BM + wr * 64 + fr; int colt = u.pn * BM; bf16_t* base = O;
        if (split_cols) { const int t = colt / split_cols; base += (size_t)t * split_stride; colt -= t * split_cols; }
        const int col0 = colt + wc * 32 + 8 * fq, bcol0 = u.pn * BM + wc * 32 + 8 * fq;
        f32x4 bv[2][2];
#pragma unroll
        for (int bj = 0; bj < 2; ++bj)
#pragma unroll
            for (int n = 0; n < 2; ++n) bv[bj][n] = bias ? *(const f32x4*)(bias + bcol0 + bj * HALF + 4 * n) : (f32x4){0.f, 0.f, 0.f, 0.f};
#pragma unroll
        for (int ai = 0; ai < 2; ++ai)
#pragma unroll
            for (int m = 0; m < 4; ++m) { bf16_t* rowp = base + (size_t)(row0 + ai * HALF + m * 16) * ldc + col0;
#pragma unroll
                for (int bj = 0; bj < 2; ++bj) { f32x4 v0 = acc[ai][bj][m][0] + bv[bj][0], v1 = acc[ai][bj][m][1] + bv[bj][1];
                    if (ACT == 1) { f32x2 a = gelu_pk((f32x2){v0[0], v0[1]}), b = gelu_pk((f32x2){v0[2], v0[3]}), c = gelu_pk((f32x2){v1[0], v1[1]}), d = gelu_pk((f32x2){v1[2], v1[3]});
                        v0 = (f32x4){a.x, a.y, b.x, b.y}; v1 = (f32x4){c.x, c.y, d.x, d.y}; }
                    if (ACT == 2) {
#pragma unroll
                        for (int j = 0; j < 4; ++j) { v0[j] = 0.5f * v0[j] * (1.0f + erff(v0[j] * 0.70710678f)); v1[j] = 0.5f * v1[j] * (1.0f + erff(v1[j] * 0.70710678f)); } }
                    u32x4 w; w.x = cvt_pk_bf16(v0[0], v0[1]); w.y = cvt_pk_bf16(v0[2], v0[3]); w.z = cvt_pk_bf16(v1[0], v1[1]); w.w = cvt_pk_bf16(v1[2], v1[3]);
                    *(u32x4*)(rowp + bj * HALF) = w; } }
    }
};
template <class Epi, class Sched, bool STAMP = false>
__device__ __forceinline__ void gemm_phase(PG8_LAS unsigned char* lds, const Gemm g, const Sched& S, const Epi& E, unsigned long long* stamps) {
    int tid_ = threadIdx.x; asm volatile("" : "+v"(tid_));
    const int tid = tid_, wid = __builtin_amdgcn_readfirstlane(tid >> 6), lane = tid & 63, wr = wid >> 2, wc = wid & 3, fr = lane & 15, fq = lane >> 4;
    const int K = g.K, nt = K / BK;
    int ts_lo = 0, ts_hi = 0, nts = 0; const unsigned long long rt_entry = STAMP ? (unsigned long long)wall_clock64() : 0ull;
#define PG8_STAMP() do { if (STAMP && wid == 0 && nts < 64) { const unsigned long long _c = (unsigned long long)clock64(); \
        ts_lo = (lane == nts) ? (int)(unsigned)_c : ts_lo; ts_hi = (lane == nts) ? (int)(unsigned)(_c >> 32) : ts_hi; ++nts; } } while (0)
    PG8_STAMP();
    unsigned voffA[2], voffB[2];
#pragma unroll
    for (int i = 0; i < 2; ++i) { int R, C; stage_rc(tid * 16 + i * 8192, R, C); const int Rb = Epi::PERM ? ((R & ~31) + perm32(R & 31)) : R;
        voffA[i] = (unsigned)(R * K + C) * 2u; voffB[i] = (unsigned)(Rb * K + C) * 2u; }
    const size_t kstep = (size_t)(BK * 2);
    const size_t hstep = (size_t)HALF * K * 2;
    const size_t tstep = 2 * hstep;
    const unsigned ldsw = (unsigned)wid * 1024u;
    const unsigned ldsdst = (unsigned)__builtin_amdgcn_readfirstlane((int)((unsigned)(size_t)lds + ldsw));
    const int aoff = lds_byte(wr * 64 + fr, fq * 8), boff = lds_byte(wc * 32 + fr, fq * 8);
#define PG8_SA(b, h) (((b) * 2 + (h)) * HTB)
#define PG8_SB(b, h) ((4 + (b) * 2 + (h)) * HTB)
#define PG8_STAGE(bufoff, gbase, voff) do { _Pragma("unroll") for (int _i = 0; _i < 2; ++_i) { unsigned keep_; \
        asm volatile("s_mov_b32 %0, m0\n\ts_mov_b32 m0, %3\n\ts_nop 0\n\tglobal_load_lds_dwordx4 %1, %2\n\ts_mov_b32 m0, %0" : "=&s"(keep_) : "v"((voff)[_i]), "s"((unsigned long long)(gbase)), "s"(ldsdst + (unsigned)((bufoff) + _i * 8192)) : "memory"); } } while (0)
#define PG8_LDA(dst, b, h) do { _Pragma("unroll") for (int m = 0; m < 4; ++m) _Pragma("unroll") for (int k = 0; k < 2; ++k) dst[m][k] = *(const PG8_LAS bf16x8*)(lds + PG8_SA(b, h) + aoff + m * 2048 + k * 1024); } while (0)
#define PG8_LDB(dst, b, h) do { _Pragma("unroll") for (int n = 0; n < 2; ++n) _Pragma("unroll") for (int k = 0; k < 2; ++k) dst[n][k] = *(const PG8_LAS bf16x8*)(lds + PG8_SB(b, h) + boff + n * 2048 + k * 1024); } while (0)
#define PG8_MMA(ai, bj, At, Bt) do { __builtin_amdgcn_s_setprio(1); _Pragma("unroll") for (int m = 0; m < 4; ++m) _Pragma("unroll") for (int n = 0; n < 2; ++n) _Pragma("unroll") for (int k = 0; k < 2; ++k) \
        acc[ai][bj][m][n] = __builtin_amdgcn_mfma_f32_16x16x32_bf16(Bt[n][k], At[m][k], acc[ai][bj][m][n], 0, 0, 0); __builtin_amdgcn_s_setprio(0); } while (0)
#define PG8_WAIT_V(n) asm volatile("s_waitcnt vmcnt(" #n ")" ::: "memory")
#define PG8_WAIT_L(n) asm volatile("s_waitcnt lgkmcnt(" #n ")" ::: "memory")
#define PG8_BAR __builtin_amdgcn_s_barrier()
#define PG8_SCHED __builtin_amdgcn_sched_barrier(0)
    Unit cur, nxt; int ui = 0;
    if (!S.next(0, cur)) return;
    f32x4 acc[2][2][4][2];
#pragma unroll
    for (int a = 0; a < 2; ++a)
#pragma unroll
        for (int b = 0; b < 2; ++b)
#pragma unroll
            for (int m = 0; m < 4; ++m)
#pragma unroll
                for (int n = 0; n < 2; ++n) acc[a][b][m][n] = (f32x4){0.f, 0.f, 0.f, 0.f};
    bf16x8 At[4][2], B0[2][2], B1[2][2];
    const char* cA = (const char*)g.A + (size_t)cur.pm * tstep; const char* cB = (const char*)g.Bt + (size_t)cur.pn * tstep;
    S.a_ready(cur);
    PG8_STAGE(PG8_SB(0, 0), cB, voffB); PG8_STAGE(PG8_SA(0, 0), cA, voffA); PG8_STAGE(PG8_SB(0, 1), cB + hstep, voffB); PG8_STAGE(PG8_SA(0, 1), cA + hstep, voffA);
    if (wr == 1) PG8_BAR;
    PG8_WAIT_V(4); PG8_BAR;
    PG8_STAGE(PG8_SB(1, 0), cB + kstep, voffB); PG8_STAGE(PG8_SA(1, 0), cA + kstep, voffA); PG8_STAGE(PG8_SB(1, 1), cB + hstep + kstep, voffB);
    PG8_WAIT_V(6); PG8_BAR;
    PG8_STAMP();
    for (;;) {
        const bool has_next = S.next(ui + 1, nxt);
        const char* nA = has_next ? (const char*)g.A + (size_t)nxt.pm * tstep : cA; const char* nB = has_next ? (const char*)g.Bt + (size_t)nxt.pn * tstep : cB;
        for (int t = 0; t < nt; t += 2) {
            const bool last = (t == nt - 2);
            const char* a1 = cA + (size_t)(t + 1) * kstep;
            const char* a2 = last ? nA : cA + (size_t)(t + 2) * kstep; const char* b2 = last ? nB : cB + (size_t)(t + 2) * kstep;
            const char* a3 = a2 + kstep; const char* b3 = b2 + kstep;
            if (last && has_next) S.a_ready(nxt);
            PG8_LDB(B0, 0, 0); PG8_SCHED; PG8_LDA(At, 0, 0); PG8_STAGE(PG8_SA(1, 1), a1 + hstep, voffA);
            PG8_WAIT_L(8); PG8_BAR; PG8_WAIT_L(0); PG8_MMA(0, 0, At, B0); PG8_BAR; PG8_SCHED;
            PG8_LDB(B1, 0, 1); PG8_STAGE(PG8_SB(0, 0), b2, voffB);
            PG8_BAR; PG8_WAIT_L(0); PG8_MMA(0, 1, At, B1); PG8_BAR;
            PG8_LDA(At, 0, 1); PG8_STAGE(PG8_SA(0, 0), a2, voffA);
            PG8_BAR; PG8_WAIT_L(0); PG8_MMA(1, 0, At, B0); PG8_BAR; PG8_SCHED;
            PG8_STAGE(PG8_SB(0, 1), b2 + hstep, voffB);
            PG8_WAIT_V(6); PG8_BAR; PG8_MMA(1, 1, At, B1); PG8_BAR;
            PG8_LDB(B0, 1, 0); PG8_SCHED; PG8_LDA(At, 1, 0); PG8_STAGE(PG8_SA(0, 1), a2 + hstep, voffA);
            PG8_WAIT_L(8); PG8_BAR; PG8_WAIT_L(0); PG8_MMA(0, 0, At, B0); PG8_BAR; PG8_SCHED;
            PG8_LDB(B1, 1, 1); PG8_STAGE(PG8_SB(1, 0), b3, voffB);
            PG8_BAR; PG8_WAIT_L(0); PG8_MMA(0, 1, At, B1); PG8_BAR;
            PG8_LDA(At, 1, 1); PG8_STAGE(PG8_SA(1, 0), a3, voffA);
            PG8_BAR; PG8_WAIT_L(0); PG8_MMA(1, 0, At, B0); PG8_BAR; PG8_SCHED;
            PG8_STAGE(PG8_SB(1, 1), b3 + hstep, voffB);
            PG8_WAIT_V(6); PG8_BAR; PG8_MMA(1, 1, At, B1); PG8_BAR;
        }
        PG8_STAMP();
        if constexpr (!Epi::AFTER_DRAIN) { E(acc, cur, wr, wc, fr, fq); S.done(cur); }
        PG8_STAMP();
        if (!has_next) break;
#pragma unroll
        for (int a = 0; a < 2; ++a)
#pragma unroll
            for (int b = 0; b < 2; ++b)
#pragma unroll
                for (int m = 0; m < 4; ++m)
#pragma unroll
                    for (int n = 0; n < 2; ++n) acc[a][b][m][n] = (f32x4){0.f, 0.f, 0.f, 0.f};
        cur = nxt; cA = nA; cB = nB; ++ui;
    }
    PG8_WAIT_V(0);
    if (wr == 0) PG8_BAR;
    PG8_BAR;
    if constexpr (Epi::AFTER_DRAIN) { E.fused(acc, cur, wr, wc, fr, fq, lds, wid, lane); S.done(cur); }
    PG8_STAMP();
    if (STAMP && wid == 0) { stamps[lane] = lane < nts ? (((unsigned long long)(unsigned)ts_hi << 32) | (unsigned)ts_lo) : 0ull;
        if (lane == 62) stamps[62] = rt_entry; if (lane == 63) stamps[63] = (unsigned long long)wall_clock64(); }
#undef PG8_STAMP
#undef PG8_SA
#undef PG8_SB
#undef PG8_STAGE
#undef PG8_LDA
#undef PG8_LDB
#undef PG8_MMA
#undef PG8_WAIT_V
#undef PG8_WAIT_L
#undef PG8_BAR
#undef PG8_SCHED
}
typedef int i32x4 __attribute__((ext_vector_type(4)));
typedef int i32x8 __attribute__((ext_vector_type(8)));
struct Gemm8 { const unsigned char* A; const unsigned char* Bt; int M, N, K; int scale; };
template <class Epi, class Sched, bool STAMP = false>
__device__ __forceinline__ void gemm_phase8(PG8_LAS unsigned char* lds, const Gemm8 g, const Sched& S, const Epi& E, unsigned long long* stamps) {
    int tid_ = threadIdx.x; asm volatile("" : "+v"(tid_));
    const int tid = tid_, wid = __builtin_amdgcn_readfirstlane(tid >> 6), lane = tid & 63, wr = wid >> 2, wc = wid & 3, fr = lane & 15, fq = lane >> 4;
    const int K = g.K  , nt = K / 128;
    int ts_lo = 0, ts_hi = 0, nts = 0; const unsigned long long rt_entry = STAMP ? (unsigned long long)wall_clock64() : 0ull;
#define PG8_STAMP() do { if (STAMP && wid == 0 && nts < 64) { const unsigned long long _c = (unsigned long long)clock64(); \
        ts_lo = (lane == nts) ? (int)(unsigned)_c : ts_lo; ts_hi = (lane == nts) ? (int)(unsigned)(_c >> 32) : ts_hi; ++nts; } } while (0)
    PG8_STAMP();
    unsigned voffA[2], voffB[2];
#pragma unroll
    for (int i = 0; i < 2; ++i) { int R, C; stage_rc(tid * 16 + i * 8192, R, C); const int Rb = Epi::PERM ? ((R & ~31) + perm32(R & 31)) : R;
        voffA[i] = (unsigned)(R * K + 2 * C); voffB[i] = (unsigned)(Rb * K + 2 * C); }
    const size_t kstep = (size_t)(BK * 2);
    const size_t hstep = (size_t)HALF * K;
    const size_t tstep = 2 * hstep;
    const unsigned ldsw = (unsigned)wid * 1024u;
    const unsigned ldsdst = (unsigned)__builtin_amdgcn_readfirstlane((int)((unsigned)(size_t)lds + ldsw));
    const int aoff = lds_byte(wr * 64 + fr, fq * 16), boff = lds_byte(wc * 32 + fr, fq * 16);
#define PG8_SA(b, h) (((b) * 2 + (h)) * HTB)
#define PG8_SB(b, h) ((4 + (b) * 2 + (h)) * HTB)
#define PG8_STAGE(bufoff, gbase, voff) do { _Pragma("unroll") for (int _i = 0; _i < 2; ++_i) { unsigned keep_; \
        asm volatile("s_mov_b32 %0, m0\n\ts_mov_b32 m0, %3\n\ts_nop 0\n\tglobal_load_lds_dwordx4 %1, %2\n\ts_mov_b32 m0, %0" : "=&s"(keep_) : "v"((voff)[_i]), "s"((unsigned long long)(gbase)), "s"(ldsdst + (unsigned)((bufoff) + _i * 8192)) : "memory"); } } while (0)
#define PG8_LDA(dst, b, h) do { _Pragma("unroll") for (int m = 0; m < 4; ++m) { const i32x4 lo_ = *(const PG8_LAS i32x4*)(lds + PG8_SA(b, h) + aoff + m * 2048), hi_ = *(const PG8_LAS i32x4*)(lds + PG8_SA(b, h) + aoff + m * 2048 + 16); dst[m] = __builtin_shufflevector(lo_, hi_, 0, 1, 2, 3, 4, 5, 6, 7); } } while (0)
#define PG8_LDB(dst, b, h) do { _Pragma("unroll") for (int n = 0; n < 2; ++n) { const i32x4 lo_ = *(const PG8_LAS i32x4*)(lds + PG8_SB(b, h) + boff + n * 2048), hi_ = *(const PG8_LAS i32x4*)(lds + PG8_SB(b, h) + boff + n * 2048 + 16); dst[n] = __builtin_shufflevector(lo_, hi_, 0, 1, 2, 3, 4, 5, 6, 7); } } while (0)
#define PG8_MMA(ai, bj, At, Bt) do { __builtin_amdgcn_s_setprio(1); _Pragma("unroll") for (int m = 0; m < 4; ++m) _Pragma("unroll") for (int n = 0; n < 2; ++n) \
        acc[ai][bj][m][n] = __builtin_amdgcn_mfma_scale_f32_16x16x128_f8f6f4(Bt[n], At[m], acc[ai][bj][m][n], 0, 0, 0, g.scale, 0, 0x7f7f7f7f); __builtin_amdgcn_s_setprio(0); } while (0)
#define PG8_WAIT_V(n) asm volatile("s_waitcnt vmcnt(" #n ")" ::: "memory")
#define PG8_WAIT_L(n) asm volatile("s_waitcnt lgkmcnt(" #n ")" ::: "memory")
#define PG8_BAR __builtin_amdgcn_s_barrier()
#define PG8_SCHED __builtin_amdgcn_sched_barrier(0)
    Unit cur, nxt; int ui = 0;
    if (!S.next(0, cur)) return;
    f32x4 acc[2][2][4][2];
#pragma unroll
    for (int a = 0; a < 2; ++a)
#pragma unroll
        for (int b = 0; b < 2; ++b)
#pragma unroll
            for (int m = 0; m < 4; ++m)
#pragma unroll
                for (int n = 0; n < 2; ++n) acc[a][b][m][n] = (f32x4){0.f, 0.f, 0.f, 0.f};
    i32x8 At[4], B0[2], B1[2];
    const char* cA = (const char*)g.A + (size_t)cur.pm * tstep; const char* cB = (const char*)g.Bt + (size_t)cur.pn * tstep;
    S.a_ready(cur);
    PG8_STAGE(PG8_SB(0, 0), cB, voffB); PG8_STAGE(PG8_SA(0, 0), cA, voffA); PG8_STAGE(PG8_SB(0, 1), cB + hstep, voffB); PG8_STAGE(PG8_SA(0, 1), cA + hstep, voffA);
    if (wr == 1) PG8_BAR;
    PG8_WAIT_V(4); PG8_BAR;
    PG8_STAGE(PG8_SB(1, 0), cB + kstep, voffB); PG8_STAGE(PG8_SA(1, 0), cA + kstep, voffA); PG8_STAGE(PG8_SB(1, 1), cB + hstep + kstep, voffB);
    PG8_WAIT_V(6); PG8_BAR;
    PG8_STAMP();
    for (;;) {
        const bool has_next = S.next(ui + 1, nxt);
        const char* nA = has_next ? (const char*)g.A + (size_t)nxt.pm * tstep : cA; const char* nB = has_next ? (const char*)g.Bt + (size_t)nxt.pn * tstep : cB;
        for (int t = 0; t < nt; t += 2) {
            const bool last = (t == nt - 2);
            const char* a1 = cA + (size_t)(t + 1) * kstep;
            const char* a2 = last ? nA : cA + (size_t)(t + 2) * kstep; const char* b2 = last ? nB : cB + (size_t)(t + 2) * kstep;
            const char* a3 = a2 + kstep; const char* b3 = b2 + kstep;
            if (last && has_next) S.a_ready(nxt);
            PG8_LDB(B0, 0, 0); PG8_SCHED; PG8_LDA(At, 0, 0); PG8_STAGE(PG8_SA(1, 1), a1 + hstep, voffA);
            PG8_WAIT_L(8); PG8_BAR; PG8_WAIT_L(0); PG8_MMA(0, 0, At, B0); PG8_BAR; PG8_SCHED;
            PG8_LDB(B1, 0, 1); PG8_STAGE(PG8_SB(0, 0), b2, voffB);
            PG8_BAR; PG8_WAIT_L(0); PG8_MMA(0, 1, At, B1); PG8_BAR;
            PG8_LDA(At, 0, 1); PG8_STAGE(PG8_SA(0, 0), a2, voffA);
            PG8_BAR; PG8_WAIT_L(0); PG8_MMA(1, 0, At, B0); PG8_BAR; PG8_SCHED;
            PG8_STAGE(PG8_SB(0, 1), b2 + hstep, voffB);
            PG8_WAIT_V(6); PG8_BAR; PG8_MMA(1, 1, At, B1); PG8_BAR;
            PG8_LDB(B0, 1, 0); PG8_SCHED; PG8_LDA(At, 1, 0); PG8_STAGE(PG8_SA(0, 1), a2 + hstep, voffA);
            PG8_WAIT_L(8); PG8_BAR; PG8_WAIT_L(0); PG8_MMA(0, 0, At, B0); PG8_BAR; PG8_SCHED;
            PG8_LDB(B1, 1, 1); PG8_STAGE(PG8_SB(1, 0), b3, voffB);
            PG8_BAR; PG8_WAIT_L(0); PG8_MMA(0, 1, At, B1); PG8_BAR;
            PG8_LDA(At, 1, 1); PG8_STAGE(PG8_SA(1, 0), a3, voffA);
            PG8_BAR; PG8_WAIT_L(0); PG8_MMA(1, 0, At, B0); PG8_BAR; PG8_SCHED;
            PG8_STAGE(PG8_SB(1, 1), b3 + hstep, voffB);
            PG8_WAIT_V(6); PG8_BAR; PG8_MMA(1, 1, At, B1); PG8_BAR;
        }
        PG8_STAMP();
        if constexpr (!Epi::AFTER_DRAIN) { E(acc, cur, wr, wc, fr, fq); S.done(cur); }
        PG8_STAMP();
        if (!has_next) break;
#pragma unroll
        for (int a = 0; a < 2; ++a)
#pragma unroll
            for (int b = 0; b < 2; ++b)
#pragma unroll
                for (int m = 0; m < 4; ++m)
#pragma unroll
                    for (int n = 0; n < 2; ++n) acc[a][b][m][n] = (f32x4){0.f, 0.f, 0.f, 0.f};
        cur = nxt; cA = nA; cB = nB; ++ui;
    }
    PG8_WAIT_V(0);
    if (wr == 0) PG8_BAR;
    PG8_BAR;
    if constexpr (Epi::AFTER_DRAIN) { E.fused(acc, cur, wr, wc, fr, fq, lds, wid, lane); S.done(cur); }
    PG8_STAMP();
    if (STAMP && wid == 0) { stamps[lane] = lane < nts ? (((unsigned long long)(unsigned)ts_hi << 32) | (unsigned)ts_lo) : 0ull;
        if (lane == 62) stamps[62] = rt_entry; if (lane == 63) stamps[63] = (unsigned long long)wall_clock64(); }
#undef PG8_STAMP
#undef PG8_SA
#undef PG8_SB
#undef PG8_STAGE
#undef PG8_LDA
#undef PG8_LDB
#undef PG8_MMA
#undef PG8_WAIT_V
#undef PG8_WAIT_L
#undef PG8_BAR
#undef PG8_SCHED
}
}
#define XB_TMO      128
#define XB_XCNT(j)  (256  + 64 * (j))
#define XB_XSUB(j)  (1280 + 64 * (j))
#define XB_XGEN(j)  (2304 + 64 * (j))
#define XB_TOP      3328
#define XB_TOPGEN   3392
#define XCD_BAR_WORDS 3456
#define XB_SPIN_CAP (1u << 23)
#define LAS __attribute__((address_space(3)))

__device__ __forceinline__ unsigned xb_ld(unsigned* p)              { return __hip_atomic_load(p, __ATOMIC_RELAXED, __HIP_MEMORY_SCOPE_AGENT); }
__device__ __forceinline__ unsigned xb_add(unsigned* p, unsigned v) { return __hip_atomic_fetch_add(p, v, __ATOMIC_RELAXED, __HIP_MEMORY_SCOPE_AGENT); }
__device__ __forceinline__ unsigned xb_xcc_id() { return (unsigned)__builtin_amdgcn_s_getreg((3 << 11) | 20) & 0xFu; }
#define XB_SPIN(cond, bar) do { unsigned _sp = 0; while (cond) { __builtin_amdgcn_s_sleep(1); \
    if ((++_sp & 255u) == 0u) { if (xb_ld(&(bar)[XB_TMO])) break; if (_sp > XB_SPIN_CAP) { atomicAdd(&(bar)[XB_TMO], 1u); break; } } } } while (0)

struct XcdBarrier {
    unsigned* bar; unsigned x;
    volatile LAS unsigned* st;
};

__device__ __forceinline__ XcdBarrier xcd_barrier_post(unsigned* bar, volatile LAS unsigned* st) {
    XcdBarrier b; b.bar = bar; b.x = xb_xcc_id(); b.st = st;
    if (threadIdx.x == 0) (void)xb_add(&bar[XB_XCNT(b.x)], 1u);
    return b;
}
__device__ __forceinline__ void xcd_barrier_complete(unsigned* bar, unsigned x, unsigned& nloc, unsigned& nx) {
    const unsigned G = gridDim.x * gridDim.y * gridDim.z;
    unsigned sum, cnt, mine, sp = 0u;
    for (;;) {
        sum = 0u; cnt = 0u; mine = 0u;
#pragma unroll
        for (unsigned j = 0; j < 16; ++j) { const unsigned c = xb_ld(&bar[XB_XCNT(j)]); sum += c; cnt += (c > 0u) ? 1u : 0u; mine = (j == x) ? c : mine; }
        if (sum == G) break;
        __builtin_amdgcn_s_sleep(1);
        if ((++sp & 255u) == 0u) { if (xb_ld(&bar[XB_TMO])) break; if (sp > XB_SPIN_CAP) { atomicAdd(&bar[XB_TMO], 1u); break; } }
    }
    nloc = mine > 0u ? mine : 1u; nx = cnt > 0u ? cnt : 1u;
}

__device__ __forceinline__ void xcd_barrier(const XcdBarrier& b) {
    asm volatile("s_waitcnt vmcnt(0)" ::: "memory");
    __syncthreads();
    if (threadIdx.x == 0) {
        unsigned* bar = b.bar; asm volatile("" : "+s"(bar));
        __builtin_amdgcn_s_waitcnt(0);
        unsigned nloc = b.st[0], nx = b.st[1];
        if (nloc == 0u) { xcd_barrier_complete(bar, b.x, nloc, nx); b.st[0] = nloc; b.st[1] = nx; }
        const unsigned old = xb_add(&bar[XB_XSUB(b.x)], 1u);
        const unsigned gen = old / nloc;
        if (old + 1u == (gen + 1u) * nloc) {
            __builtin_amdgcn_fence(__ATOMIC_RELEASE, "agent");
            asm volatile("s_waitcnt vmcnt(0)" ::: "memory");
            const unsigned og = xb_add(&bar[XB_TOP], 1u);
            const unsigned tg = og / nx;
            if (og + 1u == (tg + 1u) * nx) xb_add(&bar[XB_TOPGEN], 1u);
            else XB_SPIN(xb_ld(&bar[XB_TOPGEN]) == tg, bar);
            __builtin_amdgcn_fence(__ATOMIC_ACQUIRE, "agent");
            xb_add(&bar[XB_XGEN(b.x)], 1u);
            asm volatile("s_waitcnt vmcnt(0)" ::: "memory");
        } else {
            XB_SPIN(xb_ld(&bar[XB_XGEN(b.x)]) == gen, bar);
            __builtin_amdgcn_fence(__ATOMIC_ACQUIRE, "agent");
            asm volatile("s_waitcnt vmcnt(0)" ::: "memory");
        }
    }
    __syncthreads();
}
#define GAS __attribute__((address_space(1)))
typedef unsigned short bf16;
typedef float f32x4 __attribute__((ext_vector_type(4)));
typedef unsigned u32x4 __attribute__((ext_vector_type(4)));
typedef unsigned u32x2 __attribute__((ext_vector_type(2)));
typedef LAS float lfloat;
typedef LAS f32x4 lf32x4;

constexpr int DM = 4096, NB = 4, NMETA = 16, LT = 4112, TT = NB * LT  , MP = 16640  ;
constexpr int PN = 11008;
constexpr int C_R = 0, C_K = 1536, C_V = 3072, C_WL = 4608, C_SQ = 4864, C_SK = 6400, C_SV = 6592, C_HQ = 6912, C_HF = 7936, C_HI = 8960, C_HG = 9984;
constexpr int NE = 16384;
constexpr int NHR = 24;
constexpr int NCH = 66;

constexpr size_t MiB = 1ull << 20;
constexpr size_t WS_CTL = 0, WS_WIN = 2 * MiB, WS_WO = 88 * MiB, WS_WS = 120 * MiB, WS_U = 136 * MiB  , WS_VT = 200 * MiB  , WS_HN8 = 264 * MiB  , WS_H = 392 * MiB, WS_Z = 652 * MiB, WS_R = 782 * MiB;
constexpr size_t WS_PROJ = WS_R, WS_RA = 1132 * MiB, WS_RG = 1711 * MiB, WS_RY = 1760 * MiB, WS_HDS = 1809 * MiB, WS_HQG = 1875 * MiB, WS_HAT = 1908 * MiB, WS_HED = 1941 * MiB, WS_END = 1975 * MiB;
constexpr size_t WS_CHB = 1943 * MiB;
constexpr size_t WS_ME = 1 * MiB + 832 * 1024;
constexpr size_t WS_HM = WS_ME + 64 * 1024;
constexpr size_t WS_LW = 1 * MiB;
constexpr size_t WS_GG = WS_R, WS_SC = 1302 * MiB, WS_HG8 = 1432 * MiB  ;
constexpr size_t WS_BM = 1700 * MiB;
static_assert(WS_WIN + (size_t)PN * DM * 2 <= WS_WO && WS_WO + (size_t)DM * DM * 2 <= WS_WS && WS_WS + (size_t)2048 * DM * 2 <= WS_U && WS_U + (size_t)NE * DM <= WS_VT && WS_VT + (size_t)NE * DM <= WS_HN8 && WS_HN8 + (size_t)MP * DM <= WS_H, "ws map 1");
static_assert(WS_H + (size_t)MP * DM * 4 <= WS_Z && WS_Z + (size_t)MP * DM * 2 <= WS_R, "ws map 2");
static_assert(WS_PROJ + (size_t)MP * PN * 2 <= WS_RA && WS_RA + (size_t)96 * LT * 384 * 4 <= WS_RG && WS_RG + (size_t)TT * 1536 * 2 <= WS_RY && WS_RY + (size_t)TT * 1536 * 2 <= WS_HDS, "ws map 3");
static_assert(WS_HDS + (size_t)32 * NCH * 16384 * 2 <= WS_HQG && WS_HQG + (size_t)32 * NCH * 8192 * 2 <= WS_HAT && WS_HAT + (size_t)32 * NCH * 4096 * 4 <= WS_HED && WS_HED + (size_t)32 * NCH * 128 * 4 <= WS_END, "ws map 4");
static_assert(WS_GG + (size_t)MP * NE * 2 <= WS_SC && WS_SC + (size_t)MP * 2048 * 4 <= WS_HG8 && WS_HG8 + (size_t)MP * NE <= WS_BM && WS_BM + (size_t)16384 * 64 * 4 <= WS_END, "ws map 5");

constexpr int LDS_BYTES = 147456;
constexpr int LDS_MISC = 143360;
constexpr int CW_BAR = 4096;
constexpr int CW_HL = 8192 + 128;
constexpr int CW_M2 = 8192 + 512;
constexpr int CW_HG = 8192;
constexpr size_t CTL_ZERO_BYTES = 64 * 1024;

__device__ __forceinline__ float bf2f(unsigned b) { return __uint_as_float(b << 16); }
typedef __bf16 bf16x2_t __attribute__((ext_vector_type(2)));
typedef float f32x2_t __attribute__((ext_vector_type(2)));
__device__ __forceinline__ unsigned pk2(float lo, float hi) { const f32x2_t v = {lo, hi}; const bf16x2_t r = __builtin_convertvector(v, bf16x2_t); return __builtin_bit_cast(unsigned, r); }
__device__ __forceinline__ unsigned f2bf(float f) { return pk2(f, 0.0f) & 0xffffu; }
__device__ __forceinline__ unsigned pk4_fp8(float a, float b, float c, float d) {
    a = __builtin_amdgcn_fmed3f(a, -448.f, 448.f); b = __builtin_amdgcn_fmed3f(b, -448.f, 448.f); c = __builtin_amdgcn_fmed3f(c, -448.f, 448.f); d = __builtin_amdgcn_fmed3f(d, -448.f, 448.f);
    int v = __builtin_amdgcn_cvt_pk_fp8_f32(a, b, 0, false); v = __builtin_amdgcn_cvt_pk_fp8_f32(c, d, v, true); return (unsigned)v;
}
constexpr float U8_SCALE = 64.f, V8_SCALE = 8.f, HG8_SCALE = 64.f;
constexpr int U8_E8M0 = 0x79797979  , V8_E8M0 = 0x76767676  ;
constexpr float MX8_SCALE = 8.f, WO8_SCALE = 128.f; constexpr int WO8_E8M0 = 0x75757575  ;
constexpr size_t WS_MX8 = WS_HN8  , WS_WO8 = 332 * MiB  ;
constexpr size_t WS_U1 = 1976 * MiB  , WS_END2 = 2040 * MiB;
static_assert(WS_END <= WS_U1 && WS_U1 + (size_t)NE * DM <= WS_END2, "ws map 7");
static_assert(WS_HN8 + (size_t)MP * DM <= WS_WO8 && WS_WO8 + (size_t)DM * DM <= WS_H, "ws map 6");
__device__ __forceinline__ unsigned char fp8_1(float a) { a = __builtin_amdgcn_fmed3f(a, -448.f, 448.f); return (unsigned char)(__builtin_amdgcn_cvt_pk_fp8_f32(a, 0.f, 0, false) & 0xff); }
#define LDS_WAIT() asm volatile("s_waitcnt lgkmcnt(0)" ::: "memory")
__device__ __forceinline__ float wave_sum(float v) {
#pragma unroll
    for (int o = 1; o < 64; o <<= 1) v += __shfl_xor(v, o);
    return v;
}
template <int CTRL> __device__ __forceinline__ float dpp_mov(float x) { return __int_as_float(__builtin_amdgcn_update_dpp(0, __float_as_int(x), CTRL, 0xF, 0xF, false)); }
__device__ __forceinline__ float rowsum16(float x) {
    x += dpp_mov<0xB1>(x); x += dpp_mov<0x4E>(x); x += dpp_mov<0x141>(x); x += dpp_mov<0x140>(x); return x;
}
__device__ __forceinline__ void rope_sc(float pos, int j, float& sn, float& cs) {
    const float ang = pos * exp2f(-(float)j * 2.3664460711655218f);
    float rev = ang * 0.15915494309189535f; rev = rev - floorf(rev);
    sn = __builtin_amdgcn_sinf(rev); cs = __builtin_amdgcn_cosf(rev);
}
__device__ __forceinline__ float sigmoidf_(float x) { return 1.0f / (1.0f + __expf(-x)); }

__device__ __forceinline__ int ltid() { int t = threadIdx.x; asm volatile("" : "+v"(t)); return t; }
__device__ __forceinline__ int ROWOF(int b, int t) { return t >= NMETA ? b * 4096 + (t - NMETA) : 16384 + b * NMETA + t; }
constexpr int MAIN_ROWS = 16384;
struct Ctx {
    const float* in[25];
    float* out;
    unsigned char* ws;
    int ph_lo, ph_hi;
};
typedef const __attribute__((address_space(4))) Ctx CtxK;
__device__ __forceinline__ Ctx load_ctx() { CtxK* p = (CtxK*)__builtin_amdgcn_kernarg_segment_ptr(); asm volatile("" : "+s"(p)); Ctx c;
#pragma unroll
    for (int i = 0; i < 25; ++i) c.in[i] = p->in[i];
    c.out = p->out; c.ws = p->ws; c.ph_lo = p->ph_lo; c.ph_hi = p->ph_hi; return c; }
#define LOAD_CTX() const Ctx C = load_ctx()
__device__ __forceinline__ int uni_launder(int x) { int y = __builtin_amdgcn_readfirstlane(x); asm volatile("" : "+s"(y)); return y; }
#define UNI(x) uni_launder(x)
#define UNI_LDS(p) ((LAS unsigned char*)(uintptr_t)(unsigned)__builtin_amdgcn_readfirstlane((int)(unsigned)(uintptr_t)(p)))
enum { I_X = 0, I_META, I_NMIX, I_NFFN, I_NFIN, I_WIN, I_WOUT, I_MU, I_W0, I_W2, I_A0, I_A2, I_G2, I_KK, I_KA, I_RK, I_LNW, I_LNB, I_SINK, I_HLB, I_HNORM, I_WQ, I_KEYS, I_PU, I_PV };

namespace pg8 {
struct EpiResF32 {
    static constexpr bool PERM = false, AFTER_DRAIN = false;
    float* H; int ldc; const float* Src;
    __device__ __forceinline__ void operator()(const f32x4 (&acc)[2][2][4][2], const Unit& u, int wr, int wc, int fr, int fq) const {
        const int row0 = u.pm * BM + wr * 64 + fr, col0 = u.pn * BM + wc * 32 + 4 * fq;
#pragma unroll
        for (int ai = 0; ai < 2; ++ai)
#pragma unroll
            for (int m = 0; m < 4; ++m) { float* rowp = H + (size_t)(row0 + ai * HALF + m * 16) * ldc + col0; const float* srcp = Src + (size_t)(row0 + ai * HALF + m * 16) * ldc + col0;
                f32x4 old[2][2];
#pragma unroll
                for (int bj = 0; bj < 2; ++bj)
#pragma unroll
                    for (int n = 0; n < 2; ++n) old[bj][n] = *(const f32x4*)(srcp + bj * HALF + n * 16);
#pragma unroll
                for (int bj = 0; bj < 2; ++bj)
#pragma unroll
                    for (int n = 0; n < 2; ++n) *(f32x4*)(rowp + bj * HALF + n * 16) = old[bj][n] + acc[ai][bj][m][n]; }
    }
};
struct EpiGate8 {
    static constexpr bool PERM = true, AFTER_DRAIN = false;
    unsigned char* wsb;
    __device__ __forceinline__ void operator()(const f32x4 (&acc)[2][2][4][2], const Unit& u, int wr, int wc, int fr_, int fq_) const {
        (void)fr_; (void)fq_; int ln = (int)__builtin_amdgcn_workitem_id_x() & 63; asm volatile("" : "+v"(ln)); const int fr = ln & 15, fq = ln >> 4;
        const bf16_t* G = (const bf16_t*)(wsb + WS_GG); unsigned char* Hg = wsb + WS_HG8; const unsigned* Bm = (const unsigned*)(wsb + WS_BM); constexpr int ldc = NE;
        const int row0 = u.pm * BM + wr * 64 + fr, col0 = u.pn * BM + wc * 32 + 8 * fq;
#pragma unroll
        for (int ai = 0; ai < 2; ++ai)
#pragma unroll
            for (int m = 0; m < 4; ++m) { const size_t ro = (size_t)(row0 + ai * HALF + m * 16) * ldc + col0;
                const unsigned bits = Bm[(size_t)(row0 + ai * HALF + m * 16) * 64 + u.pn];
#pragma unroll
                for (int bj = 0; bj < 2; ++bj) {
                    u32x2 w = (u32x2){0u, 0u};
                    if ((bits >> (16 * bj + 4 * wc + fq)) & 1u) {
                        const u32x4 g = *(const u32x4*)(G + ro + bj * HALF);
                        const f32x4 v0 = acc[ai][bj][m][0], v1 = acc[ai][bj][m][1];
                        const f32x2 a = gelu_pk((f32x2){v0[0], v0[1]}), b = gelu_pk((f32x2){v0[2], v0[3]}), c = gelu_pk((f32x2){v1[0], v1[1]}), d = gelu_pk((f32x2){v1[2], v1[3]});
                        w.x = pk4_fp8(64.f * a.x * __uint_as_float(g.x << 16), 64.f * a.y * __uint_as_float(g.x & 0xffff0000u), 64.f * b.x * __uint_as_float(g.y << 16), 64.f * b.y * __uint_as_float(g.y & 0xffff0000u));
                        w.y = pk4_fp8(64.f * c.x * __uint_as_float(g.z << 16), 64.f * c.y * __uint_as_float(g.z & 0xffff0000u), 64.f * d.x * __uint_as_float(g.w << 16), 64.f * d.y * __uint_as_float(g.w & 0xffff0000u));
                    }
                    *(u32x2*)(Hg + ro + bj * HALF) = w;
                }
                __builtin_amdgcn_sched_barrier(0); }
    }
};
}

__device__ __forceinline__ void tr_load_tile(const float* W, int N, int k0, int n0, lfloat* scr, int lane) {
    const int q = lane & 15, r = lane >> 4;
    f32x4 v[16];
#pragma unroll
    for (int i = 0; i < 16; ++i) v[i] = *(const f32x4*)(W + (size_t)(k0 + r + 4 * i) * N + n0 + 4 * q);
#pragma unroll
    for (int i = 0; i < 16; ++i) { lfloat* d = scr + (r + 4 * i) * 65 + 4 * q; d[0] = v[i].x; d[1] = v[i].y; d[2] = v[i].z; d[3] = v[i].w; }
    LDS_WAIT();
}
__device__ __forceinline__ void transpose_item(const float* W, int N, bf16* WT, int Kp, int k0, int n0, int dst_row0, lfloat* scr, int lane) {
    tr_load_tile(W, N, k0, n0, scr, lane);
    const int c = lane & 7, nn = lane >> 3;
#pragma unroll
    for (int p = 0; p < 8; ++p) { const int n = 8 * p + nn; const lfloat* s = scr + (8 * c) * 65 + n;
        u32x4 o; o.x = pk2(s[0 * 65], s[1 * 65]); o.y = pk2(s[2 * 65], s[3 * 65]); o.z = pk2(s[4 * 65], s[5 * 65]); o.w = pk2(s[6 * 65], s[7 * 65]);
        *(u32x4*)(WT + (size_t)(dst_row0 + n) * Kp + k0 + 8 * c) = o; }
    LDS_WAIT();
}
__device__ __forceinline__ void transpose_item8(const float* W, int N, unsigned char* WT, int Kp, int k0, int n0, float sc, lfloat* scr, int lane) {
    tr_load_tile(W, N, k0, n0, scr, lane);
    const int c = lane & 3, nn = lane >> 2;
#pragma unroll
    for (int p = 0; p < 4; ++p) { const int n = 16 * p + nn; const lfloat* s = scr + (16 * c) * 65 + n;
        u32x4 o; o.x = pk4_fp8(s[0 * 65] * sc, s[1 * 65] * sc, s[2 * 65] * sc, s[3 * 65] * sc); o.y = pk4_fp8(s[4 * 65] * sc, s[5 * 65] * sc, s[6 * 65] * sc, s[7 * 65] * sc);
        o.z = pk4_fp8(s[8 * 65] * sc, s[9 * 65] * sc, s[10 * 65] * sc, s[11 * 65] * sc); o.w = pk4_fp8(s[12 * 65] * sc, s[13 * 65] * sc, s[14 * 65] * sc, s[15 * 65] * sc);
        *(u32x4*)(WT + (size_t)(n0 + n) * Kp + k0 + 16 * c) = o; }
    LDS_WAIT();
}
__device__ __forceinline__ void norm_row(const float* src, const float* gain, bf16* dst, float* hdst, int lane, unsigned char* dst8 = nullptr) {
    const f32x4* xr = (const f32x4*)src + lane;
    f32x4 v[16]; float ss = 0.f;
#pragma unroll
    for (int j = 0; j < 16; ++j) { v[j] = xr[64 * j]; ss += (v[j].x * v[j].x + v[j].y * v[j].y) + (v[j].z * v[j].z + v[j].w * v[j].w); }
    ss = wave_sum(ss);
    const float r = rsqrtf(ss * (1.0f / 4096.0f) + 1e-5f);
    const f32x4* gr = (const f32x4*)gain + lane;
    u32x2* o8 = (u32x2*)dst + lane;
#pragma unroll
    for (int j = 0; j < 16; ++j) { const f32x4 g = gr[64 * j]; const f32x4 y = (f32x4){v[j].x * r * g.x, v[j].y * r * g.y, v[j].z * r * g.z, v[j].w * r * g.w};
        u32x2 o; o.x = pk2(y.x, y.y); o.y = pk2(y.z, y.w); o8[64 * j] = o;
        if (dst8) ((unsigned*)dst8)[lane + 64 * j] = pk4_fp8(y.x, y.y, y.z, y.w); }
    if (hdst) { f32x4* hr = (f32x4*)hdst + lane;
#pragma unroll
        for (int j = 0; j < 16; ++j) hr[64 * j] = v[j]; }
}

#define ROW_LOAD16(v_, p_) do { const f32x4* xr_ = (const f32x4*)(p_) + lane; _Pragma("unroll") for (int j_ = 0; j_ < 16; ++j_) v_[j_] = xr_[64 * j_]; } while (0)
__device__ __forceinline__ void norm_row_fin(const f32x4 (&v)[16], const f32x4 (&gn)[16], bf16* dst, float* hdst, int lane, unsigned char* dst8) {
    float ss = 0.f;
#pragma unroll
    for (int j = 0; j < 16; ++j) ss += (v[j].x * v[j].x + v[j].y * v[j].y) + (v[j].z * v[j].z + v[j].w * v[j].w);
    ss = wave_sum(ss);
    const float r = rsqrtf(ss * (1.0f / 4096.0f) + 1e-5f);
    u32x2* o8 = (u32x2*)dst + lane;
#pragma unroll
    for (int j = 0; j < 16; ++j) { const f32x4 g = gn[j]; const f32x4 y = (f32x4){v[j].x * r * g.x, v[j].y * r * g.y, v[j].z * r * g.z, v[j].w * r * g.w};
        u32x2 o; o.x = pk2(y.x, y.y); o.y = pk2(y.z, y.w); o8[64 * j] = o;
        if (dst8) ((unsigned*)dst8)[lane + 64 * j] = pk4_fp8(y.x, y.y, y.z, y.w); }
    if (hdst) { f32x4* hr = (f32x4*)hdst + lane;
#pragma unroll
        for (int j = 0; j < 16; ++j) hr[64 * j] = v[j]; }
}
template <class SrcOf, class Fin>
__device__ __forceinline__ void rows_pipe(int first, int stride, int n, int lane, SrcOf src_of, Fin fin) {
    f32x4 va[16], vb[16];
    int m = first;
    if (m < n) ROW_LOAD16(va, src_of(m));
    while (m < n) {
        const int m2 = m + stride;
        if (m2 < n) ROW_LOAD16(vb, src_of(m2));
        fin(va, m);
        if (m2 >= n) break;
        const int m3 = m2 + stride;
        if (m3 < n) ROW_LOAD16(va, src_of(m3));
        fin(vb, m2);
        m = m3;
    }
}

__device__ __forceinline__ void u8_item(const float* pu, unsigned char* U8, int r, int lane) {
    const size_t e0 = (size_t)r * 8192;
#pragma unroll 2
    for (int j = 0; j < 8; ++j) { const size_t e = e0 + (size_t)(j * 64 + lane) * 16;
        const f32x4 a = *(const f32x4*)(pu + e), b2 = *(const f32x4*)(pu + e + 4), c2 = *(const f32x4*)(pu + e + 8), d2 = *(const f32x4*)(pu + e + 12);
        u32x4 o; o.x = pk4_fp8(a.x * U8_SCALE, a.y * U8_SCALE, a.z * U8_SCALE, a.w * U8_SCALE); o.y = pk4_fp8(b2.x * U8_SCALE, b2.y * U8_SCALE, b2.z * U8_SCALE, b2.w * U8_SCALE);
        o.z = pk4_fp8(c2.x * U8_SCALE, c2.y * U8_SCALE, c2.z * U8_SCALE, c2.w * U8_SCALE); o.w = pk4_fp8(d2.x * U8_SCALE, d2.y * U8_SCALE, d2.z * U8_SCALE, d2.w * U8_SCALE);
        *(u32x4*)(U8 + e) = o; }
}
__device__ __forceinline__ void win_item(const float* w_in, bf16* WinT, int r, lfloat* scr, int lane) {
    if (r < 64 * 170) { const int kb = r / 170, nb = r % 170, n0 = 64 * nb; transpose_item(w_in, 10880, WinT, DM, 64 * kb, n0, n0 < 6784 ? n0 : n0 + 128, scr, lane); return; }
    u32x4* z = (u32x4*)(WinT + (size_t)6784 * DM) + (size_t)(r - 64 * 170) * 1024 + lane;
#pragma unroll
    for (int j = 0; j < 16; ++j) z[64 * j] = (u32x4){0u, 0u, 0u, 0u};
}
constexpr int EX_U_T = 512, EX_W_T = (64 * 170 + 64) / 8, EX_TICKETS = EX_U_T + EX_W_T;
__device__ __forceinline__ void early_conv_ticket(int x_, LAS unsigned char* lds_) {
    LOAD_CTX(); const int x = UNI(x_); LAS unsigned char* lds = UNI_LDS(lds_);
    const int tid = ltid(), lane = tid & 63, wave = UNI(tid >> 6);
    if (x < EX_U_T) { const float* pu1 = C.in[I_PU] + (size_t)NE * DM;
        u8_item(pu1, C.ws + WS_U1, 16 * x + 2 * wave, lane); u8_item(pu1, C.ws + WS_U1, 16 * x + 2 * wave + 1, lane); return; }
    win_item(C.in[I_WIN] + (size_t)DM * 10880, (bf16*)(C.ws + WS_WIN), 8 * (x - EX_U_T) + wave, (lfloat*)(lds + wave * 16896), lane);
}

__device__ __forceinline__ void phase_conv_norm(int l_, LAS unsigned char* lds_) {
    LOAD_CTX(); const int l = UNI(l_); LAS unsigned char* lds = UNI_LDS(lds_);
    const int tid = ltid(), lane = tid & 63, wave = tid >> 6;
    const int gw = blockIdx.x * 8 + wave, NGW = gridDim.x * 8;
    unsigned char* ws = C.ws;
    bf16* WinT = (bf16*)(ws + WS_WIN); bf16* WoT = (bf16*)(ws + WS_WO); bf16* WsT = (bf16*)(ws + WS_WS); unsigned char* U8 = ws + WS_U; unsigned char* VT8 = ws + WS_VT;
    float* H = (float*)(ws + WS_H); bf16* Z = (bf16*)(ws + WS_Z);
    const float* w_in = C.in[I_WIN] + (size_t)l * DM * 10880;
    const float* w_out = C.in[I_WOUT] + (size_t)l * DM * DM;
    const float* wq = C.in[I_WQ] + (size_t)l * DM * 2048;
    const float* keys = C.in[I_KEYS] + (size_t)l * 16 * 128 * 128;
    const float* pu = C.in[I_PU] + (size_t)l * NE * DM;
    const float* pv = C.in[I_PV] + (size_t)l * NE * DM;
    lfloat* scr = (lfloat*)(lds + wave * 16896);
    const bool early = (l == 1 && gridDim.x == 256);
    constexpr int I_WIN_N = 64 * 170, I_WO_N = 64 * 64, I_VT_N = 256 * 64, I_U_N = 8192, I_ZW_N = 64, I_NORM_N = TT, I_ZP_N = MP - TT;
    constexpr int NITEMS = I_WIN_N + I_WO_N + I_VT_N + I_U_N + I_ZW_N + I_NORM_N + I_ZP_N;
    {
        const int gwu = UNI(gw);
        f32x4 gn[16]; { const f32x4* gr = (const f32x4*)(C.in[I_NMIX] + (l == 0 ? 0 : DM)) + lane;
#pragma unroll
            for (int j = 0; j < 16; ++j) gn[j] = gr[64 * j]; }
        rows_pipe(gwu, NGW, I_NORM_N, lane,
            [&](int m) -> const float* { if (l != 0) return H + (size_t)m * DM;
                const int b = m < MAIN_ROWS ? (m >> 12) : ((m - MAIN_ROWS) >> 4), t = m < MAIN_ROWS ? (m & 4095) + NMETA : ((m - MAIN_ROWS) & 15);
                return (t < NMETA) ? C.in[I_META] + (size_t)t * DM : C.in[I_X] + ((size_t)b * 4096 + (t - NMETA)) * DM; },
            [&](const f32x4 (&v)[16], int m) { norm_row_fin(v, gn, Z + (size_t)m * DM, (l == 0 && m >= MAIN_ROWS) ? H + (size_t)m * DM : nullptr, lane, nullptr); });
    }
    int it0 = gw; while (it0 < I_NORM_N) it0 += NGW;
    for (int it = it0; it < NITEMS; it += NGW) {
        int r = it;
        r -= I_NORM_N;
        if (r < I_ZP_N) {
            const int m = TT + r; u32x4* z = (u32x4*)(Z + (size_t)m * DM) + lane;
#pragma unroll
            for (int j = 0; j < 8; ++j) z[64 * j] = (u32x4){0u, 0u, 0u, 0u};
            if (l == 0) { f32x4* hz = (f32x4*)(H + (size_t)m * DM) + lane;
#pragma unroll
                for (int j = 0; j < 16; ++j) hz[64 * j] = (f32x4){0.f, 0.f, 0.f, 0.f}; }
            continue; }
        r -= I_ZP_N;
        if (r < I_WIN_N) { if (!early) win_item(w_in, WinT, r, scr, lane); continue; }
        r -= I_WIN_N;
        if (r < I_WO_N) { const int kb = r / 64, nb = r % 64; transpose_item8(w_out, DM, ws + WS_WO8, DM, 64 * kb, 64 * nb, WO8_SCALE, scr, lane);
            if (l == 0) transpose_item(w_out, DM, WoT, DM, 64 * kb, 64 * nb, 64 * nb, scr, lane);
            continue; }
        r -= I_WO_N;
        if (r < I_VT_N) { const int kb = r / 64, nb = r % 64; transpose_item8(pv, DM, VT8, NE, 64 * kb, 64 * nb, V8_SCALE, scr, lane); continue; }
        r -= I_VT_N;
        if (r < I_U_N) { if (!early) u8_item(pu, U8, r, lane); continue; }
        r -= I_U_N;
        if (!early) win_item(w_in, WinT, 64 * 170 + r, scr, lane);
    }
    {
        bf16* LW = (bf16*)(ws + WS_LW);
        const float* w2 = C.in[I_W2] + (size_t)l * 64 * 1536; const float* a2 = C.in[I_A2] + (size_t)l * 64 * 1536; const float* g2 = C.in[I_G2] + (size_t)l * 128 * 1536;
        for (int e = blockIdx.x * 512 + tid; e < 256 * 1536; e += gridDim.x * 512) { const int k = e / 1536, n = e - k * 1536;
            const float v = k < 64 ? w2[k * 1536 + n] : (k < 128 ? a2[(k - 64) * 1536 + n] : g2[(k - 128) * 1536 + n]);
            LW[n * 256 + k] = (bf16)f2bf(v); }
    }
    {
        const int wv = UNI(tid >> 6), fr = lane & 15, g4 = lane >> 4;
        for (int u = blockIdx.x; u < 1024; u += gridDim.x) {
            const int hc = u >> 6, k0 = (u & 63) * 64;
            const float* kp_ = keys + (size_t)hc * 16384 + (size_t)(16 * wv + fr) * 128 + 8 * g4;
            pg8::bf16x8 Af[4];
#pragma unroll
            for (int ks = 0; ks < 4; ++ks) { const f32x4 x = *(const f32x4*)(kp_ + 32 * ks), y = *(const f32x4*)(kp_ + 32 * ks + 4);
                const u32x4 wq_ = (u32x4){pk2(x.x, x.y), pk2(x.z, x.w), pk2(y.x, y.y), pk2(y.z, y.w)}; Af[ks] = (pg8::bf16x8)wq_; }
#pragma unroll
            for (int nt = 0; nt < 4; ++nt) {
                const float* wp = wq + (size_t)(k0 + 16 * nt + fr) * 2048 + hc * 128 + 8 * g4;
                f32x4 d = (f32x4){0.f, 0.f, 0.f, 0.f};
#pragma unroll
                for (int ks = 0; ks < 4; ++ks) { const f32x4 x = *(const f32x4*)(wp + 32 * ks), y = *(const f32x4*)(wp + 32 * ks + 4);
                    const u32x4 bw = (u32x4){pk2(x.x, x.y), pk2(x.z, x.w), pk2(y.x, y.y), pk2(y.z, y.w)};
                    d = __builtin_amdgcn_mfma_f32_16x16x32_bf16(Af[ks], (pg8::bf16x8)bw, d, 0, 0, 0); }
#pragma unroll
                for (int r = 0; r < 4; ++r) WsT[(size_t)(hc * 128 + 16 * wv + 4 * g4 + r) * DM + k0 + 16 * nt + fr] = (bf16)f2bf(d[r]);
            }
        }
    }
}

__device__ __forceinline__ void swa_unit(int l_, int u_, LAS unsigned char* lds_) {
    LOAD_CTX(); const int l = UNI(l_), u = UNI(u_); LAS unsigned char* lds = UNI_LDS(lds_);
    const int tid = ltid(), lane = tid & 63, wave = UNI(tid >> 6);
    const int qtile = u % 129, hk = (u / 129) % 3, b = u / 387;
    const int t0 = qtile * 32, lo = t0 - 127;
    const bf16* proj = (const bf16*)(C.ws + WS_PROJ);
    bf16* mixed = (bf16*)(C.ws + WS_Z);
    LAS bf16* Ks = (LAS bf16*)lds;
    LAS bf16* Vt = (LAS bf16*)(lds + 27648);
    LAS bf16* Qs = (LAS bf16*)(lds + 53248);
    __syncthreads();
#define SWA_ROPE8(dst, x, y, pos, first) do { _Pragma("unroll") for (int j_ = 0; j_ < 8; ++j_) { float sn_, cs_; rope_sc((float)(pos), j_, sn_, cs_); dst[j_] = (first) ? x[j_] * cs_ - y[j_] * sn_ : x[j_] * cs_ + y[j_] * sn_; } } while (0)
#define SWA_UNPK(dst, vec_) do { dst[0] = bf2f(vec_.x & 0xffffu); dst[1] = bf2f(vec_.x >> 16); dst[2] = bf2f(vec_.y & 0xffffu); dst[3] = bf2f(vec_.y >> 16); dst[4] = bf2f(vec_.z & 0xffffu); dst[5] = bf2f(vec_.z >> 16); dst[6] = bf2f(vec_.w & 0xffffu); dst[7] = bf2f(vec_.w >> 16); } while (0)
#pragma unroll
    for (int i = 0; i < 3; ++i) {
        const int task = tid + 512 * i, s = task >> 3, c = task & 7;
        const int ut = s < 16 ? s : lo + s - 16;
        const bool ok = (s < 16) || (s < 176 && ut >= 16 && ut < LT);
        u32x4 w = (u32x4){0u, 0u, 0u, 0u};
        if (ok) { const bf16* pr = proj + (size_t)ROWOF(b, ut) * PN + C_SK + hk * 64;
            w = *(const u32x4*)(pr + 8 * c);
            if (c < 2) { const u32x4 wo = *(const u32x4*)(pr + 8 * (c ^ 1)); float x[8], y[8], z[8]; SWA_UNPK(x, w); SWA_UNPK(y, wo); SWA_ROPE8(z, x, y, ut, c == 0);
                w.x = pk2(z[0], z[1]); w.y = pk2(z[2], z[3]); w.z = pk2(z[4], z[5]); w.w = pk2(z[6], z[7]); } }
        *(LAS u32x4*)(Ks + s * 72 + 8 * c) = w;
    }
#pragma unroll
    for (int i = 0; i < 3; ++i) {
        const int task = tid + 512 * i, s = task >> 3, c = task & 7;
        const int ut = s < 16 ? s : lo + s - 16;
        const bool ok = (s < 16) || (s < 176 && ut >= 16 && ut < LT);
        u32x4 w = (u32x4){0u, 0u, 0u, 0u};
        if (ok) w = *(const u32x4*)(proj + (size_t)ROWOF(b, ut) * PN + C_SV + hk * 64 + 8 * c);
        LAS bf16* vp = Vt + (8 * c) * 200 + s;
        vp[0] = (bf16)(w.x & 0xffffu); vp[200] = (bf16)(w.x >> 16); vp[400] = (bf16)(w.y & 0xffffu); vp[600] = (bf16)(w.y >> 16);
        vp[800] = (bf16)(w.z & 0xffffu); vp[1000] = (bf16)(w.z >> 16); vp[1200] = (bf16)(w.w & 0xffffu); vp[1400] = (bf16)(w.w >> 16);
    }
#pragma unroll
    for (int i = 0; i < 4; ++i) {
        const int task = tid + 512 * i, row = task >> 3, c = task & 7, g = row >> 5, t = t0 + (row & 31);
        u32x4 w = (u32x4){0u, 0u, 0u, 0u};
        if (t < LT) { const bf16* qp = proj + (size_t)ROWOF(b, t) * PN + C_SQ + (hk * 8 + g) * 64;
            w = *(const u32x4*)(qp + 8 * c);
            float x[8], z[8]; SWA_UNPK(x, w);
            if (c < 2) { const u32x4 wo = *(const u32x4*)(qp + 8 * (c ^ 1)); float y[8]; SWA_UNPK(y, wo); SWA_ROPE8(z, x, y, t, c == 0); }
            else {
#pragma unroll
                for (int j = 0; j < 8; ++j) z[j] = x[j]; }
            w.x = pk2(z[0] * 0.125f, z[1] * 0.125f); w.y = pk2(z[2] * 0.125f, z[3] * 0.125f); w.z = pk2(z[4] * 0.125f, z[5] * 0.125f); w.w = pk2(z[6] * 0.125f, z[7] * 0.125f); }
        *(LAS u32x4*)(Qs + row * 72 + 8 * c) = w;
    }
#undef SWA_ROPE8
#undef SWA_UNPK
    __syncthreads();
    const int fr = lane & 15, g4 = lane >> 4;
    const int hq = hk * 8 + wave;
    const float sink = C.in[I_SINK][l * 24 + hq];
    pg8::bf16x8 Qf[2][2];
#pragma unroll
    for (int qt = 0; qt < 2; ++qt)
#pragma unroll
        for (int ks = 0; ks < 2; ++ks) Qf[qt][ks] = *(const LAS pg8::bf16x8*)(Qs + (wave * 32 + 16 * qt + fr) * 72 + 32 * ks + 8 * g4);
    f32x4 sc[12][2];
#pragma unroll
    for (int kt = 0; kt < 12; ++kt) {
        const pg8::bf16x8 k0 = *(const LAS pg8::bf16x8*)(Ks + (16 * kt + fr) * 72 + 8 * g4), k1 = *(const LAS pg8::bf16x8*)(Ks + (16 * kt + fr) * 72 + 32 + 8 * g4);
#pragma unroll
        for (int qt = 0; qt < 2; ++qt) { f32x4 a = (f32x4){0.f, 0.f, 0.f, 0.f};
            a = __builtin_amdgcn_mfma_f32_16x16x32_bf16(k0, Qf[qt][0], a, 0, 0, 0); a = __builtin_amdgcn_mfma_f32_16x16x32_bf16(k1, Qf[qt][1], a, 0, 0, 0); sc[kt][qt] = a; }
    }
    float inv[2];
    pg8::bf16x8 Pf[2][6];
#pragma unroll
    for (int qt = 0; qt < 2; ++qt) {
        const int t = t0 + 16 * qt + fr; const bool tv = t < LT;
        float m = sink;
#pragma unroll
        for (int kt = 0; kt < 12; ++kt)
#pragma unroll
            for (int r = 0; r < 4; ++r) { const int s = 16 * kt + 4 * g4 + r; const int uu = lo + s - 16;
                const bool ok = tv && (kt == 0 ? (s <= t) : (uu >= 16 && uu <= t && uu >= t - 127));
                const float v = ok ? sc[kt][qt][r] : -1.0e30f; sc[kt][qt][r] = v; m = fmaxf(m, v); }
        m = fmaxf(m, __shfl_xor(m, 16)); m = fmaxf(m, __shfl_xor(m, 32));
        float ls = 0.f;
#pragma unroll
        for (int kt = 0; kt < 12; ++kt)
#pragma unroll
            for (int r = 0; r < 4; ++r) { const float p = __expf(sc[kt][qt][r] - m); sc[kt][qt][r] = p; ls += p; }
        ls += __shfl_xor(ls, 16); ls += __shfl_xor(ls, 32);
        ls += __expf(sink - m);
        inv[qt] = 1.0f / ls;
#pragma unroll
        for (int s2 = 0; s2 < 6; ++s2) { const f32x4 pa = sc[2 * s2][qt], pb = sc[2 * s2 + 1][qt];
            u32x4 w; w.x = pk2(pa[0], pa[1]); w.y = pk2(pa[2], pa[3]); w.z = pk2(pb[0], pb[1]); w.w = pk2(pb[2], pb[3]);
            Pf[qt][s2] = (pg8::bf16x8)w; }
    }
    f32x4 o[4][2];
#pragma unroll
    for (int dt = 0; dt < 4; ++dt) { o[dt][0] = (f32x4){0.f, 0.f, 0.f, 0.f}; o[dt][1] = (f32x4){0.f, 0.f, 0.f, 0.f}; }
#pragma unroll
    for (int dt = 0; dt < 4; ++dt)
#pragma unroll
        for (int s2 = 0; s2 < 6; ++s2) {
            const u32x2 va = *(const LAS u32x2*)(Vt + (16 * dt + fr) * 200 + 32 * s2 + 4 * g4), vb = *(const LAS u32x2*)(Vt + (16 * dt + fr) * 200 + 32 * s2 + 16 + 4 * g4);
            const u32x4 vw = (u32x4){va.x, va.y, vb.x, vb.y};
            const pg8::bf16x8 vf = (pg8::bf16x8)vw;
            o[dt][0] = __builtin_amdgcn_mfma_f32_16x16x32_bf16(vf, Pf[0][s2], o[dt][0], 0, 0, 0);
            o[dt][1] = __builtin_amdgcn_mfma_f32_16x16x32_bf16(vf, Pf[1][s2], o[dt][1], 0, 0, 0);
        }
#pragma unroll
    for (int qt = 0; qt < 2; ++qt) { const int t = t0 + 16 * qt + fr;
        if (t < LT) { bf16* op = mixed + (size_t)ROWOF(b, t) * DM + 1536 + hq * 64 + 4 * g4;
#pragma unroll
            for (int dt = 0; dt < 4; ++dt) { const f32x4 v = o[dt][qt] * inv[qt]; if (t < NMETA) { u32x2 w; w.x = pk2(v[0], v[1]); w.y = pk2(v[2], v[3]); *(u32x2*)(op + 16 * dt) = w; }
                *(unsigned*)(C.ws + WS_MX8 + (size_t)ROWOF(b, t) * DM + 1536 + hq * 64 + 4 * g4 + 16 * dt) = pk4_fp8(v[0] * MX8_SCALE, v[1] * MX8_SCALE, v[2] * MX8_SCALE, v[3] * MX8_SCALE); } }
    }
}

__device__ __forceinline__ void hgrn_local_unit(int l_, int u_, LAS unsigned char* lds_) {
    LOAD_CTX(); const int l = UNI(l_), u = UNI(u_); LAS unsigned char* lds = UNI_LDS(lds_);
    const int tid = ltid(), lane = tid & 63, wave = UNI(tid >> 6);
    const int bh = u / 65, c = u % 65 + 1, b = bh >> 3, h = bh & 7;
    const bf16* proj = (const bf16*)(C.ws + WS_PROJ);
    bf16* HDS = (bf16*)(C.ws + WS_HDS); bf16* HQG = (bf16*)(C.ws + WS_HQG); float* HAT = (float*)(C.ws + WS_HAT); float* HED = (float*)(C.ws + WS_HED);
    lfloat* qs = (lfloat*)lds; lfloat* kvs = qs + 8192; lfloat* Gs = qs + 16384;
    LAS bf16* iT = (LAS bf16*)(lds + 98304);
    LAS unsigned char* shr = lds + 116736;
    lfloat* segtot = (lfloat*)shr; LAS bf16* QK = (LAS bf16*)shr; LAS bf16* kdT = (LAS bf16*)shr;
    const int k = tid & 127, seg = tid >> 7;
    const int fr = lane & 15, g4 = lane >> 4;
    float lb = 0.f;
    if (l == 1) { const float a0 = C.in[I_HLB][h * 128 + k], a1 = C.in[I_HLB][1024 + h * 128 + k]; lb = 1.0f / (1.0f + __expf(a0 - a1)); }
    __syncthreads();
    float gl[16]; float run = 0.f;
#pragma unroll
    for (int r = 0; r < 16; ++r) {
        const int tl = 16 * seg + r, t = 64 * c + tl - 112;
        float qv = 0.f, kv = 0.f, lf = 0.f; unsigned ib = 0u;
        if (t >= 0 && t < LT) { const bf16* pr = proj + (size_t)ROWOF(b, t) * PN + h * 128 + k;
            qv = bf2f(pr[C_HQ]); const float frw = bf2f(pr[C_HF]); ib = pr[C_HI];
            const float f = lb + (1.0f - lb) * sigmoidf_(frw); lf = __logf(f); kv = 1.0f - f; }
        run += lf; gl[r] = run;
        qs[tl * 128 + k] = qv; kvs[tl * 128 + k] = kv; iT[k * 72 + tl] = (bf16)ib;
    }
    segtot[seg * 128 + k] = run;
    __syncthreads();
    float off = 0.f;
    for (int s2 = 0; s2 < seg; ++s2) off += segtot[s2 * 128 + k];
#pragma unroll
    for (int r = 0; r < 16; ++r) Gs[(16 * seg + r) * 128 + k] = gl[r] + off;
    __syncthreads();
    const size_t uc = (size_t)bh * NCH + c;
    float* at = HAT + uc * 4096;
    for (int e = tid; e < 4096; e += 512) { const int t_ = e >> 6, s_ = e & 63; if (s_ > t_) at[e] = 0.f; }
    if (tid < 480) {
        const int blk = tid / 120, q = tid - blk * 120;
        int tt = (int)((1.0f + sqrtf(1.0f + 8.0f * (float)q)) * 0.5f);
        if (tt * (tt - 1) / 2 > q) --tt; if ((tt + 1) * tt / 2 <= q) ++tt;
        const int ss = q - tt * (tt - 1) / 2, t_ = 16 * blk + tt, s_ = 16 * blk + ss;
        float acc = 0.f;
        for (int kk = 0; kk < 128; ++kk) { const int k2 = (kk + lane) & 127;
            acc += qs[t_ * 128 + k2] * kvs[s_ * 128 + k2] * __expf(Gs[t_ * 128 + k2] - Gs[s_ * 128 + k2]); }
        at[t_ * 64 + s_] = acc;
    }
    if (tid >= 448) {
        const int t_ = tid - 448; float acc = 0.f;
        for (int kk = 0; kk < 128; ++kk) { const int k2 = (kk + lane) & 127; acc += qs[t_ * 128 + k2] * kvs[t_ * 128 + k2]; }
        at[t_ * 64 + t_] = acc;
    }
#pragma unroll 1
    for (int pass = 0; pass < 2; ++pass) {
        __syncthreads();
#pragma unroll 4
        for (int i = 0; i < 16; ++i) { const int e = tid + 512 * i, row = e >> 7, kx = e & 127;
            int src, ref; bool isq = row < 32;
            if (pass == 0) { src = isq ? 32 + row : row - 32; ref = 31; }
            else { const int r16 = row & 15, hi = (row >> 4) & 1; src = isq ? (hi ? 48 + r16 : 16 + r16) : (hi ? 32 + r16 : r16); ref = hi ? 47 : 15; }
            const float gr = Gs[ref * 128 + kx], gs_ = Gs[src * 128 + kx];
            const float v = isq ? qs[src * 128 + kx] * __expf(gs_ - gr) : kvs[src * 128 + kx] * __expf(gr - gs_);
            QK[row * 136 + kx] = (bf16)f2bf(v); }
        __syncthreads();
        const int ntile = pass == 0 ? 4 : 2;
        if (wave < ntile) {
            const int qrow = pass == 0 ? 16 * (wave >> 1) : 16 * wave, krow = pass == 0 ? 32 + 16 * (wave & 1) : 32 + 16 * wave;
            const int I = pass == 0 ? 2 + (wave >> 1) : (wave == 0 ? 1 : 3), J = pass == 0 ? (wave & 1) : (wave == 0 ? 0 : 2);
            f32x4 d = (f32x4){0.f, 0.f, 0.f, 0.f};
#pragma unroll
            for (int ks = 0; ks < 4; ++ks) { const pg8::bf16x8 a = *(const LAS pg8::bf16x8*)(QK + (qrow + fr) * 136 + 32 * ks + 8 * g4), bb = *(const LAS pg8::bf16x8*)(QK + (krow + fr) * 136 + 32 * ks + 8 * g4);
                d = __builtin_amdgcn_mfma_f32_16x16x32_bf16(a, bb, d, 0, 0, 0); }
#pragma unroll
            for (int r = 0; r < 4; ++r) at[(16 * I + 4 * g4 + r) * 64 + 16 * J + fr] = d[r];
        }
    }
    __syncthreads();
    for (int e = tid; e < 8192; e += 512) { const int s_ = e >> 7, kx = e & 127; const float ge = Gs[e];
        HQG[uc * 8192 + e] = (bf16)f2bf(qs[e] * __expf(ge));
        kdT[kx * 72 + s_] = (bf16)f2bf(kvs[e] * __expf(Gs[63 * 128 + kx] - ge)); }
    if (tid < 128) HED[uc * 128 + tid] = __expf(Gs[63 * 128 + tid]);
    __syncthreads();
    {
        const pg8::bf16x8 a0 = *(const LAS pg8::bf16x8*)(kdT + (16 * wave + fr) * 72 + 8 * g4), a1 = *(const LAS pg8::bf16x8*)(kdT + (16 * wave + fr) * 72 + 32 + 8 * g4);
        f32x4 dd[8];
#pragma unroll
        for (int nt = 0; nt < 8; ++nt) {
            const pg8::bf16x8 b0 = *(const LAS pg8::bf16x8*)(iT + (8 * fr + nt) * 72 + 8 * g4), b1 = *(const LAS pg8::bf16x8*)(iT + (8 * fr + nt) * 72 + 32 + 8 * g4);
            f32x4 d = (f32x4){0.f, 0.f, 0.f, 0.f};
            d = __builtin_amdgcn_mfma_f32_16x16x32_bf16(a0, b0, d, 0, 0, 0); d = __builtin_amdgcn_mfma_f32_16x16x32_bf16(a1, b1, d, 0, 0, 0);
            dd[nt] = d;
        }
#pragma unroll
        for (int r = 0; r < 4; ++r) { u32x4 w; w.x = pk2(dd[0][r], dd[1][r]); w.y = pk2(dd[2][r], dd[3][r]); w.z = pk2(dd[4][r], dd[5][r]); w.w = pk2(dd[6][r], dd[7][r]);
            *(u32x4*)(HDS + (uc * 128 + 16 * wave + 4 * g4 + r) * 128 + 8 * fr) = w; }
    }
}

__device__ __forceinline__ void rwkv_chunk_prep(const Ctx& C, int bh, int c, int lane, LAS unsigned char* wl) {
    float* RAc = (float*)(C.ws + WS_RA) + ((size_t)bh * LT + 16 * c) * 384;
    unsigned char* chb = C.ws + WS_CHB + ((size_t)bh * 257 + c) * 1280;
    LAS bf16* AbS = (LAS bf16*)(wl + 4608); LAS bf16* RbS = AbS + 16 * 72; LAS bf16* BtS = RbS + 16 * 72; LAS bf16* KtS = BtS + 16 * 72;
    float kk[16], w[16], ka[16], kp[16], rr[16], vv[16];
#pragma unroll
    for (int i = 0; i < 16; ++i) { const float* p = RAc + i * 384 + lane; kk[i] = p[0]; w[i] = p[64]; ka[i] = p[128]; kp[i] = p[192]; rr[i] = p[256]; vv[i] = p[320]; }
    float g = 1.0f; float bp[16], kq[16];
#pragma unroll
    for (int i = 0; i < 16; ++i) { const float gprev = g; g *= w[i]; const float ig = 1.0f / g;
        const float ab = -kk[i] * gprev, rb = rr[i] * g, bt = ka[i] * ig, kt = kp[i] * ig;
        AbS[i * 72 + lane] = (bf16)f2bf(ab); RbS[i * 72 + lane] = (bf16)f2bf(rb); BtS[i * 72 + lane] = (bf16)f2bf(bt); KtS[i * 72 + lane] = (bf16)f2bf(kt);
        bp[i] = bt; kq[i] = kt;
        unsigned short* rec = (unsigned short*)(RAc + i * 384);
        rec[lane] = (unsigned short)f2bf(ab); rec[64 + lane] = (unsigned short)f2bf(rb); }
    const float gC = g;
    {
        u32x4 o0, o1, q0, q1;
        o0.x = pk2(bp[0] * gC, bp[1] * gC); o0.y = pk2(bp[2] * gC, bp[3] * gC); o0.z = pk2(bp[4] * gC, bp[5] * gC); o0.w = pk2(bp[6] * gC, bp[7] * gC);
        o1.x = pk2(bp[8] * gC, bp[9] * gC); o1.y = pk2(bp[10] * gC, bp[11] * gC); o1.z = pk2(bp[12] * gC, bp[13] * gC); o1.w = pk2(bp[14] * gC, bp[15] * gC);
        q0.x = pk2(kq[0] * gC, kq[1] * gC); q0.y = pk2(kq[2] * gC, kq[3] * gC); q0.z = pk2(kq[4] * gC, kq[5] * gC); q0.w = pk2(kq[6] * gC, kq[7] * gC);
        q1.x = pk2(kq[8] * gC, kq[9] * gC); q1.y = pk2(kq[10] * gC, kq[11] * gC); q1.z = pk2(kq[12] * gC, kq[13] * gC); q1.w = pk2(kq[14] * gC, kq[15] * gC);
        unsigned char* rb_ = (unsigned char*)(RAc + (lane >> 3) * 384) + 512 + (lane & 7) * 32;
        *(u32x4*)rb_ = o0; *(u32x4*)(rb_ + 16) = o1;
        unsigned char* rk_ = (unsigned char*)(RAc + (8 + (lane >> 3)) * 384) + 512 + (lane & 7) * 32;
        *(u32x4*)rk_ = q0; *(u32x4*)(rk_ + 16) = q1;
        ((float*)(chb + 1024))[lane] = gC;
    }
    LDS_WAIT();
    const int fr = lane & 15, g4 = lane >> 4;
    lfloat* AabM = (lfloat*)wl; lfloat* AakM = AabM + 16 * 17; lfloat* BrkM = AakM + 16 * 17; lfloat* TM = BrkM + 16 * 17;
    {
        const pg8::bf16x8 a0 = *(const LAS pg8::bf16x8*)(AbS + fr * 72 + 8 * g4), a1 = *(const LAS pg8::bf16x8*)(AbS + fr * 72 + 32 + 8 * g4);
        const pg8::bf16x8 r0 = *(const LAS pg8::bf16x8*)(RbS + fr * 72 + 8 * g4), r1 = *(const LAS pg8::bf16x8*)(RbS + fr * 72 + 32 + 8 * g4);
        const pg8::bf16x8 b0 = *(const LAS pg8::bf16x8*)(BtS + fr * 72 + 8 * g4), b1 = *(const LAS pg8::bf16x8*)(BtS + fr * 72 + 32 + 8 * g4);
        const pg8::bf16x8 k0 = *(const LAS pg8::bf16x8*)(KtS + fr * 72 + 8 * g4), k1 = *(const LAS pg8::bf16x8*)(KtS + fr * 72 + 32 + 8 * g4);
        const f32x4 z = (f32x4){0.f, 0.f, 0.f, 0.f};
        f32x4 aab = __builtin_amdgcn_mfma_f32_16x16x32_bf16(a0, b0, z, 0, 0, 0); aab = __builtin_amdgcn_mfma_f32_16x16x32_bf16(a1, b1, aab, 0, 0, 0);
        f32x4 aak = __builtin_amdgcn_mfma_f32_16x16x32_bf16(a0, k0, z, 0, 0, 0); aak = __builtin_amdgcn_mfma_f32_16x16x32_bf16(a1, k1, aak, 0, 0, 0);
        f32x4 brb = __builtin_amdgcn_mfma_f32_16x16x32_bf16(r0, b0, z, 0, 0, 0); brb = __builtin_amdgcn_mfma_f32_16x16x32_bf16(r1, b1, brb, 0, 0, 0);
        f32x4 brk = __builtin_amdgcn_mfma_f32_16x16x32_bf16(r0, k0, z, 0, 0, 0); brk = __builtin_amdgcn_mfma_f32_16x16x32_bf16(r1, k1, brk, 0, 0, 0);
#pragma unroll
        for (int r = 0; r < 4; ++r) { const int t = 4 * g4 + r, s = fr;
            AabM[t * 17 + s] = s < t ? aab[r] : 0.f; AakM[t * 17 + s] = s < t ? aak[r] : 0.f; BrkM[t * 17 + s] = s <= t ? brk[r] : 0.f;
            *(unsigned short*)(chb + 512 + t * 32 + s * 2) = (unsigned short)f2bf(s <= t ? brb[r] : 0.f); }
    }
    const int t_ = lane >> 2, s0 = 4 * (lane & 3);
    LDS_WAIT();
    if (lane < 16) {
        float tc[16];
#pragma unroll
        for (int t = 0; t < 16; ++t) { float acc = (t == lane) ? 1.0f : 0.0f;
#pragma unroll
            for (int s = 0; s < t; ++s) acc += AabM[t * 17 + s] * tc[s];
            tc[t] = acc; TM[t * 17 + lane] = acc; }
    }
    LDS_WAIT();
    { u32x2 wv; wv.x = pk2(TM[t_ * 17 + s0], TM[t_ * 17 + s0 + 1]); wv.y = pk2(TM[t_ * 17 + s0 + 2], TM[t_ * 17 + s0 + 3]); *(u32x2*)(chb + t_ * 32 + s0 * 2) = wv; }
#pragma unroll
    for (int t = 0; t < 16; ++t) { float p1 = 0.f, p2 = 0.f;
#pragma unroll
        for (int s = 0; s <= t; ++s) { if (s < t) p1 += AakM[t * 17 + s] * vv[s]; p2 += BrkM[t * 17 + s] * vv[s]; }
        unsigned short* rec = (unsigned short*)(RAc + t * 384);
        rec[128 + lane] = (unsigned short)f2bf(p1); rec[192 + lane] = (unsigned short)f2bf(p2); }
    LDS_WAIT();
}

__device__ __forceinline__ void rwkv_prep_unit(int l_, int u_, LAS unsigned char* lds_) {
    LOAD_CTX(); const int l = UNI(l_), u = UNI(u_); LAS unsigned char* lds = UNI_LDS(lds_);
    const int tid = ltid(), lane = tid & 63, wave = UNI(tid >> 6);
    const int b = u / 257, t0 = (u % 257) * 16;
    const bf16* proj = (const bf16*)(C.ws + WS_PROJ);
    float* RA = (float*)(C.ws + WS_RA); bf16* RG = (bf16*)(C.ws + WS_RG);
    const bf16* LW = (const bf16*)(C.ws + WS_LW);
    const float* mu = C.in[I_MU] + l * 4864;
    LAS bf16* featb = (LAS bf16*)lds;
    const size_t row0 = (size_t)ROWOF(b, t0), rowp = (size_t)ROWOF(b, t0 > 0 ? t0 - 1 : 0);
    __syncthreads();
#pragma unroll
    for (int j = 0; j < 8; ++j) { const int e = tid + 512 * j, tok = e >> 8, f = e & 255, t = t0 + tok; const size_t m = row0 + tok;
        const float cur = bf2f(proj[m * PN + C_WL + f]); const float prev = t > 0 ? bf2f(proj[(tok > 0 ? m - 1 : rowp) * PN + C_WL + f]) : 0.f;
        const float xs = cur + (prev - cur) * mu[C_WL + f];
        featb[tok * 264 + f] = (bf16)f2bf(f < 64 ? tanhf(xs) : (f < 128 ? xs : sigmoidf_(xs))); }
    __syncthreads();
    const int fr = lane & 15, kc = lane >> 4;
    pg8::bf16x8 Af[8];
#pragma unroll
    for (int ks = 0; ks < 8; ++ks) Af[ks] = *(const LAS pg8::bf16x8*)(featb + fr * 264 + 32 * ks + 8 * kc);
#pragma unroll 1
    for (int hh = 0; hh < 3; ++hh) {
        const int ch0 = 192 * wave + 64 * hh, h = ch0 >> 6;
        f32x4 aw[4], aa[4], ag[4];
#pragma unroll
        for (int nt = 0; nt < 4; ++nt) {
            const bf16* bp = LW + (size_t)(ch0 + 4 * fr + nt) * 256 + 8 * kc;
            pg8::bf16x8 Bf[8];
#pragma unroll
            for (int ks = 0; ks < 8; ++ks) Bf[ks] = *(const pg8::bf16x8*)(bp + 32 * ks);
            f32x4 z = (f32x4){0.f, 0.f, 0.f, 0.f};
            aw[nt] = __builtin_amdgcn_mfma_f32_16x16x32_bf16(Af[0], Bf[0], z, 0, 0, 0); aw[nt] = __builtin_amdgcn_mfma_f32_16x16x32_bf16(Af[1], Bf[1], aw[nt], 0, 0, 0);
            aa[nt] = __builtin_amdgcn_mfma_f32_16x16x32_bf16(Af[2], Bf[2], z, 0, 0, 0); aa[nt] = __builtin_amdgcn_mfma_f32_16x16x32_bf16(Af[3], Bf[3], aa[nt], 0, 0, 0);
            ag[nt] = __builtin_amdgcn_mfma_f32_16x16x32_bf16(Af[4], Bf[4], z, 0, 0, 0); ag[nt] = __builtin_amdgcn_mfma_f32_16x16x32_bf16(Af[5], Bf[5], ag[nt], 0, 0, 0);
            ag[nt] = __builtin_amdgcn_mfma_f32_16x16x32_bf16(Af[6], Bf[6], ag[nt], 0, 0, 0); ag[nt] = __builtin_amdgcn_mfma_f32_16x16x32_bf16(Af[7], Bf[7], ag[nt], 0, 0, 0);
        }
        const int cb = ch0 + 4 * fr;
        const f32x4 mur = *(const f32x4*)(mu + C_R + cb), muk = *(const f32x4*)(mu + C_K + cb), muv = *(const f32x4*)(mu + C_V + cb);
        const f32x4 w0c = *(const f32x4*)(C.in[I_W0] + l * 1536 + cb), a0c = *(const f32x4*)(C.in[I_A0] + l * 1536 + cb), kkc = *(const f32x4*)(C.in[I_KK] + l * 1536 + cb), kac = *(const f32x4*)(C.in[I_KA] + l * 1536 + cb);
        f32x4 pr, pk, pv;
#define PREP_LD4(dst, p_) do { const u32x2 w_ = *(const u32x2*)(p_); dst = (f32x4){bf2f(w_.x & 0xffffu), bf2f(w_.x >> 16), bf2f(w_.y & 0xffffu), bf2f(w_.y >> 16)}; } while (0)
        {
            const bool has = (kc > 0) || (t0 > 0);
            const bf16* pp = proj + (kc > 0 ? row0 + 4 * kc - 1 : rowp) * PN + cb;
            const f32x4 z4 = (f32x4){0.f, 0.f, 0.f, 0.f};
            if (has) { PREP_LD4(pr, pp + C_R); PREP_LD4(pk, pp + C_K); PREP_LD4(pv, pp + C_V); } else { pr = z4; pk = z4; pv = z4; }
        }
#pragma unroll
        for (int r = 0; r < 4; ++r) {
            const int tok = 4 * kc + r, t = t0 + tok;
            const bf16* pc = proj + (row0 + tok) * PN + cb;
            f32x4 cr, ck, cv; PREP_LD4(cr, pc + C_R); PREP_LD4(ck, pc + C_K); PREP_LD4(cv, pc + C_V);
            const f32x4 xr = cr + (pr - cr) * mur, xk = ck + (pk - ck) * muk, xv = cv + (pv - cv) * muv;
            pr = cr; pk = ck; pv = cv;
            const f32x4 kkr = xk * kkc;
            float ss = (kkr[0] * kkr[0] + kkr[1] * kkr[1]) + (kkr[2] * kkr[2] + kkr[3] * kkr[3]);
            ss = rowsum16(ss);
            const float rn = 1.0f / fmaxf(sqrtf(ss), 1e-12f);
            f32x4 dec, av, gv4;
#pragma unroll
            for (int nt = 0; nt < 4; ++nt) {
                const float x = -(w0c[nt] + aw[nt][r]);
                const float sp = fmaxf(x, 0.f) + __logf(1.0f + __expf(-fabsf(x)));
                dec[nt] = __expf(-__expf(-sp - 0.5f)); av[nt] = sigmoidf_(a0c[nt] + aa[nt][r]); gv4[nt] = ag[nt][r]; }
            const f32x4 kkn = kkr * rn;
            float* ra = RA + ((size_t)(b * NHR + h) * LT + t) * 384 + 4 * fr;
            *(f32x4*)(ra) = kkn; *(f32x4*)(ra + 64) = dec; *(f32x4*)(ra + 128) = kkn * av; *(f32x4*)(ra + 192) = xk * ((av - 1.0f) * kac + 1.0f); *(f32x4*)(ra + 256) = xr; *(f32x4*)(ra + 320) = xv;
            u32x2 gw; gw.x = pk2(gv4[0], gv4[1]); gw.y = pk2(gv4[2], gv4[3]);
            *(u32x2*)(RG + ((size_t)b * LT + t) * 1536 + cb) = gw;
        }
#undef PREP_LD4
    }
    asm volatile("s_waitcnt vmcnt(0)" ::: "memory"); __syncthreads();
#pragma unroll 1
    for (int hh = 0; hh < 3; ++hh) rwkv_chunk_prep(C, b * NHR + 3 * wave + hh, t0 >> 4, lane, lds + wave * 16640);
}

__device__ __forceinline__ pg8::bf16x8 pack8(const f32x4 a, const f32x4 b2) { u32x4 w; w.x = pk2(a[0], a[1]); w.y = pk2(a[2], a[3]); w.z = pk2(b2[0], b2[1]); w.w = pk2(b2[2], b2[3]); return (pg8::bf16x8)w; }
__device__ __forceinline__ pg8::bf16x8 ld8x2(const void* p0, const void* p1) { const u32x2 a = *(const u32x2*)p0, b2 = *(const u32x2*)p1; const u32x4 w = (u32x4){a.x, a.y, b2.x, b2.y}; return (pg8::bf16x8)w; }
__device__ __forceinline__ pg8::bf16x8 lds8x2(const LAS unsigned char* p0, const LAS unsigned char* p1) { const u32x2 a = *(const LAS u32x2*)p0, b2 = *(const LAS u32x2*)p1; const u32x4 w = (u32x4){a.x, a.y, b2.x, b2.y}; return (pg8::bf16x8)w; }
__device__ __forceinline__ void rwkv_scan_unit(int unit_, LAS unsigned char* lds_) {
    LOAD_CTX(); const int unit = UNI(unit_); LAS unsigned char* lds = UNI_LDS(lds_);
    const int tid = ltid(), lane = tid & 63, wave = UNI(tid >> 6);
    const int hsel = wave >> 2, bh = 2 * unit + hsel, vt = wave & 3, b = bh / NHR, h = bh % NHR;
    const int fr = lane & 15, g4 = lane >> 4, hl = tid & 255;
    const unsigned char* RAb = (const unsigned char*)((const float*)(C.ws + WS_RA) + (size_t)bh * LT * 384);
    const unsigned char* CHB = C.ws + WS_CHB + (size_t)bh * 257 * 1280;
    bf16* RY = (bf16*)(C.ws + WS_RY);
    constexpr int RS = 1040, SLOT = 16 * RS + 1280;
    LAS unsigned char* ring = lds + hsel * 4 * SLOT;
    const f32x4 zero4 = (f32x4){0.f, 0.f, 0.f, 0.f};
    f32x4 acc[4] = {zero4, zero4, zero4, zero4};
    u32x4 ga[5], gb[5];
#define CS_G(dst, c_) do { const unsigned char* rec = RAb + (size_t)(16 * (c_)) * 1536; const unsigned char* side = CHB + (c_) * 1280; \
        _Pragma("unroll") for (int i = 0; i < 5; ++i) { const int p = hl + 256 * i, rr = p >> 6, q = p & 63; \
            const unsigned char* src = p < 1024 ? rec + (size_t)rr * 1536 + (q < 48 ? 16 * q : 1280 + 16 * (q - 48)) : side + 16 * (p - 1024); \
            dst[i] = ((c_) < 257 && p < 1104) ? *(const u32x4*)src : (u32x4){0u, 0u, 0u, 0u}; } } while (0)
#define CS_S(src_, c_) do { LAS unsigned char* sl = ring + ((c_) & 3) * SLOT; \
        _Pragma("unroll") for (int i = 0; i < 5; ++i) { const int p = hl + 256 * i, rr = p >> 6, q = p & 63; \
            if (p < 1104) *(LAS u32x4*)(p < 1024 ? sl + rr * RS + 16 * q : sl + 16 * RS + 16 * (p - 1024)) = src_[i]; } } while (0)
#define CS_COMPUTE(c_) do { const LAS unsigned char* sl = ring + ((c_) & 3) * SLOT; const LAS unsigned char* rt = sl + fr * RS; const LAS unsigned char* side = sl + 16 * RS; \
        const pg8::bf16x8 Ab0 = lds8x2(rt + 8 * g4, rt + 32 + 8 * g4), Ab1 = lds8x2(rt + 64 + 8 * g4, rt + 96 + 8 * g4), Rb0 = lds8x2(rt + 128 + 8 * g4, rt + 160 + 8 * g4), Rb1 = lds8x2(rt + 192 + 8 * g4, rt + 224 + 8 * g4); \
        f32x4 P1, P2, Vd; \
        _Pragma("unroll") for (int r = 0; r < 4; ++r) { const LAS unsigned char* rr_ = sl + (4 * g4 + r) * RS; const int v = 16 * vt + fr; \
            P1[r] = bf2f(((const LAS unsigned short*)(rr_ + 256))[v]); P2[r] = bf2f(((const LAS unsigned short*)(rr_ + 384))[v]); Vd[r] = ((const LAS float*)(rr_ + 768))[v]; } \
        const u32x2 tw = *(const LAS u32x2*)(side + fr * 32 + 8 * g4), bw = *(const LAS u32x2*)(side + 512 + fr * 32 + 8 * g4); \
        const pg8::bf16x8 Tf = (pg8::bf16x8)((u32x4){tw.x, tw.y, 0u, 0u}), Bf = (pg8::bf16x8)((u32x4){bw.x, bw.y, 0u, 0u}); \
        const LAS unsigned char* pb = sl + (fr >> 3) * RS + 512 + (fr & 7) * 32 + 8 * g4; \
        const pg8::bf16x8 M0 = lds8x2(pb, pb + 8 * RS), M1 = lds8x2(pb + 2 * RS, pb + 10 * RS), M2 = lds8x2(pb + 4 * RS, pb + 12 * RS), M3 = lds8x2(pb + 6 * RS, pb + 14 * RS); \
        const f32x4 g0 = *(const LAS f32x4*)(side + 1024 + (4 * g4) * 4), g1 = *(const LAS f32x4*)(side + 1024 + (16 + 4 * g4) * 4), g2 = *(const LAS f32x4*)(side + 1024 + (32 + 4 * g4) * 4), g3 = *(const LAS f32x4*)(side + 1024 + (48 + 4 * g4) * 4); \
        const pg8::bf16x8 sB0 = pack8(acc[0], acc[1]), sB1 = pack8(acc[2], acc[3]); \
        f32x4 Wd = __builtin_amdgcn_mfma_f32_16x16x32_bf16(Ab0, sB0, zero4, 0, 0, 0); Wd = __builtin_amdgcn_mfma_f32_16x16x32_bf16(Ab1, sB1, Wd, 0, 0, 0); \
        f32x4 Yd = __builtin_amdgcn_mfma_f32_16x16x32_bf16(Rb0, sB0, P2, 0, 0, 0); Yd = __builtin_amdgcn_mfma_f32_16x16x32_bf16(Rb1, sB1, Yd, 0, 0, 0); \
        const f32x4 Ud = __builtin_amdgcn_mfma_f32_16x16x32_bf16(Tf, pack8(Wd + P1, zero4), zero4, 0, 0, 0); \
        Yd = __builtin_amdgcn_mfma_f32_16x16x32_bf16(Bf, pack8(Ud, zero4), Yd, 0, 0, 0); \
        const pg8::bf16x8 zB = pack8(Ud, Vd); \
        acc[0] = __builtin_amdgcn_mfma_f32_16x16x32_bf16(M0, zB, acc[0] * g0, 0, 0, 0); acc[1] = __builtin_amdgcn_mfma_f32_16x16x32_bf16(M1, zB, acc[1] * g1, 0, 0, 0); \
        acc[2] = __builtin_amdgcn_mfma_f32_16x16x32_bf16(M2, zB, acc[2] * g2, 0, 0, 0); acc[3] = __builtin_amdgcn_mfma_f32_16x16x32_bf16(M3, zB, acc[3] * g3, 0, 0, 0); \
        _Pragma("unroll") for (int r = 0; r < 4; ++r) RY[((size_t)b * LT + 16 * (c_) + 4 * g4 + r) * 1536 + h * 64 + 16 * vt + fr] = (bf16)f2bf(Yd[r]); } while (0)
    __syncthreads();
    CS_G(ga, 0); CS_G(gb, 1);
    CS_S(ga, 0); CS_S(gb, 1);
    CS_G(gb, 2);
    __syncthreads();
#pragma unroll 1
    for (int c = 0; c < 257; c += 2) {
        CS_G(ga, c + 3);
        CS_COMPUTE(c);
        CS_S(gb, c + 2);
        __syncthreads();
        if (c + 1 < 257) {
            CS_G(gb, c + 4);
            CS_COMPUTE(c + 1);
            CS_S(ga, c + 3);
            __syncthreads();
        }
    }
#undef CS_G
#undef CS_S
#undef CS_COMPUTE
}
__device__ __forceinline__ void hgrn_scan_slice(int sl_) {
    LOAD_CTX(); const int sl = UNI(sl_);
    const int tid = ltid();
    bf16* HDS = (bf16*)(C.ws + WS_HDS); const float* HED = (const float*)(C.ws + WS_HED);
    float S[4][4];
#pragma unroll
    for (int q = 0; q < 4; ++q) { S[q][0] = 0.f; S[q][1] = 0.f; S[q][2] = 0.f; S[q][3] = 0.f; }
    const int e0 = sl * 8192 + tid * 4, bh = e0 >> 14;
    for (int c = 1; c < NCH; ++c) {
        const size_t uc = (size_t)bh * NCH + c;
        u32x2 d[4]; float ed[4];
#pragma unroll
        for (int q = 0; q < 4; ++q) { const int kv = (e0 + q * 2048) & 16383; d[q] = *(const u32x2*)(HDS + uc * 16384 + kv); ed[q] = HED[uc * 128 + (kv >> 7)]; }
#pragma unroll
        for (int q = 0; q < 4; ++q) { const int kv = (e0 + q * 2048) & 16383;
            u32x2 o; o.x = pk2(S[q][0], S[q][1]); o.y = pk2(S[q][2], S[q][3]); *(u32x2*)(HDS + uc * 16384 + kv) = o;
            S[q][0] = S[q][0] * ed[q] + bf2f(d[q].x & 0xffffu); S[q][1] = S[q][1] * ed[q] + bf2f(d[q].x >> 16); S[q][2] = S[q][2] * ed[q] + bf2f(d[q].y & 0xffffu); S[q][3] = S[q][3] * ed[q] + bf2f(d[q].y >> 16); }
    }
}

__device__ __forceinline__ void rwkv_post_all(int l_) {
    LOAD_CTX(); const int l = UNI(l_);
    const int tid = ltid(), lane = tid & 63, wave = UNI(tid >> 6);
    const bf16* RY = (const bf16*)(C.ws + WS_RY); const bf16* RG = (const bf16*)(C.ws + WS_RG);
    const float* RA = (const float*)(C.ws + WS_RA);
    bf16* mixed = (bf16*)(C.ws + WS_Z);
    const float* lnw = C.in[I_LNW] + l * 1536; const float* lnb = C.in[I_LNB] + l * 1536; const float* rk = C.in[I_RK] + l * 1536;
    for (int m = blockIdx.x * 8 + wave; m < TT; m += gridDim.x * 8) {
        const int b = m / LT, t = m - b * LT;
#pragma unroll 1
        for (int hg = 0; hg < 6; ++hg) {
            float y[4], g[4], kp[4], r[4], v[4], w_[4], b_[4], k_[4];
#pragma unroll
            for (int q = 0; q < 4; ++q) { const int h = hg * 4 + q, c = h * 64 + lane;
                const float* ra = RA + ((size_t)(b * NHR + h) * LT + t) * 384 + lane;
                y[q] = bf2f(RY[(size_t)m * 1536 + c]); g[q] = bf2f(RG[(size_t)m * 1536 + c]); kp[q] = ra[192]; r[q] = ra[256]; v[q] = ra[320];
                w_[q] = lnw[c]; b_[q] = lnb[c]; k_[q] = rk[c]; }
#pragma unroll
            for (int q = 0; q < 4; ++q) { const int c = (hg * 4 + q) * 64 + lane;
                const float mean = wave_sum(y[q]) * (1.0f / 64.0f);
                const float dy = y[q] - mean;
                const float var = wave_sum(dy * dy) * (1.0f / 64.0f);
                const float yn = dy * rsqrtf(var + 64e-5f) * w_[q] + b_[q];
                const float bonus = wave_sum(r[q] * kp[q] * k_[q]) * v[q];
                const float mv = (yn + bonus) * g[q];
                if (t < NMETA) mixed[(size_t)ROWOF(b, t) * DM + c] = (bf16)f2bf(mv);
                (C.ws + WS_MX8)[(size_t)ROWOF(b, t) * DM + c] = fp8_1(mv * MX8_SCALE); }
        }
    }
}
__device__ __forceinline__ void hgrn_out_unit(int l_, int u_, LAS unsigned char* lds_) {
    LOAD_CTX(); const int l = UNI(l_), u = UNI(u_); LAS unsigned char* lds = UNI_LDS(lds_);
    const int tid = ltid(), lane = tid & 63, wave = UNI(tid >> 6);
    const int bh = u / 65, c = u % 65 + 1, b = bh >> 3, h = bh & 7;
    const bf16* proj = (const bf16*)(C.ws + WS_PROJ);
    const bf16* HDS = (const bf16*)(C.ws + WS_HDS); const bf16* HQG = (const bf16*)(C.ws + WS_HQG); const float* HAT = (const float*)(C.ws + WS_HAT);
    bf16* mixed = (bf16*)(C.ws + WS_Z);
    LAS bf16* Am = (LAS bf16*)lds;
    LAS bf16* Bt = (LAS bf16*)(lds + 25600);
    lfloat* ssum = (lfloat*)(lds + 25600 + 52224);
    const size_t uc = (size_t)bh * NCH + c;
    __syncthreads();
    for (int e = tid; e < 1024; e += 512) { const int t_ = e >> 4, s4 = 4 * (e & 15); const f32x4 a4 = *(const f32x4*)(HAT + uc * 4096 + t_ * 64 + s4);
        u32x2 w; w.x = pk2(a4[0], a4[1]); w.y = pk2(a4[2], a4[3]); *(LAS u32x2*)(Am + t_ * 200 + s4) = w; }
    for (int e = tid; e < 1024; e += 512) { const int t_ = e >> 4, ch = e & 15; *(LAS u32x4*)(Am + t_ * 200 + 64 + 8 * ch) = *(const u32x4*)(HQG + uc * 8192 + t_ * 128 + 8 * ch); }
    for (int e = tid; e < 1024; e += 512) { const int s_ = e >> 4, v8 = 8 * (e & 15), t = 64 * c + s_ - 112;
        u32x4 w = (u32x4){0u, 0u, 0u, 0u}; if (t >= 0 && t < LT) w = *(const u32x4*)(proj + (size_t)ROWOF(b, t) * PN + C_HI + h * 128 + v8);
        LAS bf16* bp_ = Bt + v8 * 204 + s_;
        bp_[0] = (bf16)(w.x & 0xffffu); bp_[204] = (bf16)(w.x >> 16); bp_[408] = (bf16)(w.y & 0xffffu); bp_[612] = (bf16)(w.y >> 16); bp_[816] = (bf16)(w.z & 0xffffu); bp_[1020] = (bf16)(w.z >> 16); bp_[1224] = (bf16)(w.w & 0xffffu); bp_[1428] = (bf16)(w.w >> 16); }
#pragma unroll
    for (int i = 0; i < 4; ++i) { const int e = tid + 512 * i, kx = e >> 4, v8 = 8 * (e & 15); const u32x4 w = *(const u32x4*)(HDS + uc * 16384 + kx * 128 + v8);
        LAS bf16* bp_ = Bt + v8 * 204 + 64 + kx;
        bp_[0] = (bf16)(w.x & 0xffffu); bp_[204] = (bf16)(w.x >> 16); bp_[408] = (bf16)(w.y & 0xffffu); bp_[612] = (bf16)(w.y >> 16); bp_[816] = (bf16)(w.z & 0xffffu); bp_[1020] = (bf16)(w.z >> 16); bp_[1224] = (bf16)(w.w & 0xffffu); bp_[1428] = (bf16)(w.w >> 16); }
    __syncthreads();
    const int fr = lane & 15, g4 = lane >> 4;
    pg8::bf16x8 Bf[6];
#pragma unroll
    for (int ks = 0; ks < 6; ++ks) { const LAS u32x2* bp = (const LAS u32x2*)(Bt + (16 * wave + fr) * 204 + 32 * ks + 8 * g4); const u32x2 lo = bp[0], hi = bp[1];
        const u32x4 w = (u32x4){lo.x, lo.y, hi.x, hi.y}; Bf[ks] = (pg8::bf16x8)w; }
    f32x4 o[4];
#pragma unroll
    for (int mt = 0; mt < 4; ++mt) { f32x4 d = (f32x4){0.f, 0.f, 0.f, 0.f};
#pragma unroll
        for (int ks = 0; ks < 6; ++ks) { const pg8::bf16x8 a = *(const LAS pg8::bf16x8*)(Am + (16 * mt + fr) * 200 + 32 * ks + 8 * g4); d = __builtin_amdgcn_mfma_f32_16x16x32_bf16(a, Bf[ks], d, 0, 0, 0); }
        o[mt] = d; }
#pragma unroll
    for (int mt = 0; mt < 4; ++mt)
#pragma unroll
        for (int r = 0; r < 4; ++r) { const float s = rowsum16(o[mt][r] * o[mt][r]); if (fr == 0) ssum[wave * 64 + 16 * mt + 4 * g4 + r] = s; }
    __syncthreads();
    const float gn = C.in[I_HNORM][l * 1024 + h * 128 + 16 * wave + fr];
#pragma unroll
    for (int mt = 0; mt < 4; ++mt)
#pragma unroll
        for (int r = 0; r < 4; ++r) { const int tl = 16 * mt + 4 * g4 + r, t = 64 * c + tl - 112;
            float ss = 0.f;
#pragma unroll
            for (int w8 = 0; w8 < 8; ++w8) ss += ssum[w8 * 64 + tl];
            if (t >= 0 && t < LT) { const size_t m = (size_t)ROWOF(b, t);
                const float gv = bf2f(proj[m * PN + C_HG + h * 128 + 16 * wave + fr]);
                const float mv = o[mt][r] * rsqrtf(ss * (1.0f / 128.0f) + 1e-5f) * gn * (gv * sigmoidf_(gv));
                if (t < NMETA) mixed[m * DM + 3072 + h * 128 + 16 * wave + fr] = (bf16)f2bf(mv);
                (C.ws + WS_MX8)[m * DM + 3072 + h * 128 + 16 * wave + fr] = fp8_1(mv * MX8_SCALE); } }
}

__device__ __forceinline__ unsigned ordkey(float v) { const unsigned b = __float_as_uint(v); return b ^ ((b >> 31) ? 0xFFFFFFFFu : 0x80000000u); }
__device__ __forceinline__ float unordkey(unsigned k) { const unsigned b = (k >> 31) ? (k ^ 0x80000000u) : ~k; return __uint_as_float(b); }
#define CE_U(a, b) do { const unsigned mx_ = (a) > (b) ? (a) : (b), mn_ = (a) > (b) ? (b) : (a); (a) = mx_; (b) = mn_; } while (0)
__device__ __forceinline__ void sort16_desc(unsigned (&k)[16]) {
#pragma unroll
    for (int size = 2; size <= 16; size <<= 1)
#pragma unroll
        for (int stride = size >> 1; stride > 0; stride >>= 1)
#pragma unroll
            for (int i = 0; i < 16; ++i) { const int j = i ^ stride; if (j > i) { if ((i & size) == 0) CE_U(k[i], k[j]); else CE_U(k[j], k[i]); } }
}
__device__ __forceinline__ void merge16_desc(unsigned (&top)[16], const unsigned (&blk)[16]) {
#pragma unroll
    for (int i = 0; i < 16; ++i) top[i] = top[i] > blk[15 - i] ? top[i] : blk[15 - i];
#pragma unroll
    for (int stride = 8; stride > 0; stride >>= 1)
#pragma unroll
        for (int i = 0; i < 16; ++i) { const int j = i ^ stride; if (j > i) CE_U(top[i], top[j]); }
}
#define CE_P(va, pa, vb, pb) do { const bool sw_ = (vb) > (va); const float tv_ = sw_ ? (vb) : (va), tw_ = sw_ ? (va) : (vb); const unsigned tp_ = sw_ ? (pb) : (pa), tq_ = sw_ ? (pa) : (pb); (va) = tv_; (vb) = tw_; (pa) = tp_; (pb) = tq_; } while (0)
__device__ __forceinline__ void sort16p_desc(float (&v)[16], unsigned (&p)[16]) {
#pragma unroll
    for (int size = 2; size <= 16; size <<= 1)
#pragma unroll
        for (int stride = size >> 1; stride > 0; stride >>= 1)
#pragma unroll
            for (int i = 0; i < 16; ++i) { const int j = i ^ stride; if (j > i) { if ((i & size) == 0) CE_P(v[i], p[i], v[j], p[j]); else CE_P(v[j], p[j], v[i], p[i]); } }
}
__device__ __forceinline__ void merge16p_desc(float (&tv)[16], unsigned (&tp)[16], const float (&bv)[16], const unsigned (&bp)[16]) {
#pragma unroll
    for (int i = 0; i < 16; ++i) { const bool tk = bv[15 - i] > tv[i]; tv[i] = tk ? bv[15 - i] : tv[i]; tp[i] = tk ? bp[15 - i] : tp[i]; }
#pragma unroll
    for (int stride = 8; stride > 0; stride >>= 1)
#pragma unroll
        for (int i = 0; i < 16; ++i) { const int j = i ^ stride; if (j > i) CE_P(tv[i], tp[i], tv[j], tp[j]); }
}
__device__ __forceinline__ void top16_half(const float* sc, int m0, int half, int lane, lfloat* stage, unsigned (&top)[16]) {
    f32x4 ld[4][8];
#pragma unroll
    for (int j = 0; j < 4; ++j)
#pragma unroll
        for (int i = 0; i < 8; ++i) { const int idx = lane + 64 * i, p = idx >> 3, part = idx & 7;
            ld[j][i] = *(const f32x4*)(sc + (size_t)(m0 + (p >> 3)) * 2048 + (p & 7) * 256 + half * 128 + 32 * j + 4 * part); }
#pragma unroll
    for (int j = 0; j < 4; ++j) {
#pragma unroll
        for (int i = 0; i < 8; ++i) { const int idx = lane + 64 * i, p = idx >> 3, part = idx & 7; lfloat* d = stage + p * 33 + 4 * part; d[0] = ld[j][i].x; d[1] = ld[j][i].y; d[2] = ld[j][i].z; d[3] = ld[j][i].w; }
        LDS_WAIT();
#pragma unroll
        for (int hb = 0; hb < 2; ++hb) {
            unsigned blk[16];
#pragma unroll
            for (int i = 0; i < 16; ++i) { const int n = 32 * j + 16 * hb + i; blk[i] = (ordkey(stage[lane * 33 + 16 * hb + i]) & ~127u) | (unsigned)(127 - n); }
            sort16_desc(blk);
            if (j == 0 && hb == 0) {
#pragma unroll
                for (int i = 0; i < 16; ++i) top[i] = blk[i];
            } else merge16_desc(top, blk);
        }
        LDS_WAIT();
    }
}
__device__ __forceinline__ void route_task(const Ctx& C, int wt, int lane, LAS unsigned char* wl) {
    const float* sc = (const float*)(C.ws + WS_SC);
    bf16* GG = (bf16*)(C.ws + WS_GG); unsigned* BMp = (unsigned*)(C.ws + WS_BM);
    lfloat* stage = (lfloat*)wl;
    LAS u32x2* ent = (LAS u32x2*)(wl + 8704);
    const int m0 = 8 * wt, tk = lane >> 3, h = lane & 7;
    unsigned s1[16], s2[16];
    top16_half(sc, m0, 0, lane, stage, s1);
    top16_half(sc, m0, 1, lane, stage, s2);
    LAS unsigned short* cid = (LAS unsigned short*)stage + lane * 66;
    unsigned top[16];
#define CAND(dst, slot, num, a, b) do { const float cv_ = unordkey(s1[a] & ~127u) + unordkey(s2[b] & ~127u); dst[slot] = (ordkey(cv_) & ~63u) | (unsigned)(63 - (num)); \
        cid[num] = (unsigned short)(((127u - (s1[a] & 127u)) << 7) | (127u - (s2[b] & 127u))); } while (0)
    {
#pragma unroll
        for (int b2 = 0; b2 < 16; ++b2) CAND(top, b2, b2, 0, b2);
        sort16_desc(top);
    }
    {
        unsigned blk[16];
#pragma unroll
        for (int b2 = 0; b2 < 8; ++b2) CAND(blk, b2, 16 + b2, 1, b2);
#pragma unroll
        for (int b2 = 0; b2 < 5; ++b2) CAND(blk, 8 + b2, 24 + b2, 2, b2);
        blk[13] = 0u; blk[14] = 0u; blk[15] = 0u;
        sort16_desc(blk); merge16_desc(top, blk);
    }
    {
        unsigned blk[16];
#pragma unroll
        for (int b2 = 0; b2 < 4; ++b2) CAND(blk, b2, 29 + b2, 3, b2);
#pragma unroll
        for (int b2 = 0; b2 < 3; ++b2) CAND(blk, 4 + b2, 33 + b2, 4, b2);
#pragma unroll
        for (int b2 = 0; b2 < 2; ++b2) { CAND(blk, 7 + b2, 36 + b2, 5, b2); CAND(blk, 9 + b2, 38 + b2, 6, b2); }
        blk[11] = 0u; blk[12] = 0u; blk[13] = 0u; blk[14] = 0u; blk[15] = 0u;
        sort16_desc(blk); merge16_desc(top, blk);
    }
    {
        unsigned blk[16];
        CAND(blk, 0, 40, 7, 0); CAND(blk, 1, 41, 7, 1);
#pragma unroll
        for (int a2 = 8; a2 < 16; ++a2) CAND(blk, a2 - 6, 34 + a2, a2, 0);
        blk[10] = 0u; blk[11] = 0u; blk[12] = 0u; blk[13] = 0u; blk[14] = 0u; blk[15] = 0u;
        sort16_desc(blk); merge16_desc(top, blk);
    }
#undef CAND
    LDS_WAIT();
    {
        const float v0 = unordkey(top[0] & ~63u);
        float e[16]; float sum = 0.f;
#pragma unroll
        for (int i = 0; i < 16; ++i) { e[i] = __expf(unordkey(top[i] & ~63u) - v0); sum += e[i]; }
        const float inv = 1.0f / sum;
#pragma unroll
        for (int i = 0; i < 16; ++i) { const unsigned id = cid[63u - (top[i] & 63u)]; ent[tk * 128 + h * 16 + i] = (u32x2){id, __float_as_uint(e[i] * inv)}; }
    }
    LDS_WAIT();
#pragma unroll 1
    for (int t8 = 0; t8 < 8; ++t8) {
        const LAS u32x2* en = ent + t8 * 128; const size_t m = (size_t)(m0 + t8);
        const int my0 = (int)en[lane].x, my1 = (int)en[lane + 64].x;
        float g0 = 0.f, g1 = 0.f; bool f0 = true, f1 = true;
#pragma unroll 8
        for (int i = 0; i < 128; ++i) { const u32x2 x = en[i]; const int id = (int)x.x; const float gv = __uint_as_float(x.y);
            if (id == my0) { g0 += gv; if (i < lane) f0 = false; }
            if (id == my1) { g1 += gv; if (i < lane + 64) f1 = false; } }
        *(u32x4*)(GG + m * NE + (my0 & ~7)) = (u32x4){0u, 0u, 0u, 0u}; *(u32x4*)(GG + m * NE + (my1 & ~7)) = (u32x4){0u, 0u, 0u, 0u};
        atomicOr(BMp + m * 64 + (my0 >> 8), 1u << ((my0 >> 3) & 31)); atomicOr(BMp + m * 64 + (my1 >> 8), 1u << ((my1 >> 3) & 31));
        asm volatile("s_waitcnt vmcnt(0)" ::: "memory");
        if (f0) GG[m * NE + my0] = (bf16)f2bf(g0);
        if (f1) GG[m * NE + my1] = (bf16)f2bf(g1);
    }
    LDS_WAIT();
}
__device__ __forceinline__ int mbcnt64(unsigned long long m) { return __builtin_amdgcn_mbcnt_hi((unsigned)(m >> 32), __builtin_amdgcn_mbcnt_lo((unsigned)m, 0u)); }
__device__ __forceinline__ void top16_of_128(float v0, float v1, int lane, lfloat* selv, LAS int* seli) {
    const unsigned k0 = (ordkey(v0) & ~127u) | (unsigned)(127 - lane), k1 = (ordkey(v1) & ~127u) | (unsigned)(63 - lane);
    unsigned thr = 0u;
    for (int bit = 31; bit >= 0; --bit) { const unsigned cand = thr | (1u << bit);
        const int cnt = __popcll(__ballot(k0 >= cand)) + __popcll(__ballot(k1 >= cand));
        if (cnt >= 16) { thr = cand; if (cnt == 16) break; } }
    const unsigned long long m0 = __ballot(k0 >= thr), m1 = __ballot(k1 >= thr);
    if (k0 >= thr) { const int s = mbcnt64(m0); if (s < 16) { selv[s] = v0; seli[s] = lane; } }
    if (k1 >= thr) { const int s = __popcll(m0) + mbcnt64(m1); if (s < 16) { selv[s] = v1; seli[s] = lane + 64; } }
}
__device__ __forceinline__ void route_token_bisect(const Ctx& C, int m, int lane, LAS unsigned char* wl) {
    const float* sc = (const float*)(C.ws + WS_SC) + (size_t)m * 2048;
    bf16* GG = (bf16*)(C.ws + WS_GG);
    lfloat* s1v = (lfloat*)wl; LAS int* s1i = (LAS int*)(wl + 64); lfloat* s2v = (lfloat*)(wl + 128); LAS int* s2i = (LAS int*)(wl + 192);
    lfloat* bv = (lfloat*)(wl + 256); LAS int* bi = (LAS int*)(wl + 320);
    LAS u32x2* ent = (LAS u32x2*)(wl + 384);
    float sv[8][4];
#pragma unroll
    for (int h = 0; h < 8; ++h) { sv[h][0] = sc[h * 256 + lane]; sv[h][1] = sc[h * 256 + 64 + lane]; sv[h][2] = sc[h * 256 + 128 + lane]; sv[h][3] = sc[h * 256 + 192 + lane]; }
#pragma unroll
    for (int h = 0; h < 8; ++h) {
        const float a0 = sv[h][0], a1 = sv[h][1], b0 = sv[h][2], b1 = sv[h][3];
        top16_of_128(a0, a1, lane, s1v, s1i);
        top16_of_128(b0, b1, lane, s2v, s2i);
        LDS_WAIT();
        const float sa = s1v[lane >> 2]; const f32x4 sb = *(const lf32x4*)(s2v + 4 * (lane & 3));
        const float cv[4] = {sa + sb.x, sa + sb.y, sa + sb.z, sa + sb.w};
        unsigned ck[4];
#pragma unroll
        for (int jj = 0; jj < 4; ++jj) ck[jj] = (ordkey(cv[jj]) & ~255u) | (unsigned)(255 - (4 * lane + jj));
        unsigned thr = 0u;
        for (int bit = 31; bit >= 0; --bit) { const unsigned cand = thr | (1u << bit);
            const int cnt = __popcll(__ballot(ck[0] >= cand)) + __popcll(__ballot(ck[1] >= cand)) + __popcll(__ballot(ck[2] >= cand)) + __popcll(__ballot(ck[3] >= cand));
            if (cnt >= 16) { thr = cand; if (cnt == 16) break; } }
        int base = 0;
        const int ia = s1i[lane >> 2];
#pragma unroll
        for (int jj = 0; jj < 4; ++jj) { const unsigned long long mk = __ballot(ck[jj] >= thr);
            if (ck[jj] >= thr) { const int s = base + mbcnt64(mk); if (s < 16) { bv[s] = cv[jj]; bi[s] = ia * 128 + s2i[4 * (lane & 3) + jj]; } }
            base += __popcll(mk); }
        LDS_WAIT();
        float mx = -3.0e38f;
#pragma unroll
        for (int i = 0; i < 16; ++i) mx = fmaxf(mx, bv[i]);
        float sum = 0.f;
#pragma unroll
        for (int i = 0; i < 16; ++i) sum += __expf(bv[i] - mx);
        if (lane < 16) ent[h * 16 + lane] = (u32x2){(unsigned)bi[lane], __float_as_uint(__expf(bv[lane] - mx) / sum)};
        LDS_WAIT();
    }
    u32x2* me = (u32x2*)(C.ws + WS_ME) + (size_t)(m - MAIN_ROWS) * 128;
    me[lane] = ent[lane]; me[lane + 64] = ent[lane + 64];
    LDS_WAIT();
}

__device__ __forceinline__ void route_all(int l_, LAS unsigned char* lds_) {
    LOAD_CTX(); const int l = UNI(l_); LAS unsigned char* lds = UNI_LDS(lds_);
    const int tid = ltid(), lane = tid & 63, wave = UNI(tid >> 6);
    __syncthreads();
    for (int wt = blockIdx.x * 8 + wave; wt < MAIN_ROWS / 8; wt += gridDim.x * 8) route_task(C, wt, lane, lds + wave * 17408);
    if (l == 0) for (int m = MAIN_ROWS + blockIdx.x * 8 + wave; m < TT; m += gridDim.x * 8) route_token_bisect(C, m, lane, lds + wave * 17408);
}
__device__ __forceinline__ void norm2_zero_all(int l_) {
    LOAD_CTX(); const int l = UNI(l_);
    const int tid = ltid(), lane = tid & 63, wave = UNI((int)(tid >> 6)), G = gridDim.x;
    unsigned char* ws = C.ws; bf16* Z = (bf16*)(ws + WS_Z); float* H = (float*)(ws + WS_H);
    unsigned char* HN8 = ws + WS_HN8;
    const int nrows = (l == 1) ? MAIN_ROWS : TT;
    {   f32x4 gn[16]; { const f32x4* gr = (const f32x4*)(C.in[I_NFFN] + l * DM) + lane;
#pragma unroll
            for (int j = 0; j < 16; ++j) gn[j] = gr[64 * j]; }
        rows_pipe(blockIdx.x * 8 + wave, G * 8, nrows, lane, [&](int m) -> const float* { return H + (size_t)m * DM; },
            [&](const f32x4 (&v)[16], int m) { norm_row_fin(v, gn, Z + (size_t)m * DM, nullptr, lane, HN8 + (size_t)m * DM); }); }
    for (int e = blockIdx.x * 512 + tid; e < (MP - TT) * DM / 16; e += G * 512) ((u32x4*)(HN8 + (size_t)TT * DM))[e] = (u32x4){0u, 0u, 0u, 0u};
    u32x4* gz = (u32x4*)(ws + WS_BM);
    const size_t n16 = (size_t)MAIN_ROWS * 64 * 4 / 16;
    for (size_t e = (size_t)blockIdx.x * 512 + tid; e < n16; e += (size_t)G * 512) gz[e] = (u32x4){0u, 0u, 0u, 0u};
}
__device__ __forceinline__ void final_norm_all() {
    LOAD_CTX();
    const int tid = ltid(), lane = tid & 63, wave = UNI((int)(tid >> 6)), G = gridDim.x;
    const float* H = (const float*)(C.ws + WS_H);
    f32x4 gn[16]; { const f32x4* gr = (const f32x4*)C.in[I_NFIN] + lane;
#pragma unroll
        for (int j = 0; j < 16; ++j) gn[j] = gr[64 * j]; }
    rows_pipe(blockIdx.x * 8 + wave, G * 8, NB * 4096, lane, [&](int m) -> const float* { return H + (size_t)m * DM; },
        [&](const f32x4 (&v)[16], int m) {
            float ss = 0.f;
#pragma unroll
            for (int j = 0; j < 16; ++j) ss += (v[j].x * v[j].x + v[j].y * v[j].y) + (v[j].z * v[j].z + v[j].w * v[j].w);
            ss = wave_sum(ss);
            const float rn = rsqrtf(ss * (1.0f / 4096.0f) + 1e-5f);
            f32x4* o = (f32x4*)(C.out + (size_t)m * DM) + lane;
#pragma unroll
            for (int j = 0; j < 16; ++j) o[64 * j] = v[j] * rn * gn[j]; });
}
constexpr int NPL = 11;
constexpr int HG_OUT_EARLY = 2080;
constexpr int NPH = 2 * NPL + 1;
template <int MODE> __device__ __forceinline__ void meta_gemm(const bf16* A, const bf16* Bt, int N, float* O, int ldo, LAS unsigned char* lds_) {
    LAS unsigned char* lds = UNI_LDS(lds_);
    const int tid = ltid(), lane = tid & 63, wave = UNI(tid >> 6), fr = lane & 15, g4 = lane >> 4;
    lfloat* part = (lfloat*)lds;
    for (int nt = blockIdx.x; nt < N / 16; nt += gridDim.x) {
        __syncthreads();
        f32x4 d = (f32x4){0.f, 0.f, 0.f, 0.f};
        const bf16* ap = A + (size_t)fr * DM + 512 * wave + 8 * g4; const bf16* bp = Bt + (size_t)(16 * nt + fr) * DM + 512 * wave + 8 * g4;
#pragma unroll
        for (int ks = 0; ks < 16; ++ks) d = __builtin_amdgcn_mfma_f32_16x16x32_bf16(*(const pg8::bf16x8*)(ap + 32 * ks), *(const pg8::bf16x8*)(bp + 32 * ks), d, 0, 0, 0);
#pragma unroll
        for (int r = 0; r < 4; ++r) part[wave * 256 + (4 * g4 + r) * 16 + fr] = d[r];
        __syncthreads();
        if (tid < 256) { const int t = tid >> 4, n = tid & 15; float s = 0.f;
#pragma unroll
            for (int w8 = 0; w8 < 8; ++w8) s += part[w8 * 256 + tid];
#pragma unroll
            for (int bb = 0; bb < 4; ++bb) { float* o = O + (size_t)(MAIN_ROWS + 16 * bb + t) * ldo + 16 * nt + n; if (MODE == 0) *o += s; else *o = s; } }
    }
}
__device__ __forceinline__ void meta_u_all(int l_) {
    LOAD_CTX(); const int l = UNI(l_);
    const int tid = ltid(), lane = tid & 63, wave = UNI(tid >> 6);
    const bf16* Z = (const bf16*)(C.ws + WS_Z); const float* pu = C.in[I_PU] + (size_t)l * NE * DM;
    const u32x2* me = (const u32x2*)(C.ws + WS_ME); float* HM = (float*)(C.ws + WS_HM);
    for (int task = blockIdx.x * 8 + wave; task < 16 * 128; task += gridDim.x * 8) {
        const int t = task >> 7, e = task & 127; const u32x2 en = me[t * 128 + e];
        const float* ur = pu + (size_t)en.x * DM + 4 * lane; const bf16* hr = Z + (size_t)(MAIN_ROWS + t) * DM + 4 * lane;
        float acc = 0.f;
#pragma unroll 8
        for (int i = 0; i < 16; ++i) { const f32x4 uu = *(const f32x4*)(ur + 256 * i); const u32x2 hh = *(const u32x2*)(hr + 256 * i);
            acc += uu.x * bf2f(hh.x & 0xffffu) + uu.y * bf2f(hh.x >> 16) + uu.z * bf2f(hh.y & 0xffffu) + uu.w * bf2f(hh.y >> 16); }
        acc = wave_sum(acc);
        if (lane == 0) HM[t * 128 + e] = __uint_as_float(en.y) * 0.5f * acc * (1.0f + erff(acc * 0.70710678118654752f));
    }
}
__device__ __forceinline__ void meta_v_all(int l_) {
    LOAD_CTX(); const int l = UNI(l_);
    const int tid = ltid(), lane = tid & 63, wave = UNI(tid >> 6);
    const float* pv = C.in[I_PV] + (size_t)l * NE * DM; float* H = (float*)(C.ws + WS_H);
    const u32x2* me = (const u32x2*)(C.ws + WS_ME); const float* HM = (const float*)(C.ws + WS_HM);
    for (int task = blockIdx.x * 8 + wave; task < 16 * 16; task += gridDim.x * 8) {
        const int t = task >> 4, n = 256 * (task & 15) + 4 * lane;
        f32x4 acc = (f32x4){0.f, 0.f, 0.f, 0.f};
#pragma unroll 8
        for (int e = 0; e < 128; ++e) { const unsigned id = me[t * 128 + e].x; const float hv = HM[t * 128 + e]; acc += *(const f32x4*)(pv + (size_t)id * DM + n) * hv; }
#pragma unroll
        for (int bb = 0; bb < 4; ++bb) { f32x4* o = (f32x4*)(H + (size_t)(MAIN_ROWS + 16 * bb + t) * DM + n); *o = *o + acc; }
    }
}

#if MK_ONE_LAUNCH
#define GRID_BAR() xcd_barrier(bar)
#else
#define GRID_BAR() do {} while (0)
#endif
#define IN(k) (lo <= (k) && (k) < hi)
#define SEAM(k) do { if (IN((k) + 1)) GRID_BAR(); } while (0)
#ifndef DUP_MASK
#define DUP_MASK 0u
#endif
#define REPS(k) ((((unsigned)DUP_MASK >> (k)) & 1u) ? 2 : 1)
template <int l> __device__ __forceinline__ void layer_phases(const int lo, const int hi, const int G, LAS unsigned char* lds, const XcdBarrier& bar) {
        const int p0 = l * NPL;
        if (IN(p0 + 0)) for (int rep = 0; rep < REPS(0); ++rep) { phase_conv_norm(l, lds); SEAM(p0 + 0); }
        if (IN(p0 + 1)) for (int rep = 0; rep < REPS(1); ++rep) {
            const Ctx Cq = load_ctx(); unsigned char* ws = Cq.ws; bf16* Z = (bf16*)(ws + WS_Z); float* H = (float*)(ws + WS_H); (void)Z; (void)H;
            pg8::Gemm g{(const pg8::bf16_t*)Z, (const pg8::bf16_t*)(ws + WS_WIN), MP, PN, DM}; pg8::StaticOrder S; S.init(MP, PN, G, (int)blockIdx.x);
            pg8::EpiBf16<0> E{(pg8::bf16_t*)(ws + WS_PROJ), PN, nullptr, 0, 0};
            pg8::gemm_phase<pg8::EpiBf16<0>, pg8::StaticOrder, false>(lds, g, S, E, nullptr);
            SEAM(p0 + 1);
        }
        if (IN(p0 + 2)) for (int rep = 0; rep < REPS(2); ++rep) {
            for (int u = blockIdx.x; u < 1028; u += G) rwkv_prep_unit(l, u, lds);
            if (G == 256 && rep == 0) {
                unsigned* qc = (unsigned*)(load_ctx().ws + WS_CTL) + CW_HL + 64 * l;
                volatile LAS unsigned* slot = (volatile LAS unsigned*)(lds + LDS_MISC) + 16;
                unsigned nxt = 0u;
                if (threadIdx.x == 0) nxt = __hip_atomic_fetch_add(qc, 1u, __ATOMIC_RELAXED, __HIP_MEMORY_SCOPE_AGENT);
                for (;;) {
                    if (threadIdx.x == 0) *slot = nxt;
                    __syncthreads();
                    const int u = __builtin_amdgcn_readfirstlane((int)*slot);
                    __syncthreads();
                    if (u >= 2080) break;
                    if (threadIdx.x == 0) nxt = __hip_atomic_fetch_add(qc, 1u, __ATOMIC_RELAXED, __HIP_MEMORY_SCOPE_AGENT);
                    hgrn_local_unit(l, u, lds);
                }
            } else
            for (int u = (blockIdx.x + G - 16) % G; u < 2080; u += G) hgrn_local_unit(l, u, lds);
            SEAM(p0 + 2);
        }
        if (IN(p0 + 3)) for (int rep = 0; rep < REPS(3); ++rep) {
            if (G == 256 && rep == 0) {
                const int r = blockIdx.x, q = r - 48;
                unsigned* ctlw = (unsigned*)(load_ctx().ws + WS_CTL);
                unsigned* hgc = ctlw + CW_HG; unsigned* qc = ctlw + CW_M2 + 64 * l;
                if (r < 48) rwkv_scan_unit(r, lds);
                else if (q < 64) {
                    hgrn_scan_slice(q);
                    asm volatile("s_waitcnt vmcnt(0)" ::: "memory"); __syncthreads();
                    if (threadIdx.x == 0) { __builtin_amdgcn_fence(__ATOMIC_RELEASE, "agent"); asm volatile("s_waitcnt vmcnt(0)" ::: "memory");
                        __hip_atomic_fetch_add(hgc, 1u, __ATOMIC_RELAXED, __HIP_MEMORY_SCOPE_AGENT); }
                }
                volatile LAS unsigned* slot = (volatile LAS unsigned*)(lds + LDS_MISC) + 16;
                unsigned nxt = 0u; bool waited = false;
                if (threadIdx.x == 0) nxt = __hip_atomic_fetch_add(qc, 1u, __ATOMIC_RELAXED, __HIP_MEMORY_SCOPE_AGENT);
                for (;;) {
                    __syncthreads();
                    if (threadIdx.x == 0) *slot = nxt;
                    __syncthreads();
                    const int t = __builtin_amdgcn_readfirstlane((int)*slot);
                    if (t >= 1548 + 2080 + (l == 0 ? EX_TICKETS : 0)) break;
                    if (threadIdx.x == 0) nxt = __hip_atomic_fetch_add(qc, 1u, __ATOMIC_RELAXED, __HIP_MEMORY_SCOPE_AGENT);
                    if (t < 1548) swa_unit(l, t, lds);
                    else if (t >= 1548 + 2080) early_conv_ticket(t - (1548 + 2080), lds);
                    else {
                        if (!waited) {
                            if (threadIdx.x == 0) { unsigned sp = 0; const unsigned want = 64u * (unsigned)(l + 1);
                                while (__hip_atomic_load(hgc, __ATOMIC_RELAXED, __HIP_MEMORY_SCOPE_AGENT) < want) { __builtin_amdgcn_s_sleep(2); if (++sp > (1u << 22)) break; }
                                __builtin_amdgcn_fence(__ATOMIC_ACQUIRE, "agent"); asm volatile("s_waitcnt vmcnt(0)" ::: "memory"); }
                            __syncthreads();
                            waited = true;
                        }
                        hgrn_out_unit(l, t - 1548, lds);
                    }
                }
            } else
            for (int r = blockIdx.x; r < 256; r += G) {
                if (r < 48) { rwkv_scan_unit(r, lds); continue; }
                const int q = r - 48;
                const bool split = (G == 256);
                unsigned* hgc = (unsigned*)(load_ctx().ws + WS_CTL) + CW_HG;
                if (q < 64 && rep == 0) {
                    hgrn_scan_slice(q);
                    if (split) {
                        asm volatile("s_waitcnt vmcnt(0)" ::: "memory"); __syncthreads();
                        if (threadIdx.x == 0) { __builtin_amdgcn_fence(__ATOMIC_RELEASE, "agent"); asm volatile("s_waitcnt vmcnt(0)" ::: "memory");
                            __hip_atomic_fetch_add(hgc, 1u, __ATOMIC_RELAXED, __HIP_MEMORY_SCOPE_AGENT); }
                    }
                }
                for (int u = q; u < 1548; u += 208) swa_unit(l, u, lds);
                if (split) {
                    if (threadIdx.x == 0) { unsigned sp = 0; const unsigned want = 64u * (unsigned)(l + 1);
                        while (__hip_atomic_load(hgc, __ATOMIC_RELAXED, __HIP_MEMORY_SCOPE_AGENT) < want) { __builtin_amdgcn_s_sleep(2); if (++sp > (1u << 22)) break; }
                        __builtin_amdgcn_fence(__ATOMIC_ACQUIRE, "agent"); asm volatile("s_waitcnt vmcnt(0)" ::: "memory"); }
                    __syncthreads();
                    for (int u = q; u < HG_OUT_EARLY; u += 208) hgrn_out_unit(l, u, lds);
                }
            }
            SEAM(p0 + 3);
        }
        if (IN(p0 + 4)) for (int rep = 0; rep < REPS(4); ++rep) {
            for (int u = ((G == 256) ? HG_OUT_EARLY : 0) + blockIdx.x; u < 2080; u += G) hgrn_out_unit(l, u, lds);
            rwkv_post_all(l);
            SEAM(p0 + 4);
        }
        if (IN(p0 + 5)) for (int rep = 0; rep < REPS(5); ++rep) {
            const Ctx Cq = load_ctx(); unsigned char* ws = Cq.ws; bf16* Z = (bf16*)(ws + WS_Z); float* H = (float*)(ws + WS_H); (void)Z; (void)H;
            constexpr int MR = MAIN_ROWS; pg8::Gemm8 g{ws + WS_MX8, ws + WS_WO8, MR, DM, DM, WO8_E8M0}; pg8::StaticOrder S; S.init(MR, DM, G, (int)blockIdx.x);
            pg8::EpiResF32 E{H, DM, (l == 0) ? Cq.in[I_X] : (const float*)H};
            pg8::gemm_phase8<pg8::EpiResF32, pg8::StaticOrder, false>(lds, g, S, E, nullptr);
            if (l == 0) meta_gemm<0>((const bf16*)Z + (size_t)MAIN_ROWS * DM, (const bf16*)(ws + WS_WO), DM, H, DM, lds);
            SEAM(p0 + 5);
        }
        if (IN(p0 + 6)) for (int rep = 0; rep < REPS(6); ++rep) { norm2_zero_all(l); SEAM(p0 + 6); }
        if (IN(p0 + 7)) for (int rep = 0; rep < REPS(7); ++rep) {
            const Ctx Cq = load_ctx(); unsigned char* ws = Cq.ws; bf16* Z = (bf16*)(ws + WS_Z); float* H = (float*)(ws + WS_H); (void)Z; (void)H;
            constexpr int MR = MAIN_ROWS; pg8::Gemm g{(const pg8::bf16_t*)Z, (const pg8::bf16_t*)(ws + WS_WS), MR, 2048, DM}; pg8::StaticOrder S; S.init(MR, 2048, G, (int)blockIdx.x);
            pg8::EpiF32 E{(float*)(ws + WS_SC), 2048, nullptr};
            pg8::gemm_phase<pg8::EpiF32, pg8::StaticOrder, false>(lds, g, S, E, nullptr);
            if (l == 0) meta_gemm<1>((const bf16*)Z + (size_t)MAIN_ROWS * DM, (const bf16*)(ws + WS_WS), 2048, (float*)(ws + WS_SC), 2048, lds);
            SEAM(p0 + 7);
        }
        if (IN(p0 + 8)) for (int rep = 0; rep < REPS(8); ++rep) { route_all(l, lds); SEAM(p0 + 8); }
        if (IN(p0 + 9)) for (int rep = 0; rep < REPS(9); ++rep) {
            const Ctx Cq = load_ctx(); unsigned char* ws = Cq.ws; bf16* Z = (bf16*)(ws + WS_Z); float* H = (float*)(ws + WS_H); (void)Z; (void)H;
            constexpr int MR = MAIN_ROWS; pg8::Gemm8 g{ws + WS_HN8, ws + ((l == 1 && G == 256) ? WS_U1 : WS_U), MR, NE, DM, U8_E8M0}; pg8::StaticOrder S; S.init(MR, NE, G, (int)blockIdx.x);
            pg8::EpiGate8 E{ws};
            pg8::gemm_phase8<pg8::EpiGate8, pg8::StaticOrder, false>(lds, g, S, E, nullptr);
            if (l == 0) meta_u_all(l);
            SEAM(p0 + 9);
        }
        if (IN(p0 + 10)) for (int rep = 0; rep < REPS(10); ++rep) {
            const Ctx Cq = load_ctx(); unsigned char* ws = Cq.ws; bf16* Z = (bf16*)(ws + WS_Z); float* H = (float*)(ws + WS_H); (void)Z; (void)H;
            constexpr int MR = MAIN_ROWS; pg8::Gemm8 g{ws + WS_HG8, ws + WS_VT, MR, DM, NE, V8_E8M0}; pg8::StaticOrder S; S.init(MR, DM, G, (int)blockIdx.x);
            pg8::EpiResF32 E{H, DM, (const float*)H};
            pg8::gemm_phase8<pg8::EpiResF32, pg8::StaticOrder, false>(lds, g, S, E, nullptr);
            if (l == 0) meta_v_all(l);
            SEAM(p0 + 10);
        }
}
__global__ void __launch_bounds__(512, 2) hybrid_fwd(Ctx C) {
    extern __shared__ __attribute__((aligned(16))) unsigned char lds_raw[];
    LAS unsigned char* lds = (LAS unsigned char*)lds_raw;
    const int tid = threadIdx.x, lane = tid & 63, wave = __builtin_amdgcn_readfirstlane(tid >> 6);
    const int G = gridDim.x;
    unsigned* ctl = (unsigned*)(C.ws + WS_CTL);
    volatile LAS unsigned* MISC = (volatile LAS unsigned*)(lds + LDS_MISC);
    if (tid < 64) MISC[tid] = 0u;
    __syncthreads();
#if MK_ONE_LAUNCH
    XcdBarrier bar = xcd_barrier_post(ctl + CW_BAR, MISC + 8);
#else
    XcdBarrier bar; bar.bar = ctl; bar.x = 0u; bar.st = MISC + 8;
#endif
    const int lo = C.ph_lo, hi = C.ph_hi;
    layer_phases<0>(lo, hi, G, lds, bar);
    layer_phases<1>(lo, hi, G, lds, bar);
    if (IN(2 * NPL)) final_norm_all();
}

extern "C" void kernel_launch(void* const* d_in, const int* in_sizes, int n_in, void* d_out, int out_size, void* d_ws, size_t ws_size, hipStream_t stream) {
    static int grid = 0;
    if (grid == 0) {
        if (n_in != 25 || ws_size < WS_END2) { fprintf(stderr, "kernel_launch: need 25 inputs and %zu bytes of workspace (got %d, %zu)\n", (size_t)WS_END2, n_in, ws_size); grid = -1; return; }
        int dev = 0, cus = 0, per_cu = 0;
        if (hipGetDevice(&dev) != hipSuccess || hipDeviceGetAttribute(&cus, hipDeviceAttributeMultiprocessorCount, dev) != hipSuccess) { grid = -1; return; }
        if (hipFuncSetAttribute((const void*)hybrid_fwd, hipFuncAttributeMaxDynamicSharedMemorySize, LDS_BYTES) != hipSuccess) { fprintf(stderr, "kernel_launch: hipFuncSetAttribute failed\n"); grid = -1; return; }
        if (hipOccupancyMaxActiveBlocksPerMultiprocessor(&per_cu, (const void*)hybrid_fwd, 512, LDS_BYTES) != hipSuccess || per_cu < 1) { fprintf(stderr, "kernel_launch: occupancy query says %d blocks per CU\n", per_cu); }
        (void)hipGetLastError();
        grid = cus;
    }
    if (grid < 0) return;
    (void)hipMemsetAsync((char*)d_ws + WS_CTL, 0, CTL_ZERO_BYTES, stream);
    Ctx c{};
    for (int i = 0; i < 25; ++i) c.in[i] = (const float*)d_in[i];
    c.out = (float*)d_out; c.ws = (unsigned char*)d_ws;
#if MK_ONE_LAUNCH
    c.ph_lo = 0; c.ph_hi = NPH;
    hipLaunchKernelGGL(hybrid_fwd, dim3(grid), dim3(512), LDS_BYTES, stream, c);
#else
    for (int p = 0; p < NPH; ++p) { c.ph_lo = p; c.ph_hi = p + 1; hipLaunchKernelGGL(hybrid_fwd, dim3(grid), dim3(512), LDS_BYTES, stream, c); }
#endif
}
```

```cpp
#include <hip/hip_runtime.h>
#include <cstdio>
#include <cstdint>
#ifndef MK_ONE_LAUNCH
#define MK_ONE_LAUNCH 1
#endif
namespace pg8 {
#define PG8_LAS __attribute__((address_space(3)))
typedef unsigned short bf16_t;
typedef short bf16x8 __attribute__((ext_vector_type(8)));
typedef float f32x4 __attribute__((ext_vector_type(4)));
typedef unsigned u32x4 __attribute__((ext_vector_type(4)));
constexpr int BM = 256, BK = 64, HALF = 128, HTB = HALF * BK * 2  , STAGE_BYTES = 8 * HTB, NXCD = 8, WGM = 8;

__host__ __device__ __forceinline__ int lds_byte(int r, int c) { const int st = (r >> 4) * 2 + (c >> 5), rr = r & 15, cc = c & 31, ob = rr * 64 + cc * 2; return st * 1024 + (ob ^ (((ob >> 9) & 1) << 5)); }
__host__ __device__ __forceinline__ void stage_rc(int b, int& R, int& C) { const int st = b / 1024, sb = b % 1024, swz = sb ^ (((sb >> 9) & 1) << 5); R = (st >> 1) * 16 + swz / 64; C = (st & 1) * 32 + (swz % 64) / 2; }
__host__ __device__ __forceinline__ int perm32(int rho) { const int n = rho >> 4, i = rho & 15; return 8 * (i >> 2) + 4 * n + (i & 3); }

struct Unit { int pm, pn; };
struct Gemm { const bf16_t* A; const bf16_t* Bt; int M, N, K; };

struct StaticOrder {
    int nM, nN, nwg, G, c;
    __host__ __device__ void init(int M, int N, int G_, int c_) { nM = M / BM; nN = N / BM; nwg = nM * nN; G = G_; c = c_; }
    __host__ __device__ bool next(int i, Unit& u) const {
        const long L = (long)i * G + c; if (L >= nwg) return false;
        int wgid = (int)L; { const int q = nwg / NXCD, r = nwg % NXCD, xcd = wgid % NXCD, off = wgid / NXCD; wgid = (xcd < r ? xcd * (q + 1) : r * (q + 1) + (xcd - r) * q) + off; }
        const int nig = WGM * nN, gid = wgid / nig, fm = gid * WGM, gsz = (nM - fm) < WGM ? (nM - fm) : WGM;
        u.pm = fm + ((wgid % nig) % gsz); u.pn = (wgid % nig) / gsz; return true;
    }
    __device__ __forceinline__ void a_ready(const Unit&) const {}
    __device__ __forceinline__ void done(const Unit&) const {}
};
__device__ __forceinline__ unsigned cvt_pk_bf16(float lo, float hi) { unsigned r; asm volatile("v_cvt_pk_bf16_f32 %0, %1, %2" : "=v"(r) : "v"(lo), "v"(hi)); return r; }
typedef float f32x2 __attribute__((ext_vector_type(2)));
__device__ __forceinline__ f32x2 gelu_pk(f32x2 v) {
    const f32x2 av = __builtin_elementwise_abs(v), d = av * 0.2316418882f + 1.0f;
    f32x2 t; t.x = __builtin_amdgcn_rcpf(d.x); t.y = __builtin_amdgcn_rcpf(d.y);
    f32x2 q = t * 0.5307027145f + (-0.7265760135f); q = q * t + 0.7107068705f; q = q * t + (-0.142248368f); q = q * t + 0.127414796f; q = q * t;
    const f32x2 s = (v * v) * (-0.72134752044f);
    f32x2 e; e.x = __builtin_amdgcn_exp2f(s.x); e.y = __builtin_amdgcn_exp2f(s.y);
    const f32x2 m = v * (q * e), r = v - m;
    f32x2 o; o.x = v.x < 0.f ? m.x : r.x; o.y = v.y < 0.f ? m.y : r.y; return o;
}
struct EpiF32 {
    static constexpr bool PERM = false, AFTER_DRAIN = false;
    float* C; int ldc; const float* bias;
    __device__ __forceinline__ void operator()(const f32x4 (&acc)[2][2][4][2], const Unit& u, int wr, int wc, int fr, int fq) const {
        const int row0 = u.pm * BM + wr * 64 + fr, col0 = u.pn * BM + wc * 32 + 4 * fq;
        f32x4 bv[2][2];
#pragma unroll
        for (int bj = 0; bj < 2; ++bj)
#pragma unroll
            for (int n = 0; n < 2; ++n) bv[bj][n] = bias ? *(const f32x4*)(bias + col0 + bj * HALF + n * 16) : (f32x4){0.f, 0.f, 0.f, 0.f};
#pragma unroll
        for (int ai = 0; ai < 2; ++ai)
#pragma unroll
            for (int m = 0; m < 4; ++m) { float* rowp = C + (size_t)(row0 + ai * HALF + m * 16) * ldc + col0;
#pragma unroll
                for (int bj = 0; bj < 2; ++bj)
#pragma unroll
                    for (int n = 0; n < 2; ++n) *(f32x4*)(rowp + bj * HALF + n * 16) = acc[ai][bj][m][n] + bv[bj][n]; }
    }
};
template <int ACT  > struct EpiBf16 {
    static constexpr bool PERM = true, AFTER_DRAIN = false;
    bf16_t* O; int ldc; const float* bias; int split_cols; size_t split_stride;
    __device__ __forceinline__ void operator()(const f32x4 (&acc)[2][2][4][2], const Unit& u, int wr, int wc, int fr, int fq) const {
        const int row0 = u.pm * BM + wr * 64 + fr; int colt = u.pn * BM; bf16_t* base = O;
        if (split_cols) { const int t = colt / split_cols; base += (size_t)t * split_stride; colt -= t * split_cols; }
        const int col0 = colt + wc * 32 + 8 * fq, bcol0 = u.pn * BM + wc * 32 + 8 * fq;
        f32x4 bv[2][2];
#pragma unroll
        for (int bj = 0; bj < 2; ++bj)
#pragma unroll
            for (int n = 0; n < 2; ++n) bv[bj][n] = bias ? *(const f32x4*)(bias + bcol0 + bj * HALF + 4 * n) : (f32x4){0.f, 0.f, 0.f, 0.f};
#pragma unroll
        for (int ai = 0; ai < 2; ++ai)
#pragma unroll
            for (int m = 0; m < 4; ++m) { bf16_t* rowp = base + (size_t)(row0 + ai * HALF + m * 16) * ldc + col0;
#pragma unroll
                for (int bj = 0; bj < 2; ++bj) { f32x4 v0 = acc[ai][bj][m][0] + bv[bj][0], v1 = acc[ai][bj][m][1] + bv[bj][1];
                    if (ACT == 1) { f32x2 a = gelu_pk((f32x2){v0[0], v0[1]}), b = gelu_pk((f32x2){v0[2], v0[3]}), c = gelu_pk((f32x2){v1[0], v1[1]}), d = gelu_pk((f32x2){v1[2], v1[3]});
                        v0 = (f32x4){a.x, a.y, b.x, b.y}; v1 = (f32x4){c.x, c.y, d.x, d.y}; }
                    if (ACT == 2) {
#pragma unroll
                        for (int j = 0; j < 4; ++j) { v0[j] = 0.5f * v0[j] * (1.0f + erff(v0[j] * 0.70710678f)); v1[j] = 0.5f * v1[j] * (1.0f + erff(v1[j] * 0.70710678f)); } }
                    u32x4 w; w.x = cvt_pk_bf16(v0[0], v0[1]); w.y = cvt_pk_bf16(v0[2], v0[3]); w.z = cvt_pk_bf16(v1[0], v1[1]); w.w = cvt_pk_bf16(v1[2], v1[3]);
                    *(u32x4*)(rowp + bj * HALF) = w; } }
    }
};
template <class Epi, class Sched, bool STAMP = false>
__device__ __forceinline__ void gemm_phase(PG8_LAS unsigned char* lds, const Gemm g, const Sched& S, const Epi& E, unsigned long long* stamps) {
    int tid_ = threadIdx.x; asm volatile("" : "+v"(tid_));
    const int tid = tid_, wid = __builtin_amdgcn_readfirstlane(tid >> 6), lane = tid & 63, wr = wid >> 2, wc = wid & 3, fr = lane & 15, fq = lane >> 4;
    const int K = g.K, nt = K / BK;
    int ts_lo = 0, ts_hi = 0, nts = 0; const unsigned long long rt_entry = STAMP ? (unsigned long long)wall_clock64() : 0ull;
#define PG8_STAMP() do { if (STAMP && wid == 0 && nts < 64) { const unsigned long long _c = (unsigned long long)clock64(); \
        ts_lo = (lane == nts) ? (int)(unsigned)_c : ts_lo; ts_hi = (lane == nts) ? (int)(unsigned)(_c >> 32) : ts_hi; ++nts; } } while (0)
    PG8_STAMP();
    unsigned voffA[2], voffB[2];
#pragma unroll
    for (int i = 0; i < 2; ++i) { int R, C; stage_rc(tid * 16 + i * 8192, R, C); const int Rb = Epi::PERM ? ((R & ~31) + perm32(R & 31)) : R;
        voffA[i] = (unsigned)(R * K + C) * 2u; voffB[i] = (unsigned)(Rb * K + C) * 2u; }
    const size_t kstep = (size_t)(BK * 2);
    const size_t hstep = (size_t)HALF * K * 2;
    const size_t tstep = 2 * hstep;
    const unsigned ldsw = (unsigned)wid * 1024u;
    const unsigned ldsdst = (unsigned)__builtin_amdgcn_readfirstlane((int)((unsigned)(size_t)lds + ldsw));
    const int aoff = lds_byte(wr * 64 + fr, fq * 8), boff = lds_byte(wc * 32 + fr, fq * 8);
#define PG8_SA(b, h) (((b) * 2 + (h)) * HTB)
#define PG8_SB(b, h) ((4 + (b) * 2 + (h)) * HTB)
#define PG8_STAGE(bufoff, gbase, voff) do { _Pragma("unroll") for (int _i = 0; _i < 2; ++_i) { unsigned keep_; \
        asm volatile("s_mov_b32 %0, m0\n\ts_mov_b32 m0, %3\n\ts_nop 0\n\tglobal_load_lds_dwordx4 %1, %2\n\ts_mov_b32 m0, %0" : "=&s"(keep_) : "v"((voff)[_i]), "s"((unsigned long long)(gbase)), "s"(ldsdst + (unsigned)((bufoff) + _i * 8192)) : "memory"); } } while (0)
#define PG8_LDA(dst, b, h) do { _Pragma("unroll") for (int m = 0; m < 4; ++m) _Pragma("unroll") for (int k = 0; k < 2; ++k) dst[m][k] = *(const PG8_LAS bf16x8*)(lds + PG8_SA(b, h) + aoff + m * 2048 + k * 1024); } while (0)
#define PG8_LDB(dst, b, h) do { _Pragma("unroll") for (int n = 0; n < 2; ++n) _Pragma("unroll") for (int k = 0; k < 2; ++k) dst[n][k] = *(const PG8_LAS bf16x8*)(lds + PG8_SB(b, h) + boff + n * 2048 + k * 1024); } while (0)
#define PG8_MMA(ai, bj, At, Bt) do { __builtin_amdgcn_s_setprio(1); _Pragma("unroll") for (int m = 0; m < 4; ++m) _Pragma("unroll") for (int n = 0; n < 2; ++n) _Pragma("unroll") for (int k = 0; k < 2; ++k) \
        acc[ai][bj][m][n] = __builtin_amdgcn_mfma_f32_16x16x32_bf16(Bt[n][k], At[m][k], acc[ai][bj][m][n], 0, 0, 0); __builtin_amdgcn_s_setprio(0); } while (0)
#define PG8_WAIT_V(n) asm volatile("s_waitcnt vmcnt(" #n ")" ::: "memory")
#define PG8_WAIT_L(n) asm volatile("s_waitcnt lgkmcnt(" #n ")" ::: "memory")
#define PG8_BAR __builtin_amdgcn_s_barrier()
#define PG8_SCHED __builtin_amdgcn_sched_barrier(0)
    Unit cur, nxt; int ui = 0;
    if (!S.next(0, cur)) return;
    f32x4 acc[2][2][4][2];
#pragma unroll
    for (int a = 0; a < 2; ++a)
#pragma unroll
        for (int b = 0; b < 2; ++b)
#pragma unroll
            for (int m = 0; m < 4; ++m)
#pragma unroll
                for (int n = 0; n < 2; ++n) acc[a][b][m][n] = (f32x4){0.f, 0.f, 0.f, 0.f};
    bf16x8 At[4][2], B0[2][2], B1[2][2];
    const char* cA = (const char*)g.A + (size_t)cur.pm * tstep; const char* cB = (const char*)g.Bt + (size_t)cur.pn * tstep;
    S.a_ready(cur);
    PG8_STAGE(PG8_SB(0, 0), cB, voffB); PG8_STAGE(PG8_SA(0, 0), cA, voffA); PG8_STAGE(PG8_SB(0, 1), cB + hstep, voffB); PG8_STAGE(PG8_SA(0, 1), cA + hstep, voffA);
    if (wr == 1) PG8_BAR;
    PG8_WAIT_V(4); PG8_BAR;
    PG8_STAGE(PG8_SB(1, 0), cB + kstep, voffB); PG8_STAGE(PG8_SA(1, 0), cA + kstep, voffA); PG8_STAGE(PG8_SB(1, 1), cB + hstep + kstep, voffB);
    PG8_WAIT_V(6); PG8_BAR;
    PG8_STAMP();
    for (;;) {
        const bool has_next = S.next(ui + 1, nxt);
        const char* nA = has_next ? (const char*)g.A + (size_t)nxt.pm * tstep : cA; const char* nB = has_next ? (const char*)g.Bt + (size_t)nxt.pn * tstep : cB;
        for (int t = 0; t < nt; t += 2) {
            const bool last = (t == nt - 2);
            const char* a1 = cA + (size_t)(t + 1) * kstep;
            const char* a2 = last ? nA : cA + (size_t)(t + 2) * kstep; const char* b2 = last ? nB : cB + (size_t)(t + 2) * kstep;
            const char* a3 = a2 + kstep; const char* b3 = b2 + kstep;
            if (last && has_next) S.a_ready(nxt);
            PG8_LDB(B0, 0, 0); PG8_SCHED; PG8_LDA(At, 0, 0); PG8_STAGE(PG8_SA(1, 1), a1 + hstep, voffA);
            PG8_WAIT_L(8); PG8_BAR; PG8_WAIT_L(0); PG8_MMA(0, 0, At, B0); PG8_BAR; PG8_SCHED;
            PG8_LDB(B1, 0, 1); PG8_STAGE(PG8_SB(0, 0), b2, voffB);
            PG8_BAR; PG8_WAIT_L(0); PG8_MMA(0, 1, At, B1); PG8_BAR;
            PG8_LDA(At, 0, 1); PG8_STAGE(PG8_SA(0, 0), a2, voffA);
            PG8_BAR; PG8_WAIT_L(0); PG8_MMA(1, 0, At, B0); PG8_BAR; PG8_SCHED;
            PG8_STAGE(PG8_SB(0, 1), b2 + hstep, voffB);
            PG8_WAIT_V(6); PG8_BAR; PG8_MMA(1, 1, At, B1); PG8_BAR;
            PG8_LDB(B0, 1, 0); PG8_SCHED; PG8_LDA(At, 1, 0); PG8_STAGE(PG8_SA(0, 1), a2 + hstep, voffA);
            PG8_WAIT_L(8); PG8_BAR; PG8_WAIT_L(0); PG8_MMA(0, 0, At, B0); PG8_BAR; PG8_SCHED;
            PG8_LDB(B1, 1, 1); PG8_STAGE(PG8_SB(1, 0), b3, voffB);
            PG8_BAR; PG8_WAIT_L(0); PG8_MMA(0, 1, At, B1); PG8_BAR;
            PG8_LDA(At, 1, 1); PG8_STAGE(PG8_SA(1, 0), a3, voffA);
            PG8_BAR; PG8_WAIT_L(0); PG8_MMA(1, 0, At, B0); PG8_BAR; PG8_SCHED;
            PG8_STAGE(PG8_SB(1, 1), b3 + hstep, voffB);
            PG8_WAIT_V(6); PG8_BAR; PG8_MMA(1, 1, At, B1); PG8_BAR;
        }
        PG8_STAMP();
        if constexpr (!Epi::AFTER_DRAIN) { E(acc, cur, wr, wc, fr, fq); S.done(cur); }
        PG8_STAMP();
        if (!has_next) break;
#pragma unroll
        for (int a = 0; a < 2; ++a)
#pragma unroll
            for (int b = 0; b < 2; ++b)
#pragma unroll
                for (int m = 0; m < 4; ++m)
#pragma unroll
                    for (int n = 0; n < 2; ++n) acc[a][b][m][n] = (f32x4){0.f, 0.f, 0.f, 0.f};
        cur = nxt; cA = nA; cB = nB; ++ui;
    }
    PG8_WAIT_V(0);
    if (wr == 0) PG8_BAR;
    PG8_BAR;
    if constexpr (Epi::AFTER_DRAIN) { E.fused(acc, cur, wr, wc, fr, fq, lds, wid, lane); S.done(cur); }
    PG8_STAMP();
    if (STAMP && wid == 0) { stamps[lane] = lane < nts ? (((unsigned long long)(unsigned)ts_hi << 32) | (unsigned)ts_lo) : 0ull;
        if (lane == 62) stamps[62] = rt_entry; if (lane == 63) stamps[63] = (unsigned long long)wall_clock64(); }
#undef PG8_STAMP
#undef PG8_SA
#undef PG8_SB
#undef PG8_STAGE
#undef PG8_LDA
#undef PG8_LDB
#undef PG8_MMA
#undef PG8_WAIT_V
#undef PG8_WAIT_L
#undef PG8_BAR
#undef PG8_SCHED
}
typedef int i32x4 __attribute__((ext_vector_type(4)));
typedef int i32x8 __attribute__((ext_vector_type(8)));
struct Gemm8 { const unsigned char* A; const unsigned char* Bt; int M, N, K; int scale; };
template <class Epi, class Sched, bool STAMP = false>
__device__ __forceinline__ void gemm_phase8(PG8_LAS unsigned char* lds, const Gemm8 g, const Sched& S, const Epi& E, unsigned long long* stamps) {
    int tid_ = threadIdx.x; asm volatile("" : "+v"(tid_));
    const int tid = tid_, wid = __builtin_amdgcn_readfirstlane(tid >> 6), lane = tid & 63, wr = wid >> 2, wc = wid & 3, fr = lane & 15, fq = lane >> 4;
    const int K = g.K  , nt = K / 128;
    int ts_lo = 0, ts_hi = 0, nts = 0; const unsigned long long rt_entry = STAMP ? (unsigned long long)wall_clock64() : 0ull;
#define PG8_STAMP() do { if (STAMP && wid == 0 && nts < 64) { const unsigned long long _c = (unsigned long long)clock64(); \
        ts_lo = (lane == nts) ? (int)(unsigned)_c : ts_lo; ts_hi = (lane == nts) ? (int)(unsigned)(_c >> 32) : ts_hi; ++nts; } } while (0)
    PG8_STAMP();
    unsigned voffA[2], voffB[2];
#pragma unroll
    for (int i = 0; i < 2; ++i) { int R, C; stage_rc(tid * 16 + i * 8192, R, C); const int Rb = Epi::PERM ? ((R & ~31) + perm32(R & 31)) : R;
        voffA[i] = (unsigned)(R * K + 2 * C); voffB[i] = (unsigned)(Rb * K + 2 * C); }
    const size_t kstep = (size_t)(BK * 2);
    const size_t hstep = (size_t)HALF * K;
    const size_t tstep = 2 * hstep;
    const unsigned ldsw = (unsigned)wid * 1024u;
    const unsigned ldsdst = (unsigned)__builtin_amdgcn_readfirstlane((int)((unsigned)(size_t)lds + ldsw));
    const int aoff = lds_byte(wr * 64 + fr, fq * 16), boff = lds_byte(wc * 32 + fr, fq * 16);
#define PG8_SA(b, h) (((b) * 2 + (h)) * HTB)
#define PG8_SB(b, h) ((4 + (b) * 2 + (h)) * HTB)
#define PG8_STAGE(bufoff, gbase, voff) do { _Pragma("unroll") for (int _i = 0; _i < 2; ++_i) { unsigned keep_; \
        asm volatile("s_mov_b32 %0, m0\n\ts_mov_b32 m0, %3\n\ts_nop 0\n\tglobal_load_lds_dwordx4 %1, %2\n\ts_mov_b32 m0, %0" : "=&s"(keep_) : "v"((voff)[_i]), "s"((unsigned long long)(gbase)), "s"(ldsdst + (unsigned)((bufoff) + _i * 8192)) : "memory"); } } while (0)
#define PG8_LDA(dst, b, h) do { _Pragma("unroll") for (int m = 0; m < 4; ++m) { const i32x4 lo_ = *(const PG8_LAS i32x4*)(lds + PG8_SA(b, h) + aoff + m * 2048), hi_ = *(const PG8_LAS i32x4*)(lds + PG8_SA(b, h) + aoff + m * 2048 + 16); dst[m] = __builtin_shufflevector(lo_, hi_, 0, 1, 2, 3, 4, 5, 6, 7); } } while (0)
#define PG8_LDB(dst, b, h) do { _Pragma("unroll") for (int n = 0; n < 2; ++n) { const i32x4 lo_ = *(const PG8_LAS i32x4*)(lds + PG8_SB(b, h) + boff + n * 2048), hi_ = *(const PG8_LAS i32x4*)(lds + PG8_SB(b, h) + boff + n * 2048 + 16); dst[n] = __builtin_shufflevector(lo_, hi_, 0, 1, 2, 3, 4, 5, 6, 7); } } while (0)
#define PG8_MMA(ai, bj, At, Bt) do { __builtin_amdgcn_s_setprio(1); _Pragma("unroll") for (int m = 0; m < 4; ++m) _Pragma("unroll") for (int n = 0; n < 2; ++n) \
        acc[ai][bj][m][n] = __builtin_amdgcn_mfma_scale_f32_16x16x128_f8f6f4(Bt[n], At[m], acc[ai][bj][m][n], 0, 0, 0, g.scale, 0, 0x7f7f7f7f); __builtin_amdgcn_s_setprio(0); } while (0)
#define PG8_WAIT_V(n) asm volatile("s_waitcnt vmcnt(" #n ")" ::: "memory")
#define PG8_WAIT_L(n) asm volatile("s_waitcnt lgkmcnt(" #n ")" ::: "memory")
#define PG8_BAR __builtin_amdgcn_s_barrier()
#define PG8_SCHED __builtin_amdgcn_sched_barrier(0)
    Unit cur, nxt; int ui = 0;
    if (!S.next(0, cur)) return;
    f32x4 acc[2][2][4][2];
#pragma unroll
    for (int a = 0; a < 2; ++a)
#pragma unroll
        for (int b = 0; b < 2; ++b)
#pragma unroll
            for (int m = 0; m < 4; ++m)
#pragma unroll
                for (int n = 0; n < 2; ++n) acc[a][b][m][n] = (f32x4){0.f, 0.f, 0.f, 0.f};
    i32x8 At[4], B0[2], B1[2];
    const char* cA = (const char*)g.A + (size_t)cur.pm * tstep; const char* cB = (const char*)g.Bt + (size_t)cur.pn * tstep;
    S.a_ready(cur);
    PG8_STAGE(PG8_SB(0, 0), cB, voffB); PG8_STAGE(PG8_SA(0, 0), cA, voffA); PG8_STAGE(PG8_SB(0, 1), cB + hstep, voffB); PG8_STAGE(PG8_SA(0, 1), cA + hstep, voffA);
    if (wr == 1) PG8_BAR;
    PG8_WAIT_V(4); PG8_BAR;
    PG8_STAGE(PG8_SB(1, 0), cB + kstep, voffB); PG8_STAGE(PG8_SA(1, 0), cA + kstep, voffA); PG8_STAGE(PG8_SB(1, 1), cB + hstep + kstep, voffB);
    PG8_WAIT_V(6); PG8_BAR;
    PG8_STAMP();
    for (;;) {
        const bool has_next = S.next(ui + 1, nxt);
        const char* nA = has_next ? (const char*)g.A + (size_t)nxt.pm * tstep : cA; const char* nB = has_next ? (const char*)g.Bt + (size_t)nxt.pn * tstep : cB;
        for (int t = 0; t < nt; t += 2) {
            const bool last = (t == nt - 2);
            const char* a1 = cA + (size_t)(t + 1) * kstep;
            const char* a2 = last ? nA : cA + (size_t)(t + 2) * kstep; const char* b2 = last ? nB : cB + (size_t)(t + 2) * kstep;
            const char* a3 = a2 + kstep; const char* b3 = b2 + kstep;
            if (last && has_next) S.a_ready(nxt);
            PG8_LDB(B0, 0, 0); PG8_SCHED; PG8_LDA(At, 0, 0); PG8_STAGE(PG8_SA(1, 1), a1 + hstep, voffA);
            PG8_WAIT_L(8); PG8_BAR; PG8_WAIT_L(0); PG8_MMA(0, 0, At, B0); PG8_BAR; PG8_SCHED;
            PG8_LDB(B1, 0, 1); PG8_STAGE(PG8_SB(0, 0), b2, voffB);
            PG8_BAR; PG8_WAIT_L(0); PG8_MMA(0, 1, At, B1); PG8_BAR;
            PG8_LDA(At, 0, 1); PG8_STAGE(PG8_SA(0, 0), a2, voffA);
            PG8_BAR; PG8_WAIT_L(0); PG8_MMA(1, 0, At, B0); PG8_BAR; PG8_SCHED;
            PG8_STAGE(PG8_SB(0, 1), b2 + hstep, voffB);
            PG8_WAIT_V(6); PG8_BAR; PG8_MMA(1, 1, At, B1); PG8_BAR;
            PG8_LDB(B0, 1, 0); PG8_SCHED; PG8_LDA(At, 1, 0); PG8_STAGE(PG8_SA(0, 1), a2 + hstep, voffA);
            PG8_WAIT_L(8); PG8_BAR; PG8_WAIT_L(0); PG8_MMA(0, 0, At, B0); PG8_BAR; PG8_SCHED;
            PG8_LDB(B1, 1, 1); PG8_STAGE(PG8_SB(1, 0), b3, voffB);
            PG8_BAR; PG8_WAIT_L(0); PG8_MMA(0, 1, At, B1); PG8_BAR;
            PG8_LDA(At, 1, 1); PG8_STAGE(PG8_SA(1, 0), a3, voffA);
            PG8_BAR; PG8_WAIT_L(0); PG8_MMA(1, 0, At, B0); PG8_BAR; PG8_SCHED;
            PG8_STAGE(PG8_SB(1, 1), b3 + hstep, voffB);
            PG8_WAIT_V(6); PG8_BAR; PG8_MMA(1, 1, At, B1); PG8_BAR;
        }
        PG8_STAMP();
        if constexpr (!Epi::AFTER_DRAIN) { E(acc, cur, wr, wc, fr, fq); S.done(cur); }
        PG8_STAMP();
        if (!has_next) break;
#pragma unroll
        for (int a = 0; a < 2; ++a)
#pragma unroll
            for (int b = 0; b < 2; ++b)
#pragma unroll
                for (int m = 0; m < 4; ++m)
#pragma unroll
                    for (int n = 0; n < 2; ++n) acc[a][b][m][n] = (f32x4){0.f, 0.f, 0.f, 0.f};
        cur = nxt; cA = nA; cB = nB; ++ui;
    }
    PG8_WAIT_V(0);
    if (wr == 0) PG8_BAR;
    PG8_BAR;
    if constexpr (Epi::AFTER_DRAIN) { E.fused(acc, cur, wr, wc, fr, fq, lds, wid, lane); S.done(cur); }
    PG8_STAMP();
    if (STAMP && wid == 0) { stamps[lane] = lane < nts ? (((unsigned long long)(unsigned)ts_hi << 32) | (unsigned)ts_lo) : 0ull;
        if (lane == 62) stamps[62] = rt_entry; if (lane == 63) stamps[63] = (unsigned long long)wall_clock64(); }
#undef PG8_STAMP
#undef PG8_SA
#undef PG8_SB
#undef PG8_STAGE
#undef PG8_LDA
#undef PG8_LDB
#undef PG8_MMA
#undef PG8_WAIT_V
#undef PG8_WAIT_L
#undef PG8_BAR
#undef PG8_SCHED
}
}
#define XB_TMO      128
#define XB_XCNT(j)  (256  + 64 * (j))
#define XB_XSUB(j)  (1280 + 64 * (j))
#define XB_XGEN(j)  (2304 + 64 * (j))
#define XB_TOP      3328
#define XB_TOPGEN   3392
#define XCD_BAR_WORDS 3456
#define XB_SPIN_CAP (1u << 23)
#define LAS __attribute__((address_space(3)))

__device__ __forceinline__ unsigned xb_ld(unsigned* p)              { return __hip_atomic_load(p, __ATOMIC_RELAXED, __HIP_MEMORY_SCOPE_AGENT); }
__device__ __forceinline__ unsigned xb_add(unsigned* p, unsigned v) { return __hip_atomic_fetch_add(p, v, __ATOMIC_RELAXED, __HIP_MEMORY_SCOPE_AGENT); }
__device__ __forceinline__ unsigned xb_xcc_id() { return (unsigned)__builtin_amdgcn_s_getreg((3 << 11) | 20) & 0xFu; }
#define XB_SPIN(cond, bar) do { unsigned _sp = 0; while (cond) { __builtin_amdgcn_s_sleep(1); \
    if ((++_sp & 255u) == 0u) { if (xb_ld(&(bar)[XB_TMO])) break; if (_sp > XB_SPIN_CAP) { atomicAdd(&(bar)[XB_TMO], 1u); break; } } } } while (0)

struct XcdBarrier {
    unsigned* bar; unsigned x;
    volatile LAS unsigned* st;
};

__device__ __forceinline__ XcdBarrier xcd_barrier_post(unsigned* bar, volatile LAS unsigned* st) {
    XcdBarrier b; b.bar = bar; b.x = xb_xcc_id(); b.st = st;
    if (threadIdx.x == 0) (void)xb_add(&bar[XB_XCNT(b.x)], 1u);
    return b;
}
__device__ __forceinline__ void xcd_barrier_complete(unsigned* bar, unsigned x, unsigned& nloc, unsigned& nx) {
    const unsigned G = gridDim.x * gridDim.y * gridDim.z;
    unsigned sum, cnt, mine, sp = 0u;
    for (;;) {
        sum = 0u; cnt = 0u; mine = 0u;
#pragma unroll
        for (unsigned j = 0; j < 16; ++j) { const unsigned c = xb_ld(&bar[XB_XCNT(j)]); sum += c; cnt += (c > 0u) ? 1u : 0u; mine = (j == x) ? c : mine; }
        if (sum == G) break;
        __builtin_amdgcn_s_sleep(1);
        if ((++sp & 255u) == 0u) { if (xb_ld(&bar[XB_TMO])) break; if (sp > XB_SPIN_CAP) { atomicAdd(&bar[XB_TMO], 1u); break; } }
    }
    nloc = mine > 0u ? mine : 1u; nx = cnt > 0u ? cnt : 1u;
}

__device__ __forceinline__ void xcd_barrier(const XcdBarrier& b) {
    asm volatile("s_waitcnt vmcnt(0)" ::: "memory");
    __syncthreads();
    if (threadIdx.x == 0) {
        unsigned* bar = b.bar; asm volatile("" : "+s"(bar));
        __builtin_amdgcn_s_waitcnt(0);
        unsigned nloc = b.st[0], nx = b.st[1];
        if (nloc == 0u) { xcd_barrier_complete(bar, b.x, nloc, nx); b.st[0] = nloc; b.st[1] = nx; }
        const unsigned old = xb_add(&bar[XB_XSUB(b.x)], 1u);
        const unsigned gen = old / nloc;
        if (old + 1u == (gen + 1u) * nloc) {
            __builtin_amdgcn_fence(__ATOMIC_RELEASE, "agent");
            asm volatile("s_waitcnt vmcnt(0)" ::: "memory");
            const unsigned og = xb_add(&bar[XB_TOP], 1u);
            const unsigned tg = og / nx;
            if (og + 1u == (tg + 1u) * nx) xb_add(&bar[XB_TOPGEN], 1u);
            else XB_SPIN(xb_ld(&bar[XB_TOPGEN]) == tg, bar);
            __builtin_amdgcn_fence(__ATOMIC_ACQUIRE, "agent");
            xb_add(&bar[XB_XGEN(b.x)], 1u);
            asm volatile("s_waitcnt vmcnt(0)" ::: "memory");
        } else {
            XB_SPIN(xb_ld(&bar[XB_XGEN(b.x)]) == gen, bar);
            __builtin_amdgcn_fence(__ATOMIC_ACQUIRE, "agent");
            asm volatile("s_waitcnt vmcnt(0)" ::: "memory");
        }
    }
    __syncthreads();
}
#define GAS __attribute__((address_space(1)))
typedef unsigned short bf16;
typedef float f32x4 __attribute__((ext_vector_type(4)));
typedef unsigned u32x4 __attribute__((ext_vector_type(4)));
typedef unsigned u32x2 __attribute__((ext_vector_type(2)));
typedef LAS float lfloat;
typedef LAS f32x4 lf32x4;

constexpr int DM = 4096, NB = 4, NMETA = 16, LT = 4112, TT = NB * LT  , MP = 16640  ;
constexpr int PN = 11008;
constexpr int C_R = 0, C_K = 1536, C_V = 3072, C_WL = 4608, C_SQ = 4864, C_SK = 6400, C_SV = 6592, C_HQ = 6912, C_HF = 7936, C_HI = 8960, C_HG = 9984;
constexpr int NE = 16384;
constexpr int NHR = 24;
constexpr int NCH = 66;

constexpr size_t MiB = 1ull << 20;
constexpr size_t WS_CTL = 0, WS_WIN = 2 * MiB, WS_WO = 88 * MiB, WS_WS = 120 * MiB, WS_U = 136 * MiB  , WS_VT = 200 * MiB  , WS_HN8 = 264 * MiB  , WS_H = 392 * MiB, WS_Z = 652 * MiB, WS_R = 782 * MiB;
constexpr size_t WS_PROJ = WS_R, WS_RA = 1132 * MiB, WS_RG = 1711 * MiB, WS_RY = 1760 * MiB, WS_HDS = 1809 * MiB, WS_HQG = 1875 * MiB, WS_HAT = 1908 * MiB, WS_HED = 1941 * MiB, WS_END = 1975 * MiB;
constexpr size_t WS_CHB = 1943 * MiB;
constexpr size_t WS_ME = 1 * MiB + 832 * 1024;
constexpr size_t WS_HM = WS_ME + 64 * 1024;
constexpr size_t WS_LW = 1 * MiB;
constexpr size_t WS_GG = WS_R, WS_SC = 1302 * MiB, WS_HG8 = 1432 * MiB  ;
constexpr size_t WS_BM = 1700 * MiB;
static_assert(WS_WIN + (size_t)PN * DM * 2 <= WS_WO && WS_WO + (size_t)DM * DM * 2 <= WS_WS && WS_WS + (size_t)2048 * DM * 2 <= WS_U && WS_U + (size_t)NE * DM <= WS_VT && WS_VT + (size_t)NE * DM <= WS_HN8 && WS_HN8 + (size_t)MP * DM <= WS_H, "ws map 1");
static_assert(WS_H + (size_t)MP * DM * 4 <= WS_Z && WS_Z + (size_t)MP * DM * 2 <= WS_R, "ws map 2");
static_assert(WS_PROJ + (size_t)MP * PN * 2 <= WS_RA && WS_RA + (size_t)96 * LT * 384 * 4 <= WS_RG && WS_RG + (size_t)TT * 1536 * 2 <= WS_RY && WS_RY + (size_t)TT * 1536 * 2 <= WS_HDS, "ws map 3");
static_assert(WS_HDS + (size_t)32 * NCH * 16384 * 2 <= WS_HQG && WS_HQG + (size_t)32 * NCH * 8192 * 2 <= WS_HAT && WS_HAT + (size_t)32 * NCH * 4096 * 4 <= WS_HED && WS_HED + (size_t)32 * NCH * 128 * 4 <= WS_END, "ws map 4");
static_assert(WS_GG + (size_t)MP * NE * 2 <= WS_SC && WS_SC + (size_t)MP * 2048 * 4 <= WS_HG8 && WS_HG8 + (size_t)MP * NE <= WS_BM && WS_BM + (size_t)16384 * 64 * 4 <= WS_END, "ws map 5");

constexpr int LDS_BYTES = 147456;
constexpr int LDS_MISC = 143360;
constexpr int CW_BAR = 4096;
constexpr int CW_HL = 8192 + 128;
constexpr int CW_M2 = 8192 + 512;
constexpr int CW_HG = 8192;
constexpr size_t CTL_ZERO_BYTES = 64 * 1024;

__device__ __forceinline__ float bf2f(unsigned b) { return __uint_as_float(b << 16); }
typedef __bf16 bf16x2_t __attribute__((ext_vector_type(2)));
typedef float f32x2_t __attribute__((ext_vector_type(2)));
__device__ __forceinline__ unsigned pk2(float lo, float hi) { const f32x2_t v = {lo, hi}; const bf16x2_t r = __builtin_convertvector(v, bf16x2_t); return __builtin_bit_cast(unsigned, r); }
__device__ __forceinline__ unsigned f2bf(float f) { return pk2(f, 0.0f) & 0xffffu; }
__device__ __forceinline__ unsigned pk4_fp8(float a, float b, float c, float d) {
    a = __builtin_amdgcn_fmed3f(a, -448.f, 448.f); b = __builtin_amdgcn_fmed3f(b, -448.f, 448.f); c = __builtin_amdgcn_fmed3f(c, -448.f, 448.f); d = __builtin_amdgcn_fmed3f(d, -448.f, 448.f);
    int v = __builtin_amdgcn_cvt_pk_fp8_f32(a, b, 0, false); v = __builtin_amdgcn_cvt_pk_fp8_f32(c, d, v, true); return (unsigned)v;
}
constexpr float U8_SCALE = 64.f, V8_SCALE = 8.f, HG8_SCALE = 64.f;
constexpr int U8_E8M0 = 0x79797979  , V8_E8M0 = 0x76767676  ;
constexpr float MX8_SCALE = 8.f, WO8_SCALE = 128.f; constexpr int WO8_E8M0 = 0x75757575  ;
constexpr size_t WS_MX8 = WS_HN8  , WS_WO8 = 332 * MiB  ;
constexpr size_t WS_U1 = 1976 * MiB  , WS_END2 = 2040 * MiB;
static_assert(WS_END <= WS_U1 && WS_U1 + (size_t)NE * DM <= WS_END2, "ws map 7");
static_assert(WS_HN8 + (size_t)MP * DM <= WS_WO8 && WS_WO8 + (size_t)DM * DM <= WS_H, "ws map 6");
__device__ __forceinline__ unsigned char fp8_1(float a) { a = __builtin_amdgcn_fmed3f(a, -448.f, 448.f); return (unsigned char)(__builtin_amdgcn_cvt_pk_fp8_f32(a, 0.f, 0, false) & 0xff); }
#define LDS_WAIT() asm volatile("s_waitcnt lgkmcnt(0)" ::: "memory")
__device__ __forceinline__ float wave_sum(float v) {
#pragma unroll
    for (int o = 1; o < 64; o <<= 1) v += __shfl_xor(v, o);
    return v;
}
template <int CTRL> __device__ __forceinline__ float dpp_mov(float x) { return __int_as_float(__builtin_amdgcn_update_dpp(0, __float_as_int(x), CTRL, 0xF, 0xF, false)); }
__device__ __forceinline__ float rowsum16(float x) {
    x += dpp_mov<0xB1>(x); x += dpp_mov<0x4E>(x); x += dpp_mov<0x141>(x); x += dpp_mov<0x140>(x); return x;
}
__device__ __forceinline__ void rope_sc(float pos, int j, float& sn, float& cs) {
    const float ang = pos * exp2f(-(float)j * 2.3664460711655218f);
    float rev = ang * 0.15915494309189535f; rev = rev - floorf(rev);
    sn = __builtin_amdgcn_sinf(rev); cs = __builtin_amdgcn_cosf(rev);
}
__device__ __forceinline__ float sigmoidf_(float x) { return 1.0f / (1.0f + __expf(-x)); }

__device__ __forceinline__ int ltid() { int t = threadIdx.x; asm volatile("" : "+v"(t)); return t; }
__device__ __forceinline__ int ROWOF(int b, int t) { return t >= NMETA ? b * 4096 + (t - NMETA) : 16384 + b * NMETA + t; }
constexpr int MAIN_ROWS = 16384;
struct Ctx {
    const float* in[25];
    float* out;
    unsigned char* ws;
    int ph_lo, ph_hi;
};
typedef const __attribute__((address_space(4))) Ctx CtxK;
__device__ __forceinline__ Ctx load_ctx() { CtxK* p = (CtxK*)__builtin_amdgcn_kernarg_segment_ptr(); asm volatile("" : "+s"(p)); Ctx c;
#pragma unroll
    for (int i = 0; i < 25; ++i) c.in[i] = p->in[i];
    c.out = p->out; c.ws = p->ws; c.ph_lo = p->ph_lo; c.ph_hi = p->ph_hi; return c; }
#define LOAD_CTX() const Ctx C = load_ctx()
__device__ __forceinline__ int uni_launder(int x) { int y = __builtin_amdgcn_readfirstlane(x); asm volatile("" : "+s"(y)); return y; }
#define UNI(x) uni_launder(x)
#define UNI_LDS(p) ((LAS unsigned char*)(uintptr_t)(unsigned)__builtin_amdgcn_readfirstlane((int)(unsigned)(uintptr_t)(p)))
enum { I_X = 0, I_META, I_NMIX, I_NFFN, I_NFIN, I_WIN, I_WOUT, I_MU, I_W0, I_W2, I_A0, I_A2, I_G2, I_KK, I_KA, I_RK, I_LNW, I_LNB, I_SINK, I_HLB, I_HNORM, I_WQ, I_KEYS, I_PU, I_PV };

namespace pg8 {
struct EpiResF32 {
    static constexpr bool PERM = false, AFTER_DRAIN = false;
    float* H; int ldc; const float* Src;
    __device__ __forceinline__ void operator()(const f32x4 (&acc)[2][2][4][2], const Unit& u, int wr, int wc, int fr, int fq) const {
        const int row0 = u.pm * BM + wr * 64 + fr, col0 = u.pn * BM + wc * 32 + 4 * fq;
#pragma unroll
        for (int ai = 0; ai < 2; ++ai)
#pragma unroll
            for (int m = 0; m < 4; ++m) { float* rowp = H + (size_t)(row0 + ai * HALF + m * 16) * ldc + col0; const float* srcp = Src + (size_t)(row0 + ai * HALF + m * 16) * ldc + col0;
                f32x4 old[2][2];
#pragma unroll
                for (int bj = 0; bj < 2; ++bj)
#pragma unroll
                    for (int n = 0; n < 2; ++n) old[bj][n] = *(const f32x4*)(srcp + bj * HALF + n * 16);
#pragma unroll
                for (int bj = 0; bj < 2; ++bj)
#pragma unroll
                    for (int n = 0; n < 2; ++n) *(f32x4*)(rowp + bj * HALF + n * 16) = old[bj][n] + acc[ai][bj][m][n]; }
    }
};
struct EpiGate8 {
    static constexpr bool PERM = true, AFTER_DRAIN = false;
    unsigned char* wsb;
    __device__ __forceinline__ void operator()(const f32x4 (&acc)[2][2][4][2], const Unit& u, int wr, int wc, int fr_, int fq_) const {
        (void)fr_; (void)fq_; int ln = (int)__builtin_amdgcn_workitem_id_x() & 63; asm volatile("" : "+v"(ln)); const int fr = ln & 15, fq = ln >> 4;
        const bf16_t* G = (const bf16_t*)(wsb + WS_GG); unsigned char* Hg = wsb + WS_HG8; const unsigned* Bm = (const unsigned*)(wsb + WS_BM); constexpr int ldc = NE;
        const int row0 = u.pm * BM + wr * 64 + fr, col0 = u.pn * BM + wc * 32 + 8 * fq;
#pragma unroll
        for (int ai = 0; ai < 2; ++ai)
#pragma unroll
            for (int m = 0; m < 4; ++m) { const size_t ro = (size_t)(row0 + ai * HALF + m * 16) * ldc + col0;
                const unsigned bits = Bm[(size_t)(row0 + ai * HALF + m * 16) * 64 + u.pn];
#pragma unroll
                for (int bj = 0; bj < 2; ++bj) {
                    u32x2 w = (u32x2){0u, 0u};
                    if ((bits >> (16 * bj + 4 * wc + fq)) & 1u) {
                        const u32x4 g = *(const u32x4*)(G + ro + bj * HALF);
                        const f32x4 v0 = acc[ai][bj][m][0], v1 = acc[ai][bj][m][1];
                        const f32x2 a = gelu_pk((f32x2){v0[0], v0[1]}), b = gelu_pk((f32x2){v0[2], v0[3]}), c = gelu_pk((f32x2){v1[0], v1[1]}), d = gelu_pk((f32x2){v1[2], v1[3]});
                        w.x = pk4_fp8(64.f * a.x * __uint_as_float(g.x << 16), 64.f * a.y * __uint_as_float(g.x & 0xffff0000u), 64.f * b.x * __uint_as_float(g.y << 16), 64.f * b.y * __uint_as_float(g.y & 0xffff0000u));
                        w.y = pk4_fp8(64.f * c.x * __uint_as_float(g.z << 16), 64.f * c.y * __uint_as_float(g.z & 0xffff0000u), 64.f * d.x * __uint_as_float(g.w << 16), 64.f * d.y * __uint_as_float(g.w & 0xffff0000u));
                    }
                    *(u32x2*)(Hg + ro + bj * HALF) = w;
                }
                __builtin_amdgcn_sched_barrier(0); }
    }
};
}

__device__ __forceinline__ void tr_load_tile(const float* W, int N, int k0, int n0, lfloat* scr, int lane) {
    const int q = lane & 15, r = lane >> 4;
    f32x4 v[16];
#pragma unroll
    for (int i = 0; i < 16; ++i) v[i] = *(const f32x4*)(W + (size_t)(k0 + r + 4 * i) * N + n0 + 4 * q);
#pragma unroll
    for (int i = 0; i < 16; ++i) { lfloat* d = scr + (r + 4 * i) * 65 + 4 * q; d[0] = v[i].x; d[1] = v[i].y; d[2] = v[i].z; d[3] = v[i].w; }
    LDS_WAIT();
}
__device__ __forceinline__ void transpose_item(const float* W, int N, bf16* WT, int Kp, int k0, int n0, int dst_row0, lfloat* scr, int lane) {
    tr_load_tile(W, N, k0, n0, scr, lane);
    const int c = lane & 7, nn = lane >> 3;
#pragma unroll
    for (int p = 0; p < 8; ++p) { const int n = 8 * p + nn; const lfloat* s = scr + (8 * c) * 65 + n;
        u32x4 o; o.x = pk2(s[0 * 65], s[1 * 65]); o.y = pk2(s[2 * 65], s[3 * 65]); o.z = pk2(s[4 * 65], s[5 * 65]); o.w = pk2(s[6 * 65], s[7 * 65]);
        *(u32x4*)(WT + (size_t)(dst_row0 + n) * Kp + k0 + 8 * c) = o; }
    LDS_WAIT();
}
__device__ __forceinline__ void transpose_item8(const float* W, int N, unsigned char* WT, int Kp, int k0, int n0, float sc, lfloat* scr, int lane) {
    tr_load_tile(W, N, k0, n0, scr, lane);
    const int c = lane & 3, nn = lane >> 2;
#pragma unroll
    for (int p = 0; p < 4; ++p) { const int n = 16 * p + nn; const lfloat* s = scr + (16 * c) * 65 + n;
        u32x4 o; o.x = pk4_fp8(s[0 * 65] * sc, s[1 * 65] * sc, s[2 * 65] * sc, s[3 * 65] * sc); o.y = pk4_fp8(s[4 * 65] * sc, s[5 * 65] * sc, s[6 * 65] * sc, s[7 * 65] * sc);
        o.z = pk4_fp8(s[8 * 65] * sc, s[9 * 65] * sc, s[10 * 65] * sc, s[11 * 65] * sc); o.w = pk4_fp8(s[12 * 65] * sc, s[13 * 65] * sc, s[14 * 65] * sc, s[15 * 65] * sc);
        *(u32x4*)(WT + (size_t)(n0 + n) * Kp + k0 + 16 * c) = o; }
    LDS_WAIT();
}
__device__ __forceinline__ void norm_row(const float* src, const float* gain, bf16* dst, float* hdst, int lane, unsigned char* dst8 = nullptr) {
    const f32x4* xr = (const f32x4*)src + lane;
    f32x4 v[16]; float ss = 0.f;
#pragma unroll
    for (int j = 0; j < 16; ++j) { v[j] = xr[64 * j]; ss += (v[j].x * v[j].x + v[j].y * v[j].y) + (v[j].z * v[j].z + v[j].w * v[j].w); }
    ss = wave_sum(ss);
    const float r = rsqrtf(ss * (1.0f / 4096.0f) + 1e-5f);
    const f32x4* gr = (const f32x4*)gain + lane;
    u32x2* o8 = (u32x2*)dst + lane;
#pragma unroll
    for (int j = 0; j < 16; ++j) { const f32x4 g = gr[64 * j]; const f32x4 y = (f32x4){v[j].x * r * g.x, v[j].y * r * g.y, v[j].z * r * g.z, v[j].w * r * g.w};
        u32x2 o; o.x = pk2(y.x, y.y); o.y = pk2(y.z, y.w); o8[64 * j] = o;
        if (dst8) ((unsigned*)dst8)[lane + 64 * j] = pk4_fp8(y.x, y.y, y.z, y.w); }
    if (hdst) { f32x4* hr = (f32x4*)hdst + lane;
#pragma unroll
        for (int j = 0; j < 16; ++j) hr[64 * j] = v[j]; }
}

#define ROW_LOAD16(v_, p_) do { const f32x4* xr_ = (const f32x4*)(p_) + lane; _Pragma("unroll") for (int j_ = 0; j_ < 16; ++j_) v_[j_] = xr_[64 * j_]; } while (0)
__device__ __forceinline__ void norm_row_fin(const f32x4 (&v)[16], const f32x4 (&gn)[16], bf16* dst, float* hdst, int lane, unsigned char* dst8) {
    float ss = 0.f;
#pragma unroll
    for (int j = 0; j < 16; ++j) ss += (v[j].x * v[j].x + v[j].y * v[j].y) + (v[j].z * v[j].z + v[j].w * v[j].w);
    ss = wave_sum(ss);
    const float r = rsqrtf(ss * (1.0f / 4096.0f) + 1e-5f);
    u32x2* o8 = (u32x2*)dst + lane;
#pragma unroll
    for (int j = 0; j < 16; ++j) { const f32x4 g = gn[j]; const f32x4 y = (f32x4){v[j].x * r * g.x, v[j].y * r * g.y, v[j].z * r * g.z, v[j].w * r * g.w};
        u32x2 o; o.x = pk2(y.x, y.y); o.y = pk2(y.z, y.w); o8[64 * j] = o;
        if (dst8) ((unsigned*)dst8)[lane + 64 * j] = pk4_fp8(y.x, y.y, y.z, y.w); }
    if (hdst) { f32x4* hr = (f32x4*)hdst + lane;
#pragma unroll
        for (int j = 0; j < 16; ++j) hr[64 * j] = v[j]; }
}
template <class SrcOf, class Fin>
__device__ __forceinline__ void rows_pipe(int first, int stride, int n, int lane, SrcOf src_of, Fin fin) {
    f32x4 va[16], vb[16];
    int m = first;
    if (m < n) ROW_LOAD16(va, src_of(m));
    while (m < n) {
        const int m2 = m + stride;
        if (m2 < n) ROW_LOAD16(vb, src_of(m2));
        fin(va, m);
        if (m2 >= n) break;
        const int m3 = m2 + stride;
        if (m3 < n) ROW_LOAD16(va, src_of(m3));
        fin(vb, m2);
        m = m3;
    }
}

__device__ __forceinline__ void u8_item(const float* pu, unsigned char* U8, int r, int lane) {
    const size_t e0 = (size_t)r * 8192;
#pragma unroll 2
    for (int j = 0; j < 8; ++j) { const size_t e = e0 + (size_t)(j * 64 + lane) * 16;
        const f32x4 a = *(const f32x4*)(pu + e), b2 = *(const f32x4*)(pu + e + 4), c2 = *(const f32x4*)(pu + e + 8), d2 = *(const f32x4*)(pu + e + 12);
        u32x4 o; o.x = pk4_fp8(a.x * U8_SCALE, a.y * U8_SCALE, a.z * U8_SCALE, a.w * U8_SCALE); o.y = pk4_fp8(b2.x * U8_SCALE, b2.y * U8_SCALE, b2.z * U8_SCALE, b2.w * U8_SCALE);
        o.z = pk4_fp8(c2.x * U8_SCALE, c2.y * U8_SCALE, c2.z * U8_SCALE, c2.w * U8_SCALE); o.w = pk4_fp8(d2.x * U8_SCALE, d2.y * U8_SCALE, d2.z * U8_SCALE, d2.w * U8_SCALE);
        *(u32x4*)(U8 + e) = o; }
}
__device__ __forceinline__ void win_item(const float* w_in, bf16* WinT, int r, lfloat* scr, int lane) {
    if (r < 64 * 170) { const int kb = r / 170, nb = r % 170, n0 = 64 * nb; transpose_item(w_in, 10880, WinT, DM, 64 * kb, n0, n0 < 6784 ? n0 : n0 + 128, scr, lane); return; }
    u32x4* z = (u32x4*)(WinT + (size_t)6784 * DM) + (size_t)(r - 64 * 170) * 1024 + lane;
#pragma unroll
    for (int j = 0; j < 16; ++j) z[64 * j] = (u32x4){0u, 0u, 0u, 0u};
}
constexpr int CT_U = 512, CT_W = (64 * 170 + 64) / 8, CT_O = 64 * 64 / 8, CT_V = 256 * 64 / 8;
__device__ __forceinline__ constexpr int conv_tickets(int l) { return l == 0 ? CT_U + CT_W + CT_U + CT_O + CT_V : CT_O + CT_V; }
__device__ __forceinline__ void conv_ticket(int l_, int x_, LAS unsigned char* lds_) {
    LOAD_CTX(); const int l = UNI(l_); int x = UNI(x_); LAS unsigned char* lds = UNI_LDS(lds_);
    const int tid = ltid(), lane = tid & 63, wave = UNI(tid >> 6);
    lfloat* scr = (lfloat*)(lds + wave * 16896);
    if (l == 0) {
        if (x < CT_U) { const float* pu1 = C.in[I_PU] + (size_t)NE * DM;
            u8_item(pu1, C.ws + WS_U1, 16 * x + 2 * wave, lane); u8_item(pu1, C.ws + WS_U1, 16 * x + 2 * wave + 1, lane); return; }
        x -= CT_U;
        if (x < CT_W) { win_item(C.in[I_WIN] + (size_t)DM * 10880, (bf16*)(C.ws + WS_WIN), 8 * x + wave, scr, lane); return; }
        x -= CT_W;
        if (x < CT_U) { u8_item(C.in[I_PU], C.ws + WS_U, 16 * x + 2 * wave, lane); u8_item(C.in[I_PU], C.ws + WS_U, 16 * x + 2 * wave + 1, lane); return; }
        x -= CT_U;
    }
    if (x < CT_O) { const int r = 8 * x + wave, kb = r / 64, nb = r % 64; const float* w_out = C.in[I_WOUT] + (size_t)l * DM * DM;
        transpose_item8(w_out, DM, C.ws + WS_WO8, DM, 64 * kb, 64 * nb, WO8_SCALE, scr, lane);
        if (l == 0) transpose_item(w_out, DM, (bf16*)(C.ws + WS_WO), DM, 64 * kb, 64 * nb, 64 * nb, scr, lane);
        return; }
    x -= CT_O;
    { const int r = 8 * x + wave, kb = r / 64, nb = r % 64; transpose_item8(C.in[I_PV] + (size_t)l * NE * DM, DM, C.ws + WS_VT, NE, 64 * kb, 64 * nb, V8_SCALE, scr, lane); }
}

__device__ __forceinline__ void phase_conv_norm(int l_, LAS unsigned char* lds_) {
    LOAD_CTX(); const int l = UNI(l_); LAS unsigned char* lds = UNI_LDS(lds_);
    const int tid = ltid(), lane = tid & 63, wave = tid >> 6;
    const int gw = blockIdx.x * 8 + wave, NGW = gridDim.x * 8;
    unsigned char* ws = C.ws;
    bf16* WinT = (bf16*)(ws + WS_WIN); bf16* WoT = (bf16*)(ws + WS_WO); bf16* WsT = (bf16*)(ws + WS_WS); unsigned char* U8 = ws + WS_U; unsigned char* VT8 = ws + WS_VT;
    float* H = (float*)(ws + WS_H); bf16* Z = (bf16*)(ws + WS_Z);
    const float* w_in = C.in[I_WIN] + (size_t)l * DM * 10880;
    const float* w_out = C.in[I_WOUT] + (size_t)l * DM * DM;
    const float* wq = C.in[I_WQ] + (size_t)l * DM * 2048;
    const float* keys = C.in[I_KEYS] + (size_t)l * 16 * 128 * 128;
    const float* pu = C.in[I_PU] + (size_t)l * NE * DM;
    const float* pv = C.in[I_PV] + (size_t)l * NE * DM;
    lfloat* scr = (lfloat*)(lds + wave * 16896);
    const bool tick = (gridDim.x == 256), early = (l == 1 && tick);
    constexpr int I_WIN_N = 64 * 170, I_WO_N = 64 * 64, I_VT_N = 256 * 64, I_U_N = 8192, I_ZW_N = 64, I_NORM_N = TT, I_ZP_N = MP - TT;
    constexpr int NITEMS = I_WIN_N + I_WO_N + I_VT_N + I_U_N + I_ZW_N + I_NORM_N + I_ZP_N;
    {
        const int gwu = UNI(gw);
        f32x4 gn[16]; { const f32x4* gr = (const f32x4*)(C.in[I_NMIX] + (l == 0 ? 0 : DM)) + lane;
#pragma unroll
            for (int j = 0; j < 16; ++j) gn[j] = gr[64 * j]; }
        rows_pipe(gwu, NGW, I_NORM_N, lane,
            [&](int m) -> const float* { if (l != 0) return H + (size_t)m * DM;
                const int b = m < MAIN_ROWS ? (m >> 12) : ((m - MAIN_ROWS) >> 4), t = m < MAIN_ROWS ? (m & 4095) + NMETA : ((m - MAIN_ROWS) & 15);
                return (t < NMETA) ? C.in[I_META] + (size_t)t * DM : C.in[I_X] + ((size_t)b * 4096 + (t - NMETA)) * DM; },
            [&](const f32x4 (&v)[16], int m) { norm_row_fin(v, gn, Z + (size_t)m * DM, (l == 0 && m >= MAIN_ROWS) ? H + (size_t)m * DM : nullptr, lane, nullptr); });
    }
    int it0 = gw; while (it0 < I_NORM_N) it0 += NGW;
    for (int it = it0; it < NITEMS; it += NGW) {
        int r = it;
        r -= I_NORM_N;
        if (r < I_ZP_N) {
            const int m = TT + r; u32x4* z = (u32x4*)(Z + (size_t)m * DM) + lane;
#pragma unroll
            for (int j = 0; j < 8; ++j) z[64 * j] = (u32x4){0u, 0u, 0u, 0u};
            if (l == 0) { f32x4* hz = (f32x4*)(H + (size_t)m * DM) + lane;
#pragma unroll
                for (int j = 0; j < 16; ++j) hz[64 * j] = (f32x4){0.f, 0.f, 0.f, 0.f}; }
            continue; }
        r -= I_ZP_N;
        if (r < I_WIN_N) { if (!early) win_item(w_in, WinT, r, scr, lane); continue; }
        r -= I_WIN_N;
        if (r < I_WO_N) { if (tick) continue; const int kb = r / 64, nb = r % 64; transpose_item8(w_out, DM, ws + WS_WO8, DM, 64 * kb, 64 * nb, WO8_SCALE, scr, lane);
            if (l == 0) transpose_item(w_out, DM, WoT, DM, 64 * kb, 64 * nb, 64 * nb, scr, lane);
            continue; }
        r -= I_WO_N;
        if (r < I_VT_N) { if (tick) continue; const int kb = r / 64, nb = r % 64; transpose_item8(pv, DM, VT8, NE, 64 * kb, 64 * nb, V8_SCALE, scr, lane); continue; }
        r -= I_VT_N;
        if (r < I_U_N) { if (!tick) u8_item(pu, U8, r, lane); continue; }
        r -= I_U_N;
        if (!early) win_item(w_in, WinT, 64 * 170 + r, scr, lane);
    }
    {
        bf16* LW = (bf16*)(ws + WS_LW);
        const float* w2 = C.in[I_W2] + (size_t)l * 64 * 1536; const float* a2 = C.in[I_A2] + (size_t)l * 64 * 1536; const float* g2 = C.in[I_G2] + (size_t)l * 128 * 1536;
        for (int e = blockIdx.x * 512 + tid; e < 256 * 1536; e += gridDim.x * 512) { const int k = e / 1536, n = e - k * 1536;
            const float v = k < 64 ? w2[k * 1536 + n] : (k < 128 ? a2[(k - 64) * 1536 + n] : g2[(k - 128) * 1536 + n]);
            LW[n * 256 + k] = (bf16)f2bf(v); }
    }
    {
        const int wv = UNI(tid >> 6), fr = lane & 15, g4 = lane >> 4;
        for (int u = blockIdx.x; u < 1024; u += gridDim.x) {
            const int hc = u >> 6, k0 = (u & 63) * 64;
            const float* kp_ = keys + (size_t)hc * 16384 + (size_t)(16 * wv + fr) * 128 + 8 * g4;
            pg8::bf16x8 Af[4];
#pragma unroll
            for (int ks = 0; ks < 4; ++ks) { const f32x4 x = *(const f32x4*)(kp_ + 32 * ks), y = *(const f32x4*)(kp_ + 32 * ks + 4);
                const u32x4 wq_ = (u32x4){pk2(x.x, x.y), pk2(x.z, x.w), pk2(y.x, y.y), pk2(y.z, y.w)}; Af[ks] = (pg8::bf16x8)wq_; }
#pragma unroll
            for (int nt = 0; nt < 4; ++nt) {
                const float* wp = wq + (size_t)(k0 + 16 * nt + fr) * 2048 + hc * 128 + 8 * g4;
                f32x4 d = (f32x4){0.f, 0.f, 0.f, 0.f};
#pragma unroll
                for (int ks = 0; ks < 4; ++ks) { const f32x4 x = *(const f32x4*)(wp + 32 * ks), y = *(const f32x4*)(wp + 32 * ks + 4);
                    const u32x4 bw = (u32x4){pk2(x.x, x.y), pk2(x.z, x.w), pk2(y.x, y.y), pk2(y.z, y.w)};
                    d = __builtin_amdgcn_mfma_f32_16x16x32_bf16(Af[ks], (pg8::bf16x8)bw, d, 0, 0, 0); }
#pragma unroll
                for (int r = 0; r < 4; ++r) WsT[(size_t)(hc * 128 + 16 * wv + 4 * g4 + r) * DM + k0 + 16 * nt + fr] = (bf16)f2bf(d[r]);
            }
        }
    }
}

__device__ __forceinline__ void swa_unit(int l_, int u_, LAS unsigned char* lds_) {
    LOAD_CTX(); const int l = UNI(l_), u = UNI(u_); LAS unsigned char* lds = UNI_LDS(lds_);
    const int tid = ltid(), lane = tid & 63, wave = UNI(tid >> 6);
    const int qtile = u % 129, hk = (u / 129) % 3, b = u / 387;
    const int t0 = qtile * 32, lo = t0 - 127;
    const bf16* proj = (const bf16*)(C.ws + WS_PROJ);
    bf16* mixed = (bf16*)(C.ws + WS_Z);
    LAS bf16* Ks = (LAS bf16*)lds;
    LAS bf16* Vt = (LAS bf16*)(lds + 27648);
    LAS bf16* Qs = (LAS bf16*)(lds + 53248);
    __syncthreads();
#define SWA_ROPE8(dst, x, y, pos, first) do { _Pragma("unroll") for (int j_ = 0; j_ < 8; ++j_) { float sn_, cs_; rope_sc((float)(pos), j_, sn_, cs_); dst[j_] = (first) ? x[j_] * cs_ - y[j_] * sn_ : x[j_] * cs_ + y[j_] * sn_; } } while (0)
#define SWA_UNPK(dst, vec_) do { dst[0] = bf2f(vec_.x & 0xffffu); dst[1] = bf2f(vec_.x >> 16); dst[2] = bf2f(vec_.y & 0xffffu); dst[3] = bf2f(vec_.y >> 16); dst[4] = bf2f(vec_.z & 0xffffu); dst[5] = bf2f(vec_.z >> 16); dst[6] = bf2f(vec_.w & 0xffffu); dst[7] = bf2f(vec_.w >> 16); } while (0)
#pragma unroll
    for (int i = 0; i < 3; ++i) {
        const int task = tid + 512 * i, s = task >> 3, c = task & 7;
        const int ut = s < 16 ? s : lo + s - 16;
        const bool ok = (s < 16) || (s < 176 && ut >= 16 && ut < LT);
        u32x4 w = (u32x4){0u, 0u, 0u, 0u};
        if (ok) { const bf16* pr = proj + (size_t)ROWOF(b, ut) * PN + C_SK + hk * 64;
            w = *(const u32x4*)(pr + 8 * c);
            if (c < 2) { const u32x4 wo = *(const u32x4*)(pr + 8 * (c ^ 1)); float x[8], y[8], z[8]; SWA_UNPK(x, w); SWA_UNPK(y, wo); SWA_ROPE8(z, x, y, ut, c == 0);
                w.x = pk2(z[0], z[1]); w.y = pk2(z[2], z[3]); w.z = pk2(z[4], z[5]); w.w = pk2(z[6], z[7]); } }
        *(LAS u32x4*)(Ks + s * 72 + 8 * c) = w;
    }
#pragma unroll
    for (int i = 0; i < 3; ++i) {
        const int task = tid + 512 * i, s = task >> 3, c = task & 7;
        const int ut = s < 16 ? s : lo + s - 16;
        const bool ok = (s < 16) || (s < 176 && ut >= 16 && ut < LT);
        u32x4 w = (u32x4){0u, 0u, 0u, 0u};
        if (ok) w = *(const u32x4*)(proj + (size_t)ROWOF(b, ut) * PN + C_SV + hk * 64 + 8 * c);
        LAS bf16* vp = Vt + (8 * c) * 200 + s;
        vp[0] = (bf16)(w.x & 0xffffu); vp[200] = (bf16)(w.x >> 16); vp[400] = (bf16)(w.y & 0xffffu); vp[600] = (bf16)(w.y >> 16);
        vp[800] = (bf16)(w.z & 0xffffu); vp[1000] = (bf16)(w.z >> 16); vp[1200] = (bf16)(w.w & 0xffffu); vp[1400] = (bf16)(w.w >> 16);
    }
#pragma unroll
    for (int i = 0; i < 4; ++i) {
        const int task = tid + 512 * i, row = task >> 3, c = task & 7, g = row >> 5, t = t0 + (row & 31);
        u32x4 w = (u32x4){0u, 0u, 0u, 0u};
        if (t < LT) { const bf16* qp = proj + (size_t)ROWOF(b, t) * PN + C_SQ + (hk * 8 + g) * 64;
            w = *(const u32x4*)(qp + 8 * c);
            float x[8], z[8]; SWA_UNPK(x, w);
            if (c < 2) { const u32x4 wo = *(const u32x4*)(qp + 8 * (c ^ 1)); float y[8]; SWA_UNPK(y, wo); SWA_ROPE8(z, x, y, t, c == 0); }
            else {
#pragma unroll
                for (int j = 0; j < 8; ++j) z[j] = x[j]; }
            w.x = pk2(z[0] * 0.125f, z[1] * 0.125f); w.y = pk2(z[2] * 0.125f, z[3] * 0.125f); w.z = pk2(z[4] * 0.125f, z[5] * 0.125f); w.w = pk2(z[6] * 0.125f, z[7] * 0.125f); }
        *(LAS u32x4*)(Qs + row * 72 + 8 * c) = w;
    }
#undef SWA_ROPE8
#undef SWA_UNPK
    __syncthreads();
    const int fr = lane & 15, g4 = lane >> 4;
    const int hq = hk * 8 + wave;
    const float sink = C.in[I_SINK][l * 24 + hq];
    pg8::bf16x8 Qf[2][2];
#pragma unroll
    for (int qt = 0; qt < 2; ++qt)
#pragma unroll
        for (int ks = 0; ks < 2; ++ks) Qf[qt][ks] = *(const LAS pg8::bf16x8*)(Qs + (wave * 32 + 16 * qt + fr) * 72 + 32 * ks + 8 * g4);
    f32x4 sc[12][2];
#pragma unroll
    for (int kt = 0; kt < 12; ++kt) {
        const pg8::bf16x8 k0 = *(const LAS pg8::bf16x8*)(Ks + (16 * kt + fr) * 72 + 8 * g4), k1 = *(const LAS pg8::bf16x8*)(Ks + (16 * kt + fr) * 72 + 32 + 8 * g4);
#pragma unroll
        for (int qt = 0; qt < 2; ++qt) { f32x4 a = (f32x4){0.f, 0.f, 0.f, 0.f};
            a = __builtin_amdgcn_mfma_f32_16x16x32_bf16(k0, Qf[qt][0], a, 0, 0, 0); a = __builtin_amdgcn_mfma_f32_16x16x32_bf16(k1, Qf[qt][1], a, 0, 0, 0); sc[kt][qt] = a; }
    }
    float inv[2];
    pg8::bf16x8 Pf[2][6];
#pragma unroll
    for (int qt = 0; qt < 2; ++qt) {
        const int t = t0 + 16 * qt + fr; const bool tv = t < LT;
        float m = sink;
#pragma unroll
        for (int kt = 0; kt < 12; ++kt)
#pragma unroll
            for (int r = 0; r < 4; ++r) { const int s = 16 * kt + 4 * g4 + r; const int uu = lo + s - 16;
                const bool ok = tv && (kt == 0 ? (s <= t) : (uu >= 16 && uu <= t && uu >= t - 127));
                const float v = ok ? sc[kt][qt][r] : -1.0e30f; sc[kt][qt][r] = v; m = fmaxf(m, v); }
        m = fmaxf(m, __shfl_xor(m, 16)); m = fmaxf(m, __shfl_xor(m, 32));
        float ls = 0.f;
#pragma unroll
        for (int kt = 0; kt < 12; ++kt)
#pragma unroll
            for (int r = 0; r < 4; ++r) { const float p = __expf(sc[kt][qt][r] - m); sc[kt][qt][r] = p; ls += p; }
        ls += __shfl_xor(ls, 16); ls += __shfl_xor(ls, 32);
        ls += __expf(sink - m);
        inv[qt] = 1.0f / ls;
#pragma unroll
        for (int s2 = 0; s2 < 6; ++s2) { const f32x4 pa = sc[2 * s2][qt], pb = sc[2 * s2 + 1][qt];
            u32x4 w; w.x = pk2(pa[0], pa[1]); w.y = pk2(pa[2], pa[3]); w.z = pk2(pb[0], pb[1]); w.w = pk2(pb[2], pb[3]);
            Pf[qt][s2] = (pg8::bf16x8)w; }
    }
    f32x4 o[4][2];
#pragma unroll
    for (int dt = 0; dt < 4; ++dt) { o[dt][0] = (f32x4){0.f, 0.f, 0.f, 0.f}; o[dt][1] = (f32x4){0.f, 0.f, 0.f, 0.f}; }
#pragma unroll
    for (int dt = 0; dt < 4; ++dt)
#pragma unroll
        for (int s2 = 0; s2 < 6; ++s2) {
            const u32x2 va = *(const LAS u32x2*)(Vt + (16 * dt + fr) * 200 + 32 * s2 + 4 * g4), vb = *(const LAS u32x2*)(Vt + (16 * dt + fr) * 200 + 32 * s2 + 16 + 4 * g4);
            const u32x4 vw = (u32x4){va.x, va.y, vb.x, vb.y};
            const pg8::bf16x8 vf = (pg8::bf16x8)vw;
            o[dt][0] = __builtin_amdgcn_mfma_f32_16x16x32_bf16(vf, Pf[0][s2], o[dt][0], 0, 0, 0);
            o[dt][1] = __builtin_amdgcn_mfma_f32_16x16x32_bf16(vf, Pf[1][s2], o[dt][1], 0, 0, 0);
        }
#pragma unroll
    for (int qt = 0; qt < 2; ++qt) { const int t = t0 + 16 * qt + fr;
        if (t < LT) { bf16* op = mixed + (size_t)ROWOF(b, t) * DM + 1536 + hq * 64 + 4 * g4;
#pragma unroll
            for (int dt = 0; dt < 4; ++dt) { const f32x4 v = o[dt][qt] * inv[qt]; if (t < NMETA) { u32x2 w; w.x = pk2(v[0], v[1]); w.y = pk2(v[2], v[3]); *(u32x2*)(op + 16 * dt) = w; }
                *(unsigned*)(C.ws + WS_MX8 + (size_t)ROWOF(b, t) * DM + 1536 + hq * 64 + 4 * g4 + 16 * dt) = pk4_fp8(v[0] * MX8_SCALE, v[1] * MX8_SCALE, v[2] * MX8_SCALE, v[3] * MX8_SCALE); } }
    }
}

__device__ __forceinline__ void hgrn_local_unit(int l_, int u_, LAS unsigned char* lds_) {
    LOAD_CTX(); const int l = UNI(l_), u = UNI(u_); LAS unsigned char* lds = UNI_LDS(lds_);
    const int tid = ltid(), lane = tid & 63, wave = UNI(tid >> 6);
    const int bh = u / 65, c = u % 65 + 1, b = bh >> 3, h = bh & 7;
    const bf16* proj = (const bf16*)(C.ws + WS_PROJ);
    bf16* HDS = (bf16*)(C.ws + WS_HDS); bf16* HQG = (bf16*)(C.ws + WS_HQG); float* HAT = (float*)(C.ws + WS_HAT); float* HED = (float*)(C.ws + WS_HED);
    lfloat* qs = (lfloat*)lds; lfloat* kvs = qs + 8192; lfloat* Gs = qs + 16384;
    LAS bf16* iT = (LAS bf16*)(lds + 98304);
    LAS unsigned char* shr = lds + 116736;
    lfloat* segtot = (lfloat*)shr; LAS bf16* QK = (LAS bf16*)shr; LAS bf16* kdT = (LAS bf16*)shr;
    const int k = tid & 127, seg = tid >> 7;
    const int fr = lane & 15, g4 = lane >> 4;
    float lb = 0.f;
    if (l == 1) { const float a0 = C.in[I_HLB][h * 128 + k], a1 = C.in[I_HLB][1024 + h * 128 + k]; lb = 1.0f / (1.0f + __expf(a0 - a1)); }
    __syncthreads();
    float gl[16]; float run = 0.f;
#pragma unroll
    for (int r = 0; r < 16; ++r) {
        const int tl = 16 * seg + r, t = 64 * c + tl - 112;
        float qv = 0.f, kv = 0.f, lf = 0.f; unsigned ib = 0u;
        if (t >= 0 && t < LT) { const bf16* pr = proj + (size_t)ROWOF(b, t) * PN + h * 128 + k;
            qv = bf2f(pr[C_HQ]); const float frw = bf2f(pr[C_HF]); ib = pr[C_HI];
            const float f = lb + (1.0f - lb) * sigmoidf_(frw); lf = __logf(f); kv = 1.0f - f; }
        run += lf; gl[r] = run;
        qs[tl * 128 + k] = qv; kvs[tl * 128 + k] = kv; iT[k * 72 + tl] = (bf16)ib;
    }
    segtot[seg * 128 + k] = run;
    __syncthreads();
    float off = 0.f;
    for (int s2 = 0; s2 < seg; ++s2) off += segtot[s2 * 128 + k];
#pragma unroll
    for (int r = 0; r < 16; ++r) Gs[(16 * seg + r) * 128 + k] = gl[r] + off;
    __syncthreads();
    const size_t uc = (size_t)bh * NCH + c;
    float* at = HAT + uc * 4096;
    for (int e = tid; e < 4096; e += 512) { const int t_ = e >> 6, s_ = e & 63; if (s_ > t_) at[e] = 0.f; }
    if (tid < 480) {
        const int blk = tid / 120, q = tid - blk * 120;
        int tt = (int)((1.0f + sqrtf(1.0f + 8.0f * (float)q)) * 0.5f);
        if (tt * (tt - 1) / 2 > q) --tt; if ((tt + 1) * tt / 2 <= q) ++tt;
        const int ss = q - tt * (tt - 1) / 2, t_ = 16 * blk + tt, s_ = 16 * blk + ss;
        float acc = 0.f;
        for (int kk = 0; kk < 128; ++kk) { const int k2 = (kk + lane) & 127;
            acc += qs[t_ * 128 + k2] * kvs[s_ * 128 + k2] * __expf(Gs[t_ * 128 + k2] - Gs[s_ * 128 + k2]); }
        at[t_ * 64 + s_] = acc;
    }
    if (tid >= 448) {
        const int t_ = tid - 448; float acc = 0.f;
        for (int kk = 0; kk < 128; ++kk) { const int k2 = (kk + lane) & 127; acc += qs[t_ * 128 + k2] * kvs[t_ * 128 + k2]; }
        at[t_ * 64 + t_] = acc;
    }
#pragma unroll 1
    for (int pass = 0; pass < 2; ++pass) {
        __syncthreads();
#pragma unroll 4
        for (int i = 0; i < 16; ++i) { const int e = tid + 512 * i, row = e >> 7, kx = e & 127;
            int src, ref; bool isq = row < 32;
            if (pass == 0) { src = isq ? 32 + row : row - 32; ref = 31; }
            else { const int r16 = row & 15, hi = (row >> 4) & 1; src = isq ? (hi ? 48 + r16 : 16 + r16) : (hi ? 32 + r16 : r16); ref = hi ? 47 : 15; }
            const float gr = Gs[ref * 128 + kx], gs_ = Gs[src * 128 + kx];
            const float v = isq ? qs[src * 128 + kx] * __expf(gs_ - gr) : kvs[src * 128 + kx] * __expf(gr - gs_);
            QK[row * 136 + kx] = (bf16)f2bf(v); }
        __syncthreads();
        const int ntile = pass == 0 ? 4 : 2;
        if (wave < ntile) {
            const int qrow = pass == 0 ? 16 * (wave >> 1) : 16 * wave, krow = pass == 0 ? 32 + 16 * (wave & 1) : 32 + 16 * wave;
            const int I = pass == 0 ? 2 + (wave >> 1) : (wave == 0 ? 1 : 3), J = pass == 0 ? (wave & 1) : (wave == 0 ? 0 : 2);
            f32x4 d = (f32x4){0.f, 0.f, 0.f, 0.f};
#pragma unroll
            for (int ks = 0; ks < 4; ++ks) { const pg8::bf16x8 a = *(const LAS pg8::bf16x8*)(QK + (qrow + fr) * 136 + 32 * ks + 8 * g4), bb = *(const LAS pg8::bf16x8*)(QK + (krow + fr) * 136 + 32 * ks + 8 * g4);
                d = __builtin_amdgcn_mfma_f32_16x16x32_bf16(a, bb, d, 0, 0, 0); }
#pragma unroll
            for (int r = 0; r < 4; ++r) at[(16 * I + 4 * g4 + r) * 64 + 16 * J + fr] = d[r];
        }
    }
    __syncthreads();
    for (int e = tid; e < 8192; e += 512) { const int s_ = e >> 7, kx = e & 127; const float ge = Gs[e];
        HQG[uc * 8192 + e] = (bf16)f2bf(qs[e] * __expf(ge));
        kdT[kx * 72 + s_] = (bf16)f2bf(kvs[e] * __expf(Gs[63 * 128 + kx] - ge)); }
    if (tid < 128) HED[uc * 128 + tid] = __expf(Gs[63 * 128 + tid]);
    __syncthreads();
    {
        const pg8::bf16x8 a0 = *(const LAS pg8::bf16x8*)(kdT + (16 * wave + fr) * 72 + 8 * g4), a1 = *(const LAS pg8::bf16x8*)(kdT + (16 * wave + fr) * 72 + 32 + 8 * g4);
        f32x4 dd[8];
#pragma unroll
        for (int nt = 0; nt < 8; ++nt) {
            const pg8::bf16x8 b0 = *(const LAS pg8::bf16x8*)(iT + (8 * fr + nt) * 72 + 8 * g4), b1 = *(const LAS pg8::bf16x8*)(iT + (8 * fr + nt) * 72 + 32 + 8 * g4);
            f32x4 d = (f32x4){0.f, 0.f, 0.f, 0.f};
            d = __builtin_amdgcn_mfma_f32_16x16x32_bf16(a0, b0, d, 0, 0, 0); d = __builtin_amdgcn_mfma_f32_16x16x32_bf16(a1, b1, d, 0, 0, 0);
            dd[nt] = d;
        }
#pragma unroll
        for (int r = 0; r < 4; ++r) { u32x4 w; w.x = pk2(dd[0][r], dd[1][r]); w.y = pk2(dd[2][r], dd[3][r]); w.z = pk2(dd[4][r], dd[5][r]); w.w = pk2(dd[6][r], dd[7][r]);
            *(u32x4*)(HDS + (uc * 128 + 16 * wave + 4 * g4 + r) * 128 + 8 * fr) = w; }
    }
}

__device__ __forceinline__ void rwkv_chunk_prep(const Ctx& C, int bh, int c, int lane, LAS unsigned char* wl) {
    float* RAc = (float*)(C.ws + WS_RA) + ((size_t)bh * LT + 16 * c) * 384;
    unsigned char* chb = C.ws + WS_CHB + ((size_t)bh * 257 + c) * 1280;
    LAS bf16* AbS = (LAS bf16*)(wl + 4608); LAS bf16* RbS = AbS + 16 * 72; LAS bf16* BtS = RbS + 16 * 72; LAS bf16* KtS = BtS + 16 * 72;
    float kk[16], w[16], ka[16], kp[16], rr[16], vv[16];
#pragma unroll
    for (int i = 0; i < 16; ++i) { const float* p = RAc + i * 384 + lane; kk[i] = p[0]; w[i] = p[64]; ka[i] = p[128]; kp[i] = p[192]; rr[i] = p[256]; vv[i] = p[320]; }
    float g = 1.0f; float bp[16], kq[16];
#pragma unroll
    for (int i = 0; i < 16; ++i) { const float gprev = g; g *= w[i]; const float ig = 1.0f / g;
        const float ab = -kk[i] * gprev, rb = rr[i] * g, bt = ka[i] * ig, kt = kp[i] * ig;
        AbS[i * 72 + lane] = (bf16)f2bf(ab); RbS[i * 72 + lane] = (bf16)f2bf(rb); BtS[i * 72 + lane] = (bf16)f2bf(bt); KtS[i * 72 + lane] = (bf16)f2bf(kt);
        bp[i] = bt; kq[i] = kt;
        unsigned short* rec = (unsigned short*)(RAc + i * 384);
        rec[lane] = (unsigned short)f2bf(ab); rec[64 + lane] = (unsigned short)f2bf(rb); }
    const float gC = g;
    {
        u32x4 o0, o1, q0, q1;
        o0.x = pk2(bp[0] * gC, bp[1] * gC); o0.y = pk2(bp[2] * gC, bp[3] * gC); o0.z = pk2(bp[4] * gC, bp[5] * gC); o0.w = pk2(bp[6] * gC, bp[7] * gC);
        o1.x = pk2(bp[8] * gC, bp[9] * gC); o1.y = pk2(bp[10] * gC, bp[11] * gC); o1.z = pk2(bp[12] * gC, bp[13] * gC); o1.w = pk2(bp[14] * gC, bp[15] * gC);
        q0.x = pk2(kq[0] * gC, kq[1] * gC); q0.y = pk2(kq[2] * gC, kq[3] * gC); q0.z = pk2(kq[4] * gC, kq[5] * gC); q0.w = pk2(kq[6] * gC, kq[7] * gC);
        q1.x = pk2(kq[8] * gC, kq[9] * gC); q1.y = pk2(kq[10] * gC, kq[11] * gC); q1.z = pk2(kq[12] * gC, kq[13] * gC); q1.w = pk2(kq[14] * gC, kq[15] * gC);
        unsigned char* rb_ = (unsigned char*)(RAc + (lane >> 3) * 384) + 512 + (lane & 7) * 32;
        *(u32x4*)rb_ = o0; *(u32x4*)(rb_ + 16) = o1;
        unsigned char* rk_ = (unsigned char*)(RAc + (8 + (lane >> 3)) * 384) + 512 + (lane & 7) * 32;
        *(u32x4*)rk_ = q0; *(u32x4*)(rk_ + 16) = q1;
        ((float*)(chb + 1024))[lane] = gC;
    }
    LDS_WAIT();
    const int fr = lane & 15, g4 = lane >> 4;
    lfloat* AabM = (lfloat*)wl; lfloat* AakM = AabM + 16 * 17; lfloat* BrkM = AakM + 16 * 17; lfloat* TM = BrkM + 16 * 17;
    {
        const pg8::bf16x8 a0 = *(const LAS pg8::bf16x8*)(AbS + fr * 72 + 8 * g4), a1 = *(const LAS pg8::bf16x8*)(AbS + fr * 72 + 32 + 8 * g4);
        const pg8::bf16x8 r0 = *(const LAS pg8::bf16x8*)(RbS + fr * 72 + 8 * g4), r1 = *(const LAS pg8::bf16x8*)(RbS + fr * 72 + 32 + 8 * g4);
        const pg8::bf16x8 b0 = *(const LAS pg8::bf16x8*)(BtS + fr * 72 + 8 * g4), b1 = *(const LAS pg8::bf16x8*)(BtS + fr * 72 + 32 + 8 * g4);
        const pg8::bf16x8 k0 = *(const LAS pg8::bf16x8*)(KtS + fr * 72 + 8 * g4), k1 = *(const LAS pg8::bf16x8*)(KtS + fr * 72 + 32 + 8 * g4);
        const f32x4 z = (f32x4){0.f, 0.f, 0.f, 0.f};
        f32x4 aab = __builtin_amdgcn_mfma_f32_16x16x32_bf16(a0, b0, z, 0, 0, 0); aab = __builtin_amdgcn_mfma_f32_16x16x32_bf16(a1, b1, aab, 0, 0, 0);
        f32x4 aak = __builtin_amdgcn_mfma_f32_16x16x32_bf16(a0, k0, z, 0, 0, 0); aak = __builtin_amdgcn_mfma_f32_16x16x32_bf16(a1, k1, aak, 0, 0, 0);
        f32x4 brb = __builtin_amdgcn_mfma_f32_16x16x32_bf16(r0, b0, z, 0, 0, 0); brb = __builtin_amdgcn_mfma_f32_16x16x32_bf16(r1, b1, brb, 0, 0, 0);
        f32x4 brk = __builtin_amdgcn_mfma_f32_16x16x32_bf16(r0, k0, z, 0, 0, 0); brk = __builtin_amdgcn_mfma_f32_16x16x32_bf16(r1, k1, brk, 0, 0, 0);
#pragma unroll
        for (int r = 0; r < 4; ++r) { const int t = 4 * g4 + r, s = fr;
            AabM[t * 17 + s] = s < t ? aab[r] : 0.f; AakM[t * 17 + s] = s < t ? aak[r] : 0.f; BrkM[t * 17 + s] = s <= t ? brk[r] : 0.f;
            *(unsigned short*)(chb + 512 + t * 32 + s * 2) = (unsigned short)f2bf(s <= t ? brb[r] : 0.f); }
    }
    const int t_ = lane >> 2, s0 = 4 * (lane & 3);
    LDS_WAIT();
    if (lane < 16) {
        float tc[16];
#pragma unroll
        for (int t = 0; t < 16; ++t) { float acc = (t == lane) ? 1.0f : 0.0f;
#pragma unroll
            for (int s = 0; s < t; ++s) acc += AabM[t * 17 + s] * tc[s];
            tc[t] = acc; TM[t * 17 + lane] = acc; }
    }
    LDS_WAIT();
    { u32x2 wv; wv.x = pk2(TM[t_ * 17 + s0], TM[t_ * 17 + s0 + 1]); wv.y = pk2(TM[t_ * 17 + s0 + 2], TM[t_ * 17 + s0 + 3]); *(u32x2*)(chb + t_ * 32 + s0 * 2) = wv; }
#pragma unroll
    for (int t = 0; t < 16; ++t) { float p1 = 0.f, p2 = 0.f;
#pragma unroll
        for (int s = 0; s <= t; ++s) { if (s < t) p1 += AakM[t * 17 + s] * vv[s]; p2 += BrkM[t * 17 + s] * vv[s]; }
        unsigned short* rec = (unsigned short*)(RAc + t * 384);
        rec[128 + lane] = (unsigned short)f2bf(p1); rec[192 + lane] = (unsigned short)f2bf(p2); }
    LDS_WAIT();
}

__device__ __forceinline__ void rwkv_prep_unit(int l_, int u_, LAS unsigned char* lds_) {
    LOAD_CTX(); const int l = UNI(l_), u = UNI(u_); LAS unsigned char* lds = UNI_LDS(lds_);
    const int tid = ltid(), lane = tid & 63, wave = UNI(tid >> 6);
    const int b = u / 257, t0 = (u % 257) * 16;
    const bf16* proj = (const bf16*)(C.ws + WS_PROJ);
    float* RA = (float*)(C.ws + WS_RA); bf16* RG = (bf16*)(C.ws + WS_RG);
    const bf16* LW = (const bf16*)(C.ws + WS_LW);
    const float* mu = C.in[I_MU] + l * 4864;
    LAS bf16* featb = (LAS bf16*)lds;
    const size_t row0 = (size_t)ROWOF(b, t0), rowp = (size_t)ROWOF(b, t0 > 0 ? t0 - 1 : 0);
    __syncthreads();
#pragma unroll
    for (int j = 0; j < 8; ++j) { const int e = tid + 512 * j, tok = e >> 8, f = e & 255, t = t0 + tok; const size_t m = row0 + tok;
        const float cur = bf2f(proj[m * PN + C_WL + f]); const float prev = t > 0 ? bf2f(proj[(tok > 0 ? m - 1 : rowp) * PN + C_WL + f]) : 0.f;
        const float xs = cur + (prev - cur) * mu[C_WL + f];
        featb[tok * 264 + f] = (bf16)f2bf(f < 64 ? tanhf(xs) : (f < 128 ? xs : sigmoidf_(xs))); }
    __syncthreads();
    const int fr = lane & 15, kc = lane >> 4;
    pg8::bf16x8 Af[8];
#pragma unroll
    for (int ks = 0; ks < 8; ++ks) Af[ks] = *(const LAS pg8::bf16x8*)(featb + fr * 264 + 32 * ks + 8 * kc);
#pragma unroll 1
    for (int hh = 0; hh < 3; ++hh) {
        const int ch0 = 192 * wave + 64 * hh, h = ch0 >> 6;
        f32x4 aw[4], aa[4], ag[4];
#pragma unroll
        for (int nt = 0; nt < 4; ++nt) {
            const bf16* bp = LW + (size_t)(ch0 + 4 * fr + nt) * 256 + 8 * kc;
            pg8::bf16x8 Bf[8];
#pragma unroll
            for (int ks = 0; ks < 8; ++ks) Bf[ks] = *(const pg8::bf16x8*)(bp + 32 * ks);
            f32x4 z = (f32x4){0.f, 0.f, 0.f, 0.f};
            aw[nt] = __builtin_amdgcn_mfma_f32_16x16x32_bf16(Af[0], Bf[0], z, 0, 0, 0); aw[nt] = __builtin_amdgcn_mfma_f32_16x16x32_bf16(Af[1], Bf[1], aw[nt], 0, 0, 0);
            aa[nt] = __builtin_amdgcn_mfma_f32_16x16x32_bf16(Af[2], Bf[2], z, 0, 0, 0); aa[nt] = __builtin_amdgcn_mfma_f32_16x16x32_bf16(Af[3], Bf[3], aa[nt], 0, 0, 0);
            ag[nt] = __builtin_amdgcn_mfma_f32_16x16x32_bf16(Af[4], Bf[4], z, 0, 0, 0); ag[nt] = __builtin_amdgcn_mfma_f32_16x16x32_bf16(Af[5], Bf[5], ag[nt], 0, 0, 0);
            ag[nt] = __builtin_amdgcn_mfma_f32_16x16x32_bf16(Af[6], Bf[6], ag[nt], 0, 0, 0); ag[nt] = __builtin_amdgcn_mfma_f32_16x16x32_bf16(Af[7], Bf[7], ag[nt], 0, 0, 0);
        }
        const int cb = ch0 + 4 * fr;
        const f32x4 mur = *(const f32x4*)(mu + C_R + cb), muk = *(const f32x4*)(mu + C_K + cb), muv = *(const f32x4*)(mu + C_V + cb);
        const f32x4 w0c = *(const f32x4*)(C.in[I_W0] + l * 1536 + cb), a0c = *(const f32x4*)(C.in[I_A0] + l * 1536 + cb), kkc = *(const f32x4*)(C.in[I_KK] + l * 1536 + cb), kac = *(const f32x4*)(C.in[I_KA] + l * 1536 + cb);
        f32x4 pr, pk, pv;
#define PREP_LD4(dst, p_) do { const u32x2 w_ = *(const u32x2*)(p_); dst = (f32x4){bf2f(w_.x & 0xffffu), bf2f(w_.x >> 16), bf2f(w_.y & 0xffffu), bf2f(w_.y >> 16)}; } while (0)
        {
            const bool has = (kc > 0) || (t0 > 0);
            const bf16* pp = proj + (kc > 0 ? row0 + 4 * kc - 1 : rowp) * PN + cb;
            const f32x4 z4 = (f32x4){0.f, 0.f, 0.f, 0.f};
            if (has) { PREP_LD4(pr, pp + C_R); PREP_LD4(pk, pp + C_K); PREP_LD4(pv, pp + C_V); } else { pr = z4; pk = z4; pv = z4; }
        }
#pragma unroll
        for (int r = 0; r < 4; ++r) {
            const int tok = 4 * kc + r, t = t0 + tok;
            const bf16* pc = proj + (row0 + tok) * PN + cb;
            f32x4 cr, ck, cv; PREP_LD4(cr, pc + C_R); PREP_LD4(ck, pc + C_K); PREP_LD4(cv, pc + C_V);
            const f32x4 xr = cr + (pr - cr) * mur, xk = ck + (pk - ck) * muk, xv = cv + (pv - cv) * muv;
            pr = cr; pk = ck; pv = cv;
            const f32x4 kkr = xk * kkc;
            float ss = (kkr[0] * kkr[0] + kkr[1] * kkr[1]) + (kkr[2] * kkr[2] + kkr[3] * kkr[3]);
            ss = rowsum16(ss);
            const float rn = 1.0f / fmaxf(sqrtf(ss), 1e-12f);
            f32x4 dec, av, gv4;
#pragma unroll
            for (int nt = 0; nt < 4; ++nt) {
                const float x = -(w0c[nt] + aw[nt][r]);
                const float sp = fmaxf(x, 0.f) + __logf(1.0f + __expf(-fabsf(x)));
                dec[nt] = __expf(-__expf(-sp - 0.5f)); av[nt] = sigmoidf_(a0c[nt] + aa[nt][r]); gv4[nt] = ag[nt][r]; }
            const f32x4 kkn = kkr * rn;
            float* ra = RA + ((size_t)(b * NHR + h) * LT + t) * 384 + 4 * fr;
            *(f32x4*)(ra) = kkn; *(f32x4*)(ra + 64) = dec; *(f32x4*)(ra + 128) = kkn * av; *(f32x4*)(ra + 192) = xk * ((av - 1.0f) * kac + 1.0f); *(f32x4*)(ra + 256) = xr; *(f32x4*)(ra + 320) = xv;
            u32x2 gw; gw.x = pk2(gv4[0], gv4[1]); gw.y = pk2(gv4[2], gv4[3]);
            *(u32x2*)(RG + ((size_t)b * LT + t) * 1536 + cb) = gw;
        }
#undef PREP_LD4
    }
    asm volatile("s_waitcnt vmcnt(0)" ::: "memory"); __syncthreads();
#pragma unroll 1
    for (int hh = 0; hh < 3; ++hh) rwkv_chunk_prep(C, b * NHR + 3 * wave + hh, t0 >> 4, lane, lds + wave * 16640);
}

__device__ __forceinline__ pg8::bf16x8 pack8(const f32x4 a, const f32x4 b2) { u32x4 w; w.x = pk2(a[0], a[1]); w.y = pk2(a[2], a[3]); w.z = pk2(b2[0], b2[1]); w.w = pk2(b2[2], b2[3]); return (pg8::bf16x8)w; }
__device__ __forceinline__ pg8::bf16x8 ld8x2(const void* p0, const void* p1) { const u32x2 a = *(const u32x2*)p0, b2 = *(const u32x2*)p1; const u32x4 w = (u32x4){a.x, a.y, b2.x, b2.y}; return (pg8::bf16x8)w; }
__device__ __forceinline__ pg8::bf16x8 lds8x2(const LAS unsigned char* p0, const LAS unsigned char* p1) { const u32x2 a = *(const LAS u32x2*)p0, b2 = *(const LAS u32x2*)p1; const u32x4 w = (u32x4){a.x, a.y, b2.x, b2.y}; return (pg8::bf16x8)w; }
__device__ __forceinline__ void rwkv_scan_unit(int unit_, LAS unsigned char* lds_) {
    LOAD_CTX(); const int unit = UNI(unit_); LAS unsigned char* lds = UNI_LDS(lds_);
    const int tid = ltid(), lane = tid & 63, wave = UNI(tid >> 6);
    const int hsel = wave >> 2, bh = 2 * unit + hsel, vt = wave & 3, b = bh / NHR, h = bh % NHR;
    const int fr = lane & 15, g4 = lane >> 4, hl = tid & 255;
    const unsigned char* RAb = (const unsigned char*)((const float*)(C.ws + WS_RA) + (size_t)bh * LT * 384);
    const unsigned char* CHB = C.ws + WS_CHB + (size_t)bh * 257 * 1280;
    bf16* RY = (bf16*)(C.ws + WS_RY);
    constexpr int RS = 1040, SLOT = 16 * RS + 1280;
    LAS unsigned char* ring = lds + hsel * 4 * SLOT;
    const f32x4 zero4 = (f32x4){0.f, 0.f, 0.f, 0.f};
    f32x4 acc[4] = {zero4, zero4, zero4, zero4};
    u32x4 ga[5], gb[5];
#define CS_G(dst, c_) do { const unsigned char* rec = RAb + (size_t)(16 * (c_)) * 1536; const unsigned char* side = CHB + (c_) * 1280; \
        _Pragma("unroll") for (int i = 0; i < 5; ++i) { const int p = hl + 256 * i, rr = p >> 6, q = p & 63; \
            const unsigned char* src = p < 1024 ? rec + (size_t)rr * 1536 + (q < 48 ? 16 * q : 1280 + 16 * (q - 48)) : side + 16 * (p - 1024); \
            dst[i] = ((c_) < 257 && p < 1104) ? *(const u32x4*)src : (u32x4){0u, 0u, 0u, 0u}; } } while (0)
#define CS_S(src_, c_) do { LAS unsigned char* sl = ring + ((c_) & 3) * SLOT; \
        _Pragma("unroll") for (int i = 0; i < 5; ++i) { const int p = hl + 256 * i, rr = p >> 6, q = p & 63; \
            if (p < 1104) *(LAS u32x4*)(p < 1024 ? sl + rr * RS + 16 * q : sl + 16 * RS + 16 * (p - 1024)) = src_[i]; } } while (0)
#define CS_COMPUTE(c_) do { const LAS unsigned char* sl = ring + ((c_) & 3) * SLOT; const LAS unsigned char* rt = sl + fr * RS; const LAS unsigned char* side = sl + 16 * RS; \
        const pg8::bf16x8 Ab0 = lds8x2(rt + 8 * g4, rt + 32 + 8 * g4), Ab1 = lds8x2(rt + 64 + 8 * g4, rt + 96 + 8 * g4), Rb0 = lds8x2(rt + 128 + 8 * g4, rt + 160 + 8 * g4), Rb1 = lds8x2(rt + 192 + 8 * g4, rt + 224 + 8 * g4); \
        f32x4 P1, P2, Vd; \
        _Pragma("unroll") for (int r = 0; r < 4; ++r) { const LAS unsigned char* rr_ = sl + (4 * g4 + r) * RS; const int v = 16 * vt + fr; \
            P1[r] = bf2f(((const LAS unsigned short*)(rr_ + 256))[v]); P2[r] = bf2f(((const LAS unsigned short*)(rr_ + 384))[v]); Vd[r] = ((const LAS float*)(rr_ + 768))[v]; } \
        const u32x2 tw = *(const LAS u32x2*)(side + fr * 32 + 8 * g4), bw = *(const LAS u32x2*)(side + 512 + fr * 32 + 8 * g4); \
        const pg8::bf16x8 Tf = (pg8::bf16x8)((u32x4){tw.x, tw.y, 0u, 0u}), Bf = (pg8::bf16x8)((u32x4){bw.x, bw.y, 0u, 0u}); \
        const LAS unsigned char* pb = sl + (fr >> 3) * RS + 512 + (fr & 7) * 32 + 8 * g4; \
        const pg8::bf16x8 M0 = lds8x2(pb, pb + 8 * RS), M1 = lds8x2(pb + 2 * RS, pb + 10 * RS), M2 = lds8x2(pb + 4 * RS, pb + 12 * RS), M3 = lds8x2(pb + 6 * RS, pb + 14 * RS); \
        const f32x4 g0 = *(const LAS f32x4*)(side + 1024 + (4 * g4) * 4), g1 = *(const LAS f32x4*)(side + 1024 + (16 + 4 * g4) * 4), g2 = *(const LAS f32x4*)(side + 1024 + (32 + 4 * g4) * 4), g3 = *(const LAS f32x4*)(side + 1024 + (48 + 4 * g4) * 4); \
        const pg8::bf16x8 sB0 = pack8(acc[0], acc[1]), sB1 = pack8(acc[2], acc[3]); \
        f32x4 Wd = __builtin_amdgcn_mfma_f32_16x16x32_bf16(Ab0, sB0, zero4, 0, 0, 0); Wd = __builtin_amdgcn_mfma_f32_16x16x32_bf16(Ab1, sB1, Wd, 0, 0, 0); \
        f32x4 Yd = __builtin_amdgcn_mfma_f32_16x16x32_bf16(Rb0, sB0, P2, 0, 0, 0); Yd = __builtin_amdgcn_mfma_f32_16x16x32_bf16(Rb1, sB1, Yd, 0, 0, 0); \
        const f32x4 Ud = __builtin_amdgcn_mfma_f32_16x16x32_bf16(Tf, pack8(Wd + P1, zero4), zero4, 0, 0, 0); \
        Yd = __builtin_amdgcn_mfma_f32_16x16x32_bf16(Bf, pack8(Ud, zero4), Yd, 0, 0, 0); \
        const pg8::bf16x8 zB = pack8(Ud, Vd); \
        acc[0] = __builtin_amdgcn_mfma_f32_16x16x32_bf16(M0, zB, acc[0] * g0, 0, 0, 0); acc[1] = __builtin_amdgcn_mfma_f32_16x16x32_bf16(M1, zB, acc[1] * g1, 0, 0, 0); \
        acc[2] = __builtin_amdgcn_mfma_f32_16x16x32_bf16(M2, zB, acc[2] * g2, 0, 0, 0); acc[3] = __builtin_amdgcn_mfma_f32_16x16x32_bf16(M3, zB, acc[3] * g3, 0, 0, 0); \
        _Pragma("unroll") for (int r = 0; r < 4; ++r) RY[((size_t)b * LT + 16 * (c_) + 4 * g4 + r) * 1536 + h * 64 + 16 * vt + fr] = (bf16)f2bf(Yd[r]); } while (0)
    __syncthreads();
    CS_G(ga, 0); CS_G(gb, 1);
    CS_S(ga, 0); CS_S(gb, 1);
    CS_G(gb, 2);
    __syncthreads();
#pragma unroll 1
    for (int c = 0; c < 257; c += 2) {
        CS_G(ga, c + 3);
        CS_COMPUTE(c);
        CS_S(gb, c + 2);
        __syncthreads();
        if (c + 1 < 257) {
            CS_G(gb, c + 4);
            CS_COMPUTE(c + 1);
            CS_S(ga, c + 3);
            __syncthreads();
        }
    }
#undef CS_G
#undef CS_S
#undef CS_COMPUTE
}
__device__ __forceinline__ void hgrn_scan_slice(int sl_) {
    LOAD_CTX(); const int sl = UNI(sl_);
    const int tid = ltid();
    bf16* HDS = (bf16*)(C.ws + WS_HDS); const float* HED = (const float*)(C.ws + WS_HED);
    float S[4][4];
#pragma unroll
    for (int q = 0; q < 4; ++q) { S[q][0] = 0.f; S[q][1] = 0.f; S[q][2] = 0.f; S[q][3] = 0.f; }
    const int e0 = sl * 8192 + tid * 4, bh = e0 >> 14;
    for (int c = 1; c < NCH; ++c) {
        const size_t uc = (size_t)bh * NCH + c;
        u32x2 d[4]; float ed[4];
#pragma unroll
        for (int q = 0; q < 4; ++q) { const int kv = (e0 + q * 2048) & 16383; d[q] = *(const u32x2*)(HDS + uc * 16384 + kv); ed[q] = HED[uc * 128 + (kv >> 7)]; }
#pragma unroll
        for (int q = 0; q < 4; ++q) { const int kv = (e0 + q * 2048) & 16383;
            u32x2 o; o.x = pk2(S[q][0], S[q][1]); o.y = pk2(S[q][2], S[q][3]); *(u32x2*)(HDS + uc * 16384 + kv) = o;
            S[q][0] = S[q][0] * ed[q] + bf2f(d[q].x & 0xffffu); S[q][1] = S[q][1] * ed[q] + bf2f(d[q].x >> 16); S[q][2] = S[q][2] * ed[q] + bf2f(d[q].y & 0xffffu); S[q][3] = S[q][3] * ed[q] + bf2f(d[q].y >> 16); }
    }
}

__device__ __forceinline__ void rwkv_post_all(int l_) {
    LOAD_CTX(); const int l = UNI(l_);
    const int tid = ltid(), lane = tid & 63, wave = UNI(tid >> 6);
    const bf16* RY = (const bf16*)(C.ws + WS_RY); const bf16* RG = (const bf16*)(C.ws + WS_RG);
    const float* RA = (const float*)(C.ws + WS_RA);
    bf16* mixed = (bf16*)(C.ws + WS_Z);
    const float* lnw = C.in[I_LNW] + l * 1536; const float* lnb = C.in[I_LNB] + l * 1536; const float* rk = C.in[I_RK] + l * 1536;
    for (int m = blockIdx.x * 8 + wave; m < TT; m += gridDim.x * 8) {
        const int b = m / LT, t = m - b * LT;
#pragma unroll 1
        for (int hg = 0; hg < 6; ++hg) {
            float y[4], g[4], kp[4], r[4], v[4], w_[4], b_[4], k_[4];
#pragma unroll
            for (int q = 0; q < 4; ++q) { const int h = hg * 4 + q, c = h * 64 + lane;
                const float* ra = RA + ((size_t)(b * NHR + h) * LT + t) * 384 + lane;
                y[q] = bf2f(RY[(size_t)m * 1536 + c]); g[q] = bf2f(RG[(size_t)m * 1536 + c]); kp[q] = ra[192]; r[q] = ra[256]; v[q] = ra[320];
                w_[q] = lnw[c]; b_[q] = lnb[c]; k_[q] = rk[c]; }
#pragma unroll
            for (int q = 0; q < 4; ++q) { const int c = (hg * 4 + q) * 64 + lane;
                const float mean = wave_sum(y[q]) * (1.0f / 64.0f);
                const float dy = y[q] - mean;
                const float var = wave_sum(dy * dy) * (1.0f / 64.0f);
                const float yn = dy * rsqrtf(var + 64e-5f) * w_[q] + b_[q];
                const float bonus = wave_sum(r[q] * kp[q] * k_[q]) * v[q];
                const float mv = (yn + bonus) * g[q];
                if (t < NMETA) mixed[(size_t)ROWOF(b, t) * DM + c] = (bf16)f2bf(mv);
                (C.ws + WS_MX8)[(size_t)ROWOF(b, t) * DM + c] = fp8_1(mv * MX8_SCALE); }
        }
    }
}
__device__ __forceinline__ void hgrn_out_unit(int l_, int u_, LAS unsigned char* lds_) {
    LOAD_CTX(); const int l = UNI(l_), u = UNI(u_); LAS unsigned char* lds = UNI_LDS(lds_);
    const int tid = ltid(), lane = tid & 63, wave = UNI(tid >> 6);
    const int bh = u / 65, c = u % 65 + 1, b = bh >> 3, h = bh & 7;
    const bf16* proj = (const bf16*)(C.ws + WS_PROJ);
    const bf16* HDS = (const bf16*)(C.ws + WS_HDS); const bf16* HQG = (const bf16*)(C.ws + WS_HQG); const float* HAT = (const float*)(C.ws + WS_HAT);
    bf16* mixed = (bf16*)(C.ws + WS_Z);
    LAS bf16* Am = (LAS bf16*)lds;
    LAS bf16* Bt = (LAS bf16*)(lds + 25600);
    lfloat* ssum = (lfloat*)(lds + 25600 + 52224);
    const size_t uc = (size_t)bh * NCH + c;
    __syncthreads();
    for (int e = tid; e < 1024; e += 512) { const int t_ = e >> 4, s4 = 4 * (e & 15); const f32x4 a4 = *(const f32x4*)(HAT + uc * 4096 + t_ * 64 + s4);
        u32x2 w; w.x = pk2(a4[0], a4[1]); w.y = pk2(a4[2], a4[3]); *(LAS u32x2*)(Am + t_ * 200 + s4) = w; }
    for (int e = tid; e < 1024; e += 512) { const int t_ = e >> 4, ch = e & 15; *(LAS u32x4*)(Am + t_ * 200 + 64 + 8 * ch) = *(const u32x4*)(HQG + uc * 8192 + t_ * 128 + 8 * ch); }
    for (int e = tid; e < 1024; e += 512) { const int s_ = e >> 4, v8 = 8 * (e & 15), t = 64 * c + s_ - 112;
        u32x4 w = (u32x4){0u, 0u, 0u, 0u}; if (t >= 0 && t < LT) w = *(const u32x4*)(proj + (size_t)ROWOF(b, t) * PN + C_HI + h * 128 + v8);
        LAS bf16* bp_ = Bt + v8 * 204 + s_;
        bp_[0] = (bf16)(w.x & 0xffffu); bp_[204] = (bf16)(w.x >> 16); bp_[408] = (bf16)(w.y & 0xffffu); bp_[612] = (bf16)(w.y >> 16); bp_[816] = (bf16)(w.z & 0xffffu); bp_[1020] = (bf16)(w.z >> 16); bp_[1224] = (bf16)(w.w & 0xffffu); bp_[1428] = (bf16)(w.w >> 16); }
#pragma unroll
    for (int i = 0; i < 4; ++i) { const int e = tid + 512 * i, kx = e >> 4, v8 = 8 * (e & 15); const u32x4 w = *(const u32x4*)(HDS + uc * 16384 + kx * 128 + v8);
        LAS bf16* bp_ = Bt + v8 * 204 + 64 + kx;
        bp_[0] = (bf16)(w.x & 0xffffu); bp_[204] = (bf16)(w.x >> 16); bp_[408] = (bf16)(w.y & 0xffffu); bp_[612] = (bf16)(w.y >> 16); bp_[816] = (bf16)(w.z & 0xffffu); bp_[1020] = (bf16)(w.z >> 16); bp_[1224] = (bf16)(w.w & 0xffffu); bp_[1428] = (bf16)(w.w >> 16); }
    __syncthreads();
    const int fr = lane & 15, g4 = lane >> 4;
    pg8::bf16x8 Bf[6];
#pragma unroll
    for (int ks = 0; ks < 6; ++ks) { const LAS u32x2* bp = (const LAS u32x2*)(Bt + (16 * wave + fr) * 204 + 32 * ks + 8 * g4); const u32x2 lo = bp[0], hi = bp[1];
        const u32x4 w = (u32x4){lo.x, lo.y, hi.x, hi.y}; Bf[ks] = (pg8::bf16x8)w; }
    f32x4 o[4];
#pragma unroll
    for (int mt = 0; mt < 4; ++mt) { f32x4 d = (f32x4){0.f, 0.f, 0.f, 0.f};
#pragma unroll
        for (int ks = 0; ks < 6; ++ks) { const pg8::bf16x8 a = *(const LAS pg8::bf16x8*)(Am + (16 * mt + fr) * 200 + 32 * ks + 8 * g4); d = __builtin_amdgcn_mfma_f32_16x16x32_bf16(a, Bf[ks], d, 0, 0, 0); }
        o[mt] = d; }
#pragma unroll
    for (int mt = 0; mt < 4; ++mt)
#pragma unroll
        for (int r = 0; r < 4; ++r) { const float s = rowsum16(o[mt][r] * o[mt][r]); if (fr == 0) ssum[wave * 64 + 16 * mt + 4 * g4 + r] = s; }
    __syncthreads();
    const float gn = C.in[I_HNORM][l * 1024 + h * 128 + 16 * wave + fr];
#pragma unroll
    for (int mt = 0; mt < 4; ++mt)
#pragma unroll
        for (int r = 0; r < 4; ++r) { const int tl = 16 * mt + 4 * g4 + r, t = 64 * c + tl - 112;
            float ss = 0.f;
#pragma unroll
            for (int w8 = 0; w8 < 8; ++w8) ss += ssum[w8 * 64 + tl];
            if (t >= 0 && t < LT) { const size_t m = (size_t)ROWOF(b, t);
                const float gv = bf2f(proj[m * PN + C_HG + h * 128 + 16 * wave + fr]);
                const float mv = o[mt][r] * rsqrtf(ss * (1.0f / 128.0f) + 1e-5f) * gn * (gv * sigmoidf_(gv));
                if (t < NMETA) mixed[m * DM + 3072 + h * 128 + 16 * wave + fr] = (bf16)f2bf(mv);
                (C.ws + WS_MX8)[m * DM + 3072 + h * 128 + 16 * wave + fr] = fp8_1(mv * MX8_SCALE); } }
}

__device__ __forceinline__ unsigned ordkey(float v) { const unsigned b = __float_as_uint(v); return b ^ ((b >> 31) ? 0xFFFFFFFFu : 0x80000000u); }
__device__ __forceinline__ float unordkey(unsigned k) { const unsigned b = (k >> 31) ? (k ^ 0x80000000u) : ~k; return __uint_as_float(b); }
#define CE_U(a, b) do { const unsigned mx_ = (a) > (b) ? (a) : (b), mn_ = (a) > (b) ? (b) : (a); (a) = mx_; (b) = mn_; } while (0)
__device__ __forceinline__ void sort16_desc(unsigned (&k)[16]) {
#pragma unroll
    for (int size = 2; size <= 16; size <<= 1)
#pragma unroll
        for (int stride = size >> 1; stride > 0; stride >>= 1)
#pragma unroll
            for (int i = 0; i < 16; ++i) { const int j = i ^ stride; if (j > i) { if ((i & size) == 0) CE_U(k[i], k[j]); else CE_U(k[j], k[i]); } }
}
__device__ __forceinline__ void merge16_desc(unsigned (&top)[16], const unsigned (&blk)[16]) {
#pragma unroll
    for (int i = 0; i < 16; ++i) top[i] = top[i] > blk[15 - i] ? top[i] : blk[15 - i];
#pragma unroll
    for (int stride = 8; stride > 0; stride >>= 1)
#pragma unroll
        for (int i = 0; i < 16; ++i) { const int j = i ^ stride; if (j > i) CE_U(top[i], top[j]); }
}
#define CE_P(va, pa, vb, pb) do { const bool sw_ = (vb) > (va); const float tv_ = sw_ ? (vb) : (va), tw_ = sw_ ? (va) : (vb); const unsigned tp_ = sw_ ? (pb) : (pa), tq_ = sw_ ? (pa) : (pb); (va) = tv_; (vb) = tw_; (pa) = tp_; (pb) = tq_; } while (0)
__device__ __forceinline__ void sort16p_desc(float (&v)[16], unsigned (&p)[16]) {
#pragma unroll
    for (int size = 2; size <= 16; size <<= 1)
#pragma unroll
        for (int stride = size >> 1; stride > 0; stride >>= 1)
#pragma unroll
            for (int i = 0; i < 16; ++i) { const int j = i ^ stride; if (j > i) { if ((i & size) == 0) CE_P(v[i], p[i], v[j], p[j]); else CE_P(v[j], p[j], v[i], p[i]); } }
}
__device__ __forceinline__ void merge16p_desc(float (&tv)[16], unsigned (&tp)[16], const float (&bv)[16], const unsigned (&bp)[16]) {
#pragma unroll
    for (int i = 0; i < 16; ++i) { const bool tk = bv[15 - i] > tv[i]; tv[i] = tk ? bv[15 - i] : tv[i]; tp[i] = tk ? bp[15 - i] : tp[i]; }
#pragma unroll
    for (int stride = 8; stride > 0; stride >>= 1)
#pragma unroll
        for (int i = 0; i < 16; ++i) { const int j = i ^ stride; if (j > i) CE_P(tv[i], tp[i], tv[j], tp[j]); }
}
__device__ __forceinline__ void top16_half(const float* sc, int m0, int half, int lane, lfloat* stage, unsigned (&top)[16]) {
    f32x4 ld[4][8];
#pragma unroll
    for (int j = 0; j < 4; ++j)
#pragma unroll
        for (int i = 0; i < 8; ++i) { const int idx = lane + 64 * i, p = idx >> 3, part = idx & 7;
            ld[j][i] = *(const f32x4*)(sc + (size_t)(m0 + (p >> 3)) * 2048 + (p & 7) * 256 + half * 128 + 32 * j + 4 * part); }
#pragma unroll
    for (int j = 0; j < 4; ++j) {
#pragma unroll
        for (int i = 0; i < 8; ++i) { const int idx = lane + 64 * i, p = idx >> 3, part = idx & 7; lfloat* d = stage + p * 33 + 4 * part; d[0] = ld[j][i].x; d[1] = ld[j][i].y; d[2] = ld[j][i].z; d[3] = ld[j][i].w; }
        LDS_WAIT();
#pragma unroll
        for (int hb = 0; hb < 2; ++hb) {
            unsigned blk[16];
#pragma unroll
            for (int i = 0; i < 16; ++i) { const int n = 32 * j + 16 * hb + i; blk[i] = (ordkey(stage[lane * 33 + 16 * hb + i]) & ~127u) | (unsigned)(127 - n); }
            sort16_desc(blk);
            if (j == 0 && hb == 0) {
#pragma unroll
                for (int i = 0; i < 16; ++i) top[i] = blk[i];
            } else merge16_desc(top, blk);
        }
        LDS_WAIT();
    }
}
__device__ __forceinline__ void route_task(const Ctx& C, int wt, int lane, LAS unsigned char* wl) {
    const float* sc = (const float*)(C.ws + WS_SC);
    bf16* GG = (bf16*)(C.ws + WS_GG); unsigned* BMp = (unsigned*)(C.ws + WS_BM);
    lfloat* stage = (lfloat*)wl;
    LAS u32x2* ent = (LAS u32x2*)(wl + 8704);
    const int m0 = 8 * wt, tk = lane >> 3, h = lane & 7;
    unsigned s1[16], s2[16];
    top16_half(sc, m0, 0, lane, stage, s1);
    top16_half(sc, m0, 1, lane, stage, s2);
    LAS unsigned short* cid = (LAS unsigned short*)stage + lane * 66;
    unsigned top[16];
#define CAND(dst, slot, num, a, b) do { const float cv_ = unordkey(s1[a] & ~127u) + unordkey(s2[b] & ~127u); dst[slot] = (ordkey(cv_) & ~63u) | (unsigned)(63 - (num)); \
        cid[num] = (unsigned short)(((127u - (s1[a] & 127u)) << 7) | (127u - (s2[b] & 127u))); } while (0)
    {
#pragma unroll
        for (int b2 = 0; b2 < 16; ++b2) CAND(top, b2, b2, 0, b2);
        sort16_desc(top);
    }
    {
        unsigned blk[16];
#pragma unroll
        for (int b2 = 0; b2 < 8; ++b2) CAND(blk, b2, 16 + b2, 1, b2);
#pragma unroll
        for (int b2 = 0; b2 < 5; ++b2) CAND(blk, 8 + b2, 24 + b2, 2, b2);
        blk[13] = 0u; blk[14] = 0u; blk[15] = 0u;
        sort16_desc(blk); merge16_desc(top, blk);
    }
    {
        unsigned blk[16];
#pragma unroll
        for (int b2 = 0; b2 < 4; ++b2) CAND(blk, b2, 29 + b2, 3, b2);
#pragma unroll
        for (int b2 = 0; b2 < 3; ++b2) CAND(blk, 4 + b2, 33 + b2, 4, b2);
#pragma unroll
        for (int b2 = 0; b2 < 2; ++b2) { CAND(blk, 7 + b2, 36 + b2, 5, b2); CAND(blk, 9 + b2, 38 + b2, 6, b2); }
        blk[11] = 0u; blk[12] = 0u; blk[13] = 0u; blk[14] = 0u; blk[15] = 0u;
        sort16_desc(blk); merge16_desc(top, blk);
    }
    {
        unsigned blk[16];
        CAND(blk, 0, 40, 7, 0); CAND(blk, 1, 41, 7, 1);
#pragma unroll
        for (int a2 = 8; a2 < 16; ++a2) CAND(blk, a2 - 6, 34 + a2, a2, 0);
        blk[10] = 0u; blk[11] = 0u; blk[12] = 0u; blk[13] = 0u; blk[14] = 0u; blk[15] = 0u;
        sort16_desc(blk); merge16_desc(top, blk);
    }
#undef CAND
    LDS_WAIT();
    {
        const float v0 = unordkey(top[0] & ~63u);
        float e[16]; float sum = 0.f;
#pragma unroll
        for (int i = 0; i < 16; ++i) { e[i] = __expf(unordkey(top[i] & ~63u) - v0); sum += e[i]; }
        const float inv = 1.0f / sum;
#pragma unroll
        for (int i = 0; i < 16; ++i) { const unsigned id = cid[63u - (top[i] & 63u)]; ent[tk * 128 + h * 16 + i] = (u32x2){id, __float_as_uint(e[i] * inv)}; }
    }
    LDS_WAIT();
#pragma unroll 1
    for (int t8 = 0; t8 < 8; ++t8) {
        const LAS u32x2* en = ent + t8 * 128; const size_t m = (size_t)(m0 + t8);
        const int my0 = (int)en[lane].x, my1 = (int)en[lane + 64].x;
        float g0 = 0.f, g1 = 0.f; bool f0 = true, f1 = true;
#pragma unroll 8
        for (int i = 0; i < 128; ++i) { const u32x2 x = en[i]; const int id = (int)x.x; const float gv = __uint_as_float(x.y);
            if (id == my0) { g0 += gv; if (i < lane) f0 = false; }
            if (id == my1) { g1 += gv; if (i < lane + 64) f1 = false; } }
        *(u32x4*)(GG + m * NE + (my0 & ~7)) = (u32x4){0u, 0u, 0u, 0u}; *(u32x4*)(GG + m * NE + (my1 & ~7)) = (u32x4){0u, 0u, 0u, 0u};
        atomicOr(BMp + m * 64 + (my0 >> 8), 1u << ((my0 >> 3) & 31)); atomicOr(BMp + m * 64 + (my1 >> 8), 1u << ((my1 >> 3) & 31));
        asm volatile("s_waitcnt vmcnt(0)" ::: "memory");
        if (f0) GG[m * NE + my0] = (bf16)f2bf(g0);
        if (f1) GG[m * NE + my1] = (bf16)f2bf(g1);
    }
    LDS_WAIT();
}
__device__ __forceinline__ int mbcnt64(unsigned long long m) { return __builtin_amdgcn_mbcnt_hi((unsigned)(m >> 32), __builtin_amdgcn_mbcnt_lo((unsigned)m, 0u)); }
__device__ __forceinline__ void top16_of_128(float v0, float v1, int lane, lfloat* selv, LAS int* seli) {
    const unsigned k0 = (ordkey(v0) & ~127u) | (unsigned)(127 - lane), k1 = (ordkey(v1) & ~127u) | (unsigned)(63 - lane);
    unsigned thr = 0u;
    for (int bit = 31; bit >= 0; --bit) { const unsigned cand = thr | (1u << bit);
        const int cnt = __popcll(__ballot(k0 >= cand)) + __popcll(__ballot(k1 >= cand));
        if (cnt >= 16) { thr = cand; if (cnt == 16) break; } }
    const unsigned long long m0 = __ballot(k0 >= thr), m1 = __ballot(k1 >= thr);
    if (k0 >= thr) { const int s = mbcnt64(m0); if (s < 16) { selv[s] = v0; seli[s] = lane; } }
    if (k1 >= thr) { const int s = __popcll(m0) + mbcnt64(m1); if (s < 16) { selv[s] = v1; seli[s] = lane + 64; } }
}
__device__ __forceinline__ void route_token_bisect(const Ctx& C, int m, int lane, LAS unsigned char* wl) {
    const float* sc = (const float*)(C.ws + WS_SC) + (size_t)m * 2048;
    bf16* GG = (bf16*)(C.ws + WS_GG);
    lfloat* s1v = (lfloat*)wl; LAS int* s1i = (LAS int*)(wl + 64); lfloat* s2v = (lfloat*)(wl + 128); LAS int* s2i = (LAS int*)(wl + 192);
    lfloat* bv = (lfloat*)(wl + 256); LAS int* bi = (LAS int*)(wl + 320);
    LAS u32x2* ent = (LAS u32x2*)(wl + 384);
    float sv[8][4];
#pragma unroll
    for (int h = 0; h < 8; ++h) { sv[h][0] = sc[h * 256 + lane]; sv[h][1] = sc[h * 256 + 64 + lane]; sv[h][2] = sc[h * 256 + 128 + lane]; sv[h][3] = sc[h * 256 + 192 + lane]; }
#pragma unroll
    for (int h = 0; h < 8; ++h) {
        const float a0 = sv[h][0], a1 = sv[h][1], b0 = sv[h][2], b1 = sv[h][3];
        top16_of_128(a0, a1, lane, s1v, s1i);
        top16_of_128(b0, b1, lane, s2v, s2i);
        LDS_WAIT();
        const float sa = s1v[lane >> 2]; const f32x4 sb = *(const lf32x4*)(s2v + 4 * (lane & 3));
        const float cv[4] = {sa + sb.x, sa + sb.y, sa + sb.z, sa + sb.w};
        unsigned ck[4];
#pragma unroll
        for (int jj = 0; jj < 4; ++jj) ck[jj] = (ordkey(cv[jj]) & ~255u) | (unsigned)(255 - (4 * lane + jj));
        unsigned thr = 0u;
        for (int bit = 31; bit >= 0; --bit) { const unsigned cand = thr | (1u << bit);
            const int cnt = __popcll(__ballot(ck[0] >= cand)) + __popcll(__ballot(ck[1] >= cand)) + __popcll(__ballot(ck[2] >= cand)) + __popcll(__ballot(ck[3] >= cand));
            if (cnt >= 16) { thr = cand; if (cnt == 16) break; } }
        int base = 0;
        const int ia = s1i[lane >> 2];
#pragma unroll
        for (int jj = 0; jj < 4; ++jj) { const unsigned long long mk = __ballot(ck[jj] >= thr);
            if (ck[jj] >= thr) { const int s = base + mbcnt64(mk); if (s < 16) { bv[s] = cv[jj]; bi[s] = ia * 128 + s2i[4 * (lane & 3) + jj]; } }
            base += __popcll(mk); }
        LDS_WAIT();
        float mx = -3.0e38f;
#pragma unroll
        for (int i = 0; i < 16; ++i) mx = fmaxf(mx, bv[i]);
        float sum = 0.f;
#pragma unroll
        for (int i = 0; i < 16; ++i) sum += __expf(bv[i] - mx);
        if (lane < 16) ent[h * 16 + lane] = (u32x2){(unsigned)bi[lane], __float_as_uint(__expf(bv[lane] - mx) / sum)};
        LDS_WAIT();
    }
    u32x2* me = (u32x2*)(C.ws + WS_ME) + (size_t)(m - MAIN_ROWS) * 128;
    me[lane] = ent[lane]; me[lane + 64] = ent[lane + 64];
    LDS_WAIT();
}

__device__ __forceinline__ void route_all(int l_, LAS unsigned char* lds_) {
    LOAD_CTX(); const int l = UNI(l_); LAS unsigned char* lds = UNI_LDS(lds_);
    const int tid = ltid(), lane = tid & 63, wave = UNI(tid >> 6);
    __syncthreads();
    for (int wt = blockIdx.x * 8 + wave; wt < MAIN_ROWS / 8; wt += gridDim.x * 8) route_task(C, wt, lane, lds + wave * 17408);
    if (l == 0) for (int m = MAIN_ROWS + blockIdx.x * 8 + wave; m < TT; m += gridDim.x * 8) route_token_bisect(C, m, lane, lds + wave * 17408);
}
__device__ __forceinline__ void norm2_zero_all(int l_) {
    LOAD_CTX(); const int l = UNI(l_);
    const int tid = ltid(), lane = tid & 63, wave = UNI((int)(tid >> 6)), G = gridDim.x;
    unsigned char* ws = C.ws; bf16* Z = (bf16*)(ws + WS_Z); float* H = (float*)(ws + WS_H);
    unsigned char* HN8 = ws + WS_HN8;
    const int nrows = (l == 1) ? MAIN_ROWS : TT;
    {   f32x4 gn[16]; { const f32x4* gr = (const f32x4*)(C.in[I_NFFN] + l * DM) + lane;
#pragma unroll
            for (int j = 0; j < 16; ++j) gn[j] = gr[64 * j]; }
        rows_pipe(blockIdx.x * 8 + wave, G * 8, nrows, lane, [&](int m) -> const float* { return H + (size_t)m * DM; },
            [&](const f32x4 (&v)[16], int m) { norm_row_fin(v, gn, Z + (size_t)m * DM, nullptr, lane, HN8 + (size_t)m * DM); }); }
    for (int e = blockIdx.x * 512 + tid; e < (MP - TT) * DM / 16; e += G * 512) ((u32x4*)(HN8 + (size_t)TT * DM))[e] = (u32x4){0u, 0u, 0u, 0u};
    u32x4* gz = (u32x4*)(ws + WS_BM);
    const size_t n16 = (size_t)MAIN_ROWS * 64 * 4 / 16;
    for (size_t e = (size_t)blockIdx.x * 512 + tid; e < n16; e += (size_t)G * 512) gz[e] = (u32x4){0u, 0u, 0u, 0u};
}
__device__ __forceinline__ void final_norm_all() {
    LOAD_CTX();
    const int tid = ltid(), lane = tid & 63, wave = UNI((int)(tid >> 6)), G = gridDim.x;
    const float* H = (const float*)(C.ws + WS_H);
    f32x4 gn[16]; { const f32x4* gr = (const f32x4*)C.in[I_NFIN] + lane;
#pragma unroll
        for (int j = 0; j < 16; ++j) gn[j] = gr[64 * j]; }
    rows_pipe(blockIdx.x * 8 + wave, G * 8, NB * 4096, lane, [&](int m) -> const float* { return H + (size_t)m * DM; },
        [&](const f32x4 (&v)[16], int m) {
            float ss = 0.f;
#pragma unroll
            for (int j = 0; j < 16; ++j) ss += (v[j].x * v[j].x + v[j].y * v[j].y) + (v[j].z * v[j].z + v[j].w * v[j].w);
            ss = wave_sum(ss);
            const float rn = rsqrtf(ss * (1.0f / 4096.0f) + 1e-5f);
            f32x4* o = (f32x4*)(C.out + (size_t)m * DM) + lane;
#pragma unroll
            for (int j = 0; j < 16; ++j) o[64 * j] = v[j] * rn * gn[j]; });
}
constexpr int NPL = 11;
constexpr int HG_OUT_EARLY = 2080;
constexpr int NPH = 2 * NPL + 1;
template <int MODE> __device__ __forceinline__ void meta_gemm(const bf16* A, const bf16* Bt, int N, float* O, int ldo, LAS unsigned char* lds_) {
    LAS unsigned char* lds = UNI_LDS(lds_);
    const int tid = ltid(), lane = tid & 63, wave = UNI(tid >> 6), fr = lane & 15, g4 = lane >> 4;
    lfloat* part = (lfloat*)lds;
    for (int nt = blockIdx.x; nt < N / 16; nt += gridDim.x) {
        __syncthreads();
        f32x4 d = (f32x4){0.f, 0.f, 0.f, 0.f};
        const bf16* ap = A + (size_t)fr * DM + 512 * wave + 8 * g4; const bf16* bp = Bt + (size_t)(16 * nt + fr) * DM + 512 * wave + 8 * g4;
#pragma unroll
        for (int ks = 0; ks < 16; ++ks) d = __builtin_amdgcn_mfma_f32_16x16x32_bf16(*(const pg8::bf16x8*)(ap + 32 * ks), *(const pg8::bf16x8*)(bp + 32 * ks), d, 0, 0, 0);
#pragma unroll
        for (int r = 0; r < 4; ++r) part[wave * 256 + (4 * g4 + r) * 16 + fr] = d[r];
        __syncthreads();
        if (tid < 256) { const int t = tid >> 4, n = tid & 15; float s = 0.f;
#pragma unroll
            for (int w8 = 0; w8 < 8; ++w8) s += part[w8 * 256 + tid];
#pragma unroll
            for (int bb = 0; bb < 4; ++bb) { float* o = O + (size_t)(MAIN_ROWS + 16 * bb + t) * ldo + 16 * nt + n; if (MODE == 0) *o += s; else *o = s; } }
    }
}
__device__ __forceinline__ void meta_u_all(int l_) {
    LOAD_CTX(); const int l = UNI(l_);
    const int tid = ltid(), lane = tid & 63, wave = UNI(tid >> 6);
    const bf16* Z = (const bf16*)(C.ws + WS_Z); const float* pu = C.in[I_PU] + (size_t)l * NE * DM;
    const u32x2* me = (const u32x2*)(C.ws + WS_ME); float* HM = (float*)(C.ws + WS_HM);
    for (int task = blockIdx.x * 8 + wave; task < 16 * 128; task += gridDim.x * 8) {
        const int t = task >> 7, e = task & 127; const u32x2 en = me[t * 128 + e];
        const float* ur = pu + (size_t)en.x * DM + 4 * lane; const bf16* hr = Z + (size_t)(MAIN_ROWS + t) * DM + 4 * lane;
        float acc = 0.f;
#pragma unroll 8
        for (int i = 0; i < 16; ++i) { const f32x4 uu = *(const f32x4*)(ur + 256 * i); const u32x2 hh = *(const u32x2*)(hr + 256 * i);
            acc += uu.x * bf2f(hh.x & 0xffffu) + uu.y * bf2f(hh.x >> 16) + uu.z * bf2f(hh.y & 0xffffu) + uu.w * bf2f(hh.y >> 16); }
        acc = wave_sum(acc);
        if (lane == 0) HM[t * 128 + e] = __uint_as_float(en.y) * 0.5f * acc * (1.0f + erff(acc * 0.70710678118654752f));
    }
}
__device__ __forceinline__ void meta_v_all(int l_) {
    LOAD_CTX(); const int l = UNI(l_);
    const int tid = ltid(), lane = tid & 63, wave = UNI(tid >> 6);
    const float* pv = C.in[I_PV] + (size_t)l * NE * DM; float* H = (float*)(C.ws + WS_H);
    const u32x2* me = (const u32x2*)(C.ws + WS_ME); const float* HM = (const float*)(C.ws + WS_HM);
    for (int task = blockIdx.x * 8 + wave; task < 16 * 16; task += gridDim.x * 8) {
        const int t = task >> 4, n = 256 * (task & 15) + 4 * lane;
        f32x4 acc = (f32x4){0.f, 0.f, 0.f, 0.f};
#pragma unroll 8
        for (int e = 0; e < 128; ++e) { const unsigned id = me[t * 128 + e].x; const float hv = HM[t * 128 + e]; acc += *(const f32x4*)(pv + (size_t)id * DM + n) * hv; }
#pragma unroll
        for (int bb = 0; bb < 4; ++bb) { f32x4* o = (f32x4*)(H + (size_t)(MAIN_ROWS + 16 * bb + t) * DM + n); *o = *o + acc; }
    }
}

#if MK_ONE_LAUNCH
#define GRID_BAR() xcd_barrier(bar)
#else
#define GRID_BAR() do {} while (0)
#endif
#define IN(k) (lo <= (k) && (k) < hi)
#define SEAM(k) do { if (IN((k) + 1)) GRID_BAR(); } while (0)
#ifndef DUP_MASK
#define DUP_MASK 0u
#endif
#define REPS(k) ((((unsigned)DUP_MASK >> (k)) & 1u) ? 2 : 1)
template <int l> __device__ __forceinline__ void layer_phases(const int lo, const int hi, const int G, LAS unsigned char* lds, const XcdBarrier& bar) {
        const int p0 = l * NPL;
        if (IN(p0 + 0)) for (int rep = 0; rep < REPS(0); ++rep) { phase_conv_norm(l, lds); SEAM(p0 + 0); }
        if (IN(p0 + 1)) for (int rep = 0; rep < REPS(1); ++rep) {
            const Ctx Cq = load_ctx(); unsigned char* ws = Cq.ws; bf16* Z = (bf16*)(ws + WS_Z); float* H = (float*)(ws + WS_H); (void)Z; (void)H;
            pg8::Gemm g{(const pg8::bf16_t*)Z, (const pg8::bf16_t*)(ws + WS_WIN), MP, PN, DM}; pg8::StaticOrder S; S.init(MP, PN, G, (int)blockIdx.x);
            pg8::EpiBf16<0> E{(pg8::bf16_t*)(ws + WS_PROJ), PN, nullptr, 0, 0};
            pg8::gemm_phase<pg8::EpiBf16<0>, pg8::StaticOrder, false>(lds, g, S, E, nullptr);
            SEAM(p0 + 1);
        }
        if (IN(p0 + 2)) for (int rep = 0; rep < REPS(2); ++rep) {
            for (int u = blockIdx.x; u < 1028; u += G) rwkv_prep_unit(l, u, lds);
            if (G == 256 && rep == 0) {
                unsigned* qc = (unsigned*)(load_ctx().ws + WS_CTL) + CW_HL + 64 * l;
                volatile LAS unsigned* slot = (volatile LAS unsigned*)(lds + LDS_MISC) + 16;
                unsigned nxt = 0u;
                if (threadIdx.x == 0) nxt = __hip_atomic_fetch_add(qc, 1u, __ATOMIC_RELAXED, __HIP_MEMORY_SCOPE_AGENT);
                for (;;) {
                    if (threadIdx.x == 0) *slot = nxt;
                    __syncthreads();
                    const int u = __builtin_amdgcn_readfirstlane((int)*slot);
                    __syncthreads();
                    if (u >= 2080) break;
                    if (threadIdx.x == 0) nxt = __hip_atomic_fetch_add(qc, 1u, __ATOMIC_RELAXED, __HIP_MEMORY_SCOPE_AGENT);
                    hgrn_local_unit(l, u, lds);
                }
            } else
            for (int u = (blockIdx.x + G - 16) % G; u < 2080; u += G) hgrn_local_unit(l, u, lds);
            SEAM(p0 + 2);
        }
        if (IN(p0 + 3)) for (int rep = 0; rep < REPS(3); ++rep) {
            if (G == 256 && rep == 0) {
                const int r = blockIdx.x, q = r - 48;
                unsigned* ctlw = (unsigned*)(load_ctx().ws + WS_CTL);
                unsigned* hgc = ctlw + CW_HG; unsigned* qc = ctlw + CW_M2 + 64 * l;
                if (r < 48) rwkv_scan_unit(r, lds);
                else if (q < 64) {
                    hgrn_scan_slice(q);
                    asm volatile("s_waitcnt vmcnt(0)" ::: "memory"); __syncthreads();
                    if (threadIdx.x == 0) { __builtin_amdgcn_fence(__ATOMIC_RELEASE, "agent"); asm volatile("s_waitcnt vmcnt(0)" ::: "memory");
                        __hip_atomic_fetch_add(hgc, 1u, __ATOMIC_RELAXED, __HIP_MEMORY_SCOPE_AGENT); }
                }
                volatile LAS unsigned* slot = (volatile LAS unsigned*)(lds + LDS_MISC) + 16;
                unsigned nxt = 0u; bool waited = false;
                if (threadIdx.x == 0) nxt = __hip_atomic_fetch_add(qc, 1u, __ATOMIC_RELAXED, __HIP_MEMORY_SCOPE_AGENT);
                for (;;) {
                    __syncthreads();
                    if (threadIdx.x == 0) *slot = nxt;
                    __syncthreads();
                    const int t = __builtin_amdgcn_readfirstlane((int)*slot);
                    constexpr int Nc = 1548 + 2080, Nv = conv_tickets(l), Ni = 2 * (Nc < Nv ? Nc : Nv);
                    if (t >= Nc + Nv) break;
                    int ct = -1, vt = -1;
                    if (t < Ni) { if (t & 1) vt = t >> 1; else ct = t >> 1; } else { const int rest = t - Ni / 2; if (Nc > Nv) ct = rest; else vt = rest; }
                    if (threadIdx.x == 0) nxt = __hip_atomic_fetch_add(qc, 1u, __ATOMIC_RELAXED, __HIP_MEMORY_SCOPE_AGENT);
                    if (vt >= 0) conv_ticket(l, vt, lds);
                    else if (ct < 1548) swa_unit(l, ct, lds);
                    else {
                        if (!waited) {
                            if (threadIdx.x == 0) { unsigned sp = 0; const unsigned want = 64u * (unsigned)(l + 1);
                                while (__hip_atomic_load(hgc, __ATOMIC_RELAXED, __HIP_MEMORY_SCOPE_AGENT) < want) { __builtin_amdgcn_s_sleep(2); if (++sp > (1u << 22)) break; }
                                __builtin_amdgcn_fence(__ATOMIC_ACQUIRE, "agent"); asm volatile("s_waitcnt vmcnt(0)" ::: "memory"); }
                            __syncthreads();
                            waited = true;
                        }
                        hgrn_out_unit(l, ct - 1548, lds);
                    }
                }
            } else
            for (int r = blockIdx.x; r < 256; r += G) {
                if (r < 48) { rwkv_scan_unit(r, lds); continue; }
                const int q = r - 48;
                const bool split = (G == 256);
                unsigned* hgc = (unsigned*)(load_ctx().ws + WS_CTL) + CW_HG;
                if (q < 64 && rep == 0) {
                    hgrn_scan_slice(q);
                    if (split) {
                        asm volatile("s_waitcnt vmcnt(0)" ::: "memory"); __syncthreads();
                        if (threadIdx.x == 0) { __builtin_amdgcn_fence(__ATOMIC_RELEASE, "agent"); asm volatile("s_waitcnt vmcnt(0)" ::: "memory");
                            __hip_atomic_fetch_add(hgc, 1u, __ATOMIC_RELAXED, __HIP_MEMORY_SCOPE_AGENT); }
                    }
                }
                for (int u = q; u < 1548; u += 208) swa_unit(l, u, lds);
                if (split) {
                    if (threadIdx.x == 0) { unsigned sp = 0; const unsigned want = 64u * (unsigned)(l + 1);
                        while (__hip_atomic_load(hgc, __ATOMIC_RELAXED, __HIP_MEMORY_SCOPE_AGENT) < want) { __builtin_amdgcn_s_sleep(2); if (++sp > (1u << 22)) break; }
                        __builtin_amdgcn_fence(__ATOMIC_ACQUIRE, "agent"); asm volatile("s_waitcnt vmcnt(0)" ::: "memory"); }
                    __syncthreads();
                    for (int u = q; u < HG_OUT_EARLY; u += 208) hgrn_out_unit(l, u, lds);
                }
            }
            SEAM(p0 + 3);
        }
        if (IN(p0 + 4)) for (int rep = 0; rep < REPS(4); ++rep) {
            for (int u = ((G == 256) ? HG_OUT_EARLY : 0) + blockIdx.x; u < 2080; u += G) hgrn_out_unit(l, u, lds);
            rwkv_post_all(l);
            SEAM(p0 + 4);
        }
        if (IN(p0 + 5)) for (int rep = 0; rep < REPS(5); ++rep) {
            const Ctx Cq = load_ctx(); unsigned char* ws = Cq.ws; bf16* Z = (bf16*)(ws + WS_Z); float* H = (float*)(ws + WS_H); (void)Z; (void)H;
            constexpr int MR = MAIN_ROWS; pg8::Gemm8 g{ws + WS_MX8, ws + WS_WO8, MR, DM, DM, WO8_E8M0}; pg8::StaticOrder S; S.init(MR, DM, G, (int)blockIdx.x);
            pg8::EpiResF32 E{H, DM, (l == 0) ? Cq.in[I_X] : (const float*)H};
            pg8::gemm_phase8<pg8::EpiResF32, pg8::StaticOrder, false>(lds, g, S, E, nullptr);
            if (l == 0) meta_gemm<0>((const bf16*)Z + (size_t)MAIN_ROWS * DM, (const bf16*)(ws + WS_WO), DM, H, DM, lds);
            SEAM(p0 + 5);
        }
        if (IN(p0 + 6)) for (int rep = 0; rep < REPS(6); ++rep) { norm2_zero_all(l); SEAM(p0 + 6); }
        if (IN(p0 + 7)) for (int rep = 0; rep < REPS(7); ++rep) {
            const Ctx Cq = load_ctx(); unsigned char* ws = Cq.ws; bf16* Z = (bf16*)(ws + WS_Z); float* H = (float*)(ws + WS_H); (void)Z; (void)H;
            constexpr int MR = MAIN_ROWS; pg8::Gemm g{(const pg8::bf16_t*)Z, (const pg8::bf16_t*)(ws + WS_WS), MR, 2048, DM}; pg8::StaticOrder S; S.init(MR, 2048, G, (int)blockIdx.x);
            pg8::EpiF32 E{(float*)(ws + WS_SC), 2048, nullptr};
            pg8::gemm_phase<pg8::EpiF32, pg8::StaticOrder, false>(lds, g, S, E, nullptr);
            if (l == 0) meta_gemm<1>((const bf16*)Z + (size_t)MAIN_ROWS * DM, (const bf16*)(ws + WS_WS), 2048, (float*)(ws + WS_SC), 2048, lds);
            SEAM(p0 + 7);
        }
        if (IN(p0 + 8)) for (int rep = 0; rep < REPS(8); ++rep) { route_all(l, lds); SEAM(p0 + 8); }
        if (IN(p0 + 9)) for (int rep = 0; rep < REPS(9); ++rep) {
            const Ctx Cq = load_ctx(); unsigned char* ws = Cq.ws; bf16* Z = (bf16*)(ws + WS_Z); float* H = (float*)(ws + WS_H); (void)Z; (void)H;
            constexpr int MR = MAIN_ROWS; pg8::Gemm8 g{ws + WS_HN8, ws + ((l == 1 && G == 256) ? WS_U1 : WS_U), MR, NE, DM, U8_E8M0}; pg8::StaticOrder S; S.init(MR, NE, G, (int)blockIdx.x);
            pg8::EpiGate8 E{ws};
            pg8::gemm_phase8<pg8::EpiGate8, pg8::StaticOrder, false>(lds, g, S, E, nullptr);
            if (l == 0) meta_u_all(l);
            SEAM(p0 + 9);
        }
        if (IN(p0 + 10)) for (int rep = 0; rep < REPS(10); ++rep) {
            const Ctx Cq = load_ctx(); unsigned char* ws = Cq.ws; bf16* Z = (bf16*)(ws + WS_Z); float* H = (float*)(ws + WS_H); (void)Z; (void)H;
            constexpr int MR = MAIN_ROWS; pg8::Gemm8 g{ws + WS_HG8, ws + WS_VT, MR, DM, NE, V8_E8M0}; pg8::StaticOrder S; S.init(MR, DM, G, (int)blockIdx.x);
            pg8::EpiResF32 E{H, DM, (const float*)H};
            pg8::gemm_phase8<pg8::EpiResF32, pg8::StaticOrder, false>(lds, g, S, E, nullptr);
            if (l == 0) meta_v_all(l);
            SEAM(p0 + 10);
        }
}
__global__ void __launch_bounds__(512, 2) hybrid_fwd(Ctx C) {
    extern __shared__ __attribute__((aligned(16))) unsigned char lds_raw[];
    LAS unsigned char* lds = (LAS unsigned char*)lds_raw;
    const int tid = threadIdx.x, lane = tid & 63, wave = __builtin_amdgcn_readfirstlane(tid >> 6);
    const int G = gridDim.x;
    unsigned* ctl = (unsigned*)(C.ws + WS_CTL);
    volatile LAS unsigned* MISC = (volatile LAS unsigned*)(lds + LDS_MISC);
    if (tid < 64) MISC[tid] = 0u;
    __syncthreads();
#if MK_ONE_LAUNCH
    XcdBarrier bar = xcd_barrier_post(ctl + CW_BAR, MISC + 8);
#else
    XcdBarrier bar; bar.bar = ctl; bar.x = 0u; bar.st = MISC + 8;
#endif
    const int lo = C.ph_lo, hi = C.ph_hi;
    layer_phases<0>(lo, hi, G, lds, bar);
    layer_phases<1>(lo, hi, G, lds, bar);
    if (IN(2 * NPL)) final_norm_all();
}

extern "C" void kernel_launch(void* const* d_in, const int* in_sizes, int n_in, void* d_out, int out_size, void* d_ws, size_t ws_size, hipStream_t stream) {
    static int grid = 0;
    if (grid == 0) {
        if (n_in != 25 || ws_size < WS_END2) { fprintf(stderr, "kernel_launch: need 25 inputs and %zu bytes of workspace (got %d, %zu)\n", (size_t)WS_END2, n_in, ws_size); grid = -1; return; }
        int dev = 0, cus = 0, per_cu = 0;
        if (hipGetDevice(&dev) != hipSuccess || hipDeviceGetAttribute(&cus, hipDeviceAttributeMultiprocessorCount, dev) != hipSuccess) { grid = -1; return; }
        if (hipFuncSetAttribute((const void*)hybrid_fwd, hipFuncAttributeMaxDynamicSharedMemorySize, LDS_BYTES) != hipSuccess) { fprintf(stderr, "kernel_launch: hipFuncSetAttribute failed\n"); grid = -1; return; }
        if (hipOccupancyMaxActiveBlocksPerMultiprocessor(&per_cu, (const void*)hybrid_fwd, 512, LDS_BYTES) != hipSuccess || per_cu < 1) { fprintf(stderr, "kernel_launch: occupancy query says %d blocks per CU\n", per_cu); }
        (void)hipGetLastError();
        grid = cus;
    }
    if (grid < 0) return;
    (void)hipMemsetAsync((char*)d_ws + WS_CTL, 0, CTL_ZERO_BYTES, stream);
    Ctx c{};
    for (int i = 0; i < 25; ++i) c.in[i] = (const float*)d_in[i];
    c.out = (float*)d_out; c.ws = (unsigned char*)d_ws;
#if MK_ONE_LAUNCH
    c.ph_lo = 0; c.ph_hi = NPH;
    hipLaunchKernelGGL(hybrid_fwd, dim3(grid), dim3(512), LDS_BYTES, stream, c);
#else
    for (int p = 0; p < NPH; ++p) { c.ph_lo = p; c.ph_hi = p + 1; hipLaunchKernelGGL(hybrid_fwd, dim3(grid), dim3(512), LDS_BYTES, stream, c); }
#endif
}
```
